# Optimizing an MI355X kernel written in HIP

```python
import math
import jax, jax.numpy as jnp
from jax import lax
import numpy as np

D_MODEL = 1024
BATCH = 4
SEQ = 4096
DEPTH = 1

NSA_HEADS = 8
NSA_KV_GROUPS = 2
NSA_HPG = NSA_HEADS // NSA_KV_GROUPS
NSA_HEAD_DIM = 64
CMP_BLOCK = 32
CMP_STRIDE = 16
CMP_HIDDEN = 256
SLC_BLOCK = 64
SLC_TOPN = 16
WINDOW = 512
Q_BLOCK = 64
FORCE_BONUS = 1e4
GLA_HEADS = 4
GLA_DK = 64
GLA_DV = 128
GLA_GATE_RANK = 16
GLA_TAU = 16.0
GLA_CHUNK = 64
N_EXPERTS = 256
TOP_K = 8
N_EXPERT_GROUPS = 8
TOPK_GROUPS = 4
EXPERT_HIDDEN = 256
SHARED_HIDDEN = 256
ROUTE_SCALE = 2.5
MOE_BLOCK = 128
MIX_WIDTH = NSA_HEADS * NSA_HEAD_DIM + GLA_HEADS * GLA_DV
LN_EPS = 1e-5
NEG = -1e30
SPLIT_SIZES = (NSA_HEADS * NSA_HEAD_DIM,
               NSA_KV_GROUPS * NSA_HEAD_DIM,
               NSA_KV_GROUPS * NSA_HEAD_DIM,
               NSA_KV_GROUPS * NSA_HEAD_DIM,
               NSA_KV_GROUPS * NSA_HEAD_DIM,
               NSA_KV_GROUPS * NSA_HEAD_DIM,
               NSA_KV_GROUPS * NSA_HEAD_DIM,
               NSA_HEADS * 3,
               GLA_HEADS * GLA_DK,
               GLA_HEADS * GLA_DK,
               GLA_HEADS * GLA_DV,
               GLA_GATE_RANK,
               GLA_HEADS * GLA_DV)
IN_COLS = sum(SPLIT_SIZES)

kernel_name = 'hybrid_nsa_gla_moe_deepnorm'


def _normalize(x):
    xf = x.astype(jnp.float32)
    mu = jnp.mean(xf, -1, keepdims=True)
    var = jnp.mean(jnp.square(xf - mu), -1, keepdims=True)
    return ((xf - mu) * lax.rsqrt(var + LN_EPS)).astype(x.dtype)


def _layer_norm(x, g, b):
    return _normalize(x) * g + b


def _alibi_slopes(n):
    return jnp.asarray(np.power(2.0, -8.0 * np.arange(1, n + 1) / n).astype(np.float32))


def _masked_softmax(s, mask):
    s = jnp.where(mask, s, NEG)
    m = jnp.max(s, -1, keepdims=True)
    e = jnp.where(mask, jnp.exp(s - m), 0.0)
    return e / jnp.maximum(jnp.sum(e, -1, keepdims=True), 1e-30)


def _compress(k, pos, w1, w2):
    B, T, G, dh = k.shape
    r = CMP_BLOCK // CMP_STRIDE
    n_sub = T // CMP_STRIDE
    sub = k.reshape(B, n_sub, CMP_STRIDE, G, dh)
    blocks = jnp.concatenate([sub[:, i:n_sub - r + 1 + i] for i in range(r)], axis=2)
    blocks = blocks + pos[None, None, :, None, :]
    n_cmp = blocks.shape[1]
    flat = blocks.transpose(0, 1, 3, 2, 4).reshape(B, n_cmp, G, CMP_BLOCK * dh)
    return jax.nn.silu(flat @ w1) @ w2


def _nsa(q, k_cmp, v_cmp, k_slc, v_slc, k_win, v_win, gate_logits,
         cmp_pos_k, cmp_w1_k, cmp_w2_k, cmp_pos_v, cmp_w1_v, cmp_w2_v):
    B, T = q.shape[:2]
    G, P, dh = NSA_KV_GROUPS, NSA_HPG, NSA_HEAD_DIM
    dt = q.dtype
    q = (q * dh ** -0.5).reshape(B, T, G, P, dh)
    gates = jax.nn.sigmoid(gate_logits.astype(jnp.float32)).astype(dt).reshape(B, T, G, P, 3)
    slopes = _alibi_slopes(NSA_HEADS).reshape(G, P)

    kc = _compress(k_cmp, cmp_pos_k, cmp_w1_k, cmp_w2_k)
    vc = _compress(v_cmp, cmp_pos_v, cmp_w1_v, cmp_w2_v)
    n_cmp = kc.shape[1]
    n_slc = T // SLC_BLOCK
    n_sel = min(SLC_TOPN, n_slc)
    cs = jnp.arange(n_cmp) * CMP_STRIDE
    ce = cs + CMP_BLOCK - 1
    ss = jnp.arange(n_slc) * SLC_BLOCK
    se = ss + SLC_BLOCK - 1
    overlap = jnp.clip(jnp.minimum(ce[:, None], se[None]) - jnp.maximum(cs[:, None], ss[None]) + 1, 0)
    overlap = overlap.astype(jnp.float32) / CMP_BLOCK
    cmp_end = ce.astype(jnp.float32)

    ks_blk = k_slc.reshape(B, n_slc, SLC_BLOCK, G, dh).transpose(0, 3, 1, 2, 4)
    vs_blk = v_slc.reshape(B, n_slc, SLC_BLOCK, G, dh).transpose(0, 3, 1, 2, 4)
    kw_pad = jnp.pad(k_win, ((0, 0), (WINDOW, 0), (0, 0), (0, 0)))
    vw_pad = jnp.pad(v_win, ((0, 0), (WINDOW, 0), (0, 0), (0, 0)))
    b_ix = jnp.arange(B)[:, None, None, None]
    g_ix = jnp.arange(G)[None, :, None, None]
    j_blk = jnp.arange(n_slc)

    def block(qb_idx):
        q0 = qb_idx * Q_BLOCK
        qb = lax.dynamic_slice_in_dim(q, q0, Q_BLOCK, axis=1)
        gb = lax.dynamic_slice_in_dim(gates, q0, Q_BLOCK, axis=1)
        t = q0 + jnp.arange(Q_BLOCK)
        tf = t.astype(jnp.float32)

        dist_c = tf[:, None] - cmp_end[None]
        s_c = jnp.einsum('bqgpd,bngd->bgpqn', qb, kc).astype(jnp.float32) - slopes[:, :, None, None] * dist_c
        p_cmp = _masked_softmax(s_c, dist_c >= 0)
        o_cmp = jnp.einsum('bgpqn,bngd->bqgpd', p_cmp.astype(dt), vc)

        imp = jnp.einsum('bgpqn,nj->bgqj', p_cmp, overlap)
        t_blk = (t // SLC_BLOCK)[:, None]
        causal_blk = j_blk[None] <= t_blk
        forced = (j_blk[None] == 0) | (j_blk[None] == t_blk) | (j_blk[None] == t_blk - 1)
        score = jnp.where(causal_blk, imp + jnp.where(forced, FORCE_BONUS, 0.0), NEG)
        _, idx = lax.top_k(score, n_sel)
        kg = ks_blk[b_ix, g_ix, idx]
        vg = vs_blk[b_ix, g_ix, idx]
        key_pos = idx[..., None] * SLC_BLOCK + jnp.arange(SLC_BLOCK)
        dist_s = (tf[None, None, :, None, None] - key_pos.astype(jnp.float32))[:, :, None]
        s_s = jnp.einsum('bqgpd,bgqnsd->bgpqns', qb, kg).astype(jnp.float32) - slopes[:, :, None, None, None] * dist_s
        shp = s_s.shape
        flat_shape = shp[:4] + (shp[4] * shp[5],)
        mask_s = jnp.broadcast_to(dist_s >= 0, shp).reshape(flat_shape)
        p_s = _masked_softmax(s_s.reshape(flat_shape), mask_s).reshape(shp)
        o_slc = jnp.einsum('bgpqns,bgqnsd->bqgpd', p_s.astype(dt), vg)

        kwb = lax.dynamic_slice_in_dim(kw_pad, q0, WINDOW + Q_BLOCK, axis=1)
        vwb = lax.dynamic_slice_in_dim(vw_pad, q0, WINDOW + Q_BLOCK, axis=1)
        wpos = q0 - WINDOW + jnp.arange(WINDOW + Q_BLOCK)
        dist_w = tf[:, None] - wpos[None].astype(jnp.float32)
        mask_w = (dist_w >= 0) & (dist_w < WINDOW) & (wpos[None] >= 0)
        s_w = jnp.einsum('bqgpd,bkgd->bgpqk', qb, kwb).astype(jnp.float32) - slopes[:, :, None, None] * dist_w
        p_w = _masked_softmax(s_w, mask_w)
        o_win = jnp.einsum('bgpqk,bkgd->bqgpd', p_w.astype(dt), vwb)

        return gb[..., 0:1] * o_cmp + gb[..., 1:2] * o_slc + gb[..., 2:3] * o_win

    out = lax.map(block, jnp.arange(T // Q_BLOCK))
    return out.transpose(1, 0, 2, 3, 4, 5).reshape(B, T, NSA_HEADS * dh)


def _gla_chunk_step(S, inp):
    q, k, v, g = inp
    b = jnp.cumsum(g, axis=2)
    C = q.shape[2]
    causal = jnp.tril(jnp.ones((C, C), bool))
    diff = b[:, :, :, None, :] - b[:, :, None, :, :]
    decay = jnp.where(causal[:, :, None], jnp.exp(jnp.minimum(diff, 0.0)), 0.0)
    attn = jnp.einsum('bhtd,bhsd,bhtsd->bhts', q, k, decay)
    o = jnp.einsum('bhtd,bhde->bhte', q * jnp.exp(b), S) + jnp.einsum('bhts,bhse->bhte', attn, v)
    b_last = b[:, :, -1:, :]
    S = jnp.exp(b_last[:, :, 0, :])[..., None] * S + jnp.einsum('bhcd,bhce->bhde', k * jnp.exp(b_last - b), v)
    return S, o


def _gla(q, k, v, gate_lr, r, w_a2, b_a2, norm_w):
    B, T = q.shape[:2]
    H, dk, dv, C = GLA_HEADS, GLA_DK, GLA_DV, GLA_CHUNK
    dt = q.dtype
    log_a = jax.nn.log_sigmoid((gate_lr @ w_a2 + b_a2).astype(jnp.float32)) / GLA_TAU

    def chunks(a, d):
        return a.astype(jnp.float32).reshape(B, T // C, C, H, d).transpose(1, 0, 3, 2, 4)

    xs = (chunks(q * dk ** -0.5, dk), chunks(k, dk), chunks(v, dv), chunks(log_a, dk))
    S0 = jnp.zeros((B, H, dk, dv), jnp.float32)
    _, o = lax.scan(_gla_chunk_step, S0, xs)
    o = o.transpose(1, 0, 3, 2, 4).reshape(B, T, H, dv)
    o = _normalize(o) * norm_w.astype(jnp.float32)
    return (o.reshape(B, T, H * dv) * jax.nn.silu(r.astype(jnp.float32))).astype(dt)


def _token_mixer(h, w_in, cmp_pos_k, cmp_w1_k, cmp_w2_k, cmp_pos_v, cmp_w1_v, cmp_w2_v,
                 gla_w_a2, gla_b_a2, gla_norm_w, w_o):
    B, T, _ = h.shape
    proj = h @ w_in
    points, acc = [], 0
    for sz in SPLIT_SIZES[:-1]:
        acc += sz
        points.append(acc)
    (nq, kc_, vc_, ks_, vs_, kw_, vw_, ng, gq, gk, gv, glr, gr) = jnp.split(proj, points, axis=-1)
    kv = lambda a: a.reshape(B, T, NSA_KV_GROUPS, NSA_HEAD_DIM)
    o_nsa = _nsa(nq.reshape(B, T, NSA_HEADS, NSA_HEAD_DIM), kv(kc_), kv(vc_), kv(ks_), kv(vs_),
                 kv(kw_), kv(vw_), ng.reshape(B, T, NSA_HEADS, 3),
                 cmp_pos_k, cmp_w1_k, cmp_w2_k, cmp_pos_v, cmp_w1_v, cmp_w2_v)
    o_gla = _gla(gq, gk, gv, glr, gr, gla_w_a2, gla_b_a2, gla_norm_w)
    return jnp.concatenate([o_nsa, o_gla], axis=-1) @ w_o


def _moe(h, w_router, router_bias, w_e_gate, w_e_up, w_e_down, w_s_gate, w_s_up, w_s_down):
    B, T, D = h.shape
    N = B * T
    dt = h.dtype
    xt = h.reshape(N, D)
    s = jax.nn.sigmoid((xt @ w_router).astype(jnp.float32))
    sb = s + router_bias.astype(jnp.float32)
    grp = sb.reshape(N, N_EXPERT_GROUPS, N_EXPERTS // N_EXPERT_GROUPS)
    grp_score = jnp.sum(lax.top_k(grp, 2)[0], -1)
    _, gidx = lax.top_k(grp_score, TOPK_GROUPS)
    gmask = jnp.sum(jax.nn.one_hot(gidx, N_EXPERT_GROUPS), axis=1) > 0
    emask = jnp.repeat(gmask, N_EXPERTS // N_EXPERT_GROUPS, axis=1)
    _, eidx = lax.top_k(jnp.where(emask, sb, NEG), TOP_K)
    w = jnp.take_along_axis(s, eidx, axis=1)
    w = w / jnp.sum(w, -1, keepdims=True) * ROUTE_SCALE

    NK = N * TOP_K
    flat_e = eidx.reshape(NK)
    flat_tok = jnp.repeat(jnp.arange(N, dtype=jnp.int32), TOP_K)
    flat_w = w.reshape(NK).astype(dt)
    order = jnp.argsort(flat_e)
    se, stok, sw = flat_e[order], flat_tok[order], flat_w[order]
    counts = jnp.bincount(flat_e, length=N_EXPERTS)
    padded = (counts + MOE_BLOCK - 1) // MOE_BLOCK * MOE_BLOCK
    pend = jnp.cumsum(padded)
    pstart = pend - padded
    start = jnp.cumsum(counts) - counts
    dest = pstart[se] + (jnp.arange(NK) - start[se])
    n_blocks = -(-NK // MOE_BLOCK) + N_EXPERTS
    R = n_blocks * MOE_BLOCK
    row_tok = jnp.full((R,), N, jnp.int32).at[dest].set(stok)
    row_w = jnp.zeros((R,), dt).at[dest].set(sw)
    blk_e = jnp.minimum(jnp.searchsorted(pend, jnp.arange(n_blocks) * MOE_BLOCK, side='right'), N_EXPERTS - 1)
    x_pad = jnp.concatenate([xt, jnp.zeros((1, D), dt)], axis=0)

    def step(acc, inp):
        tok, wt, e = inp
        xb = x_pad[tok]
        hid = jax.nn.silu(xb @ w_e_gate[e]) * (xb @ w_e_up[e])
        return acc.at[tok].add((hid @ w_e_down[e]) * wt[:, None]), None

    acc, _ = lax.scan(step, jnp.zeros((N + 1, D), dt),
                      (row_tok.reshape(n_blocks, MOE_BLOCK), row_w.reshape(n_blocks, MOE_BLOCK), blk_e))
    shared = (jax.nn.silu(xt @ w_s_gate) * (xt @ w_s_up)) @ w_s_down
    return (acc[:N] + shared).reshape(B, T, D)


def setup_inputs(seed: int = 0) -> dict:
    key = jax.random.key(seed)
    ks = jax.random.split(key, 32)
    f32 = jnp.float32
    L, D = DEPTH, D_MODEL
    beta = (8.0 * DEPTH) ** -0.25
    nrm = lambda k, shape, scale: jax.random.normal(k, shape, f32) * scale
    return {
        'x': nrm(ks[0], (BATCH, SEQ, D), 1.0),
        'c': nrm(ks[1], (BATCH, D), 1.0),
        'w_mod': nrm(ks[2], (L, D, 6 * D), 0.1 * D ** -0.5),
        'b_mod': nrm(ks[3], (L, 6 * D), 0.02),
        'w_in': nrm(ks[4], (L, D, IN_COLS), D ** -0.5),
        'cmp_pos_k': nrm(ks[5], (L, CMP_BLOCK, NSA_HEAD_DIM), 0.02),
        'cmp_w1_k': nrm(ks[6], (L, CMP_BLOCK * NSA_HEAD_DIM, CMP_HIDDEN), (CMP_BLOCK * NSA_HEAD_DIM) ** -0.5),
        'cmp_w2_k': nrm(ks[7], (L, CMP_HIDDEN, NSA_HEAD_DIM), CMP_HIDDEN ** -0.5),
        'cmp_pos_v': nrm(ks[8], (L, CMP_BLOCK, NSA_HEAD_DIM), 0.02),
        'cmp_w1_v': nrm(ks[9], (L, CMP_BLOCK * NSA_HEAD_DIM, CMP_HIDDEN), (CMP_BLOCK * NSA_HEAD_DIM) ** -0.5),
        'cmp_w2_v': nrm(ks[10], (L, CMP_HIDDEN, NSA_HEAD_DIM), CMP_HIDDEN ** -0.5),
        'gla_w_a2': nrm(ks[11], (L, GLA_GATE_RANK, GLA_HEADS * GLA_DK), GLA_GATE_RANK ** -0.5),
        'gla_b_a2': nrm(ks[12], (L, GLA_HEADS * GLA_DK), 0.1),
        'gla_norm_w': 1.0 + nrm(ks[13], (L, GLA_DV), 0.02),
        'w_o': nrm(ks[14], (L, MIX_WIDTH, D), beta * MIX_WIDTH ** -0.5),
        'ln1_g': 1.0 + nrm(ks[15], (L, D), 0.02),
        'ln1_b': nrm(ks[16], (L, D), 0.02),
        'w_router': nrm(ks[17], (L, D, N_EXPERTS), D ** -0.5),
        'router_bias': nrm(ks[18], (L, N_EXPERTS), 0.01),
        'w_e_gate': nrm(ks[19], (L, N_EXPERTS, D, EXPERT_HIDDEN), D ** -0.5),
        'w_e_up': nrm(ks[20], (L, N_EXPERTS, D, EXPERT_HIDDEN), D ** -0.5),
        'w_e_down': nrm(ks[21], (L, N_EXPERTS, EXPERT_HIDDEN, D), beta * EXPERT_HIDDEN ** -0.5),
        'w_s_gate': nrm(ks[22], (L, D, SHARED_HIDDEN), D ** -0.5),
        'w_s_up': nrm(ks[23], (L, D, SHARED_HIDDEN), D ** -0.5),
        'w_s_down': nrm(ks[24], (L, SHARED_HIDDEN, D), beta * SHARED_HIDDEN ** -0.5),
        'ln2_g': 1.0 + nrm(ks[25], (L, D), 0.02),
        'ln2_b': nrm(ks[26], (L, D), 0.02),
    }


def reference(x, c, w_mod, b_mod, w_in, cmp_pos_k, cmp_w1_k, cmp_w2_k, cmp_pos_v, cmp_w1_v, cmp_w2_v,
              gla_w_a2, gla_b_a2, gla_norm_w, w_o, ln1_g, ln1_b, w_router, router_bias,
              w_e_gate, w_e_up, w_e_down, w_s_gate, w_s_up, w_s_down, ln2_g, ln2_b):
    alpha = (2.0 * DEPTH) ** 0.25
    for l in range(DEPTH):
        mod = jax.nn.silu(c) @ w_mod[l] + b_mod[l]
        sh1, sc1, ga1, sh2, sc2, ga2 = jnp.split(mod[:, None, :], 6, axis=-1)
        h = _normalize(x) * (1.0 + sc1) + sh1
        y = _token_mixer(h, w_in[l], cmp_pos_k[l], cmp_w1_k[l], cmp_w2_k[l], cmp_pos_v[l], cmp_w1_v[l],
                         cmp_w2_v[l], gla_w_a2[l], gla_b_a2[l], gla_norm_w[l], w_o[l])
        x = _layer_norm(alpha * x + (1.0 + ga1) * y, ln1_g[l], ln1_b[l])
        h = _normalize(x) * (1.0 + sc2) + sh2
        y = _moe(h, w_router[l], router_bias[l], w_e_gate[l], w_e_up[l], w_e_down[l],
                 w_s_gate[l], w_s_up[l], w_s_down[l])
        x = _layer_norm(alpha * x + (1.0 + ga2) * y, ln2_g[l], ln2_b[l])
    return x
```

```cpp
#include <hip/hip_runtime.h>
#include <hip/hip_bf16.h>
#include <stdint.h>

#define D_MODEL 1024
#define BATCH 4
#define SEQ 4096
#define NTOK (BATCH * SEQ)
#define IN_COLS 2856
#define NCMP 255
#define NEGF (-1e30f)
#define C_NQ 0
#define C_KC 512
#define C_VC 640
#define C_KS 768
#define C_VS 896
#define C_KW 1024
#define C_VW 1152
#define C_NG 1280
#define C_GQ 1304
#define C_GK 1560
#define C_GV 1816
#define C_GLR 2328
#define C_GR 2344
#define N_EXP 256
#define TOPK 8

__device__ __forceinline__ float siluf(float x) { return x / (1.f + __expf(-x)); }
__device__ __forceinline__ float sigmoidf_(float x) { return 1.f / (1.f + __expf(-x)); }

__device__ __forceinline__ float blk_sum(float v, float* red) {
    int t = threadIdx.x;
    __syncthreads();
    red[t] = v; __syncthreads();
    for (int s = 128; s > 0; s >>= 1) { if (t < s) red[t] += red[t + s]; __syncthreads(); }
    float r = red[0];
    return r;
}
__device__ __forceinline__ float blk_max(float v, float* red) {
    int t = threadIdx.x;
    __syncthreads();
    red[t] = v; __syncthreads();
    for (int s = 128; s > 0; s >>= 1) { if (t < s) red[t] = fmaxf(red[t], red[t + s]); __syncthreads(); }
    float r = red[0];
    return r;
}

#define DBG 0
#define SINGLE_LAUNCH 1
#define DBG_REPORT -1
#if DBG
__global__ __launch_bounds__(256) void nk_mod(const float* c, const float* w_mod, const float* b_mod, float* mod) {
    int j = blockIdx.x * 256 + threadIdx.x; int b = blockIdx.y;
    float acc = b_mod[j];
    for (int k = 0; k < D_MODEL; ++k) acc += siluf(c[b * D_MODEL + k]) * w_mod[(size_t)k * 6144 + j];
    mod[b * 6144 + j] = acc;
}

__global__ __launch_bounds__(256) void nk_lnmod(const float* x, const float* mod, int sh_off, int sc_off, float* out) {
    __shared__ float red[256];
    int row = blockIdx.x; int b = row / SEQ; int t = threadIdx.x;
    const float* xr = x + (size_t)row * D_MODEL;
    float v[4]; float s = 0.f;
    for (int i = 0; i < 4; ++i) { v[i] = xr[t + 256 * i]; s += v[i]; }
    float mu = blk_sum(s, red) * (1.f / D_MODEL);
    float q = 0.f;
    for (int i = 0; i < 4; ++i) { float d = v[i] - mu; q += d * d; }
    float var = blk_sum(q, red) * (1.f / D_MODEL);
    float rstd = rsqrtf(var + 1e-5f);
    for (int i = 0; i < 4; ++i) {
        int col = t + 256 * i;
        out[(size_t)row * D_MODEL + col] = (v[i] - mu) * rstd * (1.f + mod[b * 6144 + sc_off + col]) + mod[b * 6144 + sh_off + col];
    }
}

__global__ __launch_bounds__(256) void nk_resln(const float* x, const float* y, const float* mod, int ga_off, const float* g, const float* bb, float* out) {
    __shared__ float red[256];
    int row = blockIdx.x; int b = row / SEQ; int t = threadIdx.x;
    const float alpha = 1.189207115f;
    float v[4]; float s = 0.f;
    for (int i = 0; i < 4; ++i) {
        int col = t + 256 * i;
        v[i] = alpha * x[(size_t)row * D_MODEL + col] + (1.f + mod[b * 6144 + ga_off + col]) * y[(size_t)row * D_MODEL + col];
        s += v[i];
    }
    float mu = blk_sum(s, red) * (1.f / D_MODEL);
    float q = 0.f;
    for (int i = 0; i < 4; ++i) { float d = v[i] - mu; q += d * d; }
    float var = blk_sum(q, red) * (1.f / D_MODEL);
    float rstd = rsqrtf(var + 1e-5f);
    for (int i = 0; i < 4; ++i) {
        int col = t + 256 * i;
        out[(size_t)row * D_MODEL + col] = (v[i] - mu) * rstd * g[col] + bb[col];
    }
}

__global__ __launch_bounds__(256) void nk_gemm(const float* A, int lda, const float* B, int ldb, float* C, int ldc, int M, int N, int K) {
    __shared__ float sA[16][64 + 1];
    __shared__ float sB[16][64 + 1];
    int tx = threadIdx.x & 15, ty = threadIdx.x >> 4;
    int m0 = blockIdx.y * 64, n0 = blockIdx.x * 64;
    float acc[4][4];
    for (int i = 0; i < 4; ++i) for (int j = 0; j < 4; ++j) acc[i][j] = 0.f;
    for (int k0 = 0; k0 < K; k0 += 16) {
        for (int e = threadIdx.x; e < 1024; e += 256) {
            int r = e >> 4, kk = e & 15;
            int gm = m0 + r;
            sA[kk][r] = (gm < M) ? A[(size_t)gm * lda + k0 + kk] : 0.f;
            int kb = e >> 6, nn = e & 63;
            int gn = n0 + nn;
            sB[kb][nn] = (gn < N) ? B[(size_t)(k0 + kb) * ldb + gn] : 0.f;
        }
        __syncthreads();
#pragma unroll
        for (int kk = 0; kk < 16; ++kk) {
            float a[4], bv[4];
#pragma unroll
            for (int i = 0; i < 4; ++i) a[i] = sA[kk][ty * 4 + i];
#pragma unroll
            for (int j = 0; j < 4; ++j) bv[j] = sB[kk][tx * 4 + j];
#pragma unroll
            for (int i = 0; i < 4; ++i)
#pragma unroll
                for (int j = 0; j < 4; ++j) acc[i][j] += a[i] * bv[j];
        }
        __syncthreads();
    }
#pragma unroll
    for (int i = 0; i < 4; ++i)
#pragma unroll
        for (int j = 0; j < 4; ++j) {
            int gm = m0 + ty * 4 + i, gn = n0 + tx * 4 + j;
            if (gm < M && gn < N) C[(size_t)gm * ldc + gn] = acc[i][j];
        }
}

__global__ __launch_bounds__(256) void nk_flat(const float* proj, int col0, const float* pos, float* flat) {
    int r = blockIdx.x;
    int g = r & 1; int bi = r >> 1; int i = bi % NCMP; int b = bi / NCMP;
    for (int e = threadIdx.x; e < 2048; e += 256) {
        int l = e >> 6, d = e & 63;
        flat[(size_t)r * 2048 + e] = proj[((size_t)b * SEQ + 16 * i + l) * IN_COLS + col0 + g * 64 + d] + pos[l * 64 + d];
    }
}
__global__ void nk_silu(float* x, int n) { int i = blockIdx.x * 256 + threadIdx.x; if (i < n) x[i] = siluf(x[i]); }

__global__ __launch_bounds__(256) void nk_nsa(const float* proj, const float* kc, const float* vc, float* mix) {
    __shared__ float sq[8][64];
    __shared__ float sp[1024];
    __shared__ float red[256];
    __shared__ float simp[64];
    __shared__ float sscore[64];
    __shared__ int sidx[16];
    __shared__ float sout[8][64];
    __shared__ float spart[4][64];
    const int tid = threadIdx.x;
    const int bt = blockIdx.x; const int b = bt / SEQ, t = bt % SEQ;
    const float* prow = proj + (size_t)bt * IN_COLS;
    for (int e = tid; e < 512; e += 256) { sq[e >> 6][e & 63] = prow[C_NQ + e] * 0.125f; sout[e >> 6][e & 63] = 0.f; }
    __syncthreads();
    const int tblk = t >> 6;
    const int dd = tid & 63, part = tid >> 6;
    for (int g = 0; g < 2; ++g) {
        if (tid < 64) simp[tid] = 0.f;
        __syncthreads();
        for (int hp = 0; hp < 4; ++hp) {
            int h = g * 4 + hp;
            float slope = exp2f(-(float)(h + 1));
            float s = NEGF; bool valid = false;
            if (tid < NCMP) {
                int ce = 16 * tid + 31;
                valid = (t >= ce);
                if (valid) {
                    const float* kr = kc + (((size_t)b * NCMP + tid) * 2 + g) * 64;
                    float a = 0.f;
                    for (int d = 0; d < 64; ++d) a += sq[h][d] * kr[d];
                    s = a - slope * (float)(t - ce);
                }
            }
            float m = blk_max(s, red);
            float e = valid ? __expf(s - m) : 0.f;
            float sum = blk_sum(e, red);
            float p = e / fmaxf(sum, 1e-30f);
            __syncthreads();
            sp[tid] = p;
            __syncthreads();
            float a = 0.f;
            for (int i = part; i < NCMP; i += 4) a += sp[i] * vc[(((size_t)b * NCMP + i) * 2 + g) * 64 + dd];
            spart[part][dd] = a;
            __syncthreads();
            if (tid < 64) {
                float o = spart[0][tid] + spart[1][tid] + spart[2][tid] + spart[3][tid];
                float gate = sigmoidf_(prow[C_NG + h * 3 + 0]);
                sout[h][tid] += gate * o;
                int j = tid;
                float im = sp[4 * j] + sp[4 * j + 1] + sp[4 * j + 2] + 0.5f * sp[4 * j + 3] + (j > 0 ? 0.5f * sp[4 * j - 1] : 0.f);
                simp[j] += im;
            }
            __syncthreads();
        }
        if (tid < 64) {
            int j = tid;
            bool forced = (j == 0) || (j == tblk) || (j == tblk - 1);
            sscore[j] = (j <= tblk) ? (simp[j] + (forced ? 1e4f : 0.f)) : NEGF;
        }
        __syncthreads();
        if (tid < 64) {
            int j = tid; float sj = sscore[j]; int rank = 0;
            for (int j2 = 0; j2 < 64; ++j2) { float s2 = sscore[j2]; if (s2 > sj || (s2 == sj && j2 < j)) ++rank; }
            if (rank < 16) sidx[rank] = j;
        }
        __syncthreads();
        for (int hp = 0; hp < 4; ++hp) {
            int h = g * 4 + hp;
            float slope = exp2f(-(float)(h + 1));
            float sv[4]; bool vl[4]; float mx = NEGF;
            for (int r = 0; r < 4; ++r) {
                int kk = tid + 256 * r;
                int kpos = sidx[kk >> 6] * 64 + (kk & 63);
                vl[r] = (kpos <= t);
                sv[r] = NEGF;
                if (vl[r]) {
                    const float* kr = proj + ((size_t)b * SEQ + kpos) * IN_COLS + C_KS + g * 64;
                    float a = 0.f;
                    for (int d = 0; d < 64; ++d) a += sq[h][d] * kr[d];
                    sv[r] = a - slope * (float)(t - kpos);
                }
                mx = fmaxf(mx, sv[r]);
            }
            float m = blk_max(mx, red);
            float es = 0.f; float ev[4];
            for (int r = 0; r < 4; ++r) { ev[r] = vl[r] ? __expf(sv[r] - m) : 0.f; es += ev[r]; }
            float sum = blk_sum(es, red);
            float inv = 1.f / fmaxf(sum, 1e-30f);
            __syncthreads();
            for (int r = 0; r < 4; ++r) sp[tid + 256 * r] = ev[r] * inv;
            __syncthreads();
            float a = 0.f;
            for (int kk = part; kk < 1024; kk += 4) {
                float p = sp[kk];
                if (p != 0.f) {
                    int kpos = sidx[kk >> 6] * 64 + (kk & 63);
                    a += p * proj[((size_t)b * SEQ + kpos) * IN_COLS + C_VS + g * 64 + dd];
                }
            }
            spart[part][dd] = a;
            __syncthreads();
            if (tid < 64) {
                float o = spart[0][tid] + spart[1][tid] + spart[2][tid] + spart[3][tid];
                float gate = sigmoidf_(prow[C_NG + h * 3 + 1]);
                sout[h][tid] += gate * o;
            }
            __syncthreads();
        }
        for (int hp = 0; hp < 4; ++hp) {
            int h = g * 4 + hp;
            float slope = exp2f(-(float)(h + 1));
            float sv[2]; bool vl[2]; float mx = NEGF;
            for (int r = 0; r < 2; ++r) {
                int kk = tid + 256 * r;
                int kpos = t - 511 + kk;
                vl[r] = (kpos >= 0);
                sv[r] = NEGF;
                if (vl[r]) {
                    const float* kr = proj + ((size_t)b * SEQ + kpos) * IN_COLS + C_KW + g * 64;
                    float a = 0.f;
                    for (int d = 0; d < 64; ++d) a += sq[h][d] * kr[d];
                    sv[r] = a - slope * (float)(t - kpos);
                }
                mx = fmaxf(mx, sv[r]);
            }
            float m = blk_max(mx, red);
            float es = 0.f; float ev[2];
            for (int r = 0; r < 2; ++r) { ev[r] = vl[r] ? __expf(sv[r] - m) : 0.f; es += ev[r]; }
            float sum = blk_sum(es, red);
            float inv = 1.f / fmaxf(sum, 1e-30f);
            __syncthreads();
            for (int r = 0; r < 2; ++r) sp[tid + 256 * r] = ev[r] * inv;
            __syncthreads();
            float a = 0.f;
            for (int kk = part; kk < 512; kk += 4) {
                float p = sp[kk];
                if (p != 0.f) {
                    int kpos = t - 511 + kk;
                    a += p * proj[((size_t)b * SEQ + kpos) * IN_COLS + C_VW + g * 64 + dd];
                }
            }
            spart[part][dd] = a;
            __syncthreads();
            if (tid < 64) {
                float o = spart[0][tid] + spart[1][tid] + spart[2][tid] + spart[3][tid];
                float gate = sigmoidf_(prow[C_NG + h * 3 + 2]);
                sout[h][tid] += gate * o;
            }
            __syncthreads();
        }
    }
    for (int e = tid; e < 512; e += 256) mix[(size_t)bt * D_MODEL + e] = sout[e >> 6][e & 63];
}

__global__ __launch_bounds__(256) void nk_gla(const float* proj, const float* w_a2, const float* b_a2, float* ograw) {
    __shared__ float sqv[64], skv[64], sav[64];
    __shared__ float red[8][32];
    const int tid = threadIdx.x;
    const int es = blockIdx.x & 3, bh = blockIdx.x >> 2, h = bh & 3, b = bh >> 2;
    const int e = tid & 31, dg = tid >> 5;
    float S[8];
    for (int i = 0; i < 8; ++i) S[i] = 0.f;
    for (int t = 0; t < SEQ; ++t) {
        const float* prow = proj + ((size_t)b * SEQ + t) * IN_COLS;
        if (tid < 64) {
            int d = tid;
            sqv[d] = prow[C_GQ + h * 64 + d] * 0.125f;
            skv[d] = prow[C_GK + h * 64 + d];
            float x = b_a2[h * 64 + d];
            for (int r = 0; r < 16; ++r) x += prow[C_GLR + r] * w_a2[r * 256 + h * 64 + d];
            float ls = -(fmaxf(-x, 0.f) + log1pf(__expf(-fabsf(x))));
            sav[d] = __expf(ls * (1.f / 16.f));
        }
        __syncthreads();
        float v = prow[C_GV + h * 128 + es * 32 + e];
        float part = 0.f;
        for (int i = 0; i < 8; ++i) {
            int d = dg * 8 + i;
            S[i] = sav[d] * S[i] + skv[d] * v;
            part += sqv[d] * S[i];
        }
        red[dg][e] = part;
        __syncthreads();
        if (tid < 32) {
            float o = 0.f;
            for (int i = 0; i < 8; ++i) o += red[i][tid];
            ograw[((size_t)b * SEQ + t) * 512 + h * 128 + es * 32 + tid] = o;
        }
    }
}
__global__ __launch_bounds__(256) void nk_gla_norm(const float* ograw, const float* proj, const float* norm_w, float* mix) {
    int wid = (blockIdx.x * 256 + threadIdx.x) >> 6; int lane = threadIdx.x & 63;
    int tok = wid >> 2, h = wid & 3;
    const float* o = ograw + (size_t)tok * 512 + h * 128;
    float a = o[lane], c = o[lane + 64];
    float s = a + c;
    for (int m = 32; m > 0; m >>= 1) s += __shfl_xor(s, m);
    float mu = s * (1.f / 128.f);
    float q = (a - mu) * (a - mu) + (c - mu) * (c - mu);
    for (int m = 32; m > 0; m >>= 1) q += __shfl_xor(q, m);
    float rstd = rsqrtf(q * (1.f / 128.f) + 1e-5f);
    const float* r = proj + (size_t)tok * IN_COLS + C_GR + h * 128;
    mix[(size_t)tok * D_MODEL + 512 + h * 128 + lane] = (a - mu) * rstd * norm_w[lane] * siluf(r[lane]);
    mix[(size_t)tok * D_MODEL + 512 + h * 128 + lane + 64] = (c - mu) * rstd * norm_w[lane + 64] * siluf(r[lane + 64]);
}

__global__ __launch_bounds__(256) void nk_route(const float* logits, const float* rbias, int* eidx, float* ew, int* counts, int* lists) {
    int wid = (blockIdx.x * 256 + threadIdx.x) >> 6; int lane = threadIdx.x & 63;
    int tok = wid;
    float s[4], sb[4];
    for (int i = 0; i < 4; ++i) { float l = logits[(size_t)tok * 256 + lane * 4 + i]; s[i] = 1.f / (1.f + __expf(-l)); sb[i] = s[i] + rbias[lane * 4 + i]; }
    float m1 = NEGF, m2 = NEGF;
    for (int i = 0; i < 4; ++i) { float v = sb[i]; if (v > m1) { m2 = m1; m1 = v; } else if (v > m2) m2 = v; }
    for (int m = 1; m < 8; m <<= 1) {
        float o1 = __shfl_xor(m1, m), o2 = __shfl_xor(m2, m);
        float n1 = fmaxf(m1, o1);
        float n2 = fmaxf(fminf(m1, o1), fmaxf(m2, o2));
        m1 = n1; m2 = n2;
    }
    float gs = m1 + m2;
    int grp = lane >> 3;
    int grank = 0;
    for (int g2 = 0; g2 < 8; ++g2) { float o = __shfl(gs, g2 * 8); if (o > gs || (o == gs && g2 < grp)) ++grank; }
    bool gsel = grank < 4;
    float cand[4];
    for (int i = 0; i < 4; ++i) cand[i] = gsel ? sb[i] : NEGF;
    float wsum = 0.f; float myw = 0.f; int mye = 0;
    for (int k = 0; k < TOPK; ++k) {
        float bv = cand[0]; int bi = 0;
        for (int i = 1; i < 4; ++i) if (cand[i] > bv) { bv = cand[i]; bi = i; }
        int be = lane * 4 + bi;
        float gv = bv; int ge = be;
        for (int m = 1; m < 64; m <<= 1) {
            float ov = __shfl_xor(gv, m); int oe = __shfl_xor(ge, m);
            if (ov > gv || (ov == gv && oe < ge)) { gv = ov; ge = oe; }
        }
        float sel_s = 0.f;
        if ((ge >> 2) == lane) {
            int i = ge & 3;
            sel_s = (i == 0) ? s[0] : (i == 1) ? s[1] : (i == 2) ? s[2] : s[3];
            if (i == 0) cand[0] = -3e38f; else if (i == 1) cand[1] = -3e38f; else if (i == 2) cand[2] = -3e38f; else cand[3] = -3e38f;
        }
        sel_s = __shfl(sel_s, ge >> 2);
        wsum += sel_s;
        if (lane == k) { myw = sel_s; mye = ge; }
    }
    if (lane < TOPK) {
        float w = myw / wsum * 2.5f;
        eidx[tok * 8 + lane] = mye; ew[tok * 8 + lane] = w;
        int pos = atomicAdd(&counts[mye], 1);
        lists[(size_t)mye * NTOK + pos] = tok * 8 + lane;
    }
}

__global__ __launch_bounds__(256) void nk_moe(const float* h2, const float* wg, const float* wu, const float* wd,
                                              const float* sg, const float* su, const float* sd,
                                              const int* counts, const int* lists, const float* ew, float* acc) {
    __shared__ float sh[8][D_MODEL];
    __shared__ float shid[8][256];
    __shared__ int stok[8]; __shared__ float sw[8];
    const int e = blockIdx.y, chunk = blockIdx.x, tid = threadIdx.x;
    const int cnt = (e == N_EXP) ? NTOK : counts[e];
    if (chunk * 8 >= cnt) return;
    const float* Wg = (e == N_EXP) ? sg : wg + (size_t)e * D_MODEL * 256;
    const float* Wu = (e == N_EXP) ? su : wu + (size_t)e * D_MODEL * 256;
    const float* Wd = (e == N_EXP) ? sd : wd + (size_t)e * 256 * D_MODEL;
    if (tid < 8) {
        int p = chunk * 8 + tid;
        if (p < cnt) {
            if (e == N_EXP) { stok[tid] = p; sw[tid] = 1.f; }
            else { int id = lists[(size_t)e * NTOK + p]; stok[tid] = id >> 3; sw[tid] = ew[id]; }
        } else { stok[tid] = -1; sw[tid] = 0.f; }
    }
    __syncthreads();
    for (int m = 0; m < 8; ++m) {
        int tk = stok[m];
        for (int k = tid; k < D_MODEL; k += 256) sh[m][k] = (tk >= 0) ? h2[(size_t)tk * D_MODEL + k] : 0.f;
    }
    __syncthreads();
    float ag[8], au[8];
#pragma unroll
    for (int m = 0; m < 8; ++m) { ag[m] = 0.f; au[m] = 0.f; }
    for (int k = 0; k < D_MODEL; ++k) {
        float g = Wg[(size_t)k * 256 + tid], u = Wu[(size_t)k * 256 + tid];
#pragma unroll
        for (int m = 0; m < 8; ++m) { float hv = sh[m][k]; ag[m] += hv * g; au[m] += hv * u; }
    }
#pragma unroll
    for (int m = 0; m < 8; ++m) shid[m][tid] = siluf(ag[m]) * au[m];
    __syncthreads();
    for (int jj = 0; jj < 4; ++jj) {
        int j = tid + 256 * jj;
        float ao[8];
#pragma unroll
        for (int m = 0; m < 8; ++m) ao[m] = 0.f;
        for (int n = 0; n < 256; ++n) {
            float w = Wd[(size_t)n * D_MODEL + j];
#pragma unroll
            for (int m = 0; m < 8; ++m) ao[m] += shid[m][n] * w;
        }
#pragma unroll
        for (int m = 0; m < 8; ++m) { int tk = stok[m]; if (tk >= 0) atomicAdd(&acc[(size_t)tk * D_MODEL + j], ao[m] * sw[m]); }
    }
}

#endif
typedef unsigned short bf16_t;
typedef short bf16x8 __attribute__((ext_vector_type(8)));
typedef float f32x4 __attribute__((ext_vector_type(4)));
typedef unsigned u32x4 __attribute__((ext_vector_type(4)));
typedef unsigned u32x2 __attribute__((ext_vector_type(2)));

#define PCOLS 2944
#define P_NQ 0
#define P_KC 512
#define P_VC 640
#define P_KS 768
#define P_VS 896
#define P_KW 1024
#define P_VW 1152
#define P_GQ 1280
#define P_GK 1536
#define P_GV 1792
#define P_GR 2304
#define P_MISC 2816
#define NASSIGN 9
#define LOG2E 1.4426950408889634f

__device__ __forceinline__ unsigned pk_bf16(float lo, float hi) { unsigned r; asm("v_cvt_pk_bf16_f32 %0, %1, %2" : "=v"(r) : "v"(lo), "v"(hi)); return r; }
__device__ __forceinline__ float bflo(unsigned u) { return __uint_as_float(u << 16); }
__device__ __forceinline__ float bfhi(unsigned u) { return __uint_as_float(u & 0xffff0000u); }
__device__ __forceinline__ float bf2f(bf16_t v) { return __uint_as_float(((unsigned)v) << 16); }
__device__ __forceinline__ int opaque_tid() { int t = threadIdx.x; asm volatile("" : "+v"(t)); return t; }
__device__ __forceinline__ bf16_t f2bf(float f) { return (bf16_t)(pk_bf16(f, 0.f) & 0xffffu); }

struct Params {
    const float *x, *c, *w_mod, *b_mod, *w_in, *pos_k, *w1_k, *w2_k, *pos_v, *w1_v, *w2_v, *w_a2, *b_a2, *norm_w, *w_o, *ln1_g, *ln1_b,
        *w_router, *rbias, *w_e_gate, *w_e_up, *w_e_down, *w_s_gate, *w_s_up, *w_s_down, *ln2_g, *ln2_b;
    float* out;
    float* mod;
    float* bias1;
    bf16_t* wint;
    bf16_t* wot;
    bf16_t* wrt;
    bf16_t* w1t;
    bf16_t* w2t;
    bf16_t* hb;
    bf16_t* Pb;
    bf16_t* VsT;
    bf16_t* VwT;
    bf16_t* VgT;
    float* misc;
    float* cpart;
    bf16_t* kc;
    bf16_t* vcT;
    float* dST;
    float* dec;
    bf16_t* ST;
    float* mixf;
    bf16_t* mixb;
    float* y1;
    float* x1;
    float* logits;
    float* ew;
    int* counts;
    int* lists;
    bf16_t* hid;
    bf16_t* outk;
    unsigned* bar;
    int ph_lo, ph_hi;
};

#define LDS_ROW 72
#define TILE_BYTES (128 * LDS_ROW * 2)
#define GEMM_SMEM (4 * TILE_BYTES)

struct RowsBf16 {
    const bf16_t* base; size_t stride;
    __device__ __forceinline__ u32x4 load(int r, int k) const { return *(const u32x4*)(base + (size_t)r * stride + k); }
};
struct GatherBf16 {
    const bf16_t* base; size_t stride; const int* rowidx;
    __device__ __forceinline__ u32x4 load(int r, int k) const { return *(const u32x4*)(base + (size_t)rowidx[r] * stride + k); }
};
struct BF32Plain {
    const float* base; size_t ld;
    __device__ __forceinline__ f32x4 load4(int k, int r4) const { return *(const f32x4*)(base + (size_t)k * ld + r4); }
};
struct BF32GateUp {
    const float* g; long du; size_t ld;
    __device__ __forceinline__ f32x4 load4(int k, int r4) const {
        const long sel = ((r4 >> 5) & 1) ? du : 0l;
        return *(const f32x4*)(g + sel + (size_t)k * ld + (r4 >> 6) * 32 + (r4 & 31));
    }
};

template <bool SWAP>
__device__ __forceinline__ void mma_stage(const char* sA, const char* sB, f32x4 (&acc)[4][4], int wr, int wc, int fr, int fq) {
#pragma unroll
    for (int ks = 0; ks < 2; ++ks) {
        bf16x8 a[4], b[4];
#pragma unroll
        for (int m = 0; m < 4; ++m) a[m] = *(const bf16x8*)(sA + ((wr * 64 + m * 16 + fr) * LDS_ROW + ks * 32 + fq * 8) * 2);
#pragma unroll
        for (int n = 0; n < 4; ++n) b[n] = *(const bf16x8*)(sB + ((wc * 64 + n * 16 + fr) * LDS_ROW + ks * 32 + fq * 8) * 2);
#pragma unroll
        for (int m = 0; m < 4; ++m)
#pragma unroll
            for (int n = 0; n < 4; ++n)
                acc[m][n] = SWAP ? __builtin_amdgcn_mfma_f32_16x16x32_bf16(b[n], a[m], acc[m][n], 0, 0, 0)
                                 : __builtin_amdgcn_mfma_f32_16x16x32_bf16(a[m], b[n], acc[m][n], 0, 0, 0);
    }
}

template <bool SWAP, bool BF32, class AL, class BL>
__device__ __forceinline__ void gemm_128(const AL& al, const BL& bl, int k_begin, int nk, char* smem, f32x4 (&acc)[4][4]) {
    const int tid = threadIdx.x, lane = tid & 63, wid = tid >> 6, wr = wid >> 1, wc = wid & 1, fr = lane & 15, fq = lane >> 4;
#pragma unroll
    for (int m = 0; m < 4; ++m)
#pragma unroll
        for (int n = 0; n < 4; ++n) acc[m][n] = (f32x4){0.f, 0.f, 0.f, 0.f};
    u32x4 ra[4]; u32x4 rb[4]; f32x4 rbf[8];
    const int crow = tid >> 3, ckc = (tid & 7) * 8;
    const int n4 = (tid & 31) * 4, kg = (tid >> 5) * 8;
    auto gload = [&](int kt) __attribute__((always_inline)) {
        const int k0 = k_begin + kt * 64;
#pragma unroll
        for (int i = 0; i < 4; ++i) ra[i] = al.load(crow + 32 * i, k0 + ckc);
        if constexpr (BF32) {
#pragma unroll
            for (int j = 0; j < 8; ++j) rbf[j] = bl.load4(k0 + kg + j, n4);
        } else {
#pragma unroll
            for (int i = 0; i < 4; ++i) rb[i] = bl.load(crow + 32 * i, k0 + ckc);
        }
    };
    auto swrite = [&](int buf) __attribute__((always_inline)) {
        char* sA = smem + buf * 2 * TILE_BYTES; char* sB = sA + TILE_BYTES;
#pragma unroll
        for (int i = 0; i < 4; ++i) *(u32x4*)(sA + ((crow + 32 * i) * LDS_ROW + ckc) * 2) = ra[i];
        if constexpr (BF32) {
#pragma unroll
            for (int i = 0; i < 4; ++i) {
                u32x4 w;
                w.x = pk_bf16(rbf[0][i], rbf[1][i]); w.y = pk_bf16(rbf[2][i], rbf[3][i]);
                w.z = pk_bf16(rbf[4][i], rbf[5][i]); w.w = pk_bf16(rbf[6][i], rbf[7][i]);
                *(u32x4*)(sB + ((n4 + i) * LDS_ROW + kg) * 2) = w;
            }
        } else {
#pragma unroll
            for (int i = 0; i < 4; ++i) *(u32x4*)(sB + ((crow + 32 * i) * LDS_ROW + ckc) * 2) = rb[i];
        }
    };
    gload(0); swrite(0); __syncthreads();
    for (int kt = 0; kt < nk; ++kt) {
        const int buf = kt & 1;
        if (kt + 1 < nk) gload(kt + 1);
        mma_stage<SWAP>(smem + buf * 2 * TILE_BYTES, smem + buf * 2 * TILE_BYTES + TILE_BYTES, acc, wr, wc, fr, fq);
        if (kt + 1 < nk) swrite(buf ^ 1);
        __syncthreads();
    }
}

template <int NB, bool SILU>
__device__ __forceinline__ void gemv_item(const float* in, const float* W, int ldw, const float* bias, float* out, int ldo, int K, int col0, float* sm) {
    const int tid = threadIdx.x;
    for (int i = tid; i < NB * K; i += 256) { float v = in[i]; sm[i] = SILU ? v / (1.f + __expf(-v)) : v; }
    __syncthreads();
    float acc[NB];
#pragma unroll
    for (int b = 0; b < NB; ++b) acc[b] = 0.f;
    const int kq = tid >> 6, cl = tid & 63; const int kb = kq * (K / 4);
    for (int k = kb; k < kb + K / 4; ++k) {
        float w = W[(size_t)k * ldw + col0 + cl];
#pragma unroll
        for (int b = 0; b < NB; ++b) acc[b] += sm[b * K + k] * w;
    }
    float* red = sm + NB * K;
#pragma unroll
    for (int b = 0; b < NB; ++b) red[(kq * NB + b) * 64 + cl] = acc[b];
    __syncthreads();
    if (tid < 64 * NB) {
        int b = tid >> 6, cc = tid & 63;
        float s = red[(0 * NB + b) * 64 + cc] + red[(1 * NB + b) * 64 + cc] + red[(2 * NB + b) * 64 + cc] + red[(3 * NB + b) * 64 + cc];
        out[b * ldo + col0 + cc] = s + (bias ? bias[col0 + cc] : 0.f);
    }
    __syncthreads();
}

__device__ __forceinline__ int win_srccol(int n) {
    if (n < 1280) return n;
    if (n < 2304) return n + 24;
    if (n < 2816) return n + 40;
    if (n < 2840) return n - 2816 + 1280;
    if (n < 2856) return n - 2840 + 2328;
    return -1;
}
template <bool PERM>
__device__ __forceinline__ void transpose_item(const float* W, int ldw, int K, bf16_t* out, int k0, int n0, float* sm) {
    const int tid = threadIdx.x;
    for (int i = tid; i < 4096; i += 256) {
        int kk = i >> 6, nn = i & 63;
        int src = PERM ? win_srccol(n0 + nn) : (n0 + nn);
        sm[kk * 65 + nn] = (src >= 0) ? W[(size_t)(k0 + kk) * ldw + src] : 0.f;
    }
    __syncthreads();
    for (int i = tid; i < 512; i += 256) {
        int nn = i >> 3, kc = (i & 7) * 8;
        u32x4 w;
        w.x = pk_bf16(sm[(kc + 0) * 65 + nn], sm[(kc + 1) * 65 + nn]); w.y = pk_bf16(sm[(kc + 2) * 65 + nn], sm[(kc + 3) * 65 + nn]);
        w.z = pk_bf16(sm[(kc + 4) * 65 + nn], sm[(kc + 5) * 65 + nn]); w.w = pk_bf16(sm[(kc + 6) * 65 + nn], sm[(kc + 7) * 65 + nn]);
        *(u32x4*)(out + (size_t)(n0 + nn) * K + k0 + kc) = w;
    }
    __syncthreads();
}

__device__ void phase0(const Params& p, char* smem) {
    float* sm = (float*)smem;
    const int nb = gridDim.x, bid = blockIdx.x;
    const int I_MOD = 96, I_B1 = 8, I_WIN = 16 * 46, I_WO = 256, I_WR = 64, I_W1 = 2 * 32 * 4, I_W2 = 2 * 4;
    const int total = I_MOD + I_B1 + I_WIN + I_WO + I_WR + I_W1 + I_W2;
    if (bid == 0 && threadIdx.x < 64) p.counts[264 + threadIdx.x] = 0;
    if (bid == 1) for (int i = threadIdx.x; i < 264; i += 256) p.counts[i] = 0;
    for (int it = bid; it < total; it += nb) {
        int i = it;
        if (i < I_MOD) { gemv_item<4, true>(p.c, p.w_mod, 6144, p.b_mod, p.mod, 6144, 1024, i * 64, sm); continue; }
        i -= I_MOD;
        if (i < I_B1) { int kv = i >> 2; gemv_item<1, false>(kv ? p.pos_v : p.pos_k, kv ? p.w1_v : p.w1_k, 256, nullptr, p.bias1 + kv * 256, 256, 2048, (i & 3) * 64, sm); continue; }
        i -= I_B1;
        if (i < I_WIN) { transpose_item<true>(p.w_in, IN_COLS, 1024, p.wint, (i % 16) * 64, (i / 16) * 64, sm); continue; }
        i -= I_WIN;
        if (i < I_WO) { transpose_item<false>(p.w_o, 1024, 1024, p.wot, (i % 16) * 64, (i / 16) * 64, sm); continue; }
        i -= I_WO;
        if (i < I_WR) { transpose_item<false>(p.w_router, 256, 1024, p.wrt, (i % 16) * 64, (i / 16) * 64, sm); continue; }
        i -= I_WR;
        if (i < I_W1) { int kv = i >> 7; int j = i & 127; transpose_item<false>(kv ? p.w1_v : p.w1_k, 256, 2048, p.w1t + (size_t)kv * 256 * 2048, (j % 32) * 64, (j / 32) * 64, sm); continue; }
        i -= I_W1;
        { int kv = i >> 2; int j = i & 3; transpose_item<false>(kv ? p.w2_v : p.w2_k, 64, 256, p.w2t + (size_t)kv * 64 * 256, j * 64, 0, sm); }
    }
}

__device__ __forceinline__ float wave_sum(float v) {
#pragma unroll
    for (int m = 32; m > 0; m >>= 1) v += __shfl_xor(v, m);
    return v;
}
__device__ void phase1(const Params& p) {
    const int lane = threadIdx.x & 63, gw = blockIdx.x * 4 + (threadIdx.x >> 6), nw = gridDim.x * 4;
    for (int row = gw; row < NTOK; row += nw) {
        const int b = row / SEQ;
        const float* xr = p.x + (size_t)row * D_MODEL;
        f32x4 v[4]; float s = 0.f;
#pragma unroll
        for (int i = 0; i < 4; ++i) { v[i] = *(const f32x4*)(xr + i * 256 + lane * 4); s += (v[i][0] + v[i][1]) + (v[i][2] + v[i][3]); }
        const float mu = wave_sum(s) * (1.f / D_MODEL);
        float q = 0.f;
#pragma unroll
        for (int i = 0; i < 4; ++i)
#pragma unroll
            for (int j = 0; j < 4; ++j) { float d = v[i][j] - mu; q += d * d; }
        const float rstd = rsqrtf(wave_sum(q) * (1.f / D_MODEL) + 1e-5f);
        const float* md = p.mod + b * 6144;
#pragma unroll
        for (int i = 0; i < 4; ++i) {
            const int col = i * 256 + lane * 4;
            f32x4 sh = *(const f32x4*)(md + 0 + col), sc = *(const f32x4*)(md + 1024 + col);
            float o[4];
#pragma unroll
            for (int j = 0; j < 4; ++j) o[j] = (v[i][j] - mu) * rstd * (1.f + sc[j]) + sh[j];
            u32x2 w; w.x = pk_bf16(o[0], o[1]); w.y = pk_bf16(o[2], o[3]);
            *(u32x2*)(p.hb + (size_t)row * D_MODEL + col) = w;
        }
    }
}

__device__ void phase2(const Params& p, char* smem) {
    const int bid = blockIdx.x, xcd = bid & 7, rank = bid >> 3, nranks = gridDim.x >> 3;
    const int lane = threadIdx.x & 63, wid = threadIdx.x >> 6, wr = wid >> 1, wc = wid & 1, fr = lane & 15, fq = lane >> 4;
    for (int it = rank; it < 16 * 23; it += nranks) {
        const int mt = (it / 23) * 8 + xcd, nt = it % 23;
        const int row0 = mt * 128, col0 = nt * 128;
        RowsBf16 al{p.hb + (size_t)row0 * D_MODEL, D_MODEL};
        RowsBf16 bl{p.wint + (size_t)col0 * D_MODEL, D_MODEL};
        f32x4 acc[4][4];
        const bool transposed = (nt == 7) || (nt == 9) || (nt >= 14 && nt < 18);
        if (transposed) {
            gemm_128<false, false>(al, bl, 0, 16, smem, acc);
            const int b = row0 / SEQ, t0 = row0 % SEQ;
            bf16_t* base; int rows_per;
            if (nt == 7) base = p.VsT + (size_t)b * 128 * SEQ;
            else if (nt == 9) base = p.VwT + (size_t)b * 128 * SEQ;
            else base = p.VgT + ((size_t)b * 4 + (nt - 14)) * 128 * SEQ;
            (void)rows_per;
#pragma unroll
            for (int m = 0; m < 4; ++m)
#pragma unroll
                for (int n = 0; n < 4; ++n) {
                    const int feat = wc * 64 + n * 16 + fr, tok = t0 + wr * 64 + m * 16 + fq * 4;
                    u32x2 w; w.x = pk_bf16(acc[m][n][0], acc[m][n][1]); w.y = pk_bf16(acc[m][n][2], acc[m][n][3]);
                    *(u32x2*)(base + (size_t)feat * SEQ + tok) = w;
                }
        } else {
            gemm_128<true, false>(al, bl, 0, 16, smem, acc);
            if (nt == 22) {
                if (wc == 0) {
#pragma unroll
                    for (int m = 0; m < 4; ++m)
#pragma unroll
                        for (int n = 0; n < 4; ++n) {
                            const int tok = row0 + wr * 64 + m * 16 + fr, feat = n * 16 + fq * 4;
                            *(f32x4*)(p.misc + (size_t)tok * 64 + feat) = acc[m][n];
                        }
                }
            } else {
#pragma unroll
                for (int m = 0; m < 4; ++m)
#pragma unroll
                    for (int n = 0; n < 4; ++n) {
                        const int tok = row0 + wr * 64 + m * 16 + fr, feat = col0 + wc * 64 + n * 16 + fq * 4;
                        u32x2 w; w.x = pk_bf16(acc[m][n][0], acc[m][n][1]); w.y = pk_bf16(acc[m][n][2], acc[m][n][3]);
                        *(u32x2*)(p.Pb + (size_t)tok * PCOLS + feat) = w;
                    }
            }
        }
    }
}
struct CmpALoad {
    const bf16_t* Pb; int colbase; int row0;
    __device__ __forceinline__ u32x4 load(int r, int k) const {
        const int rr = row0 + r, bg = rr >> 8, i = rr & 255, b = bg >> 1, g = bg & 1;
        const int l = k >> 6, d = k & 63;
        int tok = 16 * i + l; tok = tok < SEQ ? tok : SEQ - 1;
        return *(const u32x4*)(Pb + ((size_t)b * SEQ + tok) * PCOLS + colbase + g * 64 + d);
    }
};

__device__ __forceinline__ float log_sigmoid_f(float x) { return -(fmaxf(-x, 0.f) + log1pf(__expf(-fabsf(x)))); }

__device__ __forceinline__ void gla_cumsum(const Params& p, int tokg0, int h, float* sb, float* sglr, float* swa, float* sqt) {
    const int tid = threadIdx.x;
    for (int i = tid; i < 1024; i += 256) { int t = i >> 4, r = i & 15; sglr[i] = p.misc[(size_t)(tokg0 + t) * 64 + 24 + r]; }
    for (int i = tid; i < 1024; i += 256) { int r = i >> 6, d = i & 63; swa[i] = p.w_a2[r * 256 + h * 64 + d]; }
    __syncthreads();
    const int d = tid & 63, tq = tid >> 6;
    const float ba = p.b_a2[h * 64 + d];
    float w[16];
#pragma unroll
    for (int r = 0; r < 16; ++r) w[r] = swa[r * 64 + d];
    float run = 0.f;
#pragma unroll
    for (int tt = 0; tt < 16; ++tt) {
        const int t = tq * 16 + tt;
        float x = ba;
#pragma unroll
        for (int r = 0; r < 16; ++r) x += sglr[t * 16 + r] * w[r];
        run += log_sigmoid_f(x) * (1.f / 16.f);
        sb[t * 64 + d] = run;
    }
    sqt[tq * 64 + d] = run;
    __syncthreads();
    float off = 0.f;
#pragma unroll
    for (int q = 0; q < 3; ++q) if (q < tq) off += sqt[q * 64 + d];
#pragma unroll
    for (int tt = 0; tt < 16; ++tt) sb[(tq * 16 + tt) * 64 + d] += off;
    __syncthreads();
}

__device__ void gla_a_item(const Params& p, int item, char* smem) {
    const int tid = opaque_tid(), lane = tid & 63, wid = tid >> 6, fr = lane & 15, fq = lane >> 4;
    const int bh = item >> 6, c = item & 63, b = bh >> 2, h = bh & 3;
    const int tok0 = c * 64, tokg0 = b * SEQ + tok0;
    float* sb = (float*)smem; float* sglr = (float*)(smem + 16384); float* swa = (float*)(smem + 20480); float* sqt = (float*)(smem + 24576);
    char* skbT = smem + 25600; char* sVT = smem + 34816;
    gla_cumsum(p, tokg0, h, sb, sglr, swa, sqt);
    {
        const int d = tid & 63, tq = tid >> 6;
        const float bl = sb[63 * 64 + d];
        float v[16];
#pragma unroll
        for (int tt = 0; tt < 16; ++tt) {
            const int s = tq * 16 + tt;
            float k = bf2f(p.Pb[(size_t)(tokg0 + s) * PCOLS + P_GK + h * 64 + d]);
            v[tt] = k * __expf(bl - sb[s * 64 + d]);
        }
        u32x4 w0, w1;
        w0.x = pk_bf16(v[0], v[1]); w0.y = pk_bf16(v[2], v[3]); w0.z = pk_bf16(v[4], v[5]); w0.w = pk_bf16(v[6], v[7]);
        w1.x = pk_bf16(v[8], v[9]); w1.y = pk_bf16(v[10], v[11]); w1.z = pk_bf16(v[12], v[13]); w1.w = pk_bf16(v[14], v[15]);
        *(u32x4*)(skbT + (d * LDS_ROW + tq * 16) * 2) = w0;
        *(u32x4*)(skbT + (d * LDS_ROW + tq * 16 + 8) * 2) = w1;
        if (tid < 64) p.dec[(size_t)item * 64 + d] = __expf(bl);
    }
#pragma unroll
    for (int i = 0; i < 4; ++i) {
        const int cidx = tid + 256 * i, e = cidx >> 3, ch = (cidx & 7) * 8;
        *(u32x4*)(sVT + (e * LDS_ROW + ch) * 2) = *(const u32x4*)(p.VgT + ((size_t)bh * 128 + e) * SEQ + tok0 + ch);
    }
    __syncthreads();
    f32x4 acc[2][4];
#pragma unroll
    for (int m = 0; m < 2; ++m)
#pragma unroll
        for (int n = 0; n < 4; ++n) acc[m][n] = (f32x4){0.f, 0.f, 0.f, 0.f};
#pragma unroll
    for (int ks = 0; ks < 2; ++ks) {
        bf16x8 a[2], bb[4];
#pragma unroll
        for (int m = 0; m < 2; ++m) a[m] = *(const bf16x8*)(sVT + (((wid * 2 + m) * 16 + fr) * LDS_ROW + ks * 32 + fq * 8) * 2);
#pragma unroll
        for (int n = 0; n < 4; ++n) bb[n] = *(const bf16x8*)(skbT + ((n * 16 + fr) * LDS_ROW + ks * 32 + fq * 8) * 2);
#pragma unroll
        for (int m = 0; m < 2; ++m)
#pragma unroll
            for (int n = 0; n < 4; ++n) acc[m][n] = __builtin_amdgcn_mfma_f32_16x16x32_bf16(a[m], bb[n], acc[m][n], 0, 0, 0);
    }
    float* dst = p.dST + (size_t)item * 8192;
#pragma unroll
    for (int m = 0; m < 2; ++m)
#pragma unroll
        for (int n = 0; n < 4; ++n)
#pragma unroll
            for (int j = 0; j < 4; ++j) dst[((wid * 2 + m) * 16 + fq * 4 + j) * 64 + n * 16 + fr] = acc[m][n][j];
    __syncthreads();
}

__device__ void phase3(const Params& p, char* smem) {
    const int lane = threadIdx.x & 63, wid = threadIdx.x >> 6, wr = wid >> 1, wc = wid & 1, fr = lane & 15, fq = lane >> 4;
    for (int it = blockIdx.x; it < 256; it += gridDim.x) {
        const int kv = it >> 7, mt = (it >> 3) & 15, nt = (it >> 2) & 1, ks = it & 3;
        CmpALoad al{p.Pb, kv ? P_VC : P_KC, mt * 128};
        RowsBf16 bl{p.w1t + ((size_t)kv * 256 + nt * 128) * 2048, 2048};
        f32x4 acc[4][4];
        gemm_128<true, false>(al, bl, ks * 512, 8, smem, acc);
        float* dst = p.cpart + ((size_t)(kv * 4 + ks) * 2048 + mt * 128) * 256 + nt * 128;
#pragma unroll
        for (int m = 0; m < 4; ++m)
#pragma unroll
            for (int n = 0; n < 4; ++n)
                *(f32x4*)(dst + (size_t)(wr * 64 + m * 16 + fr) * 256 + wc * 64 + n * 16 + fq * 4) = acc[m][n];
    }
    const int first = (blockIdx.x + gridDim.x - (256 % gridDim.x)) % gridDim.x;
    for (int it = first; it < 1024; it += gridDim.x) gla_a_item(p, it, smem);
}

#define C2_ROW 264
__device__ void cmp2_item(const Params& p, int item, char* smem) {
    const int tid = opaque_tid(), lane = tid & 63, wid = tid >> 6, fr = lane & 15, fq = lane >> 4;
    const int kv = item >> 5, r0 = (item & 31) * 64;
    char* sA = smem; char* sB = smem + 64 * C2_ROW * 2;
    const float* b1 = p.bias1 + kv * 256;
#pragma unroll 2
    for (int i = 0; i < 8; ++i) {
        const int cidx = tid + 256 * i, row = cidx >> 5, col = (cidx & 31) * 8;
        f32x4 s0 = *(const f32x4*)(b1 + col), s1 = *(const f32x4*)(b1 + col + 4);
#pragma unroll
        for (int ks = 0; ks < 4; ++ks) {
            const float* src = p.cpart + ((size_t)(kv * 4 + ks) * 2048 + r0 + row) * 256 + col;
            s0 += *(const f32x4*)src; s1 += *(const f32x4*)(src + 4);
        }
        float o[8];
#pragma unroll
        for (int j = 0; j < 4; ++j) { o[j] = s0[j] / (1.f + __expf(-s0[j])); o[4 + j] = s1[j] / (1.f + __expf(-s1[j])); }
        u32x4 w; w.x = pk_bf16(o[0], o[1]); w.y = pk_bf16(o[2], o[3]); w.z = pk_bf16(o[4], o[5]); w.w = pk_bf16(o[6], o[7]);
        *(u32x4*)(sA + (row * C2_ROW + col) * 2) = w;
        *(u32x4*)(sB + (row * C2_ROW + col) * 2) = *(const u32x4*)(p.w2t + ((size_t)kv * 64 + row) * 256 + col);
    }
    __syncthreads();
    f32x4 acc[4];
#pragma unroll
    for (int n = 0; n < 4; ++n) acc[n] = (f32x4){0.f, 0.f, 0.f, 0.f};
#pragma unroll
    for (int ks = 0; ks < 8; ++ks) {
        bf16x8 a = *(const bf16x8*)(sA + ((wid * 16 + fr) * C2_ROW + ks * 32 + fq * 8) * 2);
#pragma unroll
        for (int n = 0; n < 4; ++n) {
            bf16x8 bb = *(const bf16x8*)(sB + ((n * 16 + fr) * C2_ROW + ks * 32 + fq * 8) * 2);
            acc[n] = kv ? __builtin_amdgcn_mfma_f32_16x16x32_bf16(a, bb, acc[n], 0, 0, 0)
                        : __builtin_amdgcn_mfma_f32_16x16x32_bf16(bb, a, acc[n], 0, 0, 0);
        }
    }
    if (kv == 0) {
#pragma unroll
        for (int n = 0; n < 4; ++n) {
            u32x2 w; w.x = pk_bf16(acc[n][0], acc[n][1]); w.y = pk_bf16(acc[n][2], acc[n][3]);
            *(u32x2*)(p.kc + (size_t)(r0 + wid * 16 + fr) * 64 + n * 16 + fq * 4) = w;
        }
    } else {
        const int r = r0 + wid * 16 + fq * 4, bg = r >> 8, i = r & 255;
#pragma unroll
        for (int n = 0; n < 4; ++n) {
            u32x2 w; w.x = pk_bf16(acc[n][0], acc[n][1]); w.y = pk_bf16(acc[n][2], acc[n][3]);
            *(u32x2*)(p.vcT + ((size_t)bg * 64 + n * 16 + fr) * 256 + i) = w;
        }
    }
    __syncthreads();
}

__device__ void phase4(const Params& p, char* smem) {
    for (int it = blockIdx.x; it < 64; it += gridDim.x) cmp2_item(p, it, smem);
    const int nthreads = gridDim.x * 256;
    for (int idx = blockIdx.x * 256 + threadIdx.x; idx < 16 * 8192; idx += nthreads) {
        const int bh = idx >> 13, ed = idx & 8191, d = idx & 63;
        float S = 0.f;
        for (int c0 = 0; c0 < 64; c0 += 8) {
            float dv[8], dc[8];
#pragma unroll
            for (int u = 0; u < 8; ++u) {
                dv[u] = p.dST[((size_t)(bh * 64 + c0 + u) << 13) + ed];
                dc[u] = p.dec[(size_t)(bh * 64 + c0 + u) * 64 + d];
            }
#pragma unroll
            for (int u = 0; u < 8; ++u) {
                p.ST[((size_t)(bh * 64 + c0 + u) << 13) + ed] = f2bf(S);
                S = dc[u] * S + dv[u];
            }
        }
    }
}
#define KT_BYTES (64 * LDS_ROW * 2)
#define C1_SCALE (0.125f * LOG2E)

template <bool PV>
__device__ __forceinline__ void flash_tile(const char* sK0, const char* sVT0, const bf16x8 (&qf)[2][2], float (&m)[2], float (&l)[2], f32x4 (&o)[2][4],
                                           float dl0, float dstride, float wlim, bool lanevalid, const float (&slope2)[2], int fr, int fq) {
#pragma unroll 1
    for (int half = 0; half < 2; ++half) {
        const char* sK = sK0 + half * 32 * LDS_ROW * 2;
        const char* sVT = sVT0 + half * 32 * 2;
        const float dl = dl0 + dstride * (float)(half * 32);
        bf16x8 kf[2][2], vf[4];
#pragma unroll
        for (int mk = 0; mk < 2; ++mk)
#pragma unroll
            for (int ks = 0; ks < 2; ++ks) kf[mk][ks] = *(const bf16x8*)(sK + ((mk * 16 + fr) * LDS_ROW + ks * 32 + fq * 8) * 2);
        if (PV) {
#pragma unroll
            for (int md = 0; md < 4; ++md) {
                u32x2 lo = *(const u32x2*)(sVT + ((md * 16 + fr) * LDS_ROW + fq * 4) * 2);
                u32x2 hi = *(const u32x2*)(sVT + ((md * 16 + fr) * LDS_ROW + 16 + fq * 4) * 2);
                u32x4 w; w.x = lo.x; w.y = lo.y; w.z = hi.x; w.w = hi.y;
                vf[md] = __builtin_bit_cast(bf16x8, w);
            }
        }
#pragma unroll
        for (int p = 0; p < 2; ++p) {
            f32x4 s[2];
#pragma unroll
            for (int mk = 0; mk < 2; ++mk) {
                s[mk] = (f32x4){0.f, 0.f, 0.f, 0.f};
#pragma unroll
                for (int ks = 0; ks < 2; ++ks) s[mk] = __builtin_amdgcn_mfma_f32_16x16x32_bf16(kf[mk][ks], qf[p][ks], s[mk], 0, 0, 0);
            }
            float mx = NEGF;
#pragma unroll
            for (int mk = 0; mk < 2; ++mk)
#pragma unroll
                for (int j = 0; j < 4; ++j) {
                    const float dk = dl + dstride * (float)(mk * 16 + j);
                    float v = s[mk][j] * C1_SCALE + slope2[p] * dk;
                    const bool ok = lanevalid && (dk <= 0.f) && (dk > wlim);
                    v = ok ? v : NEGF;
                    s[mk][j] = v; mx = fmaxf(mx, v);
                }
            mx = fmaxf(mx, __shfl_xor(mx, 16)); mx = fmaxf(mx, __shfl_xor(mx, 32));
            const float mn = fmaxf(m[p], mx);
            const float alpha = exp2f(m[p] - mn);
            m[p] = mn;
            float ps = 0.f;
#pragma unroll
            for (int mk = 0; mk < 2; ++mk)
#pragma unroll
                for (int j = 0; j < 4; ++j) {
                    float pv = (s[mk][j] > -1e29f) ? exp2f(s[mk][j] - mn) : 0.f;
                    s[mk][j] = pv; ps += pv;
                }
            l[p] = l[p] * alpha + ps;
            if (PV) {
#pragma unroll
                for (int md = 0; md < 4; ++md) o[p][md] *= alpha;
                u32x4 w;
                w.x = pk_bf16(s[0][0], s[0][1]); w.y = pk_bf16(s[0][2], s[0][3]);
                w.z = pk_bf16(s[1][0], s[1][1]); w.w = pk_bf16(s[1][2], s[1][3]);
                const bf16x8 pf = __builtin_bit_cast(bf16x8, w);
#pragma unroll
                for (int md = 0; md < 4; ++md) o[p][md] = __builtin_amdgcn_mfma_f32_16x16x32_bf16(vf[md], pf, o[p][md], 0, 0, 0);
            }
        }
    }
}

__device__ __forceinline__ void imp_tile(const char* sK, const bf16x8 (&qf)[2][2], const float (&m)[2], const float (&linv)[2],
                                         float dl, const float (&slope2)[2], int ct, float* simp, int fr, int fq) {
    bf16x8 kf[4][2];
#pragma unroll
    for (int mk = 0; mk < 4; ++mk)
#pragma unroll
        for (int ks = 0; ks < 2; ++ks) kf[mk][ks] = *(const bf16x8*)(sK + ((mk * 16 + fr) * LDS_ROW + ks * 32 + fq * 8) * 2);
    f32x4 hs[4];
#pragma unroll
    for (int mk = 0; mk < 4; ++mk) hs[mk] = (f32x4){0.f, 0.f, 0.f, 0.f};
#pragma unroll
    for (int p = 0; p < 2; ++p) {
#pragma unroll
        for (int mk = 0; mk < 4; ++mk) {
            f32x4 s = (f32x4){0.f, 0.f, 0.f, 0.f};
#pragma unroll
            for (int ks = 0; ks < 2; ++ks) s = __builtin_amdgcn_mfma_f32_16x16x32_bf16(kf[mk][ks], qf[p][ks], s, 0, 0, 0);
#pragma unroll
            for (int j = 0; j < 4; ++j) {
                const float dk = dl + 16.f * (float)(mk * 16 + j);
                const float v = s[j] * C1_SCALE + slope2[p] * dk;
                hs[mk][j] += (dk <= 0.f) ? exp2f(v - m[p]) * linv[p] : 0.f;
            }
        }
    }
#pragma unroll
    for (int mk = 0; mk < 4; ++mk) {
        const int jb = ct * 16 + mk * 4 + fq;
        const float a = hs[mk][0] + hs[mk][1] + hs[mk][2] + 0.5f * hs[mk][3];
        const float bnext = 0.5f * hs[mk][3];
        simp[fr * 64 + jb] += a;
        __builtin_amdgcn_wave_barrier();
        if (jb + 1 < 64) simp[fr * 64 + jb + 1] += bnext;
        __builtin_amdgcn_wave_barrier();
    }
}

__device__ void nsa_item(const Params& p, int item, char* smem) {
    const int tid = opaque_tid(), lane = tid & 63, wid = tid >> 6, fr = lane & 15, fq = lane >> 4;
    const int qb = 63 - (item >> 4), bg = (item >> 1) & 7, hp = item & 1, b = bg >> 1, g = bg & 1;
    const int q0 = qb * 64, t = q0 + wid * 16 + fr;
    const size_t tokg = (size_t)b * SEQ + t;
    float* simp = (float*)(smem + 4 * KT_BYTES) + wid * 1024;
    int* slist = (int*)(smem + 4 * KT_BYTES + 16384);
    unsigned long long* sunion = (unsigned long long*)(smem + 4 * KT_BYTES + 16384 + 1024);
    const int h0 = g * 4 + hp * 2, hx0 = g * 4 + (1 - hp) * 2;

    bf16x8 qf[2][2];
#pragma unroll
    for (int pp = 0; pp < 2; ++pp)
#pragma unroll
        for (int ks = 0; ks < 2; ++ks)
            qf[pp][ks] = *(const bf16x8*)(p.Pb + tokg * PCOLS + P_NQ + (h0 + pp) * 64 + ks * 32 + fq * 8);
    float slope2[2];
#pragma unroll
    for (int pp = 0; pp < 2; ++pp) slope2[pp] = exp2f(-(float)(h0 + pp + 1)) * LOG2E;

    float m[2], l[2], linv[2], mx_[2], lx[2], linvx[2]; f32x4 o[2][4];
    auto reset_state = [&]() __attribute__((always_inline)) {
#pragma unroll
        for (int pp = 0; pp < 2; ++pp) {
            m[pp] = NEGF; l[pp] = 0.f;
#pragma unroll
            for (int md = 0; md < 4; ++md) o[pp][md] = (f32x4){0.f, 0.f, 0.f, 0.f};
        }
    };
    auto finish_branch = [&](int br) __attribute__((always_inline)) {
        size_t tokg_o = tokg; asm volatile("" : "+v"(tokg_o));
#pragma unroll
        for (int pp = 0; pp < 2; ++pp) {
            float lt = l[pp]; lt += __shfl_xor(lt, 16); lt += __shfl_xor(lt, 32);
            const float inv = 1.f / fmaxf(lt, 1e-30f);
            linv[pp] = inv;
            const int h = h0 + pp;
            const float gl = p.misc[tokg_o * 64 + h * 3 + br];
            const float sc = inv / (1.f + __expf(-gl));
#pragma unroll
            for (int md = 0; md < 4; ++md) {
                f32x4 v = o[pp][md] * sc;
                float* dst = p.mixf + tokg_o * 512 + h * 64 + md * 16 + fq * 4;
                if (br == 0) { *(f32x4*)dst = v; }
                else if (br == 1) { f32x4 old = *(const f32x4*)dst; *(f32x4*)dst = old + v; }
                else {
                    f32x4 old = *(const f32x4*)dst; v += old;
                    u32x2 w; w.x = pk_bf16(v[0], v[1]); w.y = pk_bf16(v[2], v[3]);
                    *(u32x2*)(p.mixb + tokg_o * 1024 + h * 64 + md * 16 + fq * 4) = w;
                }
            }
        }
    };

    unsigned long long mymask = 0ull, wave_union = 0ull;
    u32x4 rk[2], rv[2];
    auto gl = [&](int e) __attribute__((always_inline)) {
        const int type = e >> 8, idx = e & 255;
        int tid_o = tid; asm volatile("" : "+v"(tid_o));
        const bf16_t* kbase; const bf16_t* vbase; size_t kst, vst;
        if (type == 2) { kbase = p.Pb + ((size_t)b * SEQ + idx * 64) * PCOLS + P_KS + g * 64; kst = PCOLS; vbase = p.VsT + (size_t)bg * 64 * SEQ + idx * 64; vst = SEQ; }
        else if (type == 3) { kbase = p.Pb + ((size_t)b * SEQ + idx * 64) * PCOLS + P_KW + g * 64; kst = PCOLS; vbase = p.VwT + (size_t)bg * 64 * SEQ + idx * 64; vst = SEQ; }
        else { kbase = p.kc + ((size_t)bg * 256 + idx * 64) * 64; kst = 64; vbase = p.vcT + (size_t)bg * 64 * 256 + idx * 64; vst = 256; }
#pragma unroll
        for (int i = 0; i < 2; ++i) {
            const int c = tid_o + 256 * i, row = c >> 3, ch = (c & 7) * 8;
            rk[i] = *(const u32x4*)(kbase + (size_t)row * kst + ch);
            rv[i] = *(const u32x4*)(vbase + (size_t)row * vst + ch);
        }
    };
    auto sw = [&](int buf) __attribute__((always_inline)) {
        char* sK = smem + buf * 2 * KT_BYTES; char* sV = sK + KT_BYTES;
#pragma unroll
        for (int i = 0; i < 2; ++i) {
            const int c = tid + 256 * i, row = c >> 3, ch = (c & 7) * 8;
            *(u32x4*)(sK + (row * LDS_ROW + ch) * 2) = rk[i];
            *(u32x4*)(sV + (row * LDS_ROW + ch) * 2) = rv[i];
        }
    };
    int prev_type = -1;
    auto process = [&](int e, int buf) __attribute__((always_inline)) {
        const int type = e >> 8, idx = e & 255;
        const char* sK = smem + buf * 2 * KT_BYTES; const char* sV = sK + KT_BYTES;
        if (type != prev_type) {
            if (type == 4) finish_branch(0);
            if (type == 1) {
#pragma unroll
                for (int pp = 0; pp < 2; ++pp) { float lt = lx[pp]; lt += __shfl_xor(lt, 16); lt += __shfl_xor(lt, 32); linvx[pp] = 1.f / fmaxf(lt, 1e-30f); }
            }
            if (type == 3) { finish_branch(1); reset_state(); }
            prev_type = type;
        }
        const float dlc = (float)(16 * (idx * 64 + fq * 4) + 31 - t);
        if (type == 4 || type == 5) {
            bf16x8 qx[2][2]; float slopex[2];
            size_t tokg_o = tokg; asm volatile("" : "+v"(tokg_o));
#pragma unroll
            for (int pp = 0; pp < 2; ++pp) {
                slopex[pp] = exp2f(-(float)(hx0 + pp + 1)) * LOG2E;
#pragma unroll
                for (int ks = 0; ks < 2; ++ks) qx[pp][ks] = *(const bf16x8*)(p.Pb + tokg_o * PCOLS + P_NQ + (hx0 + pp) * 64 + ks * 32 + fq * 8);
            }
            if (type == 4) flash_tile<false>(sK, sV, qx, mx_, lx, o, dlc, 16.f, -1e9f, true, slopex, fr, fq);
            else imp_tile(sK, qx, mx_, linvx, dlc, slopex, idx, simp, fr, fq);
        } else if (type == 1) {
            imp_tile(sK, qf, m, linv, dlc, slope2, idx, simp, fr, fq);
        } else {
            const bool run = (type != 2) || (((wave_union >> idx) & 1ull) != 0ull);
            if (run) {
                const float dl = (type == 0) ? dlc : (float)(idx * 64 + fq * 4 - t);
                const float dstride = (type == 0) ? 16.f : 1.f;
                const float wlim = (type == 3) ? -512.f : -1e9f;
                const bool lv = (type == 2) ? (((mymask >> idx) & 1ull) != 0ull) : true;
                flash_tile<true>(sK, sV, qf, m, l, o, dl, dstride, wlim, lv, slope2, fr, fq);
            }
        }
    };
    auto run_list = [&](int n) __attribute__((always_inline)) {
        if (n <= 0) return;
        gl(slist[0]); sw(0); __syncthreads();
#pragma unroll 1
        for (int i = 0; i < n; ++i) {
            const int e = slist[i];
            if (i + 1 < n) gl(slist[i + 1]);
            process(e, i & 1);
            if (i + 1 < n) sw((i + 1) & 1);
            __syncthreads();
        }
    };

    const int ncb = (4 * qb + 3) < NCMP ? (4 * qb + 3) : NCMP;
    const int nct = (ncb + 63) >> 6;
    for (int i = tid; i < 4096; i += 256) ((float*)(smem + 4 * KT_BYTES))[i] = 0.f;
    if (tid < nct) { slist[tid] = (0 << 8) | tid; slist[nct + tid] = (4 << 8) | tid; slist[2 * nct + tid] = (1 << 8) | tid; slist[3 * nct + tid] = (5 << 8) | tid; }
    __syncthreads();
#pragma unroll
    for (int pp = 0; pp < 2; ++pp) { mx_[pp] = NEGF; lx[pp] = 0.f; linvx[pp] = 0.f; linv[pp] = 0.f; }
    int nlist = 4 * nct;
#pragma unroll 1
    for (int stage = 0; stage < 2; ++stage) {
        if (stage == 1) {
            const int j = lane;
            const bool forced = (j == 0) || (j == qb) || (j == qb - 1);
            unsigned long long mine = 0ull;
#pragma unroll 1
            for (int qi = 0; qi < 16; ++qi) {
                const float sc = (j <= qb) ? (simp[qi * 64 + j] + (forced ? 1e4f : 0.f)) : NEGF;
                int rank = 0;
#pragma unroll 8
                for (int j2 = 0; j2 < 64; ++j2) {
                    const float s2 = __builtin_bit_cast(float, __builtin_amdgcn_readlane(__builtin_bit_cast(int, sc), j2));
                    rank += ((s2 > sc) || (s2 == sc && j2 < j)) ? 1 : 0;
                }
                const unsigned long long msk = __ballot(rank < 16);
                wave_union |= msk;
                if (fr == qi) mine = msk;
            }
            mymask = mine;
            if (lane == 0) sunion[wid] = wave_union;
            __syncthreads();
            const unsigned long long un = (sunion[0] | sunion[1] | sunion[2] | sunion[3]) & ((qb >= 63) ? ~0ull : ((1ull << (qb + 1)) - 1ull));
            const int wlo = (qb - 8) > 0 ? (qb - 8) : 0;
            const int nsl = __popcll(un);
            if (tid < 64 && ((un >> tid) & 1ull)) slist[__popcll(un & ((1ull << tid) - 1ull))] = (2 << 8) | tid;
            if (tid >= 64 && tid < 64 + (qb - wlo + 1)) slist[nsl + (tid - 64)] = (3 << 8) | (wlo + tid - 64);
            nlist = nsl + (qb - wlo + 1);
            __syncthreads();
            prev_type = 2;
        }
        reset_state();
        run_list(nlist);
    }
    finish_branch(2);
}

__device__ void gla_c_item(const Params& p, int item, char* smem) {
    const int tid = opaque_tid(), lane = tid & 63, wid = tid >> 6, fr = lane & 15, fq = lane >> 4;
    const int bh = item >> 6, c = item & 63, b = bh >> 2, h = bh & 3;
    const int tok0 = c * 64, tokg0 = b * SEQ + tok0;
    float* sb = (float*)smem; float* sglr = (float*)(smem + 16384); float* swa = (float*)(smem + 20480); float* sqt = (float*)(smem + 24576);
    char* sST = smem;
    char* sQB = smem + 25600; char* sKB = smem + 34816; char* sVT = smem + 44032;
    gla_cumsum(p, tokg0, h, sb, sglr, swa, sqt);
    {
        const int d = tid & 63, tq = tid >> 6;
#pragma unroll 4
        for (int tt = 0; tt < 16; ++tt) {
            const int tk = tq * 16 + tt;
            const float bt = sb[tk * 64 + d];
            const float q = bf2f(p.Pb[(size_t)(tokg0 + tk) * PCOLS + P_GQ + h * 64 + d]);
            const float k = bf2f(p.Pb[(size_t)(tokg0 + tk) * PCOLS + P_GK + h * 64 + d]);
            *(bf16_t*)(sQB + (tk * LDS_ROW + d) * 2) = f2bf(q * 0.125f * __expf(bt));
            *(bf16_t*)(sKB + (tk * LDS_ROW + d) * 2) = f2bf(k * __expf(-bt));
        }
    }
#pragma unroll
    for (int i = 0; i < 4; ++i) {
        const int cidx = tid + 256 * i, e = cidx >> 3, ch = (cidx & 7) * 8;
        *(u32x4*)(sVT + (e * LDS_ROW + ch) * 2) = *(const u32x4*)(p.VgT + ((size_t)bh * 128 + e) * SEQ + tok0 + ch);
    }
    __syncthreads();
#pragma unroll
    for (int i = 0; i < 4; ++i) {
        const int cidx = tid + 256 * i, e = cidx >> 3, ch = (cidx & 7) * 8;
        *(u32x4*)(sST + (e * LDS_ROW + ch) * 2) = *(const u32x4*)(p.ST + ((size_t)item << 13) + e * 64 + ch);
    }
    __syncthreads();
    bf16x8 qbf[2];
#pragma unroll
    for (int ks = 0; ks < 2; ++ks) qbf[ks] = *(const bf16x8*)(sQB + ((wid * 16 + fr) * LDS_ROW + ks * 32 + fq * 8) * 2);
    f32x4 sa[4];
#pragma unroll
    for (int ms = 0; ms < 4; ++ms) {
        sa[ms] = (f32x4){0.f, 0.f, 0.f, 0.f};
#pragma unroll
        for (int ks = 0; ks < 2; ++ks) {
            bf16x8 a = *(const bf16x8*)(sKB + ((ms * 16 + fr) * LDS_ROW + ks * 32 + fq * 8) * 2);
            sa[ms] = __builtin_amdgcn_mfma_f32_16x16x32_bf16(a, qbf[ks], sa[ms], 0, 0, 0);
        }
#pragma unroll
        for (int j = 0; j < 4; ++j) sa[ms][j] = (ms * 16 + fq * 4 + j <= wid * 16 + fr) ? sa[ms][j] : 0.f;
    }
    bf16x8 pf[2];
#pragma unroll
    for (int kk = 0; kk < 2; ++kk) {
        u32x4 w;
        w.x = pk_bf16(sa[2 * kk][0], sa[2 * kk][1]); w.y = pk_bf16(sa[2 * kk][2], sa[2 * kk][3]);
        w.z = pk_bf16(sa[2 * kk + 1][0], sa[2 * kk + 1][1]); w.w = pk_bf16(sa[2 * kk + 1][2], sa[2 * kk + 1][3]);
        pf[kk] = __builtin_bit_cast(bf16x8, w);
    }
    f32x4 oa[8];
    float sum = 0.f;
#pragma unroll
    for (int me = 0; me < 8; ++me) {
        f32x4 acc = (f32x4){0.f, 0.f, 0.f, 0.f};
#pragma unroll
        for (int ks = 0; ks < 2; ++ks) {
            bf16x8 a = *(const bf16x8*)(sST + ((me * 16 + fr) * LDS_ROW + ks * 32 + fq * 8) * 2);
            acc = __builtin_amdgcn_mfma_f32_16x16x32_bf16(a, qbf[ks], acc, 0, 0, 0);
        }
#pragma unroll
        for (int kk = 0; kk < 2; ++kk) {
            u32x2 lo = *(const u32x2*)(sVT + ((me * 16 + fr) * LDS_ROW + kk * 32 + fq * 4) * 2);
            u32x2 hi = *(const u32x2*)(sVT + ((me * 16 + fr) * LDS_ROW + kk * 32 + 16 + fq * 4) * 2);
            u32x4 w; w.x = lo.x; w.y = lo.y; w.z = hi.x; w.w = hi.y;
            acc = __builtin_amdgcn_mfma_f32_16x16x32_bf16(__builtin_bit_cast(bf16x8, w), pf[kk], acc, 0, 0, 0);
        }
        oa[me] = acc;
        sum += (acc[0] + acc[1]) + (acc[2] + acc[3]);
    }
    sum += __shfl_xor(sum, 16); sum += __shfl_xor(sum, 32);
    const float mu = sum * (1.f / 128.f);
    float var = 0.f;
#pragma unroll
    for (int me = 0; me < 8; ++me)
#pragma unroll
        for (int j = 0; j < 4; ++j) { const float dd = oa[me][j] - mu; var += dd * dd; }
    var += __shfl_xor(var, 16); var += __shfl_xor(var, 32);
    const float rstd = rsqrtf(var * (1.f / 128.f) + 1e-5f);
    const size_t tok = (size_t)tokg0 + wid * 16 + fr;
#pragma unroll
    for (int me = 0; me < 8; ++me) {
        const int e = me * 16 + fq * 4;
        const u32x2 rr = *(const u32x2*)(p.Pb + tok * PCOLS + P_GR + h * 128 + e);
        const f32x4 nw = *(const f32x4*)(p.norm_w + e);
        float r[4] = {bflo(rr.x), bfhi(rr.x), bflo(rr.y), bfhi(rr.y)};
        float ov[4];
#pragma unroll
        for (int j = 0; j < 4; ++j) ov[j] = (oa[me][j] - mu) * rstd * nw[j] * (r[j] / (1.f + __expf(-r[j])));
        u32x2 w; w.x = pk_bf16(ov[0], ov[1]); w.y = pk_bf16(ov[2], ov[3]);
        *(u32x2*)(p.mixb + tok * 1024 + 512 + h * 128 + e) = w;
    }
    __syncthreads();
}

__device__ void phase5(const Params& p, char* smem) {
    int* sidx = (int*)(smem + GEMM_SMEM - 16);
    for (;;) {
        __syncthreads();
        if (threadIdx.x == 0) *sidx = atomicAdd(&p.counts[264 + 0], 1);
        __syncthreads();
        const int it = *sidx;
        if (it >= 1024) break;
        nsa_item(p, it, smem);
    }
    for (;;) {
        __syncthreads();
        if (threadIdx.x == 0) *sidx = atomicAdd(&p.counts[264 + 1], 1);
        __syncthreads();
        const int it = *sidx;
        if (it >= 1024) break;
        gla_c_item(p, it, smem);
    }
}
__device__ void phase6(const Params& p, char* smem) {
    const int bid = blockIdx.x, xcd = bid & 7, rank = bid >> 3, nranks = gridDim.x >> 3;
    const int lane = threadIdx.x & 63, wid = threadIdx.x >> 6, wr = wid >> 1, wc = wid & 1, fr = lane & 15, fq = lane >> 4;
    for (int it = rank; it < 16 * 8; it += nranks) {
        const int mt = (it / 8) * 8 + xcd, nt = it % 8;
        RowsBf16 al{p.mixb + (size_t)mt * 128 * 1024, 1024};
        RowsBf16 bl{p.wot + (size_t)nt * 128 * 1024, 1024};
        f32x4 acc[4][4];
        gemm_128<true, false>(al, bl, 0, 16, smem, acc);
#pragma unroll
        for (int m = 0; m < 4; ++m)
#pragma unroll
            for (int n = 0; n < 4; ++n)
                *(f32x4*)(p.y1 + (size_t)(mt * 128 + wr * 64 + m * 16 + fr) * 1024 + nt * 128 + wc * 64 + n * 16 + fq * 4) = acc[m][n];
    }
}

__device__ void phase7(const Params& p) {
    const int lane = threadIdx.x & 63, gw = blockIdx.x * 4 + (threadIdx.x >> 6), nw = gridDim.x * 4;
    const float alpha = 1.189207115f;
    for (int row = gw; row < NTOK; row += nw) {
        const int b = row / SEQ;
        const float* md = p.mod + b * 6144;
        f32x4 v[4]; float s = 0.f;
#pragma unroll
        for (int i = 0; i < 4; ++i) {
            const int col = i * 256 + lane * 4;
            f32x4 xv = *(const f32x4*)(p.x + (size_t)row * 1024 + col), yv = *(const f32x4*)(p.y1 + (size_t)row * 1024 + col), ga = *(const f32x4*)(md + 2048 + col);
#pragma unroll
            for (int j = 0; j < 4; ++j) v[i][j] = alpha * xv[j] + (1.f + ga[j]) * yv[j];
            s += (v[i][0] + v[i][1]) + (v[i][2] + v[i][3]);
        }
        float mu = wave_sum(s) * (1.f / 1024.f);
        float q = 0.f;
#pragma unroll
        for (int i = 0; i < 4; ++i)
#pragma unroll
            for (int j = 0; j < 4; ++j) { float d = v[i][j] - mu; q += d * d; }
        float rstd = rsqrtf(wave_sum(q) * (1.f / 1024.f) + 1e-5f);
        s = 0.f;
#pragma unroll
        for (int i = 0; i < 4; ++i) {
            const int col = i * 256 + lane * 4;
            f32x4 g = *(const f32x4*)(p.ln1_g + col), bb = *(const f32x4*)(p.ln1_b + col);
#pragma unroll
            for (int j = 0; j < 4; ++j) v[i][j] = (v[i][j] - mu) * rstd * g[j] + bb[j];
            *(f32x4*)(p.x1 + (size_t)row * 1024 + col) = v[i];
            s += (v[i][0] + v[i][1]) + (v[i][2] + v[i][3]);
        }
        mu = wave_sum(s) * (1.f / 1024.f);
        q = 0.f;
#pragma unroll
        for (int i = 0; i < 4; ++i)
#pragma unroll
            for (int j = 0; j < 4; ++j) { float d = v[i][j] - mu; q += d * d; }
        rstd = rsqrtf(wave_sum(q) * (1.f / 1024.f) + 1e-5f);
#pragma unroll
        for (int i = 0; i < 4; ++i) {
            const int col = i * 256 + lane * 4;
            f32x4 sh = *(const f32x4*)(md + 3072 + col), sc = *(const f32x4*)(md + 4096 + col);
            float o[4];
#pragma unroll
            for (int j = 0; j < 4; ++j) o[j] = (v[i][j] - mu) * rstd * (1.f + sc[j]) + sh[j];
            u32x2 w; w.x = pk_bf16(o[0], o[1]); w.y = pk_bf16(o[2], o[3]);
            *(u32x2*)(p.hb + (size_t)row * 1024 + col) = w;
        }
    }
}

__device__ void phase8(const Params& p, char* smem) {
    const int lane = threadIdx.x & 63, wid = threadIdx.x >> 6, wr = wid >> 1, wc = wid & 1, fr = lane & 15, fq = lane >> 4;
    for (int it = blockIdx.x; it < 256; it += gridDim.x) {
        const int mt = it >> 1, nt = it & 1;
        RowsBf16 al{p.hb + (size_t)mt * 128 * 1024, 1024};
        RowsBf16 bl{p.wrt + (size_t)nt * 128 * 1024, 1024};
        f32x4 acc[4][4];
        gemm_128<true, false>(al, bl, 0, 16, smem, acc);
#pragma unroll
        for (int m = 0; m < 4; ++m)
#pragma unroll
            for (int n = 0; n < 4; ++n)
                *(f32x4*)(p.logits + (size_t)(mt * 128 + wr * 64 + m * 16 + fr) * 256 + nt * 128 + wc * 64 + n * 16 + fq * 4) = acc[m][n];
    }
}

__device__ void phase9(const Params& p) {
    const int lane = threadIdx.x & 63, gw = blockIdx.x * 4 + (threadIdx.x >> 6), nw = gridDim.x * 4;
    for (int tok = gw; tok < NTOK; tok += nw) {
        float s[4], sb[4];
        const f32x4 lg = *(const f32x4*)(p.logits + (size_t)tok * 256 + lane * 4);
        const f32x4 rb = *(const f32x4*)(p.rbias + lane * 4);
#pragma unroll
        for (int i = 0; i < 4; ++i) { s[i] = 1.f / (1.f + __expf(-lg[i])); sb[i] = s[i] + rb[i]; }
        float m1 = NEGF, m2 = NEGF;
#pragma unroll
        for (int i = 0; i < 4; ++i) { float v = sb[i]; if (v > m1) { m2 = m1; m1 = v; } else if (v > m2) m2 = v; }
#pragma unroll
        for (int mm = 1; mm < 8; mm <<= 1) {
            float o1 = __shfl_xor(m1, mm), o2 = __shfl_xor(m2, mm);
            float n1 = fmaxf(m1, o1);
            float n2 = fmaxf(fminf(m1, o1), fmaxf(m2, o2));
            m1 = n1; m2 = n2;
        }
        const float gs = m1 + m2;
        const int grp = lane >> 3;
        int grank = 0;
#pragma unroll
        for (int g2 = 0; g2 < 8; ++g2) { float o = __shfl(gs, g2 * 8); if (o > gs || (o == gs && g2 < grp)) ++grank; }
        const bool gsel = grank < 4;
        float cand[4];
#pragma unroll
        for (int i = 0; i < 4; ++i) cand[i] = gsel ? sb[i] : NEGF;
        float wsum = 0.f, myw = 0.f; int mye = 0;
#pragma unroll 1
        for (int k = 0; k < TOPK; ++k) {
            float bv = cand[0]; int bi = 0;
#pragma unroll
            for (int i = 1; i < 4; ++i) if (cand[i] > bv) { bv = cand[i]; bi = i; }
            float gv = bv; int ge = lane * 4 + bi;
#pragma unroll
            for (int mm = 1; mm < 64; mm <<= 1) {
                float ov = __shfl_xor(gv, mm); int oe = __shfl_xor(ge, mm);
                if (ov > gv || (ov == gv && oe < ge)) { gv = ov; ge = oe; }
            }
            float sel_s = 0.f;
            if ((ge >> 2) == lane) {
                const int i = ge & 3;
                sel_s = (i == 0) ? s[0] : (i == 1) ? s[1] : (i == 2) ? s[2] : s[3];
                if (i == 0) cand[0] = -3e38f; else if (i == 1) cand[1] = -3e38f; else if (i == 2) cand[2] = -3e38f; else cand[3] = -3e38f;
            }
            sel_s = __shfl(sel_s, ge >> 2);
            wsum += sel_s;
            if (lane == k) { myw = sel_s; mye = ge; }
        }
        if (lane < TOPK) {
            const int id = tok * NASSIGN + lane;
            p.ew[id] = myw / wsum * 2.5f;
            const int pos = atomicAdd(&p.counts[mye], 1);
            p.lists[(size_t)mye * NTOK + pos] = id;
        } else if (lane == TOPK) {
            p.ew[tok * NASSIGN + TOPK] = 1.f;
        }
    }
}

template <int NT_PER>
__device__ __forceinline__ int build_entries(const Params& p, int xcd, int* spre) {
    const int tid = threadIdx.x;
    __syncthreads();
    if (tid < 33) {
        int items;
        if (tid < 32) { const int cnt = p.counts[xcd + 8 * tid]; items = ((cnt + 127) >> 7) * NT_PER; }
        else items = 16 * NT_PER;
        spre[64 + tid] = items;
    }
    __syncthreads();
    if (tid == 0) { int a = 0; for (int i = 0; i < 33; ++i) { spre[i] = a; a += spre[64 + i]; } spre[33] = a; }
    __syncthreads();
    return spre[33];
}

template <int NT_PER>
__device__ __forceinline__ void decode_item(const Params& p, int xcd, const int* spre, int it, int& e, int& nt, int& mtile, int& cnt) {
    int ent = 0;
    for (int i = 1; i < 33; ++i) ent = (it >= spre[i]) ? i : ent;
    const int local = it - spre[ent];
    if (ent < 32) {
        e = xcd + 8 * ent; cnt = p.counts[e];
        const int mtc = (cnt + 127) >> 7;
        nt = local / mtc; mtile = local % mtc;
    } else {
        e = N_EXP; cnt = NTOK; nt = local >> 4; mtile = (local & 15) * 8 + xcd;
    }
}

__device__ void phase10(const Params& p, char* smem) {
    const int tid = threadIdx.x, bid = blockIdx.x, xcd = bid & 7, rank = bid >> 3, nranks = gridDim.x >> 3;
    const int lane = tid & 63, wid = tid >> 6, wr = wid >> 1, wc = wid & 1, fr = lane & 15, fq = lane >> 4;
    int* srow = (int*)(smem + GEMM_SMEM);
    int* spre = srow + 256;
    const int total = build_entries<4>(p, xcd, spre);
    for (int it = rank; it < total; it += nranks) {
        int e, nt, mtile, cnt;
        decode_item<4>(p, xcd, spre, it, e, nt, mtile, cnt);
        if (tid < 128) {
            const int pos = mtile * 128 + tid;
            int id = -1;
            if (pos < cnt) id = (e == N_EXP) ? (pos * NASSIGN + TOPK) : p.lists[(size_t)e * NTOK + pos];
            srow[tid] = id >= 0 ? id / NASSIGN : 0;
            srow[128 + tid] = id;
        }
        __syncthreads();
        GatherBf16 al{p.hb, 1024, srow};
        const float* Wg = (e == N_EXP) ? p.w_s_gate : p.w_e_gate + (size_t)e * 1024 * 256;
        const float* Wu = (e == N_EXP) ? p.w_s_up : p.w_e_up + (size_t)e * 1024 * 256;
        BF32GateUp bl{Wg + nt * 64, (long)(Wu - Wg), 256};
        f32x4 acc[4][4];
        gemm_128<true, true>(al, bl, 0, 16, smem, acc);
#pragma unroll
        for (int m = 0; m < 4; ++m) {
            const int id = srow[128 + wr * 64 + m * 16 + fr];
            if (id >= 0) {
#pragma unroll
                for (int n = 0; n < 2; ++n) {
                    float hv[4];
#pragma unroll
                    for (int j = 0; j < 4; ++j) { const float gte = acc[m][n][j]; hv[j] = gte / (1.f + __expf(-gte)) * acc[m][n + 2][j]; }
                    u32x2 w; w.x = pk_bf16(hv[0], hv[1]); w.y = pk_bf16(hv[2], hv[3]);
                    *(u32x2*)(p.hid + (size_t)id * 256 + nt * 64 + wc * 32 + n * 16 + fq * 4) = w;
                }
            }
        }
        __syncthreads();
    }
}

__device__ void phase11(const Params& p, char* smem) {
    const int tid = threadIdx.x, bid = blockIdx.x, xcd = bid & 7, rank = bid >> 3, nranks = gridDim.x >> 3;
    const int lane = tid & 63, wid = tid >> 6, wr = wid >> 1, wc = wid & 1, fr = lane & 15, fq = lane >> 4;
    int* srow = (int*)(smem + GEMM_SMEM);
    int* spre = srow + 256;
    const int total = build_entries<8>(p, xcd, spre);
    for (int it = rank; it < total; it += nranks) {
        int e, nt, mtile, cnt;
        decode_item<8>(p, xcd, spre, it, e, nt, mtile, cnt);
        if (tid < 128) {
            const int pos = mtile * 128 + tid;
            int id = -1;
            if (pos < cnt) id = (e == N_EXP) ? (pos * NASSIGN + TOPK) : p.lists[(size_t)e * NTOK + pos];
            srow[tid] = id >= 0 ? id : 0;
            srow[128 + tid] = id;
        }
        __syncthreads();
        GatherBf16 al{p.hid, 256, srow};
        const float* Wd = (e == N_EXP) ? p.w_s_down : p.w_e_down + (size_t)e * 256 * 1024;
        BF32Plain bl{Wd + nt * 128, 1024};
        f32x4 acc[4][4];
        gemm_128<true, true>(al, bl, 0, 4, smem, acc);
#pragma unroll
        for (int m = 0; m < 4; ++m) {
            const int id = srow[128 + wr * 64 + m * 16 + fr];
            if (id >= 0) {
                const float w8 = p.ew[id];
#pragma unroll
                for (int n = 0; n < 4; ++n) {
                    u32x2 w; w.x = pk_bf16(acc[m][n][0] * w8, acc[m][n][1] * w8); w.y = pk_bf16(acc[m][n][2] * w8, acc[m][n][3] * w8);
                    *(u32x2*)(p.outk + (size_t)id * 1024 + nt * 128 + wc * 64 + n * 16 + fq * 4) = w;
                }
            }
        }
        __syncthreads();
    }
}

__device__ void phase12(const Params& p) {
    const int lane = threadIdx.x & 63, gw = blockIdx.x * 4 + (threadIdx.x >> 6), nw = gridDim.x * 4;
    const float alpha = 1.189207115f;
    for (int row = gw; row < NTOK; row += nw) {
        const int b = row / SEQ;
        const float* md = p.mod + b * 6144;
        float v[16];
#pragma unroll
        for (int i = 0; i < 16; ++i) v[i] = 0.f;
#pragma unroll
        for (int k = 0; k < NASSIGN; ++k) {
#pragma unroll
            for (int cidx = 0; cidx < 2; ++cidx) {
                const u32x4 w = *(const u32x4*)(p.outk + ((size_t)row * NASSIGN + k) * 1024 + cidx * 512 + lane * 8);
                v[cidx * 8 + 0] += bflo(w.x); v[cidx * 8 + 1] += bfhi(w.x); v[cidx * 8 + 2] += bflo(w.y); v[cidx * 8 + 3] += bfhi(w.y);
                v[cidx * 8 + 4] += bflo(w.z); v[cidx * 8 + 5] += bfhi(w.z); v[cidx * 8 + 6] += bflo(w.w); v[cidx * 8 + 7] += bfhi(w.w);
            }
        }
        float s = 0.f;
#pragma unroll
        for (int cidx = 0; cidx < 2; ++cidx)
#pragma unroll
            for (int hh = 0; hh < 2; ++hh) {
                const int col = cidx * 512 + lane * 8 + hh * 4;
                const f32x4 xv = *(const f32x4*)(p.x1 + (size_t)row * 1024 + col), ga = *(const f32x4*)(md + 5120 + col);
#pragma unroll
                for (int j = 0; j < 4; ++j) { float t = alpha * xv[j] + (1.f + ga[j]) * v[cidx * 8 + hh * 4 + j]; v[cidx * 8 + hh * 4 + j] = t; s += t; }
            }
        const float mu = wave_sum(s) * (1.f / 1024.f);
        float q = 0.f;
#pragma unroll
        for (int i = 0; i < 16; ++i) { float d = v[i] - mu; q += d * d; }
        const float rstd = rsqrtf(wave_sum(q) * (1.f / 1024.f) + 1e-5f);
#pragma unroll
        for (int cidx = 0; cidx < 2; ++cidx)
#pragma unroll
            for (int hh = 0; hh < 2; ++hh) {
                const int col = cidx * 512 + lane * 8 + hh * 4;
                const f32x4 g = *(const f32x4*)(p.ln2_g + col), bb = *(const f32x4*)(p.ln2_b + col);
                f32x4 o;
#pragma unroll
                for (int j = 0; j < 4; ++j) o[j] = (v[cidx * 8 + hh * 4 + j] - mu) * rstd * g[j] + bb[j];
                *(f32x4*)(p.out + (size_t)row * 1024 + col) = o;
            }
    }
}

#define XB_TMO      128
#define XB_XCNT(j)  (256  + 64 * (j))
#define XB_XSUB(j)  (1280 + 64 * (j))
#define XB_XGEN(j)  (2304 + 64 * (j))
#define XB_TOP      3328
#define XB_TOPGEN   3392
#define XCD_BAR_WORDS 3456
#define XB_SPIN_CAP (1u << 22)
#define LAS __attribute__((address_space(3)))
__device__ __forceinline__ unsigned xb_ld(unsigned* p) { return __hip_atomic_load(p, __ATOMIC_RELAXED, __HIP_MEMORY_SCOPE_AGENT); }
__device__ __forceinline__ unsigned xb_add(unsigned* p, unsigned v) { return __hip_atomic_fetch_add(p, v, __ATOMIC_RELAXED, __HIP_MEMORY_SCOPE_AGENT); }
__device__ __forceinline__ unsigned xb_xcc_id() { return (unsigned)__builtin_amdgcn_s_getreg((3 << 11) | 20) & 0xFu; }
#define XB_SPIN(cond, bar) do { unsigned _sp = 0; while (cond) { __builtin_amdgcn_s_sleep(1); \
    if ((++_sp & 255u) == 0u) { if (xb_ld(&(bar)[XB_TMO])) break; if (_sp > XB_SPIN_CAP) { atomicAdd(&(bar)[XB_TMO], 1u); break; } } } } while (0)
struct XcdBarrier { unsigned* bar; unsigned x; volatile LAS unsigned* st; };
__device__ __forceinline__ XcdBarrier xcd_barrier_post(unsigned* bar, volatile LAS unsigned* st) {
    XcdBarrier b; b.bar = bar; b.x = xb_xcc_id(); b.st = st;
    if (threadIdx.x == 0) (void)xb_add(&bar[XB_XCNT(b.x)], 1u);
    return b;
}
__device__ __forceinline__ void xcd_barrier_complete(unsigned* bar, unsigned x, unsigned& nloc, unsigned& nx) {
    const unsigned G = gridDim.x * gridDim.y * gridDim.z;
    unsigned sum, cnt, mine, sp = 0u;
    for (;;) {
        sum = 0u; cnt = 0u; mine = 0u;
#pragma unroll
        for (unsigned j = 0; j < 16; ++j) { const unsigned c = xb_ld(&bar[XB_XCNT(j)]); sum += c; cnt += (c > 0u) ? 1u : 0u; mine = (j == x) ? c : mine; }
        if (sum == G) break;
        __builtin_amdgcn_s_sleep(1);
        if ((++sp & 255u) == 0u) { if (xb_ld(&bar[XB_TMO])) break; if (sp > XB_SPIN_CAP) { atomicAdd(&bar[XB_TMO], 1u); break; } }
    }
    nloc = mine > 0u ? mine : 1u; nx = cnt > 0u ? cnt : 1u;
}
__device__ __forceinline__ void xcd_barrier(const XcdBarrier& b) {
    asm volatile("s_waitcnt vmcnt(0)" ::: "memory");
    __syncthreads();
    if (threadIdx.x == 0) {
        unsigned* bar = b.bar;
        __builtin_amdgcn_s_waitcnt(0);
        unsigned nloc = b.st[0], nx = b.st[1];
        if (nloc == 0u) { xcd_barrier_complete(bar, b.x, nloc, nx); b.st[0] = nloc; b.st[1] = nx; }
        const unsigned old = xb_add(&bar[XB_XSUB(b.x)], 1u);
        const unsigned gen = old / nloc;
        if (old + 1u == (gen + 1u) * nloc) {
            __builtin_amdgcn_fence(__ATOMIC_RELEASE, "agent");
            asm volatile("s_waitcnt vmcnt(0)" ::: "memory");
            const unsigned og = xb_add(&bar[XB_TOP], 1u);
            const unsigned tg = og / nx;
            if (og + 1u == (tg + 1u) * nx) xb_add(&bar[XB_TOPGEN], 1u);
            else XB_SPIN(xb_ld(&bar[XB_TOPGEN]) == tg, bar);
            __builtin_amdgcn_fence(__ATOMIC_ACQUIRE, "agent");
            xb_add(&bar[XB_XGEN(b.x)], 1u);
            asm volatile("s_waitcnt vmcnt(0)" ::: "memory");
        } else {
            XB_SPIN(xb_ld(&bar[XB_XGEN(b.x)]) == gen, bar);
            __builtin_amdgcn_fence(__ATOMIC_ACQUIRE, "agent");
            asm volatile("s_waitcnt vmcnt(0)" ::: "memory");
        }
    }
    __syncthreads();
}

#define MEGA_SMEM (GEMM_SMEM + 2048)
#define N_PHASES 13
__global__ void __launch_bounds__(256, 2) mega(Params p) {
    extern __shared__ __attribute__((aligned(16))) char smem[];
    volatile LAS unsigned* st = (volatile LAS unsigned*)(smem + GEMM_SMEM + 2032);
    XcdBarrier xb; xb.bar = p.bar; xb.x = 0; xb.st = st;
    if (p.ph_hi - p.ph_lo > 1) {
        if (threadIdx.x == 0) { st[0] = 0u; st[1] = 0u; }
        __syncthreads();
        xb = xcd_barrier_post(p.bar, st);
    }
#define RUN_PHASE(N, CALL) if (p.ph_lo <= N && N < p.ph_hi) { if (N > p.ph_lo) xcd_barrier(xb); CALL; }
    RUN_PHASE(0, phase0(p, smem))
    RUN_PHASE(1, phase1(p))
    RUN_PHASE(2, phase2(p, smem))
    RUN_PHASE(3, phase3(p, smem))
    RUN_PHASE(4, phase4(p, smem))
    RUN_PHASE(5, phase5(p, smem))
    RUN_PHASE(6, phase6(p, smem))
    RUN_PHASE(7, phase7(p))
    RUN_PHASE(8, phase8(p, smem))
    RUN_PHASE(9, phase9(p))
    RUN_PHASE(10, phase10(p, smem))
    RUN_PHASE(11, phase11(p, smem))
    RUN_PHASE(12, phase12(p))
}
#if DBG
struct NaiveBufs { float *mod, *h, *proj, *flat, *hidk, *hidv, *kc, *vc, *mix, *ograw, *y, *x1, *logits; };
__device__ __forceinline__ void dbg_pair(int seam, size_t i, const Params& p, const NaiveBufs& nb, float& a, float& b, bool& use) {
    use = true; a = 0.f; b = 0.f;
    switch (seam) {
        case 0: {
            a = nb.mod[i]; b = p.mod[i]; break; }
        case 1: {
            size_t tok = i / PCOLS; int n = (int)(i % PCOLS);
            int src = win_srccol(n);
            bool transposed = (n >= 896 && n < 1024) || (n >= 1152 && n < 1280) || (n >= 1792 && n < 2304) || n >= 2816;
            if (transposed || src < 0) { use = false; break; }
            a = nb.proj[tok * IN_COLS + src]; b = bf2f(p.Pb[i]); break; }
        case 2: {
            size_t half = (size_t)BATCH * 128 * SEQ; int which = i >= half; size_t j = which ? i - half : i;
            int t = (int)(j % SEQ); int f = (int)((j / SEQ) % 128); int bb = (int)(j / ((size_t)SEQ * 128));
            a = nb.proj[((size_t)bb * SEQ + t) * IN_COLS + (which ? C_VW : C_VS) + f];
            b = bf2f(which ? p.VwT[j] : p.VsT[j]); break; }
        case 3: {
            size_t nv = (size_t)BATCH * 512 * SEQ;
            if (i < nv) { int t = (int)(i % SEQ); int f = (int)((i / SEQ) % 512); int bb = (int)(i / ((size_t)SEQ * 512));
                a = nb.proj[((size_t)bb * SEQ + t) * IN_COLS + C_GV + f]; b = bf2f(p.VgT[i]); }
            else { size_t j = i - nv; size_t tok = j / 40; int f = (int)(j % 40);
                a = nb.proj[tok * IN_COLS + (f < 24 ? C_NG + f : C_GLR + f - 24)]; b = p.misc[tok * 64 + f]; }
            break; }
        case 4: {
            size_t nk = (size_t)BATCH * NCMP * 2 * 64;
            size_t j = i < nk ? i : i - nk;
            int d = (int)(j % 64); int g = (int)((j / 64) % 2); int ii = (int)((j / 128) % NCMP); int bb = (int)(j / (128 * NCMP));
            if (i < nk) { a = nb.kc[j]; b = bf2f(p.kc[((size_t)(bb * 2 + g) * 256 + ii) * 64 + d]); }
            else { a = nb.vc[j]; b = bf2f(p.vcT[((size_t)(bb * 2 + g) * 64 + d) * 256 + ii]); }
            break; }
        case 5: {
            size_t tok = i / 512; int cidx = (int)(i % 512);
            a = nb.mix[tok * 1024 + cidx]; b = bf2f(p.mixb[tok * 1024 + cidx]); break; }
        case 6: {
            size_t tok = i / 512; int cidx = (int)(i % 512);
            a = nb.mix[tok * 1024 + 512 + cidx]; b = bf2f(p.mixb[tok * 1024 + 512 + cidx]); break; }
        case 7: { a = nb.x1[i]; b = p.x1[i]; break; }
        case 8: { a = nb.logits[i]; b = p.logits[i]; break; }
    }
}
__global__ __launch_bounds__(256) void dbg_compare(int seam, size_t n, Params p, NaiveBufs nb, float* dbg) {
    __shared__ float red[256];
    float sd = 0.f, sa = 0.f;
    for (size_t i = (size_t)blockIdx.x * 256 + threadIdx.x; i < n; i += (size_t)gridDim.x * 256) {
        float a, b; bool use;
        dbg_pair(seam, i, p, nb, a, b, use);
        if (use) { float d = a - b; if (!(d == d)) d = 1e10f; sd += d * d; sa += a * a; }
    }
    sd = blk_sum(sd, red); sa = blk_sum(sa, red);
    if (threadIdx.x == 0) { atomicAdd(&dbg[2 * seam], sd); atomicAdd(&dbg[2 * seam + 1], sa); }
}
__global__ void dbg_decide(float* dbg, int nseams, int report_seam) {
    float code = 0.f;
    for (int k = 0; k < nseams; ++k) {
        float err = dbg[2 * k] / fmaxf(dbg[2 * k + 1], 1e-30f);
        const float thr = (k == 5) ? 3e-2f : 1e-3f;
        bool bad = !(err < thr);
        if (bad || k == report_seam) {
            float lg = log10f(fmaxf(err, 1e-12f));
            int dgt = (int)floorf(lg) + 6; dgt = dgt < 0 ? 0 : (dgt > 9 ? 9 : dgt);
            code = 100.f * (k + 1) + 10.f * dgt; break;
        }
    }
    dbg[64] = code;
}
__global__ void dbg_apply(const float* dbg, float* out, size_t n) {
    float code = dbg[64];
    if (code <= 0.f) return;
    float cst = sqrtf(code);
    for (size_t i = (size_t)blockIdx.x * 256 + threadIdx.x; i < n; i += (size_t)gridDim.x * 256) out[i] = cst;
}
#endif

extern "C" void kernel_launch(void* const* d_in, const int* in_sizes, int n_in, void* d_out, int out_size,
                              void* d_ws, size_t ws_size, hipStream_t stream) {
    Params p{};
    const float** ins = (const float**)&p;
    for (int i = 0; i < 27; ++i) ins[i] = (const float*)d_in[i];
    p.out = (float*)d_out;

    char* ws = (char*)d_ws;
    size_t off = 0;
    auto alloc = [&](size_t bytes) { char* q = ws + off; off += (bytes + 255) & ~(size_t)255; return q; };
#if DBG
    NaiveBufs nb{};
    nb.mod = (float*)alloc(4 * 6144 * 4);
    nb.h = (float*)alloc((size_t)NTOK * 1024 * 4);
    nb.proj = (float*)alloc((size_t)NTOK * IN_COLS * 4);
    nb.flat = (float*)alloc((size_t)2040 * 2048 * 4);
    nb.hidk = (float*)alloc((size_t)2040 * 256 * 4);
    nb.hidv = (float*)alloc((size_t)2040 * 256 * 4);
    nb.kc = (float*)alloc((size_t)2040 * 64 * 4);
    nb.vc = (float*)alloc((size_t)2040 * 64 * 4);
    nb.mix = (float*)alloc((size_t)NTOK * 1024 * 4);
    nb.ograw = (float*)alloc((size_t)NTOK * 512 * 4);
    nb.y = (float*)alloc((size_t)NTOK * 1024 * 4);
    nb.x1 = (float*)alloc((size_t)NTOK * 1024 * 4);
    nb.logits = (float*)alloc((size_t)NTOK * 256 * 4);
    float* dbg = (float*)alloc(1024);
    p.outk = (bf16_t*)ws;
    p.hid = (bf16_t*)(ws + (((size_t)NTOK * NASSIGN * 1024 * 2 + 255) & ~(size_t)255));
#else
    p.hid = (bf16_t*)alloc((size_t)NTOK * NASSIGN * 256 * 2);
    p.outk = (bf16_t*)alloc((size_t)NTOK * NASSIGN * 1024 * 2);
#endif
    p.mod = (float*)alloc(4 * 6144 * 4);
    p.bias1 = (float*)alloc(2 * 256 * 4);
    p.wint = (bf16_t*)alloc((size_t)PCOLS * 1024 * 2);
    p.wot = (bf16_t*)alloc((size_t)1024 * 1024 * 2);
    p.wrt = (bf16_t*)alloc((size_t)256 * 1024 * 2);
    p.w1t = (bf16_t*)alloc((size_t)2 * 256 * 2048 * 2);
    p.w2t = (bf16_t*)alloc((size_t)2 * 64 * 256 * 2);
    p.hb = (bf16_t*)alloc((size_t)NTOK * 1024 * 2);
    p.Pb = (bf16_t*)alloc((size_t)NTOK * PCOLS * 2);
    p.VsT = (bf16_t*)alloc((size_t)BATCH * 128 * SEQ * 2);
    p.VwT = (bf16_t*)alloc((size_t)BATCH * 128 * SEQ * 2);
    p.VgT = (bf16_t*)alloc((size_t)BATCH * 512 * SEQ * 2);
    p.misc = (float*)alloc((size_t)NTOK * 64 * 4);
    p.cpart = (float*)alloc((size_t)2 * 4 * 2048 * 256 * 4);
    p.kc = (bf16_t*)alloc((size_t)8 * 256 * 64 * 2);
    p.vcT = (bf16_t*)alloc((size_t)8 * 64 * 256 * 2);
    p.dST = (float*)alloc((size_t)16 * 64 * 8192 * 4);
    p.dec = (float*)alloc((size_t)16 * 64 * 64 * 4);
    p.ST = (bf16_t*)alloc((size_t)16 * 64 * 8192 * 2);
    p.mixf = (float*)alloc((size_t)NTOK * 512 * 4);
    p.mixb = (bf16_t*)alloc((size_t)NTOK * 1024 * 2);
    p.y1 = (float*)alloc((size_t)NTOK * 1024 * 4);
    p.x1 = (float*)alloc((size_t)NTOK * 1024 * 4);
    p.logits = (float*)alloc((size_t)NTOK * 256 * 4);
    p.ew = (float*)alloc((size_t)NTOK * NASSIGN * 4);
    p.counts = (int*)alloc(512 * 4);
    p.lists = (int*)alloc((size_t)N_EXP * NTOK * 4);
    p.bar = (unsigned*)alloc(XCD_BAR_WORDS * 4);
    if (off > ws_size) return;

    static int grid = 0;
    if (grid == 0) {
        int dev = 0, cus = 0, per_cu = 0;
        (void)hipGetDevice(&dev);
        (void)hipDeviceGetAttribute(&cus, hipDeviceAttributeMultiprocessorCount, dev);
        (void)hipFuncSetAttribute((const void*)mega, hipFuncAttributeMaxDynamicSharedMemorySize, MEGA_SMEM);
        (void)hipOccupancyMaxActiveBlocksPerMultiprocessor(&per_cu, (const void*)mega, 256, MEGA_SMEM);
        if (per_cu > 2) per_cu = 2;
        if (per_cu < 1) per_cu = 1;
        grid = cus * per_cu;
        grid &= ~7;
    }
    (void)hipMemsetAsync(p.bar, 0, XCD_BAR_WORDS * 4, stream);

#if DBG
    (void)hipMemsetAsync(dbg, 0, 1024, stream);
    nk_mod<<<dim3(24, 4), 256, 0, stream>>>(p.c, p.w_mod, p.b_mod, nb.mod);
    nk_lnmod<<<NTOK, 256, 0, stream>>>(p.x, nb.mod, 0, 1024, nb.h);
    nk_gemm<<<dim3((IN_COLS + 63) / 64, NTOK / 64), 256, 0, stream>>>(nb.h, 1024, p.w_in, IN_COLS, nb.proj, IN_COLS, NTOK, IN_COLS, 1024);
    nk_flat<<<2040, 256, 0, stream>>>(nb.proj, C_KC, p.pos_k, nb.flat);
    nk_gemm<<<dim3(4, 32), 256, 0, stream>>>(nb.flat, 2048, p.w1_k, 256, nb.hidk, 256, 2040, 256, 2048);
    nk_silu<<<(2040 * 256 + 255) / 256, 256, 0, stream>>>(nb.hidk, 2040 * 256);
    nk_gemm<<<dim3(1, 32), 256, 0, stream>>>(nb.hidk, 256, p.w2_k, 64, nb.kc, 64, 2040, 64, 256);
    nk_flat<<<2040, 256, 0, stream>>>(nb.proj, C_VC, p.pos_v, nb.flat);
    nk_gemm<<<dim3(4, 32), 256, 0, stream>>>(nb.flat, 2048, p.w1_v, 256, nb.hidv, 256, 2040, 256, 2048);
    nk_silu<<<(2040 * 256 + 255) / 256, 256, 0, stream>>>(nb.hidv, 2040 * 256);
    nk_gemm<<<dim3(1, 32), 256, 0, stream>>>(nb.hidv, 256, p.w2_v, 64, nb.vc, 64, 2040, 64, 256);
    nk_nsa<<<NTOK, 256, 0, stream>>>(nb.proj, nb.kc, nb.vc, nb.mix);
    nk_gla<<<64, 256, 0, stream>>>(nb.proj, p.w_a2, p.b_a2, nb.ograw);
    nk_gla_norm<<<NTOK, 256, 0, stream>>>(nb.ograw, nb.proj, p.norm_w, nb.mix);
    nk_gemm<<<dim3(16, NTOK / 64), 256, 0, stream>>>(nb.mix, 1024, p.w_o, 1024, nb.y, 1024, NTOK, 1024, 1024);
    nk_resln<<<NTOK, 256, 0, stream>>>(p.x, nb.y, nb.mod, 2048, p.ln1_g, p.ln1_b, nb.x1);
    nk_lnmod<<<NTOK, 256, 0, stream>>>(nb.x1, nb.mod, 3072, 4096, nb.h);
    nk_gemm<<<dim3(4, NTOK / 64), 256, 0, stream>>>(nb.h, 1024, p.w_router, 256, nb.logits, 256, NTOK, 256, 1024);
    auto cmp = [&](int seam, size_t n) { dbg_compare<<<1024, 256, 0, stream>>>(seam, n, p, nb, dbg); };
#endif

#if SINGLE_LAUNCH
    p.ph_lo = 0; p.ph_hi = N_PHASES;
    mega<<<grid, 256, MEGA_SMEM, stream>>>(p);
#else
    for (int ph = 0; ph < N_PHASES; ++ph) {
        p.ph_lo = ph; p.ph_hi = ph + 1;
        mega<<<grid, 256, MEGA_SMEM, stream>>>(p);
#if DBG
        if (ph == 0) cmp(0, 4 * 6144);
        if (ph == 2) { cmp(1, (size_t)NTOK * PCOLS); cmp(2, (size_t)2 * BATCH * 128 * SEQ); cmp(3, (size_t)BATCH * 512 * SEQ + (size_t)NTOK * 40); }
        if (ph == 4) cmp(4, (size_t)2 * BATCH * NCMP * 128);
        if (ph == 5) { cmp(5, (size_t)NTOK * 512); cmp(6, (size_t)NTOK * 512); }
        if (ph == 7) cmp(7, (size_t)NTOK * 1024);
        if (ph == 8) cmp(8, (size_t)NTOK * 256);
#endif
    }
#endif
#if DBG
    dbg_decide<<<1, 1, 0, stream>>>(dbg, 9, DBG_REPORT);
    dbg_apply<<<1024, 256, 0, stream>>>(dbg, p.out, (size_t)NTOK * 1024);
#endif
}
```

```cpp
#include <hip/hip_runtime.h>
#include <hip/hip_bf16.h>
#include <stdint.h>

#define D_MODEL 1024
#define BATCH 4
#define SEQ 4096
#define NTOK (BATCH * SEQ)
#define IN_COLS 2856
#define NCMP 255
#define NEGF (-1e30f)
#define C_NQ 0
#define C_KC 512
#define C_VC 640
#define C_KS 768
#define C_VS 896
#define C_KW 1024
#define C_VW 1152
#define C_NG 1280
#define C_GQ 1304
#define C_GK 1560
#define C_GV 1816
#define C_GLR 2328
#define C_GR 2344
#define N_EXP 256
#define TOPK 8

__device__ __forceinline__ float siluf(float x) { return x / (1.f + __expf(-x)); }
__device__ __forceinline__ float sigmoidf_(float x) { return 1.f / (1.f + __expf(-x)); }

__device__ __forceinline__ float blk_sum(float v, float* red) {
    int t = threadIdx.x;
    __syncthreads();
    red[t] = v; __syncthreads();
    for (int s = 128; s > 0; s >>= 1) { if (t < s) red[t] += red[t + s]; __syncthreads(); }
    float r = red[0];
    return r;
}
__device__ __forceinline__ float blk_max(float v, float* red) {
    int t = threadIdx.x;
    __syncthreads();
    red[t] = v; __syncthreads();
    for (int s = 128; s > 0; s >>= 1) { if (t < s) red[t] = fmaxf(red[t], red[t + s]); __syncthreads(); }
    float r = red[0];
    return r;
}

#define DBG 0
#define SINGLE_LAUNCH 1
#define DBG_REPORT -1
#define REP_PHASE -1
#if DBG
__global__ __launch_bounds__(256) void nk_mod(const float* c, const float* w_mod, const float* b_mod, float* mod) {
    int j = blockIdx.x * 256 + threadIdx.x; int b = blockIdx.y;
    float acc = b_mod[j];
    for (int k = 0; k < D_MODEL; ++k) acc += siluf(c[b * D_MODEL + k]) * w_mod[(size_t)k * 6144 + j];
    mod[b * 6144 + j] = acc;
}

__global__ __launch_bounds__(256) void nk_lnmod(const float* x, const float* mod, int sh_off, int sc_off, float* out) {
    __shared__ float red[256];
    int row = blockIdx.x; int b = row / SEQ; int t = threadIdx.x;
    const float* xr = x + (size_t)row * D_MODEL;
    float v[4]; float s = 0.f;
    for (int i = 0; i < 4; ++i) { v[i] = xr[t + 256 * i]; s += v[i]; }
    float mu = blk_sum(s, red) * (1.f / D_MODEL);
    float q = 0.f;
    for (int i = 0; i < 4; ++i) { float d = v[i] - mu; q += d * d; }
    float var = blk_sum(q, red) * (1.f / D_MODEL);
    float rstd = rsqrtf(var + 1e-5f);
    for (int i = 0; i < 4; ++i) {
        int col = t + 256 * i;
        out[(size_t)row * D_MODEL + col] = (v[i] - mu) * rstd * (1.f + mod[b * 6144 + sc_off + col]) + mod[b * 6144 + sh_off + col];
    }
}

__global__ __launch_bounds__(256) void nk_resln(const float* x, const float* y, const float* mod, int ga_off, const float* g, const float* bb, float* out) {
    __shared__ float red[256];
    int row = blockIdx.x; int b = row / SEQ; int t = threadIdx.x;
    const float alpha = 1.189207115f;
    float v[4]; float s = 0.f;
    for (int i = 0; i < 4; ++i) {
        int col = t + 256 * i;
        v[i] = alpha * x[(size_t)row * D_MODEL + col] + (1.f + mod[b * 6144 + ga_off + col]) * y[(size_t)row * D_MODEL + col];
        s += v[i];
    }
    float mu = blk_sum(s, red) * (1.f / D_MODEL);
    float q = 0.f;
    for (int i = 0; i < 4; ++i) { float d = v[i] - mu; q += d * d; }
    float var = blk_sum(q, red) * (1.f / D_MODEL);
    float rstd = rsqrtf(var + 1e-5f);
    for (int i = 0; i < 4; ++i) {
        int col = t + 256 * i;
        out[(size_t)row * D_MODEL + col] = (v[i] - mu) * rstd * g[col] + bb[col];
    }
}

__global__ __launch_bounds__(256) void nk_gemm(const float* A, int lda, const float* B, int ldb, float* C, int ldc, int M, int N, int K) {
    __shared__ float sA[16][64 + 1];
    __shared__ float sB[16][64 + 1];
    int tx = threadIdx.x & 15, ty = threadIdx.x >> 4;
    int m0 = blockIdx.y * 64, n0 = blockIdx.x * 64;
    float acc[4][4];
    for (int i = 0; i < 4; ++i) for (int j = 0; j < 4; ++j) acc[i][j] = 0.f;
    for (int k0 = 0; k0 < K; k0 += 16) {
        for (int e = threadIdx.x; e < 1024; e += 256) {
            int r = e >> 4, kk = e & 15;
            int gm = m0 + r;
            sA[kk][r] = (gm < M) ? A[(size_t)gm * lda + k0 + kk] : 0.f;
            int kb = e >> 6, nn = e & 63;
            int gn = n0 + nn;
            sB[kb][nn] = (gn < N) ? B[(size_t)(k0 + kb) * ldb + gn] : 0.f;
        }
        __syncthreads();
#pragma unroll
        for (int kk = 0; kk < 16; ++kk) {
            float a[4], bv[4];
#pragma unroll
            for (int i = 0; i < 4; ++i) a[i] = sA[kk][ty * 4 + i];
#pragma unroll
            for (int j = 0; j < 4; ++j) bv[j] = sB[kk][tx * 4 + j];
#pragma unroll
            for (int i = 0; i < 4; ++i)
#pragma unroll
                for (int j = 0; j < 4; ++j) acc[i][j] += a[i] * bv[j];
        }
        __syncthreads();
    }
#pragma unroll
    for (int i = 0; i < 4; ++i)
#pragma unroll
        for (int j = 0; j < 4; ++j) {
            int gm = m0 + ty * 4 + i, gn = n0 + tx * 4 + j;
            if (gm < M && gn < N) C[(size_t)gm * ldc + gn] = acc[i][j];
        }
}

__global__ __launch_bounds__(256) void nk_flat(const float* proj, int col0, const float* pos, float* flat) {
    int r = blockIdx.x;
    int g = r & 1; int bi = r >> 1; int i = bi % NCMP; int b = bi / NCMP;
    for (int e = threadIdx.x; e < 2048; e += 256) {
        int l = e >> 6, d = e & 63;
        flat[(size_t)r * 2048 + e] = proj[((size_t)b * SEQ + 16 * i + l) * IN_COLS + col0 + g * 64 + d] + pos[l * 64 + d];
    }
}
__global__ void nk_silu(float* x, int n) { int i = blockIdx.x * 256 + threadIdx.x; if (i < n) x[i] = siluf(x[i]); }

__global__ __launch_bounds__(256) void nk_nsa(const float* proj, const float* kc, const float* vc, float* mix) {
    __shared__ float sq[8][64];
    __shared__ float sp[1024];
    __shared__ float red[256];
    __shared__ float simp[64];
    __shared__ float sscore[64];
    __shared__ int sidx[16];
    __shared__ float sout[8][64];
    __shared__ float spart[4][64];
    const int tid = threadIdx.x;
    const int bt = blockIdx.x; const int b = bt / SEQ, t = bt % SEQ;
    const float* prow = proj + (size_t)bt * IN_COLS;
    for (int e = tid; e < 512; e += 256) { sq[e >> 6][e & 63] = prow[C_NQ + e] * 0.125f; sout[e >> 6][e & 63] = 0.f; }
    __syncthreads();
    const int tblk = t >> 6;
    const int dd = tid & 63, part = tid >> 6;
    for (int g = 0; g < 2; ++g) {
        if (tid < 64) simp[tid] = 0.f;
        __syncthreads();
        for (int hp = 0; hp < 4; ++hp) {
            int h = g * 4 + hp;
            float slope = exp2f(-(float)(h + 1));
            float s = NEGF; bool valid = false;
            if (tid < NCMP) {
                int ce = 16 * tid + 31;
                valid = (t >= ce);
                if (valid) {
                    const float* kr = kc + (((size_t)b * NCMP + tid) * 2 + g) * 64;
                    float a = 0.f;
                    for (int d = 0; d < 64; ++d) a += sq[h][d] * kr[d];
                    s = a - slope * (float)(t - ce);
                }
            }
            float m = blk_max(s, red);
            float e = valid ? __expf(s - m) : 0.f;
            float sum = blk_sum(e, red);
            float p = e / fmaxf(sum, 1e-30f);
            __syncthreads();
            sp[tid] = p;
            __syncthreads();
            float a = 0.f;
            for (int i = part; i < NCMP; i += 4) a += sp[i] * vc[(((size_t)b * NCMP + i) * 2 + g) * 64 + dd];
            spart[part][dd] = a;
            __syncthreads();
            if (tid < 64) {
                float o = spart[0][tid] + spart[1][tid] + spart[2][tid] + spart[3][tid];
                float gate = sigmoidf_(prow[C_NG + h * 3 + 0]);
                sout[h][tid] += gate * o;
                int j = tid;
                float im = sp[4 * j] + sp[4 * j + 1] + sp[4 * j + 2] + 0.5f * sp[4 * j + 3] + (j > 0 ? 0.5f * sp[4 * j - 1] : 0.f);
                simp[j] += im;
            }
            __syncthreads();
        }
        if (tid < 64) {
            int j = tid;
            bool forced = (j == 0) || (j == tblk) || (j == tblk - 1);
            sscore[j] = (j <= tblk) ? (simp[j] + (forced ? 1e4f : 0.f)) : NEGF;
        }
        __syncthreads();
        if (tid < 64) {
            int j = tid; float sj = sscore[j]; int rank = 0;
            for (int j2 = 0; j2 < 64; ++j2) { float s2 = sscore[j2]; if (s2 > sj || (s2 == sj && j2 < j)) ++rank; }
            if (rank < 16) sidx[rank] = j;
        }
        __syncthreads();
        for (int hp = 0; hp < 4; ++hp) {
            int h = g * 4 + hp;
            float slope = exp2f(-(float)(h + 1));
            float sv[4]; bool vl[4]; float mx = NEGF;
            for (int r = 0; r < 4; ++r) {
                int kk = tid + 256 * r;
                int kpos = sidx[kk >> 6] * 64 + (kk & 63);
                vl[r] = (kpos <= t);
                sv[r] = NEGF;
                if (vl[r]) {
                    const float* kr = proj + ((size_t)b * SEQ + kpos) * IN_COLS + C_KS + g * 64;
                    float a = 0.f;
                    for (int d = 0; d < 64; ++d) a += sq[h][d] * kr[d];
                    sv[r] = a - slope * (float)(t - kpos);
                }
                mx = fmaxf(mx, sv[r]);
            }
            float m = blk_max(mx, red);
            float es = 0.f; float ev[4];
            for (int r = 0; r < 4; ++r) { ev[r] = vl[r] ? __expf(sv[r] - m) : 0.f; es += ev[r]; }
            float sum = blk_sum(es, red);
            float inv = 1.f / fmaxf(sum, 1e-30f);
            __syncthreads();
            for (int r = 0; r < 4; ++r) sp[tid + 256 * r] = ev[r] * inv;
            __syncthreads();
            float a = 0.f;
            for (int kk = part; kk < 1024; kk += 4) {
                float p = sp[kk];
                if (p != 0.f) {
                    int kpos = sidx[kk >> 6] * 64 + (kk & 63);
                    a += p * proj[((size_t)b * SEQ + kpos) * IN_COLS + C_VS + g * 64 + dd];
                }
            }
            spart[part][dd] = a;
            __syncthreads();
            if (tid < 64) {
                float o = spart[0][tid] + spart[1][tid] + spart[2][tid] + spart[3][tid];
                float gate = sigmoidf_(prow[C_NG + h * 3 + 1]);
                sout[h][tid] += gate * o;
            }
            __syncthreads();
        }
        for (int hp = 0; hp < 4; ++hp) {
            int h = g * 4 + hp;
            float slope = exp2f(-(float)(h + 1));
            float sv[2]; bool vl[2]; float mx = NEGF;
            for (int r = 0; r < 2; ++r) {
                int kk = tid + 256 * r;
                int kpos = t - 511 + kk;
                vl[r] = (kpos >= 0);
                sv[r] = NEGF;
                if (vl[r]) {
                    const float* kr = proj + ((size_t)b * SEQ + kpos) * IN_COLS + C_KW + g * 64;
                    float a = 0.f;
                    for (int d = 0; d < 64; ++d) a += sq[h][d] * kr[d];
                    sv[r] = a - slope * (float)(t - kpos);
                }
                mx = fmaxf(mx, sv[r]);
            }
            float m = blk_max(mx, red);
            float es = 0.f; float ev[2];
            for (int r = 0; r < 2; ++r) { ev[r] = vl[r] ? __expf(sv[r] - m) : 0.f; es += ev[r]; }
            float sum = blk_sum(es, red);
            float inv = 1.f / fmaxf(sum, 1e-30f);
            __syncthreads();
            for (int r = 0; r < 2; ++r) sp[tid + 256 * r] = ev[r] * inv;
            __syncthreads();
            float a = 0.f;
            for (int kk = part; kk < 512; kk += 4) {
                float p = sp[kk];
                if (p != 0.f) {
                    int kpos = t - 511 + kk;
                    a += p * proj[((size_t)b * SEQ + kpos) * IN_COLS + C_VW + g * 64 + dd];
                }
            }
            spart[part][dd] = a;
            __syncthreads();
            if (tid < 64) {
                float o = spart[0][tid] + spart[1][tid] + spart[2][tid] + spart[3][tid];
                float gate = sigmoidf_(prow[C_NG + h * 3 + 2]);
                sout[h][tid] += gate * o;
            }
            __syncthreads();
        }
    }
    for (int e = tid; e < 512; e += 256) mix[(size_t)bt * D_MODEL + e] = sout[e >> 6][e & 63];
}

__global__ __launch_bounds__(256) void nk_gla(const float* proj, const float* w_a2, const float* b_a2, float* ograw) {
    __shared__ float sqv[64], skv[64], sav[64];
    __shared__ float red[8][32];
    const int tid = threadIdx.x;
    const int es = blockIdx.x & 3, bh = blockIdx.x >> 2, h = bh & 3, b = bh >> 2;
    const int e = tid & 31, dg = tid >> 5;
    float S[8];
    for (int i = 0; i < 8; ++i) S[i] = 0.f;
    for (int t = 0; t < SEQ; ++t) {
        const float* prow = proj + ((size_t)b * SEQ + t) * IN_COLS;
        if (tid < 64) {
            int d = tid;
            sqv[d] = prow[C_GQ + h * 64 + d] * 0.125f;
            skv[d] = prow[C_GK + h * 64 + d];
            float x = b_a2[h * 64 + d];
            for (int r = 0; r < 16; ++r) x += prow[C_GLR + r] * w_a2[r * 256 + h * 64 + d];
            float ls = -(fmaxf(-x, 0.f) + log1pf(__expf(-fabsf(x))));
            sav[d] = __expf(ls * (1.f / 16.f));
        }
        __syncthreads();
        float v = prow[C_GV + h * 128 + es * 32 + e];
        float part = 0.f;
        for (int i = 0; i < 8; ++i) {
            int d = dg * 8 + i;
            S[i] = sav[d] * S[i] + skv[d] * v;
            part += sqv[d] * S[i];
        }
        red[dg][e] = part;
        __syncthreads();
        if (tid < 32) {
            float o = 0.f;
            for (int i = 0; i < 8; ++i) o += red[i][tid];
            ograw[((size_t)b * SEQ + t) * 512 + h * 128 + es * 32 + tid] = o;
        }
    }
}
__global__ __launch_bounds__(256) void nk_gla_norm(const float* ograw, const float* proj, const float* norm_w, float* mix) {
    int wid = (blockIdx.x * 256 + threadIdx.x) >> 6; int lane = threadIdx.x & 63;
    int tok = wid >> 2, h = wid & 3;
    const float* o = ograw + (size_t)tok * 512 + h * 128;
    float a = o[lane], c = o[lane + 64];
    float s = a + c;
    for (int m = 32; m > 0; m >>= 1) s += __shfl_xor(s, m);
    float mu = s * (1.f / 128.f);
    float q = (a - mu) * (a - mu) + (c - mu) * (c - mu);
    for (int m = 32; m > 0; m >>= 1) q += __shfl_xor(q, m);
    float rstd = rsqrtf(q * (1.f / 128.f) + 1e-5f);
    const float* r = proj + (size_t)tok * IN_COLS + C_GR + h * 128;
    mix[(size_t)tok * D_MODEL + 512 + h * 128 + lane] = (a - mu) * rstd * norm_w[lane] * siluf(r[lane]);
    mix[(size_t)tok * D_MODEL + 512 + h * 128 + lane + 64] = (c - mu) * rstd * norm_w[lane + 64] * siluf(r[lane + 64]);
}

__global__ __launch_bounds__(256) void nk_route(const float* logits, const float* rbias, int* eidx, float* ew, int* counts, int* lists) {
    int wid = (blockIdx.x * 256 + threadIdx.x) >> 6; int lane = threadIdx.x & 63;
    int tok = wid;
    float s[4], sb[4];
    for (int i = 0; i < 4; ++i) { float l = logits[(size_t)tok * 256 + lane * 4 + i]; s[i] = 1.f / (1.f + __expf(-l)); sb[i] = s[i] + rbias[lane * 4 + i]; }
    float m1 = NEGF, m2 = NEGF;
    for (int i = 0; i < 4; ++i) { float v = sb[i]; if (v > m1) { m2 = m1; m1 = v; } else if (v > m2) m2 = v; }
    for (int m = 1; m < 8; m <<= 1) {
        float o1 = __shfl_xor(m1, m), o2 = __shfl_xor(m2, m);
        float n1 = fmaxf(m1, o1);
        float n2 = fmaxf(fminf(m1, o1), fmaxf(m2, o2));
        m1 = n1; m2 = n2;
    }
    float gs = m1 + m2;
    int grp = lane >> 3;
    int grank = 0;
    for (int g2 = 0; g2 < 8; ++g2) { float o = __shfl(gs, g2 * 8); if (o > gs || (o == gs && g2 < grp)) ++grank; }
    bool gsel = grank < 4;
    float cand[4];
    for (int i = 0; i < 4; ++i) cand[i] = gsel ? sb[i] : NEGF;
    float wsum = 0.f; float myw = 0.f; int mye = 0;
    for (int k = 0; k < TOPK; ++k) {
        float bv = cand[0]; int bi = 0;
        for (int i = 1; i < 4; ++i) if (cand[i] > bv) { bv = cand[i]; bi = i; }
        int be = lane * 4 + bi;
        float gv = bv; int ge = be;
        for (int m = 1; m < 64; m <<= 1) {
            float ov = __shfl_xor(gv, m); int oe = __shfl_xor(ge, m);
            if (ov > gv || (ov == gv && oe < ge)) { gv = ov; ge = oe; }
        }
        float sel_s = 0.f;
        if ((ge >> 2) == lane) {
            int i = ge & 3;
            sel_s = (i == 0) ? s[0] : (i == 1) ? s[1] : (i == 2) ? s[2] : s[3];
            if (i == 0) cand[0] = -3e38f; else if (i == 1) cand[1] = -3e38f; else if (i == 2) cand[2] = -3e38f; else cand[3] = -3e38f;
        }
        sel_s = __shfl(sel_s, ge >> 2);
        wsum += sel_s;
        if (lane == k) { myw = sel_s; mye = ge; }
    }
    if (lane < TOPK) {
        float w = myw / wsum * 2.5f;
        eidx[tok * 8 + lane] = mye; ew[tok * 8 + lane] = w;
        int pos = atomicAdd(&counts[mye], 1);
        lists[(size_t)mye * NTOK + pos] = tok * 8 + lane;
    }
}

__global__ __launch_bounds__(256) void nk_moe(const float* h2, const float* wg, const float* wu, const float* wd,
                                              const float* sg, const float* su, const float* sd,
                                              const int* counts, const int* lists, const float* ew, float* acc) {
    __shared__ float sh[8][D_MODEL];
    __shared__ float shid[8][256];
    __shared__ int stok[8]; __shared__ float sw[8];
    const int e = blockIdx.y, chunk = blockIdx.x, tid = threadIdx.x;
    const int cnt = (e == N_EXP) ? NTOK : counts[e];
    if (chunk * 8 >= cnt) return;
    const float* Wg = (e == N_EXP) ? sg : wg + (size_t)e * D_MODEL * 256;
    const float* Wu = (e == N_EXP) ? su : wu + (size_t)e * D_MODEL * 256;
    const float* Wd = (e == N_EXP) ? sd : wd + (size_t)e * 256 * D_MODEL;
    if (tid < 8) {
        int p = chunk * 8 + tid;
        if (p < cnt) {
            if (e == N_EXP) { stok[tid] = p; sw[tid] = 1.f; }
            else { int id = lists[(size_t)e * NTOK + p]; stok[tid] = id >> 3; sw[tid] = ew[id]; }
        } else { stok[tid] = -1; sw[tid] = 0.f; }
    }
    __syncthreads();
    for (int m = 0; m < 8; ++m) {
        int tk = stok[m];
        for (int k = tid; k < D_MODEL; k += 256) sh[m][k] = (tk >= 0) ? h2[(size_t)tk * D_MODEL + k] : 0.f;
    }
    __syncthreads();
    float ag[8], au[8];
#pragma unroll
    for (int m = 0; m < 8; ++m) { ag[m] = 0.f; au[m] = 0.f; }
    for (int k = 0; k < D_MODEL; ++k) {
        float g = Wg[(size_t)k * 256 + tid], u = Wu[(size_t)k * 256 + tid];
#pragma unroll
        for (int m = 0; m < 8; ++m) { float hv = sh[m][k]; ag[m] += hv * g; au[m] += hv * u; }
    }
#pragma unroll
    for (int m = 0; m < 8; ++m) shid[m][tid] = siluf(ag[m]) * au[m];
    __syncthreads();
    for (int jj = 0; jj < 4; ++jj) {
        int j = tid + 256 * jj;
        float ao[8];
#pragma unroll
        for (int m = 0; m < 8; ++m) ao[m] = 0.f;
        for (int n = 0; n < 256; ++n) {
            float w = Wd[(size_t)n * D_MODEL + j];
#pragma unroll
            for (int m = 0; m < 8; ++m) ao[m] += shid[m][n] * w;
        }
#pragma unroll
        for (int m = 0; m < 8; ++m) { int tk = stok[m]; if (tk >= 0) atomicAdd(&acc[(size_t)tk * D_MODEL + j], ao[m] * sw[m]); }
    }
}

#endif
typedef unsigned short bf16_t;
typedef short bf16x8 __attribute__((ext_vector_type(8)));
typedef float f32x4 __attribute__((ext_vector_type(4)));
typedef unsigned u32x4 __attribute__((ext_vector_type(4)));
typedef unsigned u32x2 __attribute__((ext_vector_type(2)));

#define PCOLS 2944
#define P_NQ 0
#define P_KC 512
#define P_VC 640
#define P_KS 768
#define P_VS 896
#define P_KW 1024
#define P_VW 1152
#define P_GQ 1280
#define P_GK 1536
#define P_GV 1792
#define P_GR 2304
#define P_MISC 2816
#define NASSIGN 9
#define LOG2E 1.4426950408889634f

typedef float f32x2_t __attribute__((ext_vector_type(2)));
typedef __bf16 bf16x2_t __attribute__((ext_vector_type(2)));
__device__ __forceinline__ unsigned pk_bf16(float lo, float hi) { const f32x2_t v = {lo, hi}; return __builtin_bit_cast(unsigned, __builtin_convertvector(v, bf16x2_t)); }
__device__ __forceinline__ float bflo(unsigned u) { return __uint_as_float(u << 16); }
__device__ __forceinline__ float bfhi(unsigned u) { return __uint_as_float(u & 0xffff0000u); }
__device__ __forceinline__ float bf2f(bf16_t v) { return __uint_as_float(((unsigned)v) << 16); }
__device__ __forceinline__ int opaque_tid() { int t = threadIdx.x; asm volatile("" : "+v"(t)); return t; }
__device__ __forceinline__ bf16_t f2bf(float f) { return (bf16_t)(pk_bf16(f, 0.f) & 0xffffu); }

#if DBG
#define WS_BASE ((size_t)560 << 20)
#else
#define WS_BASE ((size_t)0)
#endif
#define WS_ALIGN(x) (((size_t)(x) + 255) & ~(size_t)255)
constexpr size_t OFF_mod = WS_BASE;
constexpr size_t OFF_bias1 = OFF_mod + WS_ALIGN(4*6144*4);
constexpr size_t OFF_wint = OFF_bias1 + WS_ALIGN(2*256*4);
constexpr size_t OFF_wot = OFF_wint + WS_ALIGN((size_t)PCOLS*1024*2);
constexpr size_t OFF_wrt = OFF_wot + WS_ALIGN((size_t)1024*1024*2);
constexpr size_t OFF_w1t = OFF_wrt + WS_ALIGN((size_t)256*1024*2);
constexpr size_t OFF_w2t = OFF_w1t + WS_ALIGN((size_t)2*256*2048*2);
constexpr size_t OFF_hb = OFF_w2t + WS_ALIGN((size_t)2*64*256*2);
constexpr size_t OFF_Pb = OFF_hb + WS_ALIGN((size_t)NTOK*1024*2);
constexpr size_t OFF_VsT = OFF_Pb + WS_ALIGN((size_t)NTOK*PCOLS*2);
constexpr size_t OFF_VwT = OFF_VsT + WS_ALIGN((size_t)BATCH*128*SEQ*2);
constexpr size_t OFF_VgT = OFF_VwT + WS_ALIGN((size_t)BATCH*128*SEQ*2);
constexpr size_t OFF_misc = OFF_VgT + WS_ALIGN((size_t)BATCH*512*SEQ*2);
constexpr size_t OFF_cpart = OFF_misc + WS_ALIGN((size_t)NTOK*64*4);
constexpr size_t OFF_kc = OFF_cpart + WS_ALIGN((size_t)2*4*2048*256*4);
constexpr size_t OFF_vcT = OFF_kc + WS_ALIGN((size_t)8*256*64*2);
constexpr size_t OFF_dST = OFF_vcT + WS_ALIGN((size_t)8*64*256*2);
constexpr size_t OFF_dec = OFF_dST + WS_ALIGN((size_t)16*64*8192*4);
constexpr size_t OFF_ST = OFF_dec + WS_ALIGN((size_t)16*64*64*4);
constexpr size_t OFF_mixf = OFF_ST + WS_ALIGN((size_t)16*64*8192*2);
constexpr size_t OFF_mixb = OFF_mixf + WS_ALIGN((size_t)NTOK*512*4);
constexpr size_t OFF_y1 = OFF_mixb + WS_ALIGN((size_t)NTOK*1024*2);
constexpr size_t OFF_x1 = OFF_y1 + WS_ALIGN((size_t)NTOK*1024*4);
constexpr size_t OFF_logits = OFF_x1 + WS_ALIGN((size_t)NTOK*1024*4);
constexpr size_t OFF_ew = OFF_logits + WS_ALIGN((size_t)NTOK*256*4);
constexpr size_t OFF_counts = OFF_ew + WS_ALIGN((size_t)NTOK*NASSIGN*4);
constexpr size_t OFF_lists = OFF_counts + WS_ALIGN(512*4);
constexpr size_t OFF_bar = OFF_lists + WS_ALIGN((size_t)N_EXP*NTOK*4);
constexpr size_t OFF_hid = OFF_bar + WS_ALIGN(4096*4);
constexpr size_t OFF_outk = OFF_hid + WS_ALIGN((size_t)NTOK*NASSIGN*256*2);
constexpr size_t OFF_selm = OFF_outk + WS_ALIGN((size_t)NTOK*NASSIGN*1024*2);
constexpr size_t OFF_selu = OFF_selm + WS_ALIGN((size_t)NTOK*2*8);
constexpr size_t OFF_mixf2 = OFF_selu + WS_ALIGN((size_t)8*64*4*8);
constexpr size_t WS_TOTAL = OFF_mixf2 + WS_ALIGN((size_t)NTOK*512*4);
struct Params {
    const float *x, *c, *w_mod, *b_mod, *w_in, *pos_k, *w1_k, *w2_k, *pos_v, *w1_v, *w2_v, *w_a2, *b_a2, *norm_w, *w_o, *ln1_g, *ln1_b,
        *w_router, *rbias, *w_e_gate, *w_e_up, *w_e_down, *w_s_gate, *w_s_up, *w_s_down, *ln2_g, *ln2_b;
    float* out;
    char* ws;
    int ph_lo, ph_hi;
    __device__ __forceinline__ float* mod() const { return (float*)(ws + OFF_mod); }
    __device__ __forceinline__ float* bias1() const { return (float*)(ws + OFF_bias1); }
    __device__ __forceinline__ bf16_t* wint() const { return (bf16_t*)(ws + OFF_wint); }
    __device__ __forceinline__ bf16_t* wot() const { return (bf16_t*)(ws + OFF_wot); }
    __device__ __forceinline__ bf16_t* wrt() const { return (bf16_t*)(ws + OFF_wrt); }
    __device__ __forceinline__ bf16_t* w1t() const { return (bf16_t*)(ws + OFF_w1t); }
    __device__ __forceinline__ bf16_t* w2t() const { return (bf16_t*)(ws + OFF_w2t); }
    __device__ __forceinline__ bf16_t* hb() const { return (bf16_t*)(ws + OFF_hb); }
    __device__ __forceinline__ bf16_t* Pb() const { return (bf16_t*)(ws + OFF_Pb); }
    __device__ __forceinline__ bf16_t* VsT() const { return (bf16_t*)(ws + OFF_VsT); }
    __device__ __forceinline__ bf16_t* VwT() const { return (bf16_t*)(ws + OFF_VwT); }
    __device__ __forceinline__ bf16_t* VgT() const { return (bf16_t*)(ws + OFF_VgT); }
    __device__ __forceinline__ float* misc() const { return (float*)(ws + OFF_misc); }
    __device__ __forceinline__ float* cpart() const { return (float*)(ws + OFF_cpart); }
    __device__ __forceinline__ bf16_t* kc() const { return (bf16_t*)(ws + OFF_kc); }
    __device__ __forceinline__ bf16_t* vcT() const { return (bf16_t*)(ws + OFF_vcT); }
    __device__ __forceinline__ float* dST() const { return (float*)(ws + OFF_dST); }
    __device__ __forceinline__ float* dec() const { return (float*)(ws + OFF_dec); }
    __device__ __forceinline__ bf16_t* ST() const { return (bf16_t*)(ws + OFF_ST); }
    __device__ __forceinline__ float* mixf() const { return (float*)(ws + OFF_mixf); }
    __device__ __forceinline__ bf16_t* mixb() const { return (bf16_t*)(ws + OFF_mixb); }
    __device__ __forceinline__ float* y1() const { return (float*)(ws + OFF_y1); }
    __device__ __forceinline__ float* x1() const { return (float*)(ws + OFF_x1); }
    __device__ __forceinline__ float* logits() const { return (float*)(ws + OFF_logits); }
    __device__ __forceinline__ float* ew() const { return (float*)(ws + OFF_ew); }
    __device__ __forceinline__ int* counts() const { return (int*)(ws + OFF_counts); }
    __device__ __forceinline__ int* lists() const { return (int*)(ws + OFF_lists); }
    __device__ __forceinline__ unsigned* bar() const { return (unsigned*)(ws + OFF_bar); }
    __device__ __forceinline__ bf16_t* hid() const { return (bf16_t*)(ws + OFF_hid); }
    __device__ __forceinline__ bf16_t* outk() const { return (bf16_t*)(ws + OFF_outk); }
};

#define LDS_ROW 72
#define TILE_BYTES 16384
#define GEMM_SMEM 69632
__device__ __forceinline__ int swz_key(int row) { return ((row >> 2) & 1) | ((((row >> 1) ^ (row >> 3)) & 1) << 1) | ((((row >> 2) ^ (row >> 4)) & 1) << 2); }
__device__ __forceinline__ int swz_off(int row, int chunk) { return row * 128 + ((chunk ^ swz_key(row)) << 4); }
typedef __attribute__((address_space(3))) unsigned lds_u32;

struct RowsBf16 {
    static constexpr bool NT = false;
    const bf16_t* base; size_t stride;
    __device__ __forceinline__ const bf16_t* ptr(int r, int k) const { return base + (size_t)r * stride + k; }
    __device__ __forceinline__ const bf16_t* pp(int i, int tid, int k) const { return ptr(i * 32 + (tid >> 3), k); }
};
struct GatherBf16 {
    static constexpr bool NT = true;
    const bf16_t* base; size_t stride; const int* rowidx;
    __device__ __forceinline__ const bf16_t* ptr(int r, int k) const { return base + (size_t)rowidx[r] * stride + k; }
    __device__ __forceinline__ const bf16_t* pp(int i, int tid, int k) const { return ptr(i * 32 + (tid >> 3), k); }
};
struct BF32Plain {
    const float* base; size_t ld;
    __device__ __forceinline__ f32x4 load4(int k, int r4) const { return *(const f32x4*)(base + (size_t)k * ld + r4); }
};
struct BF32GateUp {
    const float* g; long du; size_t ld;
    __device__ __forceinline__ f32x4 load4(int k, int r4) const {
        const long sel = ((r4 >> 5) & 1) ? du : 0l;
#ifdef NT_B
        return __builtin_nontemporal_load((const f32x4*)(g + sel + (size_t)k * ld + (r4 >> 6) * 32 + (r4 & 31)));
#else
        return *(const f32x4*)(g + sel + (size_t)k * ld + (r4 >> 6) * 32 + (r4 & 31));
#endif
    }
};

template <class L>
__device__ __forceinline__ void bf16_piece_load(u32x4& r, const L& ld, int k0, int i, int tid) { r = *(const u32x4*)ld.pp(i, tid, k0 + ((tid & 7) << 3)); }
__device__ __forceinline__ void bf16_piece_write(const u32x4& r, char* tile, int i, int tid) { *(u32x4*)(tile + swz_off(i * 32 + (tid >> 3), tid & 7)) = r; }
template <int J0, class BL>
__device__ __forceinline__ void f32_rows_load(f32x4 (&r)[8], const BL& bl, int k0, int tid) {
    const int kg = (tid >> 5) * 8, n4 = (tid & 31) * 4;
#pragma unroll
    for (int j = 0; j < 4; ++j) r[J0 + j] = bl.load4(k0 + kg + J0 + j, n4);
}
template <int I>
__device__ __forceinline__ void f32_col_write(const f32x4 (&r)[8], char* tile, int tid) {
    const int kgc = tid >> 5, n4 = (tid & 31) * 4;
    u32x4 w;
    w.x = pk_bf16(r[0][I], r[1][I]); w.y = pk_bf16(r[2][I], r[3][I]);
    w.z = pk_bf16(r[4][I], r[5][I]); w.w = pk_bf16(r[6][I], r[7][I]);
    *(u32x4*)(tile + swz_off(n4 + I, kgc)) = w;
}

#ifdef USE_SETPRIO
#define SETPRIO_HI __builtin_amdgcn_s_setprio(1);
#define SETPRIO_LO __builtin_amdgcn_s_setprio(0);
#else
#define SETPRIO_HI
#define SETPRIO_LO
#endif
template <bool SWAP, bool BF32, class AL, class BL, class EPI>
__device__ __forceinline__ void gemm_core(const AL& al, const BL& bl, int k_begin, int nk, int nkt, char* smem, f32x4 (&acc)[4][4], EPI&& epi) {
    const int tid = opaque_tid(), lane = tid & 63, wid = tid >> 6, wr = wid >> 1, wc = wid & 1, fr = lane & 15, fq = lane >> 4;
#pragma unroll
    for (int m = 0; m < 4; ++m)
#pragma unroll
        for (int n = 0; n < 4; ++n) acc[m][n] = (f32x4){0.f, 0.f, 0.f, 0.f};
    u32x4 ra[4]; u32x4 rb[4]; f32x4 rbf[8];
#pragma unroll
    for (int i = 0; i < 4; ++i) { bf16_piece_load(ra[i], al, k_begin, i, tid); if constexpr (!BF32) bf16_piece_load(rb[i], bl, k_begin, i, tid); }
    if constexpr (BF32) { f32_rows_load<0>(rbf, bl, k_begin, tid); f32_rows_load<4>(rbf, bl, k_begin, tid); }
#pragma unroll
    for (int i = 0; i < 4; ++i) { bf16_piece_write(ra[i], smem, i, tid); if constexpr (!BF32) bf16_piece_write(rb[i], smem + TILE_BYTES, i, tid); }
    if constexpr (BF32) { f32_col_write<0>(rbf, smem + TILE_BYTES, tid); f32_col_write<1>(rbf, smem + TILE_BYTES, tid); f32_col_write<2>(rbf, smem + TILE_BYTES, tid); f32_col_write<3>(rbf, smem + TILE_BYTES, tid); }
    if (nk > 1) {
#pragma unroll
        for (int i = 0; i < 4; ++i) { bf16_piece_load(ra[i], al, k_begin + 64, i, tid); if constexpr (!BF32) bf16_piece_load(rb[i], bl, k_begin + 64, i, tid); }
        if constexpr (BF32) { f32_rows_load<0>(rbf, bl, k_begin + 64, tid); f32_rows_load<4>(rbf, bl, k_begin + 64, tid); }
    }
    __syncthreads();
    int tile = 0, kin = 0;
    for (int kt = 0; kt < nk; ++kt) {
        const char* sA = smem + (kt & 1) * 2 * TILE_BYTES; const char* sB = sA + TILE_BYTES;
        char* nA = smem + ((kt & 1) ^ 1) * 2 * TILE_BYTES; char* nB = nA + TILE_BYTES;
        const bool w1 = kt + 1 < nk, l2 = kt + 2 < nk;
        const int k2 = k_begin + (kt + 2) * 64;
        bf16x8 a[2][4], b[2][4];
#pragma unroll
        for (int ks = 0; ks < 2; ++ks) {
#pragma unroll
            for (int m = 0; m < 4; ++m) a[ks][m] = *(const bf16x8*)(sA + swz_off(wr * 64 + m * 16 + fr, ks * 4 + fq));
#pragma unroll
            for (int n = 0; n < 4; ++n) b[ks][n] = *(const bf16x8*)(sB + swz_off(wc * 64 + n * 16 + fr, ks * 4 + fq));
        }
#define GEMM_GROUP(G) { \
            constexpr int ks = (G) >> 1, m0 = ((G) & 1) * 2; \
            __builtin_amdgcn_sched_barrier(0); \
            SETPRIO_HI \
            _Pragma("unroll") for (int m = m0; m < m0 + 2; ++m) \
            _Pragma("unroll") for (int n = 0; n < 4; ++n) \
                acc[m][n] = SWAP ? __builtin_amdgcn_mfma_f32_16x16x32_bf16(b[ks][n], a[ks][m], acc[m][n], 0, 0, 0) \
                                 : __builtin_amdgcn_mfma_f32_16x16x32_bf16(a[ks][m], b[ks][n], acc[m][n], 0, 0, 0); \
            SETPRIO_LO \
            __builtin_amdgcn_sched_barrier(0); \
            if (w1) bf16_piece_write(ra[G], nA, G, tid); \
            if (l2) bf16_piece_load(ra[G], al, k2, G, tid); \
            if constexpr (BF32) { \
                if constexpr ((G) == 0) { if (w1) { f32_col_write<0>(rbf, nB, tid); f32_col_write<1>(rbf, nB, tid); } } \
                if constexpr ((G) == 1) { if (w1) { f32_col_write<2>(rbf, nB, tid); f32_col_write<3>(rbf, nB, tid); } } \
                if constexpr ((G) == 2) { if (l2) f32_rows_load<0>(rbf, bl, k2, tid); } \
                if constexpr ((G) == 3) { if (l2) f32_rows_load<4>(rbf, bl, k2, tid); } \
            } else { \
                if (w1) bf16_piece_write(rb[G], nB, G, tid); \
                if (l2) bf16_piece_load(rb[G], bl, k2, G, tid); \
            } }
        GEMM_GROUP(0) GEMM_GROUP(1) GEMM_GROUP(2) GEMM_GROUP(3)
#undef GEMM_GROUP
        kin += 1;
        if (kin == nkt && kt + 1 < nk) {
            epi(tile, acc);
            tile += 1; kin = 0;
#pragma unroll
            for (int m = 0; m < 4; ++m)
#pragma unroll
                for (int n = 0; n < 4; ++n) acc[m][n] = (f32x4){0.f, 0.f, 0.f, 0.f};
        }
        __syncthreads();
    }
    epi(tile, acc);
}
struct NoEpi { __device__ __forceinline__ void operator()(int, const f32x4 (&)[4][4]) const {} };
template <bool SWAP, bool BF32, class AL, class BL>
__device__ __forceinline__ void gemm_128(const AL& al, const BL& bl, int k_begin, int nk, char* smem, f32x4 (&acc)[4][4]) {
    gemm_core<SWAP, BF32>(al, bl, k_begin, nk, nk, smem, acc, NoEpi());
}

__device__ __forceinline__ int xcd_of(const char* smem) { return (int)(((const unsigned*)(smem + GEMM_SMEM + 2048))[3] & 7u); }
__device__ __forceinline__ int rank_of(const char* smem) { return (int)((const unsigned*)(smem + GEMM_SMEM + 2048))[2]; }
__device__ __forceinline__ int nranks_of(const char* smem) { int n = (int)((const unsigned*)(smem + GEMM_SMEM + 2048))[0]; return n > 0 ? n : 1; }
template <int NB, bool SILU>
__device__ __forceinline__ void gemv_item(const float* in, const float* W, int ldw, const float* bias, float* out, int ldo, int K, int col0, float* sm) {
    const int tid = opaque_tid();
    for (int i = tid; i < NB * K; i += 256) { float v = in[i]; sm[i] = SILU ? v / (1.f + __expf(-v)) : v; }
    __syncthreads();
    float acc[NB];
#pragma unroll
    for (int b = 0; b < NB; ++b) acc[b] = 0.f;
    const int kq = tid >> 6, cl = tid & 63; const int kb = kq * (K / 4);
    for (int k = kb; k < kb + K / 4; k += 16) {
        float w[16];
#pragma unroll
        for (int u = 0; u < 16; ++u) w[u] = W[(size_t)(k + u) * ldw + col0 + cl];
#pragma unroll
        for (int u = 0; u < 16; ++u)
#pragma unroll
            for (int b = 0; b < NB; ++b) acc[b] += sm[b * K + k + u] * w[u];
    }
    float* red = sm + NB * K;
#pragma unroll
    for (int b = 0; b < NB; ++b) red[(kq * NB + b) * 64 + cl] = acc[b];
    __syncthreads();
    if (tid < 64 * NB) {
        int b = tid >> 6, cc = tid & 63;
        float s = red[(0 * NB + b) * 64 + cc] + red[(1 * NB + b) * 64 + cc] + red[(2 * NB + b) * 64 + cc] + red[(3 * NB + b) * 64 + cc];
        out[b * ldo + col0 + cc] = s + (bias ? bias[col0 + cc] : 0.f);
    }
    __syncthreads();
}

__device__ __forceinline__ int win_srccol(int n) {
    if (n < 1280) return n;
    if (n < 2304) return n + 24;
    if (n < 2816) return n + 40;
    if (n < 2840) return n - 2816 + 1280;
    if (n < 2856) return n - 2840 + 2328;
    return -1;
}
template <bool PERM>
__device__ __forceinline__ void transpose_item(const float* W, int ldw, int K, bf16_t* out, int k0, int n0, float* sm) {
    const int tid = opaque_tid();
    f32x4 v[4];
#pragma unroll
    for (int i = 0; i < 4; ++i) {
        const int c = tid + 256 * i, kk = c >> 4, nn = (c & 15) * 4;
        const int src = PERM ? win_srccol(n0 + nn) : (n0 + nn);
        v[i] = (src >= 0) ? *(const f32x4*)(W + (size_t)(k0 + kk) * ldw + src) : (f32x4){0.f, 0.f, 0.f, 0.f};
    }
#pragma unroll
    for (int i = 0; i < 4; ++i) {
        const int c = tid + 256 * i, kk = c >> 4, nn = (c & 15) * 4;
#pragma unroll
        for (int j = 0; j < 4; ++j) sm[(nn + j) * 65 + kk] = v[i][j];
    }
    __syncthreads();
#pragma unroll
    for (int i = 0; i < 2; ++i) {
        const int c = tid + 256 * i, nn = c >> 3, kc = (c & 7) * 8;
        const float* r = sm + nn * 65 + kc;
        u32x4 w;
        w.x = pk_bf16(r[0], r[1]); w.y = pk_bf16(r[2], r[3]); w.z = pk_bf16(r[4], r[5]); w.w = pk_bf16(r[6], r[7]);
        *(u32x4*)(out + (size_t)(n0 + nn) * K + k0 + kc) = w;
    }
    __syncthreads();
}

__device__ void phase0(const Params& p, char* smem) {
    float* sm = (float*)smem;
    const int nb = gridDim.x, bid = blockIdx.x;
    const int I_MOD = 96, I_B1 = 8, I_WIN = 16 * 46, I_WO = 256, I_WR = 64, I_W1 = 2 * 32 * 4, I_W2 = 2 * 4;
    const int total = I_MOD + I_B1 + I_WIN + I_WO + I_WR + I_W1 + I_W2;
    if (bid == 0 && opaque_tid() < 64) p.counts()[264 + opaque_tid()] = 0;
    if (bid == 1) for (int i = opaque_tid(); i < 264; i += 256) p.counts()[i] = 0;
    for (int it = bid; it < total; it += nb) {
        int i = it;
        if (i < I_MOD) { gemv_item<4, true>(p.c, p.w_mod, 6144, p.b_mod, p.mod(), 6144, 1024, i * 64, sm); continue; }
        i -= I_MOD;
        if (i < I_B1) { int kv = i >> 2; gemv_item<1, false>(kv ? p.pos_v : p.pos_k, kv ? p.w1_v : p.w1_k, 256, nullptr, p.bias1() + kv * 256, 256, 2048, (i & 3) * 64, sm); continue; }
        i -= I_B1;
        if (i < I_WIN) { transpose_item<true>(p.w_in, IN_COLS, 1024, p.wint(), (i % 16) * 64, (i / 16) * 64, sm); continue; }
        i -= I_WIN;
        if (i < I_WO) { transpose_item<false>(p.w_o, 1024, 1024, p.wot(), (i % 16) * 64, (i / 16) * 64, sm); continue; }
        i -= I_WO;
        if (i < I_WR) { transpose_item<false>(p.w_router, 256, 1024, p.wrt(), (i % 16) * 64, (i / 16) * 64, sm); continue; }
        i -= I_WR;
        if (i < I_W1) { int kv = i >> 7; int j = i & 127; transpose_item<false>(kv ? p.w1_v : p.w1_k, 256, 2048, p.w1t() + (size_t)kv * 256 * 2048, (j % 32) * 64, (j / 32) * 64, sm); continue; }
        i -= I_W1;
        { int kv = i >> 2; int j = i & 3; transpose_item<false>(kv ? p.w2_v : p.w2_k, 64, 256, p.w2t() + (size_t)kv * 64 * 256, j * 64, 0, sm); }
    }
}

__device__ __forceinline__ float wave_sum(float v) {
#pragma unroll
    for (int m = 32; m > 0; m >>= 1) v += __shfl_xor(v, m);
    return v;
}
__device__ void phase1(const Params& p) {
    const int lane = opaque_tid() & 63, gw = blockIdx.x * 4 + (opaque_tid() >> 6), nw = gridDim.x * 4;
    for (int row0 = gw * 2; row0 < NTOK; row0 += nw * 2) {
        f32x4 v[2][4]; float s[2];
#pragma unroll
        for (int r = 0; r < 2; ++r) {
            const float* xr = p.x + (size_t)(row0 + r) * D_MODEL;
            s[r] = 0.f;
#pragma unroll
            for (int i = 0; i < 4; ++i) v[r][i] = *(const f32x4*)(xr + i * 256 + lane * 4);
        }
        const int b = row0 / SEQ;
        const float* md = p.mod() + b * 6144;
#pragma unroll
        for (int r = 0; r < 2; ++r) {
#pragma unroll
            for (int i = 0; i < 4; ++i) s[r] += (v[r][i][0] + v[r][i][1]) + (v[r][i][2] + v[r][i][3]);
            const float mu = wave_sum(s[r]) * (1.f / D_MODEL);
            float q = 0.f;
#pragma unroll
            for (int i = 0; i < 4; ++i)
#pragma unroll
                for (int j = 0; j < 4; ++j) { float d = v[r][i][j] - mu; q += d * d; }
            const float rstd = rsqrtf(wave_sum(q) * (1.f / D_MODEL) + 1e-5f);
#pragma unroll
            for (int i = 0; i < 4; ++i) {
                const int col = i * 256 + lane * 4;
                f32x4 sh = *(const f32x4*)(md + 0 + col), sc = *(const f32x4*)(md + 1024 + col);
                float o[4];
#pragma unroll
                for (int j = 0; j < 4; ++j) o[j] = (v[r][i][j] - mu) * rstd * (1.f + sc[j]) + sh[j];
                u32x2 w; w.x = pk_bf16(o[0], o[1]); w.y = pk_bf16(o[2], o[3]);
                *(u32x2*)(p.hb() + (size_t)(row0 + r) * D_MODEL + col) = w;
            }
        }
    }
}

__device__ void phase2(const Params& p, char* smem) {
    const int xcd = xcd_of(smem), rank = rank_of(smem), nranks = nranks_of(smem);
    const int lane = opaque_tid() & 63, wid = opaque_tid() >> 6, wr = wid >> 1, wc = wid & 1, fr = lane & 15, fq = lane >> 4;
#ifndef P2_REP
#define P2_REP 1
#endif
    for (int it0 = rank; it0 < 16 * 23 * P2_REP; it0 += nranks) {
        const int it = it0 % (16 * 23);
        const int mt = (it / 23) * 8 + xcd, nt = it % 23;
        const int row0 = mt * 128, col0 = nt * 128;
        RowsBf16 al{p.hb() + (size_t)row0 * D_MODEL, D_MODEL};
        RowsBf16 bl{p.wint() + (size_t)col0 * D_MODEL, D_MODEL};
        f32x4 acc[4][4];
        const bool transposed = (nt == 7) || (nt == 9) || (nt >= 14 && nt < 18);
        if (transposed) {
            gemm_128<false, false>(al, bl, 0, 16, smem, acc);
            const int b = row0 / SEQ, t0 = row0 % SEQ;
            bf16_t* base; int rows_per;
            if (nt == 7) base = p.VsT() + (size_t)b * 128 * SEQ;
            else if (nt == 9) base = p.VwT() + (size_t)b * 128 * SEQ;
            else base = p.VgT() + ((size_t)b * 4 + (nt - 14)) * 128 * SEQ;
            (void)rows_per;
#pragma unroll
            for (int m = 0; m < 4; ++m)
#pragma unroll
                for (int n = 0; n < 4; ++n) {
                    const int feat = wc * 64 + n * 16 + fr, tok = t0 + wr * 64 + m * 16 + fq * 4;
                    u32x2 w; w.x = pk_bf16(acc[m][n][0], acc[m][n][1]); w.y = pk_bf16(acc[m][n][2], acc[m][n][3]);
                    *(u32x2*)(base + (size_t)feat * SEQ + tok) = w;
                }
        } else {
            gemm_128<true, false>(al, bl, 0, 16, smem, acc);
            if (nt == 22) {
                if (wc == 0) {
#pragma unroll
                    for (int m = 0; m < 4; ++m)
#pragma unroll
                        for (int n = 0; n < 4; ++n) {
                            const int tok = row0 + wr * 64 + m * 16 + fr, feat = n * 16 + fq * 4;
                            *(f32x4*)(p.misc() + (size_t)tok * 64 + feat) = acc[m][n];
                        }
                }
            } else {
#pragma unroll
                for (int m = 0; m < 4; ++m)
#pragma unroll
                    for (int n = 0; n < 4; ++n) {
                        const int tok = row0 + wr * 64 + m * 16 + fr, feat = col0 + wc * 64 + n * 16 + fq * 4;
                        u32x2 w; w.x = pk_bf16(acc[m][n][0], acc[m][n][1]); w.y = pk_bf16(acc[m][n][2], acc[m][n][3]);
                        *(u32x2*)(p.Pb() + (size_t)tok * PCOLS + feat) = w;
                    }
            }
        }
    }
}
struct CmpALoad {
    static constexpr bool NT = false;
    const bf16_t* Pb; int colbase; int row0;
    __device__ __forceinline__ const bf16_t* ptr(int r, int k) const {
        const int rr = row0 + r, bg = rr >> 8, i = rr & 255, b = bg >> 1, g = bg & 1;
        const int l = k >> 6, d = k & 63;
        int tok = 16 * i + l; tok = tok < SEQ ? tok : SEQ - 1;
        return Pb + ((size_t)b * SEQ + tok) * PCOLS + colbase + g * 64 + d;
    }
    __device__ __forceinline__ const bf16_t* pp(int i, int tid, int k) const { return ptr(i * 32 + (tid >> 3), k); }
};

__device__ __forceinline__ float log_sigmoid_f(float x) { return -(fmaxf(-x, 0.f) + log1pf(__expf(-fabsf(x)))); }

__device__ __forceinline__ void gla_cumsum(const Params& p, int tokg0, int h, float* sb, float* sglr, float* swa, float* sqt) {
    const int tid = opaque_tid();
    for (int i = tid; i < 1024; i += 256) { int t = i >> 4, r = i & 15; sglr[i] = p.misc()[(size_t)(tokg0 + t) * 64 + 24 + r]; }
    for (int i = tid; i < 1024; i += 256) { int r = i >> 6, d = i & 63; swa[i] = p.w_a2[r * 256 + h * 64 + d]; }
    __syncthreads();
    const int d = tid & 63, tq = tid >> 6;
    const float ba = p.b_a2[h * 64 + d];
    float w[16];
#pragma unroll
    for (int r = 0; r < 16; ++r) w[r] = swa[r * 64 + d];
    float run = 0.f;
#pragma unroll
    for (int tt = 0; tt < 16; ++tt) {
        const int t = tq * 16 + tt;
        float x = ba;
#pragma unroll
        for (int r = 0; r < 16; ++r) x += sglr[t * 16 + r] * w[r];
        run += log_sigmoid_f(x) * (1.f / 16.f);
        sb[t * 64 + d] = run;
    }
    sqt[tq * 64 + d] = run;
    __syncthreads();
    float off = 0.f;
#pragma unroll
    for (int q = 0; q < 3; ++q) if (q < tq) off += sqt[q * 64 + d];
#pragma unroll
    for (int tt = 0; tt < 16; ++tt) sb[(tq * 16 + tt) * 64 + d] += off;
    __syncthreads();
}

__device__ void gla_a_item(const Params& p, int item, char* smem) {
    const int tid = opaque_tid(), lane = tid & 63, wid = tid >> 6, fr = lane & 15, fq = lane >> 4;
    const int bh = item >> 6, c = item & 63, b = bh >> 2, h = bh & 3;
    const int tok0 = c * 64, tokg0 = b * SEQ + tok0;
    float* sb = (float*)smem; float* sglr = (float*)(smem + 16384); float* swa = (float*)(smem + 20480); float* sqt = (float*)(smem + 24576);
    char* skbT = smem + 25600; char* sVT = smem + 34816;
    gla_cumsum(p, tokg0, h, sb, sglr, swa, sqt);
    {
        const int d = tid & 63, tq = tid >> 6;
        const float bl = sb[63 * 64 + d];
        float v[16];
#pragma unroll
        for (int tt = 0; tt < 16; ++tt) {
            const int s = tq * 16 + tt;
            float k = bf2f(p.Pb()[(size_t)(tokg0 + s) * PCOLS + P_GK + h * 64 + d]);
            v[tt] = k * __expf(bl - sb[s * 64 + d]);
        }
        u32x4 w0, w1;
        w0.x = pk_bf16(v[0], v[1]); w0.y = pk_bf16(v[2], v[3]); w0.z = pk_bf16(v[4], v[5]); w0.w = pk_bf16(v[6], v[7]);
        w1.x = pk_bf16(v[8], v[9]); w1.y = pk_bf16(v[10], v[11]); w1.z = pk_bf16(v[12], v[13]); w1.w = pk_bf16(v[14], v[15]);
        *(u32x4*)(skbT + (d * LDS_ROW + tq * 16) * 2) = w0;
        *(u32x4*)(skbT + (d * LDS_ROW + tq * 16 + 8) * 2) = w1;
        if (tid < 64) p.dec()[(size_t)item * 64 + d] = __expf(bl);
    }
#pragma unroll
    for (int i = 0; i < 4; ++i) {
        const int cidx = tid + 256 * i, e = cidx >> 3, ch = (cidx & 7) * 8;
        *(u32x4*)(sVT + (e * LDS_ROW + ch) * 2) = *(const u32x4*)(p.VgT() + ((size_t)bh * 128 + e) * SEQ + tok0 + ch);
    }
    __syncthreads();
    f32x4 acc[2][4];
#pragma unroll
    for (int m = 0; m < 2; ++m)
#pragma unroll
        for (int n = 0; n < 4; ++n) acc[m][n] = (f32x4){0.f, 0.f, 0.f, 0.f};
#pragma unroll
    for (int ks = 0; ks < 2; ++ks) {
        bf16x8 a[2], bb[4];
#pragma unroll
        for (int m = 0; m < 2; ++m) a[m] = *(const bf16x8*)(sVT + (((wid * 2 + m) * 16 + fr) * LDS_ROW + ks * 32 + fq * 8) * 2);
#pragma unroll
        for (int n = 0; n < 4; ++n) bb[n] = *(const bf16x8*)(skbT + ((n * 16 + fr) * LDS_ROW + ks * 32 + fq * 8) * 2);
#pragma unroll
        for (int m = 0; m < 2; ++m)
#pragma unroll
            for (int n = 0; n < 4; ++n) acc[m][n] = __builtin_amdgcn_mfma_f32_16x16x32_bf16(a[m], bb[n], acc[m][n], 0, 0, 0);
    }
    float* dst = p.dST() + (size_t)item * 8192;
#pragma unroll
    for (int m = 0; m < 2; ++m)
#pragma unroll
        for (int n = 0; n < 4; ++n)
#pragma unroll
            for (int j = 0; j < 4; ++j) dst[((wid * 2 + m) * 16 + fq * 4 + j) * 64 + n * 16 + fr] = acc[m][n][j];
    __syncthreads();
}

__device__ void phase3(const Params& p, char* smem) {
    const int lane = opaque_tid() & 63, wid = opaque_tid() >> 6, wr = wid >> 1, wc = wid & 1, fr = lane & 15, fq = lane >> 4;
    for (int it = blockIdx.x; it < 256; it += gridDim.x) {
        const int kv = it >> 7, mt = (it >> 3) & 15, nt = (it >> 2) & 1, ks = it & 3;
        CmpALoad al{p.Pb(), kv ? P_VC : P_KC, mt * 128};
        RowsBf16 bl{p.w1t() + ((size_t)kv * 256 + nt * 128) * 2048, 2048};
        f32x4 acc[4][4];
        gemm_128<true, 0>(al, bl, ks * 512, 8, smem, acc);
        float* dst = p.cpart() + ((size_t)(kv * 4 + ks) * 2048 + mt * 128) * 256 + nt * 128;
#pragma unroll
        for (int m = 0; m < 4; ++m)
#pragma unroll
            for (int n = 0; n < 4; ++n)
                *(f32x4*)(dst + (size_t)(wr * 64 + m * 16 + fr) * 256 + wc * 64 + n * 16 + fq * 4) = acc[m][n];
    }
    const int first = (blockIdx.x + gridDim.x - (256 % gridDim.x)) % gridDim.x;
    for (int it = first; it < 1024; it += gridDim.x) gla_a_item(p, it, smem);
}

#define C2_ROW 264
__device__ void cmp2_item(const Params& p, int item, char* smem) {
    const int tid = opaque_tid(), lane = tid & 63, wid = tid >> 6, fr = lane & 15, fq = lane >> 4;
    const int kv = item >> 5, r0 = (item & 31) * 64;
    char* sA = smem; char* sB = smem + 64 * C2_ROW * 2;
    const float* b1 = p.bias1() + kv * 256;
#pragma unroll 2
    for (int i = 0; i < 8; ++i) {
        const int cidx = tid + 256 * i, row = cidx >> 5, col = (cidx & 31) * 8;
        f32x4 s0 = *(const f32x4*)(b1 + col), s1 = *(const f32x4*)(b1 + col + 4);
#pragma unroll
        for (int ks = 0; ks < 4; ++ks) {
            const float* src = p.cpart() + ((size_t)(kv * 4 + ks) * 2048 + r0 + row) * 256 + col;
            s0 += *(const f32x4*)src; s1 += *(const f32x4*)(src + 4);
        }
        float o[8];
#pragma unroll
        for (int j = 0; j < 4; ++j) { o[j] = s0[j] / (1.f + __expf(-s0[j])); o[4 + j] = s1[j] / (1.f + __expf(-s1[j])); }
        u32x4 w; w.x = pk_bf16(o[0], o[1]); w.y = pk_bf16(o[2], o[3]); w.z = pk_bf16(o[4], o[5]); w.w = pk_bf16(o[6], o[7]);
        *(u32x4*)(sA + (row * C2_ROW + col) * 2) = w;
        *(u32x4*)(sB + (row * C2_ROW + col) * 2) = *(const u32x4*)(p.w2t() + ((size_t)kv * 64 + row) * 256 + col);
    }
    __syncthreads();
    f32x4 acc[4];
#pragma unroll
    for (int n = 0; n < 4; ++n) acc[n] = (f32x4){0.f, 0.f, 0.f, 0.f};
#pragma unroll
    for (int ks = 0; ks < 8; ++ks) {
        bf16x8 a = *(const bf16x8*)(sA + ((wid * 16 + fr) * C2_ROW + ks * 32 + fq * 8) * 2);
#pragma unroll
        for (int n = 0; n < 4; ++n) {
            bf16x8 bb = *(const bf16x8*)(sB + ((n * 16 + fr) * C2_ROW + ks * 32 + fq * 8) * 2);
            acc[n] = kv ? __builtin_amdgcn_mfma_f32_16x16x32_bf16(a, bb, acc[n], 0, 0, 0)
                        : __builtin_amdgcn_mfma_f32_16x16x32_bf16(bb, a, acc[n], 0, 0, 0);
        }
    }
    if (kv == 0) {
#pragma unroll
        for (int n = 0; n < 4; ++n) {
            u32x2 w; w.x = pk_bf16(acc[n][0], acc[n][1]); w.y = pk_bf16(acc[n][2], acc[n][3]);
            *(u32x2*)(p.kc() + (size_t)(r0 + wid * 16 + fr) * 64 + n * 16 + fq * 4) = w;
        }
    } else {
        const int r = r0 + wid * 16 + fq * 4, bg = r >> 8, i = r & 255;
#pragma unroll
        for (int n = 0; n < 4; ++n) {
            u32x2 w; w.x = pk_bf16(acc[n][0], acc[n][1]); w.y = pk_bf16(acc[n][2], acc[n][3]);
            *(u32x2*)(p.vcT() + ((size_t)bg * 64 + n * 16 + fr) * 256 + i) = w;
        }
    }
    __syncthreads();
}

__device__ void phase4(const Params& p, char* smem) {
    for (int it = blockIdx.x; it < 64; it += gridDim.x) cmp2_item(p, it, smem);
    const int nthreads = gridDim.x * 256;
    for (int idx = blockIdx.x * 256 + opaque_tid(); idx < 16 * 8192; idx += nthreads) {
        const int bh = idx >> 13, ed = idx & 8191, d = idx & 63;
        float S = 0.f;
        for (int c0 = 0; c0 < 64; c0 += 8) {
            float dv[8], dc[8];
#pragma unroll
            for (int u = 0; u < 8; ++u) {
                dv[u] = p.dST()[((size_t)(bh * 64 + c0 + u) << 13) + ed];
                dc[u] = p.dec()[(size_t)(bh * 64 + c0 + u) * 64 + d];
            }
#pragma unroll
            for (int u = 0; u < 8; ++u) {
                p.ST()[((size_t)(bh * 64 + c0 + u) << 13) + ed] = f2bf(S);
                S = dc[u] * S + dv[u];
            }
        }
    }
}
#define KT_BYTES (64 * LDS_ROW * 2)
#define C1_SCALE (0.125f * LOG2E)

#define MASK_BIAS (-2e30f)
__device__ __forceinline__ bf16x8 scale_frag(bf16x8 v, float c) {
    u32x4 u = __builtin_bit_cast(u32x4, v); u32x4 r;
    r.x = pk_bf16(bflo(u.x) * c, bfhi(u.x) * c); r.y = pk_bf16(bflo(u.y) * c, bfhi(u.y) * c);
    r.z = pk_bf16(bflo(u.z) * c, bfhi(u.z) * c); r.w = pk_bf16(bflo(u.w) * c, bfhi(u.w) * c);
    return __builtin_bit_cast(bf16x8, r);
}
__device__ __forceinline__ float max3f(float a, float b, float c) { return fmaxf(fmaxf(a, b), c); }
__device__ __forceinline__ float rowmax4(float x) {
    auto r = __builtin_amdgcn_permlane32_swap(__float_as_uint(x), __float_as_uint(x), false, false);
    float y = fmaxf(__uint_as_float(r[0]), __uint_as_float(r[1]));
    auto q = __builtin_amdgcn_permlane16_swap(__float_as_uint(y), __float_as_uint(y), false, false);
    return fmaxf(__uint_as_float(q[0]), __uint_as_float(q[1]));
}
template <bool PV>
__device__ __forceinline__ void flash_tile(const char* sK0, const char* sVT0, const bf16x8 (&qf)[2][2], float (&m)[2], f32x4 (&l)[2], f32x4 (&o)[2][4],
                                           float dl0, float dstride, float wlim, bool lanevalid, bool needmask, const float (&slope2)[2], int fr, int fq, bool lazy, bf16x8 ones) {
#pragma unroll 1
    for (int half = 0; half < 2; ++half) {
        const char* sK = sK0 + half * 32 * LDS_ROW * 2;
        const char* sVT = sVT0 + half * 32 * 2;
        const float dl = dl0 + dstride * (float)(half * 32);
        bf16x8 kf[2][2], vf[4];
#pragma unroll
        for (int mk = 0; mk < 2; ++mk)
#pragma unroll
            for (int ks = 0; ks < 2; ++ks) kf[mk][ks] = *(const bf16x8*)(sK + ((mk * 16 + fr) * LDS_ROW + ks * 32 + fq * 8) * 2);
        if (PV) {
#pragma unroll
            for (int md = 0; md < 4; ++md) {
                u32x2 lo = *(const u32x2*)(sVT + ((md * 16 + fr) * LDS_ROW + fq * 4) * 2);
                u32x2 hi = *(const u32x2*)(sVT + ((md * 16 + fr) * LDS_ROW + 16 + fq * 4) * 2);
                u32x4 w; w.x = lo.x; w.y = lo.y; w.z = hi.x; w.w = hi.y;
                vf[md] = __builtin_bit_cast(bf16x8, w);
            }
        }
        f32x4 s[2][2];
#pragma unroll
        for (int p = 0; p < 2; ++p) {
            const float mref = lazy ? m[p] : 0.f;
            if (needmask) {
#pragma unroll
                for (int mk = 0; mk < 2; ++mk)
#pragma unroll
                    for (int j = 0; j < 4; ++j) {
                        const float dk = dl + dstride * (float)(mk * 16 + j);
                        const bool ok = lanevalid && (dk <= 0.f) && (dk > wlim);
                        s[p][mk][j] = ok ? (slope2[p] * dk - mref) : MASK_BIAS;
                    }
            } else {
                const float sb = lanevalid ? (slope2[p] * dl - mref) : MASK_BIAS, sd = lanevalid ? slope2[p] * dstride : 0.f;
#pragma unroll
                for (int mk = 0; mk < 2; ++mk)
#pragma unroll
                    for (int j = 0; j < 4; ++j) s[p][mk][j] = sb + sd * (float)(mk * 16 + j);
            }
        }
#pragma unroll
        for (int ks = 0; ks < 2; ++ks)
#pragma unroll
            for (int p = 0; p < 2; ++p)
#pragma unroll
                for (int mk = 0; mk < 2; ++mk) s[p][mk] = __builtin_amdgcn_mfma_f32_16x16x32_bf16(kf[mk][ks], qf[p][ks], s[p][mk], 0, 0, 0);
        float mx[2];
#pragma unroll
        for (int p = 0; p < 2; ++p)
            mx[p] = max3f(max3f(max3f(s[p][0][0], s[p][0][1], s[p][0][2]), s[p][0][3], s[p][1][0]), max3f(s[p][1][1], s[p][1][2], s[p][1][3]), MASK_BIAS);
        if (!lazy) {
            float mn[2];
#pragma unroll
            for (int p = 0; p < 2; ++p) mn[p] = fmaxf(m[p], rowmax4(mx[p]));
            if (__any((mn[0] > m[0]) || (mn[1] > m[1]))) {
#pragma unroll
                for (int p = 0; p < 2; ++p) {
                    const float alpha = __builtin_amdgcn_exp2f(m[p] - mn[p]);
                    l[p] *= alpha;
                    if (PV) {
#pragma unroll
                        for (int md = 0; md < 4; ++md) o[p][md] *= alpha;
                    }
                    m[p] = mn[p];
                }
            }
#pragma unroll
            for (int p = 0; p < 2; ++p)
#pragma unroll
                for (int mk = 0; mk < 2; ++mk)
#pragma unroll
                    for (int j = 0; j < 4; ++j) s[p][mk][j] -= m[p];
        }
        bf16x8 pf[2];
#pragma unroll
        for (int p = 0; p < 2; ++p) {
#pragma unroll
            for (int mk = 0; mk < 2; ++mk)
#pragma unroll
                for (int j = 0; j < 4; ++j) s[p][mk][j] = __builtin_amdgcn_exp2f(s[p][mk][j]);
            u32x4 w;
            w.x = pk_bf16(s[p][0][0], s[p][0][1]); w.y = pk_bf16(s[p][0][2], s[p][0][3]);
            w.z = pk_bf16(s[p][1][0], s[p][1][1]); w.w = pk_bf16(s[p][1][2], s[p][1][3]);
            pf[p] = __builtin_bit_cast(bf16x8, w);
        }
#pragma unroll
        for (int p = 0; p < 2; ++p) l[p] = __builtin_amdgcn_mfma_f32_16x16x32_bf16(ones, pf[p], l[p], 0, 0, 0);
        if (PV) {
#pragma unroll
            for (int md = 0; md < 4; ++md)
#pragma unroll
                for (int p = 0; p < 2; ++p) o[p][md] = __builtin_amdgcn_mfma_f32_16x16x32_bf16(vf[md], pf[p], o[p][md], 0, 0, 0);
        }
        if (lazy) {
            float up[2];
#pragma unroll
            for (int p = 0; p < 2; ++p) up[p] = fmaxf(rowmax4(mx[p]), 0.f);
            if (__any((up[0] > 0.f) || (up[1] > 0.f))) {
#pragma unroll
                for (int p = 0; p < 2; ++p) {
                    const float alpha = __builtin_amdgcn_exp2f(-up[p]);
                    l[p] *= alpha;
                    if (PV) {
#pragma unroll
                        for (int md = 0; md < 4; ++md) o[p][md] *= alpha;
                    }
                    m[p] += up[p];
                }
            }
        }
    }
}
__device__ __forceinline__ float l_total(const f32x4& l, int fr) { return __shfl(l[0], fr); }

__device__ __forceinline__ void imp_tile(const char* sK, const bf16x8 (&qf)[2][2], const float (&m)[2], const float (&linv)[2],
                                         float dl, const float (&slope2)[2], int ct, float* simp, int fr, int fq) {
    bf16x8 kf[4][2];
#pragma unroll
    for (int mk = 0; mk < 4; ++mk)
#pragma unroll
        for (int ks = 0; ks < 2; ++ks) kf[mk][ks] = *(const bf16x8*)(sK + ((mk * 16 + fr) * LDS_ROW + ks * 32 + fq * 8) * 2);
    f32x4 hs[4];
#pragma unroll
    for (int mk = 0; mk < 4; ++mk) hs[mk] = (f32x4){0.f, 0.f, 0.f, 0.f};
#pragma unroll
    for (int p = 0; p < 2; ++p) {
#pragma unroll
        for (int mk = 0; mk < 4; ++mk) {
            f32x4 s;
#pragma unroll
            for (int j = 0; j < 4; ++j) { const float dk = dl + 16.f * (float)(mk * 16 + j); s[j] = (dk <= 0.f) ? slope2[p] * dk : MASK_BIAS; }
#pragma unroll
            for (int ks = 0; ks < 2; ++ks) s = __builtin_amdgcn_mfma_f32_16x16x32_bf16(kf[mk][ks], qf[p][ks], s, 0, 0, 0);
#pragma unroll
            for (int j = 0; j < 4; ++j) hs[mk][j] += __builtin_amdgcn_exp2f(s[j] - m[p]) * linv[p];
        }
    }
#pragma unroll
    for (int mk = 0; mk < 4; ++mk) {
        const int jb = ct * 16 + mk * 4 + fq;
        const float a = hs[mk][0] + hs[mk][1] + hs[mk][2] + 0.5f * hs[mk][3];
        const float bnext = 0.5f * hs[mk][3];
        simp[fr * 64 + jb] += a;
        __builtin_amdgcn_wave_barrier();
        if (jb + 1 < 64) simp[fr * 64 + jb + 1] += bnext;
        __builtin_amdgcn_wave_barrier();
    }
}

struct TileSrc { const bf16_t* k; const bf16_t* v; };
struct TileOff { int k[2], v[2]; };
__device__ __forceinline__ TileOff tile_offsets(int kst, int vst, int tid) {
    TileOff to;
#pragma unroll
    for (int i = 0; i < 2; ++i) { const int c = tid + 256 * i, row = c >> 3, ch = (c & 7) * 8; to.k[i] = row * kst + ch; to.v[i] = row * vst + ch; }
    return to;
}
__device__ __forceinline__ void tile_gload(const TileSrc& ts, const TileOff& to, u32x4 (&rk)[2], u32x4 (&rv)[2]) {
#pragma unroll
    for (int i = 0; i < 2; ++i) {
        rk[i] = *(const u32x4*)(ts.k + to.k[i]);
        rv[i] = *(const u32x4*)(ts.v + to.v[i]);
    }
}
__device__ __forceinline__ void tile_swrite(char* smem, int buf, const u32x4 (&rk)[2], const u32x4 (&rv)[2], int tid) {
    char* sK = smem + buf * 2 * KT_BYTES; char* sV = sK + KT_BYTES;
#pragma unroll
    for (int i = 0; i < 2; ++i) {
        const int c = tid + 256 * i, row = c >> 3, ch = (c & 7) * 8;
        *(u32x4*)(sK + (row * LDS_ROW + ch) * 2) = rk[i];
        *(u32x4*)(sV + (row * LDS_ROW + ch) * 2) = rv[i];
    }
}

__device__ void nsa_cmp_item(const Params& p, int qrev, int bg, char* smem) {
    const int tid = opaque_tid(), lane = tid & 63, wid = tid >> 6, fr = lane & 15, fq = lane >> 4;
    const int qb = 63 - qrev, b = bg >> 1, g = bg & 1;
    const int q0 = qb * 64, t = q0 + wid * 16 + fr;
    const size_t tokg = (size_t)b * SEQ + t;
    float* simp = (float*)(smem + 4 * KT_BYTES) + wid * 1024;
    auto wsb = [&]() __attribute__((always_inline)) { char* w = p.ws; asm volatile("" : "+s"(w)); return w; };
    const unsigned onew = (fr == 0) ? 0x3f803f80u : 0u;
    const bf16x8 ones = __builtin_bit_cast(bf16x8, (u32x4){onew, onew, onew, onew});
    const int ncb = (4 * qb + 3) < NCMP ? (4 * qb + 3) : NCMP;
    const int nct = (ncb + 63) >> 6;
    for (int i = tid; i < 4096; i += 256) ((float*)(smem + 4 * KT_BYTES))[i] = 0.f;
    __syncthreads();
#pragma unroll 1
    for (int hp = 0; hp < 2; ++hp) {
        const int h0 = g * 4 + hp * 2;
        bf16x8 qf[2][2]; float slope2[2];
#pragma unroll
        for (int pp = 0; pp < 2; ++pp) {
            slope2[pp] = exp2f(-(float)(h0 + pp + 1)) * LOG2E;
#pragma unroll
            for (int ks = 0; ks < 2; ++ks)
                qf[pp][ks] = scale_frag(*(const bf16x8*)((const bf16_t*)(wsb() + OFF_Pb) + tokg * PCOLS + P_NQ + (h0 + pp) * 64 + ks * 32 + fq * 8), C1_SCALE);
        }
        float m[2], linv[2]; f32x4 l[2]; f32x4 o[2][4];
#pragma unroll
        for (int pp = 0; pp < 2; ++pp) {
            m[pp] = NEGF; l[pp] = (f32x4){0.f, 0.f, 0.f, 0.f}; linv[pp] = 0.f;
#pragma unroll
            for (int md = 0; md < 4; ++md) o[pp][md] = (f32x4){0.f, 0.f, 0.f, 0.f};
        }
        u32x4 rk[2], rv[2];
        const int n = 2 * nct;
        auto src = [&](int step) __attribute__((always_inline)) {
            const int idx = step < nct ? (nct - 1 - step) : step - nct;
            char* wb = wsb();
            TileSrc ts; ts.k = (const bf16_t*)(wb + OFF_kc) + ((size_t)bg * 256 + idx * 64) * 64;
            ts.v = (const bf16_t*)(wb + OFF_vcT) + (size_t)bg * 64 * 256 + idx * 64;
            return ts;
        };
        const TileOff toff = tile_offsets(64, 256, tid);
        tile_gload(src(0), toff, rk, rv); tile_swrite(smem, 0, rk, rv, tid); __syncthreads();
#pragma unroll 1
        for (int i = 0; i < n; ++i) {
            if (i + 1 < n) tile_gload(src(i + 1), toff, rk, rv);
            __builtin_amdgcn_sched_barrier(0);
            const int idx = i < nct ? (nct - 1 - i) : i - nct;
            const char* sK = smem + (i & 1) * 2 * KT_BYTES; const char* sV = sK + KT_BYTES;
            const float dlc = (float)(16 * (idx * 64 + fq * 4) + 31 - t);
            if (i < nct) {
                const bool cmask = (16 * (idx * 64 + 63) + 31) > q0;
                flash_tile<true>(sK, sV, qf, m, l, o, dlc, 16.f, -1e9f, true, cmask, slope2, fr, fq, i >= 2, ones);
            } else {
                if (i == nct) {
                    size_t tokg_o = tokg; asm volatile("" : "+v"(tokg_o));
                    char* wb = wsb();
#pragma unroll
                    for (int pp = 0; pp < 2; ++pp) {
                        const float inv = 1.f / fmaxf(l_total(l[pp], fr), 1e-30f);
                        linv[pp] = inv;
                        const int h = h0 + pp;
                        const float gl = ((const float*)(wb + OFF_misc))[tokg_o * 64 + h * 3 + 0];
                        const float sc = inv / (1.f + __expf(-gl));
#pragma unroll
                        for (int md = 0; md < 4; ++md) *(f32x4*)((float*)(wb + OFF_mixf) + tokg_o * 512 + h * 64 + md * 16 + fq * 4) = o[pp][md] * sc;
                    }
                }
                imp_tile(sK, qf, m, linv, dlc, slope2, idx, simp, fr, fq);
            }
            __builtin_amdgcn_sched_barrier(0);
            if (i + 1 < n) tile_swrite(smem, (i + 1) & 1, rk, rv, tid);
            __syncthreads();
        }
    }
    {
        const int j = lane;
        const bool forced = (j == 0) || (j == qb) || (j == qb - 1);
        unsigned long long mine = 0ull, wave_union = 0ull;
#pragma unroll 1
        for (int qi = 0; qi < 16; ++qi) {
            const float sc = (j <= qb) ? (simp[qi * 64 + j] + (forced ? 1e4f : 0.f)) : NEGF;
            int rank = 0;
#pragma unroll 4
            for (int j2 = 0; j2 < 64; ++j2) {
                const float s2 = __builtin_bit_cast(float, __builtin_amdgcn_readlane(__builtin_bit_cast(int, sc), j2));
                rank += ((s2 > sc) || (s2 == sc && j2 < j)) ? 1 : 0;
            }
            const unsigned long long msk = __ballot(rank < 16);
            wave_union |= msk;
            if (fr == qi) mine = msk;
        }
        const unsigned long long causal = (qb >= 63) ? ~0ull : ((1ull << (qb + 1)) - 1ull);
        unsigned long long* selm = (unsigned long long*)(wsb() + OFF_selm);
        if (fq == 0) selm[(size_t)g * NTOK + tokg] = mine & causal;
        if (lane == 0) ((unsigned long long*)(wsb() + OFF_selu))[((size_t)bg * 64 + qb) * 4 + wid] = wave_union & causal;
    }
    __syncthreads();
}

__device__ void nsa_sw_item(const Params& p, int qrev, int bg, int hp, char* smem, int mode) {
    const int tid = opaque_tid(), lane = tid & 63, wid = tid >> 6, fr = lane & 15, fq = lane >> 4;
    const int qb = 63 - qrev, b = bg >> 1, g = bg & 1;
    const int q0 = qb * 64, t = q0 + wid * 16 + fr;
    const size_t tokg = (size_t)b * SEQ + t;
    int* slist = (int*)(smem + 4 * KT_BYTES);
    const int h0 = g * 4 + hp * 2;
    auto wsb = [&]() __attribute__((always_inline)) { char* w = p.ws; asm volatile("" : "+s"(w)); return w; };
    bf16x8 qf[2][2]; float slope2[2];
#pragma unroll
    for (int pp = 0; pp < 2; ++pp) {
        slope2[pp] = exp2f(-(float)(h0 + pp + 1)) * LOG2E;
#pragma unroll
        for (int ks = 0; ks < 2; ++ks)
            qf[pp][ks] = scale_frag(*(const bf16x8*)((const bf16_t*)(wsb() + OFF_Pb) + tokg * PCOLS + P_NQ + (h0 + pp) * 64 + ks * 32 + fq * 8), C1_SCALE);
    }
    const unsigned long long mymask = ((const unsigned long long*)(wsb() + OFF_selm))[(size_t)g * NTOK + tokg];
    const unsigned long long* su = (const unsigned long long*)(wsb() + OFF_selu) + ((size_t)bg * 64 + qb) * 4;
    const unsigned long long wave_union = su[wid];
    const unsigned long long un = su[0] | su[1] | su[2] | su[3];
    const int wlo = (qb - 8) > 0 ? (qb - 8) : 0;
    const int nsl = __popcll(un);
    const int n = nsl + (qb - wlo + 1);
    if (tid < 64 && ((un >> tid) & 1ull)) slist[nsl - 1 - __popcll(un & ((1ull << tid) - 1ull))] = tid;
    if (tid >= 64 && tid < 64 + (qb - wlo + 1)) slist[nsl + (tid - 64)] = 256 + (qb - (tid - 64));
    __syncthreads();
    const unsigned onew = (fr == 0) ? 0x3f803f80u : 0u;
    const bf16x8 ones = __builtin_bit_cast(bf16x8, (u32x4){onew, onew, onew, onew});
    float m[2]; f32x4 l[2]; f32x4 o[2][4];
#pragma unroll
    for (int pp = 0; pp < 2; ++pp) {
        m[pp] = NEGF; l[pp] = (f32x4){0.f, 0.f, 0.f, 0.f};
#pragma unroll
        for (int md = 0; md < 4; ++md) o[pp][md] = (f32x4){0.f, 0.f, 0.f, 0.f};
    }
    auto finish_branch = [&](int br) __attribute__((always_inline)) {
        size_t tokg_o = tokg; asm volatile("" : "+v"(tokg_o));
        char* wb = wsb();
#pragma unroll
        for (int pp = 0; pp < 2; ++pp) {
            const float inv = 1.f / fmaxf(l_total(l[pp], fr), 1e-30f);
            const int h = h0 + pp;
            const float gl = ((const float*)(wb + OFF_misc))[tokg_o * 64 + h * 3 + br];
            const float sc = inv / (1.f + __expf(-gl));
#pragma unroll
            for (int md = 0; md < 4; ++md) {
                const size_t eo = tokg_o * 512 + h * 64 + md * 16 + fq * 4;
                f32x4 v = o[pp][md] * sc;
                if (mode != 0) { asm volatile("" :: "v"(v[0]), "v"(v[1]), "v"(v[2]), "v"(v[3])); }
                else if (br == 1) *(f32x4*)((float*)(wb + OFF_mixf2) + eo) = v;
                else { v += *(const f32x4*)((const float*)(wb + OFF_mixf) + eo) + *(const f32x4*)((const float*)(wb + OFF_mixf2) + eo);
                       u32x2 w; w.x = pk_bf16(v[0], v[1]); w.y = pk_bf16(v[2], v[3]); *(u32x2*)((bf16_t*)(wb + OFF_mixb) + tokg_o * 1024 + h * 64 + md * 16 + fq * 4) = w; }
            }
            m[pp] = NEGF; l[pp] = (f32x4){0.f, 0.f, 0.f, 0.f};
#pragma unroll
            for (int md = 0; md < 4; ++md) o[pp][md] = (f32x4){0.f, 0.f, 0.f, 0.f};
        }
    };
    u32x4 rkA[2], rvA[2], rkB[2], rvB[2];
    auto src = [&](int e) __attribute__((always_inline)) {
        const int win = e >> 8, idx = e & 255;
        char* wb = wsb();
        TileSrc ts;
        ts.k = (const bf16_t*)(wb + OFF_Pb) + ((size_t)b * SEQ + idx * 64) * PCOLS + (win ? P_KW : P_KS) + g * 64;
        ts.v = (const bf16_t*)(wb + (win ? OFF_VwT : OFF_VsT)) + (size_t)bg * 64 * SEQ + idx * 64;
        return ts;
    };
    auto step = [&](int i, int buf) __attribute__((always_inline)) {
        const int e = slist[i];
        const int win = e >> 8, idx = e & 255;
        if (i == nsl) finish_branch(1);
        const char* sK = smem + buf * 2 * KT_BYTES; const char* sV = sK + KT_BYTES;
        if (mode != 1 && (win || ((wave_union >> idx) & 1ull))) {
            const bool lv = win ? true : (((mymask >> idx) & 1ull) != 0ull);
            const bool nm = (idx == qb) || (win && idx == qb - 8);
            flash_tile<true>(sK, sV, qf, m, l, o, (float)(idx * 64 + fq * 4 - t), 1.f, win ? -512.f : -1e9f, lv, nm, slope2, fr, fq, (i != 0) && (i != nsl), ones);
        }
    };
#ifdef PROF
    volatile unsigned* sprof = (volatile unsigned*)(smem + 4 * KT_BYTES + 2048);
    if (tid == 0) { sprof[1] = 0u; sprof[2] = 0u; sprof[3] = (unsigned)__builtin_amdgcn_s_memtime(); }
#define PROF_T0 if (tid == 0) sprof[0] = (unsigned)__builtin_amdgcn_s_memtime();
#define PROF_T1 if (tid == 0) { sprof[1] += (unsigned)__builtin_amdgcn_s_memtime() - sprof[0]; sprof[2] += 1u; }
#else
#define PROF_T0
#define PROF_T1
#endif
    const TileOff toff = tile_offsets(PCOLS, SEQ, tid);
    tile_gload(src(slist[0]), toff, rkA, rvA); tile_swrite(smem, 0, rkA, rvA, tid);
    if (n > 1) tile_gload(src(slist[1]), toff, rkA, rvA);
    __syncthreads();
#pragma unroll 1
    for (int i = 0; i < n; i += 2) {
        if (i + 2 < n) tile_gload(src(slist[i + 2]), toff, rkB, rvB);
        __builtin_amdgcn_sched_barrier(0);
        PROF_T0 step(i, 0); PROF_T1
        __builtin_amdgcn_sched_barrier(0);
        if (i + 1 < n) tile_swrite(smem, 1, rkA, rvA, tid);
        __syncthreads();
        if (i + 1 >= n) break;
        if (i + 3 < n) tile_gload(src(slist[i + 3]), toff, rkA, rvA);
        __builtin_amdgcn_sched_barrier(0);
        PROF_T0 step(i + 1, 1); PROF_T1
        __builtin_amdgcn_sched_barrier(0);
        if (i + 2 < n) tile_swrite(smem, 0, rkB, rvB, tid);
        __syncthreads();
    }
    finish_branch(2);
#ifdef PROF
    if (tid == 0) {
        unsigned long long* pw = (unsigned long long*)(p.ws + OFF_counts + 1024);
        atomicAdd(&pw[0], (unsigned long long)sprof[1]); atomicAdd(&pw[1], (unsigned long long)((unsigned)__builtin_amdgcn_s_memtime() - sprof[3])); atomicAdd(&pw[2], (unsigned long long)sprof[2]);
    }
#endif
}

__device__ void gla_c_item(const Params& p, int item, char* smem) {
    const int tid = opaque_tid(), lane = tid & 63, wid = tid >> 6, fr = lane & 15, fq = lane >> 4;
    const int bh = item >> 6, c = item & 63, b = bh >> 2, h = bh & 3;
    const int tok0 = c * 64, tokg0 = b * SEQ + tok0;
    float* sb = (float*)smem; float* sglr = (float*)(smem + 16384); float* swa = (float*)(smem + 20480); float* sqt = (float*)(smem + 24576);
    char* sST = smem;
    char* sQB = smem + 25600; char* sKB = smem + 34816; char* sVT = smem + 44032;
    gla_cumsum(p, tokg0, h, sb, sglr, swa, sqt);
    {
        const int d = tid & 63, tq = tid >> 6;
#pragma unroll 4
        for (int tt = 0; tt < 16; ++tt) {
            const int tk = tq * 16 + tt;
            const float bt = sb[tk * 64 + d];
            const float q = bf2f(p.Pb()[(size_t)(tokg0 + tk) * PCOLS + P_GQ + h * 64 + d]);
            const float k = bf2f(p.Pb()[(size_t)(tokg0 + tk) * PCOLS + P_GK + h * 64 + d]);
            *(bf16_t*)(sQB + (tk * LDS_ROW + d) * 2) = f2bf(q * 0.125f * __expf(bt));
            *(bf16_t*)(sKB + (tk * LDS_ROW + d) * 2) = f2bf(k * __expf(-bt));
        }
    }
#pragma unroll
    for (int i = 0; i < 4; ++i) {
        const int cidx = tid + 256 * i, e = cidx >> 3, ch = (cidx & 7) * 8;
        *(u32x4*)(sVT + (e * LDS_ROW + ch) * 2) = *(const u32x4*)(p.VgT() + ((size_t)bh * 128 + e) * SEQ + tok0 + ch);
    }
    __syncthreads();
#pragma unroll
    for (int i = 0; i < 4; ++i) {
        const int cidx = tid + 256 * i, e = cidx >> 3, ch = (cidx & 7) * 8;
        *(u32x4*)(sST + (e * LDS_ROW + ch) * 2) = *(const u32x4*)(p.ST() + ((size_t)item << 13) + e * 64 + ch);
    }
    __syncthreads();
    bf16x8 qbf[2];
#pragma unroll
    for (int ks = 0; ks < 2; ++ks) qbf[ks] = *(const bf16x8*)(sQB + ((wid * 16 + fr) * LDS_ROW + ks * 32 + fq * 8) * 2);
    f32x4 sa[4];
#pragma unroll
    for (int ms = 0; ms < 4; ++ms) {
        sa[ms] = (f32x4){0.f, 0.f, 0.f, 0.f};
#pragma unroll
        for (int ks = 0; ks < 2; ++ks) {
            bf16x8 a = *(const bf16x8*)(sKB + ((ms * 16 + fr) * LDS_ROW + ks * 32 + fq * 8) * 2);
            sa[ms] = __builtin_amdgcn_mfma_f32_16x16x32_bf16(a, qbf[ks], sa[ms], 0, 0, 0);
        }
#pragma unroll
        for (int j = 0; j < 4; ++j) sa[ms][j] = (ms * 16 + fq * 4 + j <= wid * 16 + fr) ? sa[ms][j] : 0.f;
    }
    bf16x8 pf[2];
#pragma unroll
    for (int kk = 0; kk < 2; ++kk) {
        u32x4 w;
        w.x = pk_bf16(sa[2 * kk][0], sa[2 * kk][1]); w.y = pk_bf16(sa[2 * kk][2], sa[2 * kk][3]);
        w.z = pk_bf16(sa[2 * kk + 1][0], sa[2 * kk + 1][1]); w.w = pk_bf16(sa[2 * kk + 1][2], sa[2 * kk + 1][3]);
        pf[kk] = __builtin_bit_cast(bf16x8, w);
    }
    f32x4 oa[8];
    float sum = 0.f;
#pragma unroll
    for (int me = 0; me < 8; ++me) {
        f32x4 acc = (f32x4){0.f, 0.f, 0.f, 0.f};
#pragma unroll
        for (int ks = 0; ks < 2; ++ks) {
            bf16x8 a = *(const bf16x8*)(sST + ((me * 16 + fr) * LDS_ROW + ks * 32 + fq * 8) * 2);
            acc = __builtin_amdgcn_mfma_f32_16x16x32_bf16(a, qbf[ks], acc, 0, 0, 0);
        }
#pragma unroll
        for (int kk = 0; kk < 2; ++kk) {
            u32x2 lo = *(const u32x2*)(sVT + ((me * 16 + fr) * LDS_ROW + kk * 32 + fq * 4) * 2);
            u32x2 hi = *(const u32x2*)(sVT + ((me * 16 + fr) * LDS_ROW + kk * 32 + 16 + fq * 4) * 2);
            u32x4 w; w.x = lo.x; w.y = lo.y; w.z = hi.x; w.w = hi.y;
            acc = __builtin_amdgcn_mfma_f32_16x16x32_bf16(__builtin_bit_cast(bf16x8, w), pf[kk], acc, 0, 0, 0);
        }
        oa[me] = acc;
        sum += (acc[0] + acc[1]) + (acc[2] + acc[3]);
    }
    sum += __shfl_xor(sum, 16); sum += __shfl_xor(sum, 32);
    const float mu = sum * (1.f / 128.f);
    float var = 0.f;
#pragma unroll
    for (int me = 0; me < 8; ++me)
#pragma unroll
        for (int j = 0; j < 4; ++j) { const float dd = oa[me][j] - mu; var += dd * dd; }
    var += __shfl_xor(var, 16); var += __shfl_xor(var, 32);
    const float rstd = rsqrtf(var * (1.f / 128.f) + 1e-5f);
    const size_t tok = (size_t)tokg0 + wid * 16 + fr;
#pragma unroll
    for (int me = 0; me < 8; ++me) {
        const int e = me * 16 + fq * 4;
        const u32x2 rr = *(const u32x2*)(p.Pb() + tok * PCOLS + P_GR + h * 128 + e);
        const f32x4 nw = *(const f32x4*)(p.norm_w + e);
        float r[4] = {bflo(rr.x), bfhi(rr.x), bflo(rr.y), bfhi(rr.y)};
        float ov[4];
#pragma unroll
        for (int j = 0; j < 4; ++j) ov[j] = (oa[me][j] - mu) * rstd * nw[j] * (r[j] / (1.f + __expf(-r[j])));
        u32x2 w; w.x = pk_bf16(ov[0], ov[1]); w.y = pk_bf16(ov[2], ov[3]);
        *(u32x2*)(p.mixb() + tok * 1024 + 512 + h * 128 + e) = w;
    }
    __syncthreads();
}

#ifndef NSA_REP
#define NSA_REP 1
#endif
#ifndef NSA_MODE2
#define NSA_MODE2 0
#endif
#ifndef GLAC_REP
#define GLAC_REP 1
#endif
__device__ void phase5a(const Params& p, char* smem, int rep) {
    int* sidx = (int*)(smem + GEMM_SMEM - 16);
    for (;;) {
        __syncthreads();
        if (opaque_tid() == 0) *sidx = atomicAdd(&p.counts()[264 + 4 * rep], 1);
        __syncthreads();
        const int it = *sidx;
        if (it >= 512) break;
        nsa_cmp_item(p, it >> 3, it & 7, smem);
    }
    for (;;) {
        __syncthreads();
        if (opaque_tid() == 0) *sidx = atomicAdd(&p.counts()[265 + 4 * rep], 1);
        __syncthreads();
        const int it = *sidx;
        if (it >= 1024 * GLAC_REP) break;
        gla_c_item(p, it & 1023, smem);
    }
}
__device__ void phase5b(const Params& p, char* smem, int rep) {
    int* sidx = (int*)(smem + GEMM_SMEM - 16);
    for (;;) {
        __syncthreads();
        if (opaque_tid() == 0) *sidx = atomicAdd(&p.counts()[266 + 4 * rep], 1);
        __syncthreads();
        const int it = *sidx;
        if (it >= 1024 * NSA_REP) break;
        const int item = it & 1023;
        nsa_sw_item(p, item >> 4, (item >> 1) & 7, item & 1, smem, it >= 1024 ? NSA_MODE2 : 0);
    }
}
__device__ void phase6(const Params& p, char* smem) {
    const int xcd = xcd_of(smem), rank = rank_of(smem), nranks = nranks_of(smem);
    const int lane = opaque_tid() & 63, wid = opaque_tid() >> 6, wr = wid >> 1, wc = wid & 1, fr = lane & 15, fq = lane >> 4;
    for (int it = rank; it < 16 * 8; it += nranks) {
        const int mt = (it / 8) * 8 + xcd, nt = it % 8;
        RowsBf16 al{p.mixb() + (size_t)mt * 128 * 1024, 1024};
        RowsBf16 bl{p.wot() + (size_t)nt * 128 * 1024, 1024};
        f32x4 acc[4][4];
        gemm_128<true, false>(al, bl, 0, 16, smem, acc);
#pragma unroll
        for (int m = 0; m < 4; ++m)
#pragma unroll
            for (int n = 0; n < 4; ++n)
                *(f32x4*)(p.y1() + (size_t)(mt * 128 + wr * 64 + m * 16 + fr) * 1024 + nt * 128 + wc * 64 + n * 16 + fq * 4) = acc[m][n];
    }
}

__device__ void phase7(const Params& p) {
    const int lane = opaque_tid() & 63, gw = blockIdx.x * 4 + (opaque_tid() >> 6), nw = gridDim.x * 4;
    const float alpha = 1.189207115f;
    for (int row0 = gw * 2; row0 < NTOK; row0 += nw * 2) {
        const int b = row0 / SEQ;
        const float* md = p.mod() + b * 6144;
        f32x4 xv[2][4], yv[2][4];
#pragma unroll
        for (int r = 0; r < 2; ++r)
#pragma unroll
            for (int i = 0; i < 4; ++i) {
                const int col = i * 256 + lane * 4;
                xv[r][i] = *(const f32x4*)(p.x + (size_t)(row0 + r) * 1024 + col);
                yv[r][i] = *(const f32x4*)(p.y1() + (size_t)(row0 + r) * 1024 + col);
            }
#pragma unroll
        for (int r = 0; r < 2; ++r) {
            const int row = row0 + r;
            f32x4 v[4]; float s = 0.f;
#pragma unroll
            for (int i = 0; i < 4; ++i) {
                const int col = i * 256 + lane * 4;
                const f32x4 ga = *(const f32x4*)(md + 2048 + col);
#pragma unroll
                for (int j = 0; j < 4; ++j) v[i][j] = alpha * xv[r][i][j] + (1.f + ga[j]) * yv[r][i][j];
                s += (v[i][0] + v[i][1]) + (v[i][2] + v[i][3]);
            }
            float mu = wave_sum(s) * (1.f / 1024.f);
            float q = 0.f;
#pragma unroll
            for (int i = 0; i < 4; ++i)
#pragma unroll
                for (int j = 0; j < 4; ++j) { float d = v[i][j] - mu; q += d * d; }
            float rstd = rsqrtf(wave_sum(q) * (1.f / 1024.f) + 1e-5f);
            s = 0.f;
#pragma unroll
            for (int i = 0; i < 4; ++i) {
                const int col = i * 256 + lane * 4;
                f32x4 g = *(const f32x4*)(p.ln1_g + col), bb = *(const f32x4*)(p.ln1_b + col);
#pragma unroll
                for (int j = 0; j < 4; ++j) v[i][j] = (v[i][j] - mu) * rstd * g[j] + bb[j];
                *(f32x4*)(p.x1() + (size_t)row * 1024 + col) = v[i];
                s += (v[i][0] + v[i][1]) + (v[i][2] + v[i][3]);
            }
            mu = wave_sum(s) * (1.f / 1024.f);
            q = 0.f;
#pragma unroll
            for (int i = 0; i < 4; ++i)
#pragma unroll
                for (int j = 0; j < 4; ++j) { float d = v[i][j] - mu; q += d * d; }
            rstd = rsqrtf(wave_sum(q) * (1.f / 1024.f) + 1e-5f);
#pragma unroll
            for (int i = 0; i < 4; ++i) {
                const int col = i * 256 + lane * 4;
                f32x4 sh = *(const f32x4*)(md + 3072 + col), sc = *(const f32x4*)(md + 4096 + col);
                float o[4];
#pragma unroll
                for (int j = 0; j < 4; ++j) o[j] = (v[i][j] - mu) * rstd * (1.f + sc[j]) + sh[j];
                u32x2 w; w.x = pk_bf16(o[0], o[1]); w.y = pk_bf16(o[2], o[3]);
                *(u32x2*)(p.hb() + (size_t)row * 1024 + col) = w;
            }
        }
    }
}

__device__ void phase8(const Params& p, char* smem) {
    const int lane = opaque_tid() & 63, wid = opaque_tid() >> 6, wr = wid >> 1, wc = wid & 1, fr = lane & 15, fq = lane >> 4;
    for (int it = blockIdx.x; it < 256; it += gridDim.x) {
        const int mt = it >> 1, nt = it & 1;
        RowsBf16 al{p.hb() + (size_t)mt * 128 * 1024, 1024};
        RowsBf16 bl{p.wrt() + (size_t)nt * 128 * 1024, 1024};
        f32x4 acc[4][4];
        gemm_128<true, false>(al, bl, 0, 16, smem, acc);
#pragma unroll
        for (int m = 0; m < 4; ++m)
#pragma unroll
            for (int n = 0; n < 4; ++n)
                *(f32x4*)(p.logits() + (size_t)(mt * 128 + wr * 64 + m * 16 + fr) * 256 + nt * 128 + wc * 64 + n * 16 + fq * 4) = acc[m][n];
    }
}

__device__ void phase9(const Params& p) {
    const int lane = opaque_tid() & 63, gw = blockIdx.x * 4 + (opaque_tid() >> 6), nw = gridDim.x * 4;
    for (int tok = gw; tok < NTOK; tok += nw) {
        float s[4], sb[4];
        const f32x4 lg = *(const f32x4*)(p.logits() + (size_t)tok * 256 + lane * 4);
        const f32x4 rb = *(const f32x4*)(p.rbias + lane * 4);
#pragma unroll
        for (int i = 0; i < 4; ++i) { s[i] = 1.f / (1.f + __expf(-lg[i])); sb[i] = s[i] + rb[i]; }
        float m1 = NEGF, m2 = NEGF;
#pragma unroll
        for (int i = 0; i < 4; ++i) { float v = sb[i]; if (v > m1) { m2 = m1; m1 = v; } else if (v > m2) m2 = v; }
#pragma unroll
        for (int mm = 1; mm < 8; mm <<= 1) {
            float o1 = __shfl_xor(m1, mm), o2 = __shfl_xor(m2, mm);
            float n1 = fmaxf(m1, o1);
            float n2 = fmaxf(fminf(m1, o1), fmaxf(m2, o2));
            m1 = n1; m2 = n2;
        }
        const float gs = m1 + m2;
        const int grp = lane >> 3;
        int grank = 0;
#pragma unroll
        for (int g2 = 0; g2 < 8; ++g2) { float o = __shfl(gs, g2 * 8); if (o > gs || (o == gs && g2 < grp)) ++grank; }
        const bool gsel = grank < 4;
        float cand[4];
#pragma unroll
        for (int i = 0; i < 4; ++i) cand[i] = gsel ? sb[i] : NEGF;
        float wsum = 0.f, myw = 0.f; int mye = 0;
#pragma unroll 1
        for (int k = 0; k < TOPK; ++k) {
            float bv = cand[0]; int bi = 0;
#pragma unroll
            for (int i = 1; i < 4; ++i) if (cand[i] > bv) { bv = cand[i]; bi = i; }
            float gv = bv; int ge = lane * 4 + bi;
#pragma unroll
            for (int mm = 1; mm < 64; mm <<= 1) {
                float ov = __shfl_xor(gv, mm); int oe = __shfl_xor(ge, mm);
                if (ov > gv || (ov == gv && oe < ge)) { gv = ov; ge = oe; }
            }
            float sel_s = 0.f;
            if ((ge >> 2) == lane) {
                const int i = ge & 3;
                sel_s = (i == 0) ? s[0] : (i == 1) ? s[1] : (i == 2) ? s[2] : s[3];
                if (i == 0) cand[0] = -3e38f; else if (i == 1) cand[1] = -3e38f; else if (i == 2) cand[2] = -3e38f; else cand[3] = -3e38f;
            }
            sel_s = __shfl(sel_s, ge >> 2);
            wsum += sel_s;
            if (lane == k) { myw = sel_s; mye = ge; }
        }
        if (lane < TOPK) {
            const int id = tok * NASSIGN + lane;
            p.ew()[id] = myw / wsum * 2.5f;
            const int pos = atomicAdd(&p.counts()[mye], 1);
            p.lists()[(size_t)mye * NTOK + pos] = id;
        } else if (lane == TOPK) {
            p.ew()[tok * NASSIGN + TOPK] = 1.f;
        }
    }
}

struct Rows4 {
    static constexpr bool NT = false;
    const bf16_t *p0, *p1, *p2, *p3; int kmask;
    __device__ __forceinline__ const bf16_t* pp(int i, int tid, int k) const { return (i == 0 ? p0 : i == 1 ? p1 : i == 2 ? p2 : p3) + (k & kmask); }
};
template <int NT_PER>
__device__ __forceinline__ int build_entries(const Params& p, int xcd, int* spre) {
    const int tid = opaque_tid();
    __syncthreads();
    if (tid < 33) {
        int items;
        if (tid < 32) { const int cnt = p.counts()[xcd + 8 * tid]; items = ((cnt + 127) >> 7) * NT_PER; }
        else items = 16 * NT_PER;
        spre[64 + tid] = items;
    }
    __syncthreads();
    if (tid == 0) { int a = 0; for (int i = 0; i < 33; ++i) { spre[i] = a; a += spre[64 + i]; } spre[33] = a; }
    __syncthreads();
    return spre[33];
}

template <int NT_PER>
__device__ __forceinline__ void decode_item(const Params& p, int xcd, const int* spre, int it, int& e, int& nt, int& mtile, int& cnt) {
    int ent = 0;
    for (int i = 1; i < 33; ++i) ent = (it >= spre[i]) ? i : ent;
    const int local = it - spre[ent];
    if (ent < 32) {
        e = xcd + 8 * ent; cnt = p.counts()[e];
        const int mtc = (cnt + 127) >> 7;
        nt = local / mtc; mtile = local % mtc;
    } else {
        e = N_EXP; cnt = NTOK; nt = local >> 4; mtile = (local & 15) * 8 + xcd;
    }
}

#ifndef P10_NT
#define P10_NT 4
#endif
struct BF32GateUpS {
    const float* g; long du;
    __device__ __forceinline__ f32x4 load4(int kk, int r4) const {
        const long sel = ((r4 >> 5) & 1) ? du : 0l;
        return *(const f32x4*)(g + sel + (size_t)(kk & 1023) * 256 + (kk >> 10) * 64 + (r4 >> 6) * 32 + (r4 & 31));
    }
};
__device__ void phase10(const Params& p, char* smem) {
    const int tid = opaque_tid(), xcd = xcd_of(smem), rank = rank_of(smem), nranks = nranks_of(smem);
    const int lane = tid & 63, wid = tid >> 6, wr = wid >> 1, wc = wid & 1, fr = lane & 15, fq = lane >> 4;
    int* srow = (int*)(smem + GEMM_SMEM);
    int* spre = srow + 256;
#ifndef P10_REP
#define P10_REP 1
#endif
    const int total = build_entries<P10_NT>(p, xcd, spre);
#ifdef STAGGER
    for (int i = 0; i < (rank & 3) * STAGGER; ++i) __builtin_amdgcn_s_sleep(32);
#endif
    for (int it0 = rank; it0 < total * P10_REP; it0 += nranks) {
        const int it = it0 % total;
        int e, nt, mtile, cnt;
        decode_item<P10_NT>(p, xcd, spre, it, e, nt, mtile, cnt);
        if (tid < 128) {
            const int pos = mtile * 128 + tid;
            int id = -1;
            if (pos < cnt) id = (e == N_EXP) ? (pos * NASSIGN + TOPK) : p.lists()[(size_t)e * NTOK + pos];
            srow[tid] = id >= 0 ? id / NASSIGN : 0;
            srow[128 + tid] = id;
        }
        __syncthreads();
        Rows4 al; al.kmask = 1023;
        al.p0 = p.hb() + (size_t)srow[(tid >> 3)] * 1024; al.p1 = p.hb() + (size_t)srow[32 + (tid >> 3)] * 1024;
        al.p2 = p.hb() + (size_t)srow[64 + (tid >> 3)] * 1024; al.p3 = p.hb() + (size_t)srow[96 + (tid >> 3)] * 1024;
        const float* Wg = (e == N_EXP) ? p.w_s_gate : p.w_e_gate + (size_t)e * 1024 * 256;
        const float* Wu = (e == N_EXP) ? p.w_s_up : p.w_e_up + (size_t)e * 1024 * 256;
        BF32GateUpS bl{Wg + nt * (256 / P10_NT), (long)(Wu - Wg)};
        f32x4 acc[4][4];
        bf16_t* hidp = p.hid();
        gemm_core<true, true>(al, bl, 0, 16 * (4 / P10_NT), 16, smem, acc, [&](int tl, const f32x4 (&a)[4][4]) __attribute__((always_inline)) {
            const int nt4 = nt * (4 / P10_NT) + tl;
#pragma unroll
            for (int m = 0; m < 4; ++m) {
                const int id = srow[128 + wr * 64 + m * 16 + fr];
                if (id >= 0) {
#pragma unroll
                    for (int n = 0; n < 2; ++n) {
                        float hv[4];
#pragma unroll
                        for (int j = 0; j < 4; ++j) { const float gte = a[m][n][j]; hv[j] = gte / (1.f + __expf(-gte)) * a[m][n + 2][j]; }
                        u32x2 w; w.x = pk_bf16(hv[0], hv[1]); w.y = pk_bf16(hv[2], hv[3]);
                        *(u32x2*)(hidp + (size_t)id * 256 + nt4 * 64 + wc * 32 + n * 16 + fq * 4) = w;
                    }
                }
            }
        });
        __syncthreads();
    }
}

struct DownB {
    const float* base;
    __device__ __forceinline__ f32x4 load4(int kk, int r4) const {
#ifdef NT_B
        return __builtin_nontemporal_load((const f32x4*)(base + (size_t)(kk & 255) * 1024 + (kk >> 8) * 128 + r4));
#else
        return *(const f32x4*)(base + (size_t)(kk & 255) * 1024 + (kk >> 8) * 128 + r4);
#endif
    }
};
struct HidA {
    static constexpr bool NT = true;
    const bf16_t* base; const int* rowidx;
    __device__ __forceinline__ const bf16_t* ptr(int r, int kk) const { return base + (size_t)rowidx[r] * 256 + (kk & 255); }
    __device__ __forceinline__ const bf16_t* pp(int i, int tid, int k) const { return ptr(i * 32 + (tid >> 3), k); }
};
#ifndef P11_NT
#define P11_NT 4
#endif
__device__ void phase11(const Params& p, char* smem) {
    const int tid = opaque_tid(), xcd = xcd_of(smem), rank = rank_of(smem), nranks = nranks_of(smem);
    const int lane = tid & 63, wid = tid >> 6, wr = wid >> 1, wc = wid & 1, fr = lane & 15, fq = lane >> 4;
    int* srow = (int*)(smem + GEMM_SMEM);
    int* spre = srow + 256;
    float* sew = (float*)(srow + 384);
#ifndef P11_REP
#define P11_REP 1
#endif
    const int total = build_entries<P11_NT>(p, xcd, spre);
    for (int it0 = rank; it0 < total * P11_REP; it0 += nranks) {
        const int it = it0 % total;
        int e, nt, mtile, cnt;
        decode_item<P11_NT>(p, xcd, spre, it, e, nt, mtile, cnt);
        if (tid < 128) {
            const int pos = mtile * 128 + tid;
            int id = -1;
            if (pos < cnt) id = (e == N_EXP) ? (pos * NASSIGN + TOPK) : p.lists()[(size_t)e * NTOK + pos];
            srow[tid] = id >= 0 ? id : 0;
            srow[128 + tid] = id;
            sew[tid] = id >= 0 ? p.ew()[id] : 0.f;
        }
        __syncthreads();
        Rows4 al; al.kmask = 255;
        al.p0 = p.hid() + (size_t)srow[(tid >> 3)] * 256; al.p1 = p.hid() + (size_t)srow[32 + (tid >> 3)] * 256;
        al.p2 = p.hid() + (size_t)srow[64 + (tid >> 3)] * 256; al.p3 = p.hid() + (size_t)srow[96 + (tid >> 3)] * 256;
        DownB bl{(e == N_EXP) ? p.w_s_down : p.w_e_down + (size_t)e * 256 * 1024};
        f32x4 acc[4][4];
        bf16_t* outk = p.outk();
        auto epi = [&](int tile, const f32x4 (&a)[4][4]) __attribute__((always_inline)) {
#pragma unroll
            for (int m = 0; m < 4; ++m) {
                const int rr = wr * 64 + m * 16 + fr;
                const int id = srow[128 + rr];
                if (id >= 0) {
                    const float w8 = sew[rr];
#pragma unroll
                    for (int n = 0; n < 4; ++n) {
                        u32x2 w; w.x = pk_bf16(a[m][n][0] * w8, a[m][n][1] * w8); w.y = pk_bf16(a[m][n][2] * w8, a[m][n][3] * w8);
                        *(u32x2*)(outk + (size_t)id * 1024 + tile * 128 + wc * 64 + n * 16 + fq * 4) = w;
                    }
                }
            }
        };
        gemm_core<true, true>(al, bl, nt * (2048 / P11_NT), 32 / P11_NT, 4, smem, acc, [&](int tl, const f32x4 (&a)[4][4]) __attribute__((always_inline)) { epi(nt * (8 / P11_NT) + tl, a); });
        __syncthreads();
    }
}

__device__ void phase12(const Params& p) {
    const int lane = opaque_tid() & 63, gw = blockIdx.x * 4 + (opaque_tid() >> 6), nw = gridDim.x * 4;
    const float alpha = 1.189207115f;
    for (int row = gw; row < NTOK; row += nw) {
        const int b = row / SEQ;
        const float* md = p.mod() + b * 6144;
        float v[16];
#pragma unroll
        for (int i = 0; i < 16; ++i) v[i] = 0.f;
#pragma unroll
        for (int k = 0; k < NASSIGN; ++k) {
#pragma unroll
            for (int cidx = 0; cidx < 2; ++cidx) {
                const u32x4 w = *(const u32x4*)(p.outk() + ((size_t)row * NASSIGN + k) * 1024 + cidx * 512 + lane * 8);
                v[cidx * 8 + 0] += bflo(w.x); v[cidx * 8 + 1] += bfhi(w.x); v[cidx * 8 + 2] += bflo(w.y); v[cidx * 8 + 3] += bfhi(w.y);
                v[cidx * 8 + 4] += bflo(w.z); v[cidx * 8 + 5] += bfhi(w.z); v[cidx * 8 + 6] += bflo(w.w); v[cidx * 8 + 7] += bfhi(w.w);
            }
        }
        float s = 0.f;
#pragma unroll
        for (int cidx = 0; cidx < 2; ++cidx)
#pragma unroll
            for (int hh = 0; hh < 2; ++hh) {
                const int col = cidx * 512 + lane * 8 + hh * 4;
                const f32x4 xv = *(const f32x4*)(p.x1() + (size_t)row * 1024 + col), ga = *(const f32x4*)(md + 5120 + col);
#pragma unroll
                for (int j = 0; j < 4; ++j) { float t = alpha * xv[j] + (1.f + ga[j]) * v[cidx * 8 + hh * 4 + j]; v[cidx * 8 + hh * 4 + j] = t; s += t; }
            }
        const float mu = wave_sum(s) * (1.f / 1024.f);
        float q = 0.f;
#pragma unroll
        for (int i = 0; i < 16; ++i) { float d = v[i] - mu; q += d * d; }
        const float rstd = rsqrtf(wave_sum(q) * (1.f / 1024.f) + 1e-5f);
#pragma unroll
        for (int cidx = 0; cidx < 2; ++cidx)
#pragma unroll
            for (int hh = 0; hh < 2; ++hh) {
                const int col = cidx * 512 + lane * 8 + hh * 4;
                const f32x4 g = *(const f32x4*)(p.ln2_g + col), bb = *(const f32x4*)(p.ln2_b + col);
                f32x4 o;
#pragma unroll
                for (int j = 0; j < 4; ++j) o[j] = (v[cidx * 8 + hh * 4 + j] - mu) * rstd * g[j] + bb[j];
                *(f32x4*)(p.out + (size_t)row * 1024 + col) = o;
            }
    }
}

#define XB_TMO      128
#define XB_XCNT(j)  (256  + 64 * (j))
#define XB_XSUB(j)  (1280 + 64 * (j))
#define XB_XGEN(j)  (2304 + 64 * (j))
#define XB_TOP      3328
#define XB_TOPGEN   3392
#define XCD_BAR_WORDS 3456
#define XB_SPIN_CAP (1u << 22)
#define LAS __attribute__((address_space(3)))
__device__ __forceinline__ unsigned xb_ld(unsigned* p) { return __hip_atomic_load(p, __ATOMIC_RELAXED, __HIP_MEMORY_SCOPE_AGENT); }
__device__ __forceinline__ unsigned xb_add(unsigned* p, unsigned v) { return __hip_atomic_fetch_add(p, v, __ATOMIC_RELAXED, __HIP_MEMORY_SCOPE_AGENT); }
__device__ __forceinline__ unsigned xb_xcc_id() { return (unsigned)__builtin_amdgcn_s_getreg((3 << 11) | 20) & 0xFu; }
#define XB_SPIN(cond, bar) do { unsigned _sp = 0; while (cond) { __builtin_amdgcn_s_sleep(1); \
    if ((++_sp & 255u) == 0u) { if (xb_ld(&(bar)[XB_TMO])) break; if (_sp > XB_SPIN_CAP) { atomicAdd(&(bar)[XB_TMO], 1u); break; } } } } while (0)
struct XcdBarrier { unsigned* bar; unsigned x; volatile LAS unsigned* st; };
__device__ __forceinline__ XcdBarrier xcd_barrier_post(unsigned* bar, volatile LAS unsigned* st) {
    XcdBarrier b; b.bar = bar; b.x = xb_xcc_id(); b.st = st;
    if (opaque_tid() == 0) st[2] = xb_add(&bar[XB_XCNT(b.x)], 1u);
    return b;
}
__device__ __forceinline__ void xcd_barrier_complete(unsigned* bar, unsigned x, unsigned& nloc, unsigned& nx) {
    const unsigned G = gridDim.x * gridDim.y * gridDim.z;
    unsigned sum, cnt, mine, sp = 0u;
    for (;;) {
        sum = 0u; cnt = 0u; mine = 0u;
#pragma unroll
        for (unsigned j = 0; j < 16; ++j) { const unsigned c = xb_ld(&bar[XB_XCNT(j)]); sum += c; cnt += (c > 0u) ? 1u : 0u; mine = (j == x) ? c : mine; }
        if (sum == G) break;
        __builtin_amdgcn_s_sleep(1);
        if ((++sp & 255u) == 0u) { if (xb_ld(&bar[XB_TMO])) break; if (sp > XB_SPIN_CAP) { atomicAdd(&bar[XB_TMO], 1u); break; } }
    }
    nloc = mine > 0u ? mine : 1u; nx = cnt > 0u ? cnt : 1u;
}
__device__ __forceinline__ void xcd_barrier(unsigned* bar, volatile LAS unsigned* st) {
    asm volatile("s_waitcnt vmcnt(0)" ::: "memory");
    __syncthreads();
    if (opaque_tid() == 0) {
        __builtin_amdgcn_s_waitcnt(0);
        const unsigned x = st[3];
        unsigned nloc = st[0], nx = st[1];
        if (nloc == 0u) { xcd_barrier_complete(bar, x, nloc, nx); st[0] = nloc; st[1] = nx; }
        const unsigned old = xb_add(&bar[XB_XSUB(x)], 1u);
        const unsigned gen = old / nloc;
        if (old + 1u == (gen + 1u) * nloc) {
            __builtin_amdgcn_fence(__ATOMIC_RELEASE, "agent");
            asm volatile("s_waitcnt vmcnt(0)" ::: "memory");
            const unsigned og = xb_add(&bar[XB_TOP], 1u);
            const unsigned tg = og / nx;
            if (og + 1u == (tg + 1u) * nx) xb_add(&bar[XB_TOPGEN], 1u);
            else XB_SPIN(xb_ld(&bar[XB_TOPGEN]) == tg, bar);
            __builtin_amdgcn_fence(__ATOMIC_ACQUIRE, "agent");
            xb_add(&bar[XB_XGEN(x)], 1u);
            asm volatile("s_waitcnt vmcnt(0)" ::: "memory");
        } else {
            XB_SPIN(xb_ld(&bar[XB_XGEN(x)]) == gen, bar);
            __builtin_amdgcn_fence(__ATOMIC_ACQUIRE, "agent");
            asm volatile("s_waitcnt vmcnt(0)" ::: "memory");
        }
    }
    __syncthreads();
}

#define MEGA_SMEM (GEMM_SMEM + 2048 + 64)
#define N_PHASES 14
__global__ void __launch_bounds__(256, 2) mega(Params p) {
    extern __shared__ __attribute__((aligned(16))) char smem[];
    volatile LAS unsigned* st = (volatile LAS unsigned*)(smem + GEMM_SMEM + 2048);
    if (p.ph_hi - p.ph_lo > 1) {
        if (opaque_tid() == 0) {
            const unsigned x = xb_xcc_id();
            st[0] = 0u; st[1] = 0u; st[3] = x;
            st[2] = xb_add(&p.bar()[XB_XCNT(x)], 1u);
        }
    } else {
        if (opaque_tid() == 0) { st[0] = gridDim.x >> 3; st[1] = 8u; st[2] = blockIdx.x >> 3; st[3] = blockIdx.x & 7; }
    }
    __syncthreads();
#ifndef REP_PHASE
#define REP_PHASE -1
#endif
#ifdef PHPROF
#define PH_STAMP(N) if (blockIdx.x == 0 && opaque_tid() == 0) ((unsigned long long*)(p.ws + OFF_counts + 1536))[N] = __builtin_amdgcn_s_memrealtime();
#else
#define PH_STAMP(N)
#endif
#define RUN_PHASE(N, CALL) if (p.ph_lo <= N && N < p.ph_hi) { if (N > p.ph_lo) xcd_barrier(p.bar(), st); PH_STAMP(N) { const int rep = 0; (void)rep; CALL; } \
        if (REP_PHASE == N) { xcd_barrier(p.bar(), st); { const int rep = 1; (void)rep; CALL; } } }
    RUN_PHASE(0, phase0(p, smem))
    RUN_PHASE(1, phase1(p))
    RUN_PHASE(2, phase2(p, smem))
    RUN_PHASE(3, phase3(p, smem))
    RUN_PHASE(4, phase4(p, smem))
    RUN_PHASE(5, phase5a(p, smem, rep))
    RUN_PHASE(6, phase5b(p, smem, rep))
    RUN_PHASE(7, phase6(p, smem))
    RUN_PHASE(8, phase7(p))
    RUN_PHASE(9, phase8(p, smem))
    RUN_PHASE(10, phase9(p))
    RUN_PHASE(11, phase10(p, smem))
    RUN_PHASE(12, phase11(p, smem))
    RUN_PHASE(13, phase12(p))
#ifdef EXTRA_BARRIERS
    for (int i = 0; i < EXTRA_BARRIERS; ++i) xcd_barrier(p.bar(), st);
#endif
    PH_STAMP(14)
    PH_STAMP(15)
}
#if DBG
struct NaiveBufs { float *mod, *h, *proj, *flat, *hidk, *hidv, *kc, *vc, *mix, *ograw, *y, *x1, *logits; };
__device__ __forceinline__ void dbg_pair(int seam, size_t i, const Params& p, const NaiveBufs& nb, float& a, float& b, bool& use) {
    use = true; a = 0.f; b = 0.f;
    switch (seam) {
        case 0: {
            a = nb.mod[i]; b = p.mod()[i]; break; }
        case 1: {
            size_t tok = i / PCOLS; int n = (int)(i % PCOLS);
            int src = win_srccol(n);
            bool transposed = (n >= 896 && n < 1024) || (n >= 1152 && n < 1280) || (n >= 1792 && n < 2304) || n >= 2816;
            if (transposed || src < 0) { use = false; break; }
            a = nb.proj[tok * IN_COLS + src]; b = bf2f(p.Pb()[i]); break; }
        case 2: {
            size_t half = (size_t)BATCH * 128 * SEQ; int which = i >= half; size_t j = which ? i - half : i;
            int t = (int)(j % SEQ); int f = (int)((j / SEQ) % 128); int bb = (int)(j / ((size_t)SEQ * 128));
            a = nb.proj[((size_t)bb * SEQ + t) * IN_COLS + (which ? C_VW : C_VS) + f];
            b = bf2f(which ? p.VwT()[j] : p.VsT()[j]); break; }
        case 3: {
            size_t nv = (size_t)BATCH * 512 * SEQ;
            if (i < nv) { int t = (int)(i % SEQ); int f = (int)((i / SEQ) % 512); int bb = (int)(i / ((size_t)SEQ * 512));
                a = nb.proj[((size_t)bb * SEQ + t) * IN_COLS + C_GV + f]; b = bf2f(p.VgT()[i]); }
            else { size_t j = i - nv; size_t tok = j / 40; int f = (int)(j % 40);
                a = nb.proj[tok * IN_COLS + (f < 24 ? C_NG + f : C_GLR + f - 24)]; b = p.misc()[tok * 64 + f]; }
            break; }
        case 4: {
            size_t nk = (size_t)BATCH * NCMP * 2 * 64;
            size_t j = i < nk ? i : i - nk;
            int d = (int)(j % 64); int g = (int)((j / 64) % 2); int ii = (int)((j / 128) % NCMP); int bb = (int)(j / (128 * NCMP));
            if (i < nk) { a = nb.kc[j]; b = bf2f(p.kc()[((size_t)(bb * 2 + g) * 256 + ii) * 64 + d]); }
            else { a = nb.vc[j]; b = bf2f(p.vcT()[((size_t)(bb * 2 + g) * 64 + d) * 256 + ii]); }
            break; }
        case 5: {
            size_t tok = i / 512; int cidx = (int)(i % 512);
            a = nb.mix[tok * 1024 + cidx]; b = bf2f(p.mixb()[tok * 1024 + cidx]); break; }
        case 6: {
            size_t tok = i / 512; int cidx = (int)(i % 512);
            a = nb.mix[tok * 1024 + 512 + cidx]; b = bf2f(p.mixb()[tok * 1024 + 512 + cidx]); break; }
        case 7: { a = nb.x1[i]; b = p.x1()[i]; break; }
        case 8: { a = nb.logits[i]; b = p.logits()[i]; break; }
    }
}
__global__ __launch_bounds__(256) void dbg_compare(int seam, size_t n, Params p, NaiveBufs nb, float* dbg) {
    __shared__ float red[256];
    float sd = 0.f, sa = 0.f;
    for (size_t i = (size_t)blockIdx.x * 256 + threadIdx.x; i < n; i += (size_t)gridDim.x * 256) {
        float a, b; bool use;
        dbg_pair(seam, i, p, nb, a, b, use);
        if (use) { float d = a - b; if (!(d == d)) d = 1e10f; sd += d * d; sa += a * a; }
    }
    sd = blk_sum(sd, red); sa = blk_sum(sa, red);
    if (threadIdx.x == 0) { atomicAdd(&dbg[2 * seam], sd); atomicAdd(&dbg[2 * seam + 1], sa); }
}
__global__ void dbg_decide(float* dbg, int nseams, int report_seam) {
    float code = 0.f;
    for (int k = 0; k < nseams; ++k) {
        float err = dbg[2 * k] / fmaxf(dbg[2 * k + 1], 1e-30f);
        const float thr = (k == 5) ? 3e-2f : 1e-3f;
        bool bad = !(err < thr);
        if (bad || k == report_seam) {
            float lg = log10f(fmaxf(err, 1e-12f));
            int dgt = (int)floorf(lg) + 6; dgt = dgt < 0 ? 0 : (dgt > 9 ? 9 : dgt);
            code = 100.f * (k + 1) + 10.f * dgt; break;
        }
    }
    dbg[64] = code;
}
__global__ void dbg_apply(const float* dbg, float* out, size_t n) {
    float code = dbg[64];
    if (code <= 0.f) return;
    float cst = sqrtf(code);
    for (size_t i = (size_t)blockIdx.x * 256 + threadIdx.x; i < n; i += (size_t)gridDim.x * 256) out[i] = cst;
}
#endif

#ifdef PROF
__global__ void prof_apply(const unsigned long long* pw, float* out, size_t n, int sel) {
    const double proc = (double)pw[0], tot = (double)pw[1], steps = (double)pw[2];
    float code = 0.f;
    if (sel == 0) code = (float)(100.0 * proc / tot);
    if (sel == 1) code = (float)(tot / steps / 10.0);
    if (sel == 2) code = (float)(proc / steps / 10.0);
    if (sel == 3) code = (float)(steps / 1024.0);
    const float cst = sqrtf(code);
    for (size_t i = (size_t)blockIdx.x * 256 + threadIdx.x; i < n; i += (size_t)gridDim.x * 256) out[i] = cst;
}
#endif
#ifdef PHPROF
__global__ void phase_prof_apply(const unsigned long long* ts, float* out, size_t n, int sel) {
    double us;
    if (sel >= 100) us = (double)(ts[15] - ts[0]) / 100.0;
    else us = (double)(ts[sel + 1] - ts[sel]) / 100.0;
    const float cst = (float)log2(us > 1.0 ? us : 1.0);
    for (size_t i = (size_t)blockIdx.x * 256 + threadIdx.x; i < n; i += (size_t)gridDim.x * 256) out[i] = cst;
}
#endif
extern "C" void kernel_launch(void* const* d_in, const int* in_sizes, int n_in, void* d_out, int out_size,
                              void* d_ws, size_t ws_size, hipStream_t stream) {
    Params p{};
    const float** ins = (const float**)&p;
    for (int i = 0; i < 27; ++i) ins[i] = (const float*)d_in[i];
    p.out = (float*)d_out;

    char* ws = (char*)d_ws;
    p.ws = ws;
    if (WS_TOTAL > ws_size) return;
#if DBG
    size_t off = 0;
    auto alloc = [&](size_t bytes) { char* q = ws + off; off += (bytes + 255) & ~(size_t)255; return q; };
    NaiveBufs nb{};
    nb.mod = (float*)alloc(4 * 6144 * 4);
    nb.h = (float*)alloc((size_t)NTOK * 1024 * 4);
    nb.proj = (float*)alloc((size_t)NTOK * IN_COLS * 4);
    nb.flat = (float*)alloc((size_t)2040 * 2048 * 4);
    nb.hidk = (float*)alloc((size_t)2040 * 256 * 4);
    nb.hidv = (float*)alloc((size_t)2040 * 256 * 4);
    nb.kc = (float*)alloc((size_t)2040 * 64 * 4);
    nb.vc = (float*)alloc((size_t)2040 * 64 * 4);
    nb.mix = (float*)alloc((size_t)NTOK * 1024 * 4);
    nb.ograw = (float*)alloc((size_t)NTOK * 512 * 4);
    nb.y = (float*)alloc((size_t)NTOK * 1024 * 4);
    nb.x1 = (float*)alloc((size_t)NTOK * 1024 * 4);
    nb.logits = (float*)alloc((size_t)NTOK * 256 * 4);
    float* dbg = (float*)alloc(1024);
    if (off > WS_BASE) return;
#endif

    static int grid = 0;
    if (grid == 0) {
        int dev = 0, cus = 0, per_cu = 0;
        (void)hipGetDevice(&dev);
        (void)hipDeviceGetAttribute(&cus, hipDeviceAttributeMultiprocessorCount, dev);
        (void)hipFuncSetAttribute((const void*)mega, hipFuncAttributeMaxDynamicSharedMemorySize, MEGA_SMEM);
        (void)hipOccupancyMaxActiveBlocksPerMultiprocessor(&per_cu, (const void*)mega, 256, MEGA_SMEM);
        per_cu = 2;
        grid = cus * per_cu;
        grid &= ~7;
    }
    (void)hipMemsetAsync(ws + OFF_bar, 0, XCD_BAR_WORDS * 4, stream);

#if DBG
    (void)hipMemsetAsync(dbg, 0, 1024, stream);
    nk_mod<<<dim3(24, 4), 256, 0, stream>>>(p.c, p.w_mod, p.b_mod, nb.mod);
    nk_lnmod<<<NTOK, 256, 0, stream>>>(p.x, nb.mod, 0, 1024, nb.h);
    nk_gemm<<<dim3((IN_COLS + 63) / 64, NTOK / 64), 256, 0, stream>>>(nb.h, 1024, p.w_in, IN_COLS, nb.proj, IN_COLS, NTOK, IN_COLS, 1024);
    nk_flat<<<2040, 256, 0, stream>>>(nb.proj, C_KC, p.pos_k, nb.flat);
    nk_gemm<<<dim3(4, 32), 256, 0, stream>>>(nb.flat, 2048, p.w1_k, 256, nb.hidk, 256, 2040, 256, 2048);
    nk_silu<<<(2040 * 256 + 255) / 256, 256, 0, stream>>>(nb.hidk, 2040 * 256);
    nk_gemm<<<dim3(1, 32), 256, 0, stream>>>(nb.hidk, 256, p.w2_k, 64, nb.kc, 64, 2040, 64, 256);
    nk_flat<<<2040, 256, 0, stream>>>(nb.proj, C_VC, p.pos_v, nb.flat);
    nk_gemm<<<dim3(4, 32), 256, 0, stream>>>(nb.flat, 2048, p.w1_v, 256, nb.hidv, 256, 2040, 256, 2048);
    nk_silu<<<(2040 * 256 + 255) / 256, 256, 0, stream>>>(nb.hidv, 2040 * 256);
    nk_gemm<<<dim3(1, 32), 256, 0, stream>>>(nb.hidv, 256, p.w2_v, 64, nb.vc, 64, 2040, 64, 256);
    nk_nsa<<<NTOK, 256, 0, stream>>>(nb.proj, nb.kc, nb.vc, nb.mix);
    nk_gla<<<64, 256, 0, stream>>>(nb.proj, p.w_a2, p.b_a2, nb.ograw);
    nk_gla_norm<<<NTOK, 256, 0, stream>>>(nb.ograw, nb.proj, p.norm_w, nb.mix);
    nk_gemm<<<dim3(16, NTOK / 64), 256, 0, stream>>>(nb.mix, 1024, p.w_o, 1024, nb.y, 1024, NTOK, 1024, 1024);
    nk_resln<<<NTOK, 256, 0, stream>>>(p.x, nb.y, nb.mod, 2048, p.ln1_g, p.ln1_b, nb.x1);
    nk_lnmod<<<NTOK, 256, 0, stream>>>(nb.x1, nb.mod, 3072, 4096, nb.h);
    nk_gemm<<<dim3(4, NTOK / 64), 256, 0, stream>>>(nb.h, 1024, p.w_router, 256, nb.logits, 256, NTOK, 256, 1024);
    auto cmp = [&](int seam, size_t n) { dbg_compare<<<1024, 256, 0, stream>>>(seam, n, p, nb, dbg); };
#endif

#if SINGLE_LAUNCH
    p.ph_lo = 0; p.ph_hi = N_PHASES;
    mega<<<grid, 256, MEGA_SMEM, stream>>>(p);
#else
    for (int ph = 0; ph < N_PHASES; ++ph) {
        p.ph_lo = ph; p.ph_hi = ph + 1;
        mega<<<grid, 256, MEGA_SMEM, stream>>>(p);
#if DBG
        if (ph == 0) cmp(0, 4 * 6144);
        if (ph == 2) { cmp(1, (size_t)NTOK * PCOLS); cmp(2, (size_t)2 * BATCH * 128 * SEQ); cmp(3, (size_t)BATCH * 512 * SEQ + (size_t)NTOK * 40); }
        if (ph == 4) cmp(4, (size_t)2 * BATCH * NCMP * 128);
        if (ph == 5) { cmp(5, (size_t)NTOK * 512); cmp(6, (size_t)NTOK * 512); }
        if (ph == 7) cmp(7, (size_t)NTOK * 1024);
        if (ph == 8) cmp(8, (size_t)NTOK * 256);
#endif
    }
#endif
#ifdef PHPROF
    phase_prof_apply<<<1024, 256, 0, stream>>>((const unsigned long long*)(ws + OFF_counts + 1536), p.out, (size_t)NTOK * 1024, PHPROF);
#endif
#ifdef PROF
    prof_apply<<<1024, 256, 0, stream>>>((const unsigned long long*)(ws + OFF_counts + 1024), p.out, (size_t)NTOK * 1024, PROF);
#endif
#if DBG
    dbg_decide<<<1, 1, 0, stream>>>(dbg, 9, DBG_REPORT);
    dbg_apply<<<1024, 256, 0, stream>>>(dbg, p.out, (size_t)NTOK * 1024);
#endif
}
```

```cpp
#include <hip/hip_runtime.h>
#include <hip/hip_bf16.h>
#include <stdint.h>

#define D_MODEL 1024
#define BATCH 4
#define SEQ 4096
#define NTOK (BATCH * SEQ)
#define IN_COLS 2856
#define NCMP 255
#define NEGF (-1e30f)
#define C_NQ 0
#define C_KC 512
#define C_VC 640
#define C_KS 768
#define C_VS 896
#define C_KW 1024
#define C_VW 1152
#define C_NG 1280
#define C_GQ 1304
#define C_GK 1560
#define C_GV 1816
#define C_GLR 2328
#define C_GR 2344
#define N_EXP 256
#define TOPK 8

__device__ __forceinline__ float siluf(float x) { return x / (1.f + __expf(-x)); }
__device__ __forceinline__ float sigmoidf_(float x) { return 1.f / (1.f + __expf(-x)); }

__device__ __forceinline__ float blk_sum(float v, float* red) {
    int t = threadIdx.x;
    __syncthreads();
    red[t] = v; __syncthreads();
    for (int s = 128; s > 0; s >>= 1) { if (t < s) red[t] += red[t + s]; __syncthreads(); }
    float r = red[0];
    return r;
}
__device__ __forceinline__ float blk_max(float v, float* red) {
    int t = threadIdx.x;
    __syncthreads();
    red[t] = v; __syncthreads();
    for (int s = 128; s > 0; s >>= 1) { if (t < s) red[t] = fmaxf(red[t], red[t + s]); __syncthreads(); }
    float r = red[0];
    return r;
}

#define DBG 0
#define SINGLE_LAUNCH 1
#define DBG_REPORT -1
#define REP_PHASE -1
#if DBG
__global__ __launch_bounds__(256) void nk_mod(const float* c, const float* w_mod, const float* b_mod, float* mod) {
    int j = blockIdx.x * 256 + threadIdx.x; int b = blockIdx.y;
    float acc = b_mod[j];
    for (int k = 0; k < D_MODEL; ++k) acc += siluf(c[b * D_MODEL + k]) * w_mod[(size_t)k * 6144 + j];
    mod[b * 6144 + j] = acc;
}

__global__ __launch_bounds__(256) void nk_lnmod(const float* x, const float* mod, int sh_off, int sc_off, float* out) {
    __shared__ float red[256];
    int row = blockIdx.x; int b = row / SEQ; int t = threadIdx.x;
    const float* xr = x + (size_t)row * D_MODEL;
    float v[4]; float s = 0.f;
    for (int i = 0; i < 4; ++i) { v[i] = xr[t + 256 * i]; s += v[i]; }
    float mu = blk_sum(s, red) * (1.f / D_MODEL);
    float q = 0.f;
    for (int i = 0; i < 4; ++i) { float d = v[i] - mu; q += d * d; }
    float var = blk_sum(q, red) * (1.f / D_MODEL);
    float rstd = rsqrtf(var + 1e-5f);
    for (int i = 0; i < 4; ++i) {
        int col = t + 256 * i;
        out[(size_t)row * D_MODEL + col] = (v[i] - mu) * rstd * (1.f + mod[b * 6144 + sc_off + col]) + mod[b * 6144 + sh_off + col];
    }
}

__global__ __launch_bounds__(256) void nk_resln(const float* x, const float* y, const float* mod, int ga_off, const float* g, const float* bb, float* out) {
    __shared__ float red[256];
    int row = blockIdx.x; int b = row / SEQ; int t = threadIdx.x;
    const float alpha = 1.189207115f;
    float v[4]; float s = 0.f;
    for (int i = 0; i < 4; ++i) {
        int col = t + 256 * i;
        v[i] = alpha * x[(size_t)row * D_MODEL + col] + (1.f + mod[b * 6144 + ga_off + col]) * y[(size_t)row * D_MODEL + col];
        s += v[i];
    }
    float mu = blk_sum(s, red) * (1.f / D_MODEL);
    float q = 0.f;
    for (int i = 0; i < 4; ++i) { float d = v[i] - mu; q += d * d; }
    float var = blk_sum(q, red) * (1.f / D_MODEL);
    float rstd = rsqrtf(var + 1e-5f);
    for (int i = 0; i < 4; ++i) {
        int col = t + 256 * i;
        out[(size_t)row * D_MODEL + col] = (v[i] - mu) * rstd * g[col] + bb[col];
    }
}

__global__ __launch_bounds__(256) void nk_gemm(const float* A, int lda, const float* B, int ldb, float* C, int ldc, int M, int N, int K) {
    __shared__ float sA[16][64 + 1];
    __shared__ float sB[16][64 + 1];
    int tx = threadIdx.x & 15, ty = threadIdx.x >> 4;
    int m0 = blockIdx.y * 64, n0 = blockIdx.x * 64;
    float acc[4][4];
    for (int i = 0; i < 4; ++i) for (int j = 0; j < 4; ++j) acc[i][j] = 0.f;
    for (int k0 = 0; k0 < K; k0 += 16) {
        for (int e = threadIdx.x; e < 1024; e += 256) {
            int r = e >> 4, kk = e & 15;
            int gm = m0 + r;
            sA[kk][r] = (gm < M) ? A[(size_t)gm * lda + k0 + kk] : 0.f;
            int kb = e >> 6, nn = e & 63;
            int gn = n0 + nn;
            sB[kb][nn] = (gn < N) ? B[(size_t)(k0 + kb) * ldb + gn] : 0.f;
        }
        __syncthreads();
#pragma unroll
        for (int kk = 0; kk < 16; ++kk) {
            float a[4], bv[4];
#pragma unroll
            for (int i = 0; i < 4; ++i) a[i] = sA[kk][ty * 4 + i];
#pragma unroll
            for (int j = 0; j < 4; ++j) bv[j] = sB[kk][tx * 4 + j];
#pragma unroll
            for (int i = 0; i < 4; ++i)
#pragma unroll
                for (int j = 0; j < 4; ++j) acc[i][j] += a[i] * bv[j];
        }
        __syncthreads();
    }
#pragma unroll
    for (int i = 0; i < 4; ++i)
#pragma unroll
        for (int j = 0; j < 4; ++j) {
            int gm = m0 + ty * 4 + i, gn = n0 + tx * 4 + j;
            if (gm < M && gn < N) C[(size_t)gm * ldc + gn] = acc[i][j];
        }
}

__global__ __launch_bounds__(256) void nk_flat(const float* proj, int col0, const float* pos, float* flat) {
    int r = blockIdx.x;
    int g = r & 1; int bi = r >> 1; int i = bi % NCMP; int b = bi / NCMP;
    for (int e = threadIdx.x; e < 2048; e += 256) {
        int l = e >> 6, d = e & 63;
        flat[(size_t)r * 2048 + e] = proj[((size_t)b * SEQ + 16 * i + l) * IN_COLS + col0 + g * 64 + d] + pos[l * 64 + d];
    }
}
__global__ void nk_silu(float* x, int n) { int i = blockIdx.x * 256 + threadIdx.x; if (i < n) x[i] = siluf(x[i]); }

__global__ __launch_bounds__(256) void nk_nsa(const float* proj, const float* kc, const float* vc, float* mix) {
    __shared__ float sq[8][64];
    __shared__ float sp[1024];
    __shared__ float red[256];
    __shared__ float simp[64];
    __shared__ float sscore[64];
    __shared__ int sidx[16];
    __shared__ float sout[8][64];
    __shared__ float spart[4][64];
    const int tid = threadIdx.x;
    const int bt = blockIdx.x; const int b = bt / SEQ, t = bt % SEQ;
    const float* prow = proj + (size_t)bt * IN_COLS;
    for (int e = tid; e < 512; e += 256) { sq[e >> 6][e & 63] = prow[C_NQ + e] * 0.125f; sout[e >> 6][e & 63] = 0.f; }
    __syncthreads();
    const int tblk = t >> 6;
    const int dd = tid & 63, part = tid >> 6;
    for (int g = 0; g < 2; ++g) {
        if (tid < 64) simp[tid] = 0.f;
        __syncthreads();
        for (int hp = 0; hp < 4; ++hp) {
            int h = g * 4 + hp;
            float slope = exp2f(-(float)(h + 1));
            float s = NEGF; bool valid = false;
            if (tid < NCMP) {
                int ce = 16 * tid + 31;
                valid = (t >= ce);
                if (valid) {
                    const float* kr = kc + (((size_t)b * NCMP + tid) * 2 + g) * 64;
                    float a = 0.f;
                    for (int d = 0; d < 64; ++d) a += sq[h][d] * kr[d];
                    s = a - slope * (float)(t - ce);
                }
            }
            float m = blk_max(s, red);
            float e = valid ? __expf(s - m) : 0.f;
            float sum = blk_sum(e, red);
            float p = e / fmaxf(sum, 1e-30f);
            __syncthreads();
            sp[tid] = p;
            __syncthreads();
            float a = 0.f;
            for (int i = part; i < NCMP; i += 4) a += sp[i] * vc[(((size_t)b * NCMP + i) * 2 + g) * 64 + dd];
            spart[part][dd] = a;
            __syncthreads();
            if (tid < 64) {
                float o = spart[0][tid] + spart[1][tid] + spart[2][tid] + spart[3][tid];
                float gate = sigmoidf_(prow[C_NG + h * 3 + 0]);
                sout[h][tid] += gate * o;
                int j = tid;
                float im = sp[4 * j] + sp[4 * j + 1] + sp[4 * j + 2] + 0.5f * sp[4 * j + 3] + (j > 0 ? 0.5f * sp[4 * j - 1] : 0.f);
                simp[j] += im;
            }
            __syncthreads();
        }
        if (tid < 64) {
            int j = tid;
            bool forced = (j == 0) || (j == tblk) || (j == tblk - 1);
            sscore[j] = (j <= tblk) ? (simp[j] + (forced ? 1e4f : 0.f)) : NEGF;
        }
        __syncthreads();
        if (tid < 64) {
            int j = tid; float sj = sscore[j]; int rank = 0;
            for (int j2 = 0; j2 < 64; ++j2) { float s2 = sscore[j2]; if (s2 > sj || (s2 == sj && j2 < j)) ++rank; }
            if (rank < 16) sidx[rank] = j;
        }
        __syncthreads();
        for (int hp = 0; hp < 4; ++hp) {
            int h = g * 4 + hp;
            float slope = exp2f(-(float)(h + 1));
            float sv[4]; bool vl[4]; float mx = NEGF;
            for (int r = 0; r < 4; ++r) {
                int kk = tid + 256 * r;
                int kpos = sidx[kk >> 6] * 64 + (kk & 63);
                vl[r] = (kpos <= t);
                sv[r] = NEGF;
                if (vl[r]) {
                    const float* kr = proj + ((size_t)b * SEQ + kpos) * IN_COLS + C_KS + g * 64;
                    float a = 0.f;
                    for (int d = 0; d < 64; ++d) a += sq[h][d] * kr[d];
                    sv[r] = a - slope * (float)(t - kpos);
                }
                mx = fmaxf(mx, sv[r]);
            }
            float m = blk_max(mx, red);
            float es = 0.f; float ev[4];
            for (int r = 0; r < 4; ++r) { ev[r] = vl[r] ? __expf(sv[r] - m) : 0.f; es += ev[r]; }
            float sum = blk_sum(es, red);
            float inv = 1.f / fmaxf(sum, 1e-30f);
            __syncthreads();
            for (int r = 0; r < 4; ++r) sp[tid + 256 * r] = ev[r] * inv;
            __syncthreads();
            float a = 0.f;
            for (int kk = part; kk < 1024; kk += 4) {
                float p = sp[kk];
                if (p != 0.f) {
                    int kpos = sidx[kk >> 6] * 64 + (kk & 63);
                    a += p * proj[((size_t)b * SEQ + kpos) * IN_COLS + C_VS + g * 64 + dd];
                }
            }
            spart[part][dd] = a;
            __syncthreads();
            if (tid < 64) {
                float o = spart[0][tid] + spart[1][tid] + spart[2][tid] + spart[3][tid];
                float gate = sigmoidf_(prow[C_NG + h * 3 + 1]);
                sout[h][tid] += gate * o;
            }
            __syncthreads();
        }
        for (int hp = 0; hp < 4; ++hp) {
            int h = g * 4 + hp;
            float slope = exp2f(-(float)(h + 1));
            float sv[2]; bool vl[2]; float mx = NEGF;
            for (int r = 0; r < 2; ++r) {
                int kk = tid + 256 * r;
                int kpos = t - 511 + kk;
                vl[r] = (kpos >= 0);
                sv[r] = NEGF;
                if (vl[r]) {
                    const float* kr = proj + ((size_t)b * SEQ + kpos) * IN_COLS + C_KW + g * 64;
                    float a = 0.f;
                    for (int d = 0; d < 64; ++d) a += sq[h][d] * kr[d];
                    sv[r] = a - slope * (float)(t - kpos);
                }
                mx = fmaxf(mx, sv[r]);
            }
            float m = blk_max(mx, red);
            float es = 0.f; float ev[2];
            for (int r = 0; r < 2; ++r) { ev[r] = vl[r] ? __expf(sv[r] - m) : 0.f; es += ev[r]; }
            float sum = blk_sum(es, red);
            float inv = 1.f / fmaxf(sum, 1e-30f);
            __syncthreads();
            for (int r = 0; r < 2; ++r) sp[tid + 256 * r] = ev[r] * inv;
            __syncthreads();
            float a = 0.f;
            for (int kk = part; kk < 512; kk += 4) {
                float p = sp[kk];
                if (p != 0.f) {
                    int kpos = t - 511 + kk;
                    a += p * proj[((size_t)b * SEQ + kpos) * IN_COLS + C_VW + g * 64 + dd];
                }
            }
            spart[part][dd] = a;
            __syncthreads();
            if (tid < 64) {
                float o = spart[0][tid] + spart[1][tid] + spart[2][tid] + spart[3][tid];
                float gate = sigmoidf_(prow[C_NG + h * 3 + 2]);
                sout[h][tid] += gate * o;
            }
            __syncthreads();
        }
    }
    for (int e = tid; e < 512; e += 256) mix[(size_t)bt * D_MODEL + e] = sout[e >> 6][e & 63];
}

__global__ __launch_bounds__(256) void nk_gla(const float* proj, const float* w_a2, const float* b_a2, float* ograw) {
    __shared__ float sqv[64], skv[64], sav[64];
    __shared__ float red[8][32];
    const int tid = threadIdx.x;
    const int es = blockIdx.x & 3, bh = blockIdx.x >> 2, h = bh & 3, b = bh >> 2;
    const int e = tid & 31, dg = tid >> 5;
    float S[8];
    for (int i = 0; i < 8; ++i) S[i] = 0.f;
    for (int t = 0; t < SEQ; ++t) {
        const float* prow = proj + ((size_t)b * SEQ + t) * IN_COLS;
        if (tid < 64) {
            int d = tid;
            sqv[d] = prow[C_GQ + h * 64 + d] * 0.125f;
            skv[d] = prow[C_GK + h * 64 + d];
            float x = b_a2[h * 64 + d];
            for (int r = 0; r < 16; ++r) x += prow[C_GLR + r] * w_a2[r * 256 + h * 64 + d];
            float ls = -(fmaxf(-x, 0.f) + log1pf(__expf(-fabsf(x))));
            sav[d] = __expf(ls * (1.f / 16.f));
        }
        __syncthreads();
        float v = prow[C_GV + h * 128 + es * 32 + e];
        float part = 0.f;
        for (int i = 0; i < 8; ++i) {
            int d = dg * 8 + i;
            S[i] = sav[d] * S[i] + skv[d] * v;
            part += sqv[d] * S[i];
        }
        red[dg][e] = part;
        __syncthreads();
        if (tid < 32) {
            float o = 0.f;
            for (int i = 0; i < 8; ++i) o += red[i][tid];
            ograw[((size_t)b * SEQ + t) * 512 + h * 128 + es * 32 + tid] = o;
        }
    }
}
__global__ __launch_bounds__(256) void nk_gla_norm(const float* ograw, const float* proj, const float* norm_w, float* mix) {
    int wid = (blockIdx.x * 256 + threadIdx.x) >> 6; int lane = threadIdx.x & 63;
    int tok = wid >> 2, h = wid & 3;
    const float* o = ograw + (size_t)tok * 512 + h * 128;
    float a = o[lane], c = o[lane + 64];
    float s = a + c;
    for (int m = 32; m > 0; m >>= 1) s += __shfl_xor(s, m);
    float mu = s * (1.f / 128.f);
    float q = (a - mu) * (a - mu) + (c - mu) * (c - mu);
    for (int m = 32; m > 0; m >>= 1) q += __shfl_xor(q, m);
    float rstd = rsqrtf(q * (1.f / 128.f) + 1e-5f);
    const float* r = proj + (size_t)tok * IN_COLS + C_GR + h * 128;
    mix[(size_t)tok * D_MODEL + 512 + h * 128 + lane] = (a - mu) * rstd * norm_w[lane] * siluf(r[lane]);
    mix[(size_t)tok * D_MODEL + 512 + h * 128 + lane + 64] = (c - mu) * rstd * norm_w[lane + 64] * siluf(r[lane + 64]);
}

__global__ __launch_bounds__(256) void nk_route(const float* logits, const float* rbias, int* eidx, float* ew, int* counts, int* lists) {
    int wid = (blockIdx.x * 256 + threadIdx.x) >> 6; int lane = threadIdx.x & 63;
    int tok = wid;
    float s[4], sb[4];
    for (int i = 0; i < 4; ++i) { float l = logits[(size_t)tok * 256 + lane * 4 + i]; s[i] = 1.f / (1.f + __expf(-l)); sb[i] = s[i] + rbias[lane * 4 + i]; }
    float m1 = NEGF, m2 = NEGF;
    for (int i = 0; i < 4; ++i) { float v = sb[i]; if (v > m1) { m2 = m1; m1 = v; } else if (v > m2) m2 = v; }
    for (int m = 1; m < 8; m <<= 1) {
        float o1 = __shfl_xor(m1, m), o2 = __shfl_xor(m2, m);
        float n1 = fmaxf(m1, o1);
        float n2 = fmaxf(fminf(m1, o1), fmaxf(m2, o2));
        m1 = n1; m2 = n2;
    }
    float gs = m1 + m2;
    int grp = lane >> 3;
    int grank = 0;
    for (int g2 = 0; g2 < 8; ++g2) { float o = __shfl(gs, g2 * 8); if (o > gs || (o == gs && g2 < grp)) ++grank; }
    bool gsel = grank < 4;
    float cand[4];
    for (int i = 0; i < 4; ++i) cand[i] = gsel ? sb[i] : NEGF;
    float wsum = 0.f; float myw = 0.f; int mye = 0;
    for (int k = 0; k < TOPK; ++k) {
        float bv = cand[0]; int bi = 0;
        for (int i = 1; i < 4; ++i) if (cand[i] > bv) { bv = cand[i]; bi = i; }
        int be = lane * 4 + bi;
        float gv = bv; int ge = be;
        for (int m = 1; m < 64; m <<= 1) {
            float ov = __shfl_xor(gv, m); int oe = __shfl_xor(ge, m);
            if (ov > gv || (ov == gv && oe < ge)) { gv = ov; ge = oe; }
        }
        float sel_s = 0.f;
        if ((ge >> 2) == lane) {
            int i = ge & 3;
            sel_s = (i == 0) ? s[0] : (i == 1) ? s[1] : (i == 2) ? s[2] : s[3];
            if (i == 0) cand[0] = -3e38f; else if (i == 1) cand[1] = -3e38f; else if (i == 2) cand[2] = -3e38f; else cand[3] = -3e38f;
        }
        sel_s = __shfl(sel_s, ge >> 2);
        wsum += sel_s;
        if (lane == k) { myw = sel_s; mye = ge; }
    }
    if (lane < TOPK) {
        float w = myw / wsum * 2.5f;
        eidx[tok * 8 + lane] = mye; ew[tok * 8 + lane] = w;
        int pos = atomicAdd(&counts[mye], 1);
        lists[(size_t)mye * NTOK + pos] = tok * 8 + lane;
    }
}

__global__ __launch_bounds__(256) void nk_moe(const float* h2, const float* wg, const float* wu, const float* wd,
                                              const float* sg, const float* su, const float* sd,
                                              const int* counts, const int* lists, const float* ew, float* acc) {
    __shared__ float sh[8][D_MODEL];
    __shared__ float shid[8][256];
    __shared__ int stok[8]; __shared__ float sw[8];
    const int e = blockIdx.y, chunk = blockIdx.x, tid = threadIdx.x;
    const int cnt = (e == N_EXP) ? NTOK : counts[e];
    if (chunk * 8 >= cnt) return;
    const float* Wg = (e == N_EXP) ? sg : wg + (size_t)e * D_MODEL * 256;
    const float* Wu = (e == N_EXP) ? su : wu + (size_t)e * D_MODEL * 256;
    const float* Wd = (e == N_EXP) ? sd : wd + (size_t)e * 256 * D_MODEL;
    if (tid < 8) {
        int p = chunk * 8 + tid;
        if (p < cnt) {
            if (e == N_EXP) { stok[tid] = p; sw[tid] = 1.f; }
            else { int id = lists[(size_t)e * NTOK + p]; stok[tid] = id >> 3; sw[tid] = ew[id]; }
        } else { stok[tid] = -1; sw[tid] = 0.f; }
    }
    __syncthreads();
    for (int m = 0; m < 8; ++m) {
        int tk = stok[m];
        for (int k = tid; k < D_MODEL; k += 256) sh[m][k] = (tk >= 0) ? h2[(size_t)tk * D_MODEL + k] : 0.f;
    }
    __syncthreads();
    float ag[8], au[8];
#pragma unroll
    for (int m = 0; m < 8; ++m) { ag[m] = 0.f; au[m] = 0.f; }
    for (int k = 0; k < D_MODEL; ++k) {
        float g = Wg[(size_t)k * 256 + tid], u = Wu[(size_t)k * 256 + tid];
#pragma unroll
        for (int m = 0; m < 8; ++m) { float hv = sh[m][k]; ag[m] += hv * g; au[m] += hv * u; }
    }
#pragma unroll
    for (int m = 0; m < 8; ++m) shid[m][tid] = siluf(ag[m]) * au[m];
    __syncthreads();
    for (int jj = 0; jj < 4; ++jj) {
        int j = tid + 256 * jj;
        float ao[8];
#pragma unroll
        for (int m = 0; m < 8; ++m) ao[m] = 0.f;
        for (int n = 0; n < 256; ++n) {
            float w = Wd[(size_t)n * D_MODEL + j];
#pragma unroll
            for (int m = 0; m < 8; ++m) ao[m] += shid[m][n] * w;
        }
#pragma unroll
        for (int m = 0; m < 8; ++m) { int tk = stok[m]; if (tk >= 0) atomicAdd(&acc[(size_t)tk * D_MODEL + j], ao[m] * sw[m]); }
    }
}

#endif
typedef unsigned short bf16_t;
typedef short bf16x8 __attribute__((ext_vector_type(8)));
typedef float f32x4 __attribute__((ext_vector_type(4)));
typedef unsigned u32x4 __attribute__((ext_vector_type(4)));
typedef unsigned u32x2 __attribute__((ext_vector_type(2)));

#define PCOLS 2944
#define P_NQ 0
#define P_KC 512
#define P_VC 640
#define P_KS 768
#define P_VS 896
#define P_KW 1024
#define P_VW 1152
#define P_GQ 1280
#define P_GK 1536
#define P_GV 1792
#define P_GR 2304
#define P_MISC 2816
#define NASSIGN 9
#define LOG2E 1.4426950408889634f

typedef float f32x2_t __attribute__((ext_vector_type(2)));
typedef __bf16 bf16x2_t __attribute__((ext_vector_type(2)));
__device__ __forceinline__ unsigned pk_bf16(float lo, float hi) { const f32x2_t v = {lo, hi}; return __builtin_bit_cast(unsigned, __builtin_convertvector(v, bf16x2_t)); }
__device__ __forceinline__ float bflo(unsigned u) { return __uint_as_float(u << 16); }
__device__ __forceinline__ float bfhi(unsigned u) { return __uint_as_float(u & 0xffff0000u); }
__device__ __forceinline__ float bf2f(bf16_t v) { return __uint_as_float(((unsigned)v) << 16); }
__device__ __forceinline__ int opaque_tid() { int t = threadIdx.x; asm volatile("" : "+v"(t)); return t; }
__device__ __forceinline__ bf16_t f2bf(float f) { return (bf16_t)(pk_bf16(f, 0.f) & 0xffffu); }

#if DBG
#define WS_BASE ((size_t)560 << 20)
#else
#define WS_BASE ((size_t)0)
#endif
#define WS_ALIGN(x) (((size_t)(x) + 255) & ~(size_t)255)
constexpr size_t OFF_mod = WS_BASE;
constexpr size_t OFF_bias1 = OFF_mod + WS_ALIGN(4*6144*4);
constexpr size_t OFF_wint = OFF_bias1 + WS_ALIGN(2*256*4);
constexpr size_t OFF_wot = OFF_wint + WS_ALIGN((size_t)PCOLS*1024*2);
constexpr size_t OFF_wrt = OFF_wot + WS_ALIGN((size_t)1024*1024*2);
constexpr size_t OFF_w1t = OFF_wrt + WS_ALIGN((size_t)256*1024*2);
constexpr size_t OFF_w2t = OFF_w1t + WS_ALIGN((size_t)2*256*2048*2);
constexpr size_t OFF_hb = OFF_w2t + WS_ALIGN((size_t)2*64*256*2);
constexpr size_t OFF_Pb = OFF_hb + WS_ALIGN((size_t)NTOK*1024*2);
constexpr size_t OFF_VsT = OFF_Pb + WS_ALIGN((size_t)NTOK*PCOLS*2);
constexpr size_t OFF_VwT = OFF_VsT + WS_ALIGN((size_t)BATCH*128*SEQ*2);
constexpr size_t OFF_VgT = OFF_VwT + WS_ALIGN((size_t)BATCH*128*SEQ*2);
constexpr size_t OFF_misc = OFF_VgT + WS_ALIGN((size_t)BATCH*512*SEQ*2);
constexpr size_t OFF_cpart = OFF_misc + WS_ALIGN((size_t)NTOK*64*4);
constexpr size_t OFF_kc = OFF_cpart + WS_ALIGN((size_t)2*4*2048*256*4);
constexpr size_t OFF_vcT = OFF_kc + WS_ALIGN((size_t)8*256*64*2);
constexpr size_t OFF_dST = OFF_vcT + WS_ALIGN((size_t)8*64*256*2);
constexpr size_t OFF_dec = OFF_dST + WS_ALIGN((size_t)16*64*8192*4);
constexpr size_t OFF_ST = OFF_dec + WS_ALIGN((size_t)16*64*64*4);
constexpr size_t OFF_mixf = OFF_ST + WS_ALIGN((size_t)16*64*8192*2);
constexpr size_t OFF_mixb = OFF_mixf + WS_ALIGN((size_t)NTOK*512*4);
constexpr size_t OFF_y1 = OFF_mixb + WS_ALIGN((size_t)NTOK*1024*2);
constexpr size_t OFF_x1 = OFF_y1 + WS_ALIGN((size_t)NTOK*1024*4);
constexpr size_t OFF_logits = OFF_x1 + WS_ALIGN((size_t)NTOK*1024*4);
constexpr size_t OFF_ew = OFF_logits + WS_ALIGN((size_t)NTOK*256*4);
constexpr size_t OFF_counts = OFF_ew + WS_ALIGN((size_t)NTOK*NASSIGN*4);
constexpr size_t OFF_lists = OFF_counts + WS_ALIGN(512*4);
constexpr size_t OFF_bar = OFF_lists + WS_ALIGN((size_t)N_EXP*NTOK*4);
constexpr size_t OFF_hid = OFF_bar + WS_ALIGN(4096*4);
constexpr size_t OFF_outk = OFF_hid + WS_ALIGN((size_t)NTOK*NASSIGN*256*2);
constexpr size_t OFF_selm = OFF_outk + WS_ALIGN((size_t)NTOK*NASSIGN*1024*2);
constexpr size_t OFF_selu = OFF_selm + WS_ALIGN((size_t)NTOK*2*8);
constexpr size_t OFF_mixf2 = OFF_selu + WS_ALIGN((size_t)8*64*4*8);
constexpr size_t WS_TOTAL = OFF_mixf2 + WS_ALIGN((size_t)NTOK*512*4);
struct Params {
    const float *x, *c, *w_mod, *b_mod, *w_in, *pos_k, *w1_k, *w2_k, *pos_v, *w1_v, *w2_v, *w_a2, *b_a2, *norm_w, *w_o, *ln1_g, *ln1_b,
        *w_router, *rbias, *w_e_gate, *w_e_up, *w_e_down, *w_s_gate, *w_s_up, *w_s_down, *ln2_g, *ln2_b;
    float* out;
    char* ws;
    int ph_lo, ph_hi;
    __device__ __forceinline__ float* mod() const { return (float*)(ws + OFF_mod); }
    __device__ __forceinline__ float* bias1() const { return (float*)(ws + OFF_bias1); }
    __device__ __forceinline__ bf16_t* wint() const { return (bf16_t*)(ws + OFF_wint); }
    __device__ __forceinline__ bf16_t* wot() const { return (bf16_t*)(ws + OFF_wot); }
    __device__ __forceinline__ bf16_t* wrt() const { return (bf16_t*)(ws + OFF_wrt); }
    __device__ __forceinline__ bf16_t* w1t() const { return (bf16_t*)(ws + OFF_w1t); }
    __device__ __forceinline__ bf16_t* w2t() const { return (bf16_t*)(ws + OFF_w2t); }
    __device__ __forceinline__ bf16_t* hb() const { return (bf16_t*)(ws + OFF_hb); }
    __device__ __forceinline__ bf16_t* Pb() const { return (bf16_t*)(ws + OFF_Pb); }
    __device__ __forceinline__ bf16_t* VsT() const { return (bf16_t*)(ws + OFF_VsT); }
    __device__ __forceinline__ bf16_t* VwT() const { return (bf16_t*)(ws + OFF_VwT); }
    __device__ __forceinline__ bf16_t* VgT() const { return (bf16_t*)(ws + OFF_VgT); }
    __device__ __forceinline__ float* misc() const { return (float*)(ws + OFF_misc); }
    __device__ __forceinline__ float* cpart() const { return (float*)(ws + OFF_cpart); }
    __device__ __forceinline__ bf16_t* kc() const { return (bf16_t*)(ws + OFF_kc); }
    __device__ __forceinline__ bf16_t* vcT() const { return (bf16_t*)(ws + OFF_vcT); }
    __device__ __forceinline__ float* dST() const { return (float*)(ws + OFF_dST); }
    __device__ __forceinline__ float* dec() const { return (float*)(ws + OFF_dec); }
    __device__ __forceinline__ bf16_t* ST() const { return (bf16_t*)(ws + OFF_ST); }
    __device__ __forceinline__ float* mixf() const { return (float*)(ws + OFF_mixf); }
    __device__ __forceinline__ bf16_t* mixb() const { return (bf16_t*)(ws + OFF_mixb); }
    __device__ __forceinline__ float* y1() const { return (float*)(ws + OFF_y1); }
    __device__ __forceinline__ float* x1() const { return (float*)(ws + OFF_x1); }
    __device__ __forceinline__ float* logits() const { return (float*)(ws + OFF_logits); }
    __device__ __forceinline__ float* ew() const { return (float*)(ws + OFF_ew); }
    __device__ __forceinline__ int* counts() const { return (int*)(ws + OFF_counts); }
    __device__ __forceinline__ int* lists() const { return (int*)(ws + OFF_lists); }
    __device__ __forceinline__ unsigned* bar() const { return (unsigned*)(ws + OFF_bar); }
    __device__ __forceinline__ bf16_t* hid() const { return (bf16_t*)(ws + OFF_hid); }
    __device__ __forceinline__ bf16_t* outk() const { return (bf16_t*)(ws + OFF_outk); }
};

#define LDS_ROW 72
#define TILE_BYTES 16384
#define GEMM_SMEM 69632
__device__ __forceinline__ int swz_key(int row) { return ((row >> 2) & 1) | ((((row >> 1) ^ (row >> 3)) & 1) << 1) | ((((row >> 2) ^ (row >> 4)) & 1) << 2); }
__device__ __forceinline__ int swz_off(int row, int chunk) { return row * 128 + ((chunk ^ swz_key(row)) << 4); }
typedef __attribute__((address_space(3))) unsigned lds_u32;

struct RowsBf16 {
    static constexpr bool NT = false;
    const bf16_t* base; size_t stride;
    __device__ __forceinline__ const bf16_t* ptr(int r, int k) const { return base + (size_t)r * stride + k; }
    __device__ __forceinline__ const bf16_t* pp(int i, int tid, int k) const { return ptr(i * 32 + (tid >> 3), k); }
};
struct GatherBf16 {
    static constexpr bool NT = true;
    const bf16_t* base; size_t stride; const int* rowidx;
    __device__ __forceinline__ const bf16_t* ptr(int r, int k) const { return base + (size_t)rowidx[r] * stride + k; }
    __device__ __forceinline__ const bf16_t* pp(int i, int tid, int k) const { return ptr(i * 32 + (tid >> 3), k); }
};
struct BF32Plain {
    const float* base; size_t ld;
    __device__ __forceinline__ f32x4 load4(int k, int r4) const { return *(const f32x4*)(base + (size_t)k * ld + r4); }
};
struct BF32GateUp {
    const float* g; long du; size_t ld;
    __device__ __forceinline__ f32x4 load4(int k, int r4) const {
        const long sel = ((r4 >> 5) & 1) ? du : 0l;
#ifdef NT_B
        return __builtin_nontemporal_load((const f32x4*)(g + sel + (size_t)k * ld + (r4 >> 6) * 32 + (r4 & 31)));
#else
        return *(const f32x4*)(g + sel + (size_t)k * ld + (r4 >> 6) * 32 + (r4 & 31));
#endif
    }
};

template <class L>
__device__ __forceinline__ void bf16_piece_load(u32x4& r, const L& ld, int k0, int i, int tid) { r = *(const u32x4*)ld.pp(i, tid, k0 + ((tid & 7) << 3)); }
__device__ __forceinline__ void bf16_piece_write(const u32x4& r, char* tile, int i, int tid) { *(u32x4*)(tile + swz_off(i * 32 + (tid >> 3), tid & 7)) = r; }
template <int J0, class BL>
__device__ __forceinline__ void f32_rows_load(f32x4 (&r)[8], const BL& bl, int k0, int tid) {
    const int kg = (tid >> 5) * 8, n4 = (tid & 31) * 4;
#pragma unroll
    for (int j = 0; j < 4; ++j) r[J0 + j] = bl.load4(k0 + kg + J0 + j, n4);
}
template <int I>
__device__ __forceinline__ void f32_col_write(const f32x4 (&r)[8], char* tile, int tid) {
    const int kgc = tid >> 5, n4 = (tid & 31) * 4;
    u32x4 w;
    w.x = pk_bf16(r[0][I], r[1][I]); w.y = pk_bf16(r[2][I], r[3][I]);
    w.z = pk_bf16(r[4][I], r[5][I]); w.w = pk_bf16(r[6][I], r[7][I]);
    *(u32x4*)(tile + swz_off(n4 + I, kgc)) = w;
}

#ifdef USE_SETPRIO
#define SETPRIO_HI __builtin_amdgcn_s_setprio(1);
#define SETPRIO_LO __builtin_amdgcn_s_setprio(0);
#else
#define SETPRIO_HI
#define SETPRIO_LO
#endif
template <bool SWAP, bool BF32, class AL, class BL, class EPI>
__device__ __forceinline__ void gemm_core(const AL& al, const BL& bl, int k_begin, int nk, int nkt, char* smem, f32x4 (&acc)[4][4], EPI&& epi) {
    const int tid = opaque_tid(), lane = tid & 63, wid = tid >> 6, wr = wid >> 1, wc = wid & 1, fr = lane & 15, fq = lane >> 4;
#pragma unroll
    for (int m = 0; m < 4; ++m)
#pragma unroll
        for (int n = 0; n < 4; ++n) acc[m][n] = (f32x4){0.f, 0.f, 0.f, 0.f};
    u32x4 ra[4]; u32x4 rb[4]; f32x4 rbf[8];
#pragma unroll
    for (int i = 0; i < 4; ++i) { bf16_piece_load(ra[i], al, k_begin, i, tid); if constexpr (!BF32) bf16_piece_load(rb[i], bl, k_begin, i, tid); }
    if constexpr (BF32) { f32_rows_load<0>(rbf, bl, k_begin, tid); f32_rows_load<4>(rbf, bl, k_begin, tid); }
#pragma unroll
    for (int i = 0; i < 4; ++i) { bf16_piece_write(ra[i], smem, i, tid); if constexpr (!BF32) bf16_piece_write(rb[i], smem + TILE_BYTES, i, tid); }
    if constexpr (BF32) { f32_col_write<0>(rbf, smem + TILE_BYTES, tid); f32_col_write<1>(rbf, smem + TILE_BYTES, tid); f32_col_write<2>(rbf, smem + TILE_BYTES, tid); f32_col_write<3>(rbf, smem + TILE_BYTES, tid); }
    if (nk > 1) {
#pragma unroll
        for (int i = 0; i < 4; ++i) { bf16_piece_load(ra[i], al, k_begin + 64, i, tid); if constexpr (!BF32) bf16_piece_load(rb[i], bl, k_begin + 64, i, tid); }
        if constexpr (BF32) { f32_rows_load<0>(rbf, bl, k_begin + 64, tid); f32_rows_load<4>(rbf, bl, k_begin + 64, tid); }
    }
    __syncthreads();
    int tile = 0, kin = 0;
    for (int kt = 0; kt < nk; ++kt) {
        const char* sA = smem + (kt & 1) * 2 * TILE_BYTES; const char* sB = sA + TILE_BYTES;
        char* nA = smem + ((kt & 1) ^ 1) * 2 * TILE_BYTES; char* nB = nA + TILE_BYTES;
        const bool w1 = kt + 1 < nk, l2 = kt + 2 < nk;
        const int k2 = k_begin + (kt + 2) * 64;
        bf16x8 a[2][4], b[2][4];
#pragma unroll
        for (int ks = 0; ks < 2; ++ks) {
#pragma unroll
            for (int m = 0; m < 4; ++m) a[ks][m] = *(const bf16x8*)(sA + swz_off(wr * 64 + m * 16 + fr, ks * 4 + fq));
#pragma unroll
            for (int n = 0; n < 4; ++n) b[ks][n] = *(const bf16x8*)(sB + swz_off(wc * 64 + n * 16 + fr, ks * 4 + fq));
        }
#define GEMM_GROUP(G) { \
            constexpr int ks = (G) >> 1, m0 = ((G) & 1) * 2; \
            __builtin_amdgcn_sched_barrier(0); \
            SETPRIO_HI \
            _Pragma("unroll") for (int m = m0; m < m0 + 2; ++m) \
            _Pragma("unroll") for (int n = 0; n < 4; ++n) \
                acc[m][n] = SWAP ? __builtin_amdgcn_mfma_f32_16x16x32_bf16(b[ks][n], a[ks][m], acc[m][n], 0, 0, 0) \
                                 : __builtin_amdgcn_mfma_f32_16x16x32_bf16(a[ks][m], b[ks][n], acc[m][n], 0, 0, 0); \
            SETPRIO_LO \
            __builtin_amdgcn_sched_barrier(0); \
            if (w1) bf16_piece_write(ra[G], nA, G, tid); \
            if (l2) bf16_piece_load(ra[G], al, k2, G, tid); \
            if constexpr (BF32) { \
                if constexpr ((G) == 0) { if (w1) { f32_col_write<0>(rbf, nB, tid); f32_col_write<1>(rbf, nB, tid); } } \
                if constexpr ((G) == 1) { if (w1) { f32_col_write<2>(rbf, nB, tid); f32_col_write<3>(rbf, nB, tid); } } \
                if constexpr ((G) == 2) { if (l2) f32_rows_load<0>(rbf, bl, k2, tid); } \
                if constexpr ((G) == 3) { if (l2) f32_rows_load<4>(rbf, bl, k2, tid); } \
            } else { \
                if (w1) bf16_piece_write(rb[G], nB, G, tid); \
                if (l2) bf16_piece_load(rb[G], bl, k2, G, tid); \
            } }
        GEMM_GROUP(0) GEMM_GROUP(1) GEMM_GROUP(2) GEMM_GROUP(3)
#undef GEMM_GROUP
        kin += 1;
        if (kin == nkt && kt + 1 < nk) {
            epi(tile, acc);
            tile += 1; kin = 0;
#pragma unroll
            for (int m = 0; m < 4; ++m)
#pragma unroll
                for (int n = 0; n < 4; ++n) acc[m][n] = (f32x4){0.f, 0.f, 0.f, 0.f};
        }
        __syncthreads();
    }
    epi(tile, acc);
}
struct NoEpi { __device__ __forceinline__ void operator()(int, const f32x4 (&)[4][4]) const {} };
template <bool SWAP, bool BF32, class AL, class BL>
__device__ __forceinline__ void gemm_128(const AL& al, const BL& bl, int k_begin, int nk, char* smem, f32x4 (&acc)[4][4]) {
    gemm_core<SWAP, BF32>(al, bl, k_begin, nk, nk, smem, acc, NoEpi());
}

__device__ __forceinline__ int xcd_of(const char* smem) { return (int)(((const unsigned*)(smem + GEMM_SMEM + 2048))[4] & 7u); }
__device__ __forceinline__ int rank_of(const char* smem) { return (int)((const unsigned*)(smem + GEMM_SMEM + 2048))[5]; }
__device__ __forceinline__ int nranks_of(const char* smem) { int n = (int)((const unsigned*)(smem + GEMM_SMEM + 2048))[6]; return n > 0 ? n : 1; }
template <int NB, bool SILU>
__device__ __forceinline__ void gemv_item(const float* in, const float* W, int ldw, const float* bias, float* out, int ldo, int K, int col0, float* sm) {
    const int tid = opaque_tid();
    for (int i = tid; i < NB * K; i += 256) { float v = in[i]; sm[i] = SILU ? v / (1.f + __expf(-v)) : v; }
    __syncthreads();
    float acc[NB];
#pragma unroll
    for (int b = 0; b < NB; ++b) acc[b] = 0.f;
    const int kq = tid >> 6, cl = tid & 63; const int kb = kq * (K / 4);
    for (int k = kb; k < kb + K / 4; k += 16) {
        float w[16];
#pragma unroll
        for (int u = 0; u < 16; ++u) w[u] = W[(size_t)(k + u) * ldw + col0 + cl];
#pragma unroll
        for (int u = 0; u < 16; ++u)
#pragma unroll
            for (int b = 0; b < NB; ++b) acc[b] += sm[b * K + k + u] * w[u];
    }
    float* red = sm + NB * K;
#pragma unroll
    for (int b = 0; b < NB; ++b) red[(kq * NB + b) * 64 + cl] = acc[b];
    __syncthreads();
    if (tid < 64 * NB) {
        int b = tid >> 6, cc = tid & 63;
        float s = red[(0 * NB + b) * 64 + cc] + red[(1 * NB + b) * 64 + cc] + red[(2 * NB + b) * 64 + cc] + red[(3 * NB + b) * 64 + cc];
        out[b * ldo + col0 + cc] = s + (bias ? bias[col0 + cc] : 0.f);
    }
    __syncthreads();
}

__device__ __forceinline__ int win_srccol(int n) {
    if (n < 1280) return n;
    if (n < 2304) return n + 24;
    if (n < 2816) return n + 40;
    if (n < 2840) return n - 2816 + 1280;
    if (n < 2856) return n - 2840 + 2328;
    return -1;
}
template <bool PERM>
__device__ __forceinline__ void transpose_item(const float* W, int ldw, int K, bf16_t* out, int k0, int n0, float* sm) {
    const int tid = opaque_tid();
    f32x4 v[4];
#pragma unroll
    for (int i = 0; i < 4; ++i) {
        const int c = tid + 256 * i, kk = c >> 4, nn = (c & 15) * 4;
        const int src = PERM ? win_srccol(n0 + nn) : (n0 + nn);
        v[i] = (src >= 0) ? *(const f32x4*)(W + (size_t)(k0 + kk) * ldw + src) : (f32x4){0.f, 0.f, 0.f, 0.f};
    }
#pragma unroll
    for (int i = 0; i < 4; ++i) {
        const int c = tid + 256 * i, kk = c >> 4, nn = (c & 15) * 4;
#pragma unroll
        for (int j = 0; j < 4; ++j) sm[(nn + j) * 65 + kk] = v[i][j];
    }
    __syncthreads();
#pragma unroll
    for (int i = 0; i < 2; ++i) {
        const int c = tid + 256 * i, nn = c >> 3, kc = (c & 7) * 8;
        const float* r = sm + nn * 65 + kc;
        u32x4 w;
        w.x = pk_bf16(r[0], r[1]); w.y = pk_bf16(r[2], r[3]); w.z = pk_bf16(r[4], r[5]); w.w = pk_bf16(r[6], r[7]);
        *(u32x4*)(out + (size_t)(n0 + nn) * K + k0 + kc) = w;
    }
    __syncthreads();
}

__device__ void phase0(const Params& p, char* smem) {
    float* sm = (float*)smem;
    const int nb = gridDim.x, bid = blockIdx.x;
    const int I_MOD = 96, I_B1 = 8, I_WIN = 16 * 46, I_WO = 256, I_WR = 64, I_W1 = 2 * 32 * 4, I_W2 = 2 * 4;
    const int total = I_MOD + I_B1 + I_WIN + I_WO + I_WR + I_W1 + I_W2;
    if (bid == 0 && opaque_tid() < 64) p.counts()[264 + opaque_tid()] = 0;
    if (bid == 1) for (int i = opaque_tid(); i < 264; i += 256) p.counts()[i] = 0;
    for (int it = bid; it < total; it += nb) {
        int i = it;
        if (i < I_MOD) { gemv_item<4, true>(p.c, p.w_mod, 6144, p.b_mod, p.mod(), 6144, 1024, i * 64, sm); continue; }
        i -= I_MOD;
        if (i < I_B1) { int kv = i >> 2; gemv_item<1, false>(kv ? p.pos_v : p.pos_k, kv ? p.w1_v : p.w1_k, 256, nullptr, p.bias1() + kv * 256, 256, 2048, (i & 3) * 64, sm); continue; }
        i -= I_B1;
        if (i < I_WIN) { transpose_item<true>(p.w_in, IN_COLS, 1024, p.wint(), (i % 16) * 64, (i / 16) * 64, sm); continue; }
        i -= I_WIN;
        if (i < I_WO) { transpose_item<false>(p.w_o, 1024, 1024, p.wot(), (i % 16) * 64, (i / 16) * 64, sm); continue; }
        i -= I_WO;
        if (i < I_WR) { transpose_item<false>(p.w_router, 256, 1024, p.wrt(), (i % 16) * 64, (i / 16) * 64, sm); continue; }
        i -= I_WR;
        if (i < I_W1) { int kv = i >> 7; int j = i & 127; transpose_item<false>(kv ? p.w1_v : p.w1_k, 256, 2048, p.w1t() + (size_t)kv * 256 * 2048, (j % 32) * 64, (j / 32) * 64, sm); continue; }
        i -= I_W1;
        { int kv = i >> 2; int j = i & 3; transpose_item<false>(kv ? p.w2_v : p.w2_k, 64, 256, p.w2t() + (size_t)kv * 64 * 256, j * 64, 0, sm); }
    }
}

__device__ __forceinline__ float wave_sum(float v) {
#pragma unroll
    for (int m = 32; m > 0; m >>= 1) v += __shfl_xor(v, m);
    return v;
}
__device__ void phase1(const Params& p) {
    const int lane = opaque_tid() & 63, gw = blockIdx.x * 4 + (opaque_tid() >> 6), nw = gridDim.x * 4;
    for (int row0 = gw * 2; row0 < NTOK; row0 += nw * 2) {
        f32x4 v[2][4]; float s[2];
#pragma unroll
        for (int r = 0; r < 2; ++r) {
            const float* xr = p.x + (size_t)(row0 + r) * D_MODEL;
            s[r] = 0.f;
#pragma unroll
            for (int i = 0; i < 4; ++i) v[r][i] = *(const f32x4*)(xr + i * 256 + lane * 4);
        }
        const int b = row0 / SEQ;
        const float* md = p.mod() + b * 6144;
#pragma unroll
        for (int r = 0; r < 2; ++r) {
#pragma unroll
            for (int i = 0; i < 4; ++i) s[r] += (v[r][i][0] + v[r][i][1]) + (v[r][i][2] + v[r][i][3]);
            const float mu = wave_sum(s[r]) * (1.f / D_MODEL);
            float q = 0.f;
#pragma unroll
            for (int i = 0; i < 4; ++i)
#pragma unroll
                for (int j = 0; j < 4; ++j) { float d = v[r][i][j] - mu; q += d * d; }
            const float rstd = rsqrtf(wave_sum(q) * (1.f / D_MODEL) + 1e-5f);
#pragma unroll
            for (int i = 0; i < 4; ++i) {
                const int col = i * 256 + lane * 4;
                f32x4 sh = *(const f32x4*)(md + 0 + col), sc = *(const f32x4*)(md + 1024 + col);
                float o[4];
#pragma unroll
                for (int j = 0; j < 4; ++j) o[j] = (v[r][i][j] - mu) * rstd * (1.f + sc[j]) + sh[j];
                u32x2 w; w.x = pk_bf16(o[0], o[1]); w.y = pk_bf16(o[2], o[3]);
                *(u32x2*)(p.hb() + (size_t)(row0 + r) * D_MODEL + col) = w;
            }
        }
    }
}

__device__ void phase2(const Params& p, char* smem) {
    const int xcd = xcd_of(smem), rank = rank_of(smem), nranks = nranks_of(smem);
    const int lane = opaque_tid() & 63, wid = opaque_tid() >> 6, wr = wid >> 1, wc = wid & 1, fr = lane & 15, fq = lane >> 4;
#ifndef P2_REP
#define P2_REP 1
#endif
    for (int it0 = rank; it0 < 16 * 23 * P2_REP; it0 += nranks) {
        const int it = it0 % (16 * 23);
        const int mt = (it / 23) * 8 + xcd, nt = it % 23;
        const int row0 = mt * 128, col0 = nt * 128;
        RowsBf16 al{p.hb() + (size_t)row0 * D_MODEL, D_MODEL};
        RowsBf16 bl{p.wint() + (size_t)col0 * D_MODEL, D_MODEL};
        f32x4 acc[4][4];
        const bool transposed = (nt == 7) || (nt == 9) || (nt >= 14 && nt < 18);
        if (transposed) {
            gemm_128<false, false>(al, bl, 0, 16, smem, acc);
            const int b = row0 / SEQ, t0 = row0 % SEQ;
            bf16_t* base; int rows_per;
            if (nt == 7) base = p.VsT() + (size_t)b * 128 * SEQ;
            else if (nt == 9) base = p.VwT() + (size_t)b * 128 * SEQ;
            else base = p.VgT() + ((size_t)b * 4 + (nt - 14)) * 128 * SEQ;
            (void)rows_per;
#pragma unroll
            for (int m = 0; m < 4; ++m)
#pragma unroll
                for (int n = 0; n < 4; ++n) {
                    const int feat = wc * 64 + n * 16 + fr, tok = t0 + wr * 64 + m * 16 + fq * 4;
                    u32x2 w; w.x = pk_bf16(acc[m][n][0], acc[m][n][1]); w.y = pk_bf16(acc[m][n][2], acc[m][n][3]);
                    *(u32x2*)(base + (size_t)feat * SEQ + tok) = w;
                }
        } else {
            gemm_128<true, false>(al, bl, 0, 16, smem, acc);
            if (nt == 22) {
                if (wc == 0) {
#pragma unroll
                    for (int m = 0; m < 4; ++m)
#pragma unroll
                        for (int n = 0; n < 4; ++n) {
                            const int tok = row0 + wr * 64 + m * 16 + fr, feat = n * 16 + fq * 4;
                            *(f32x4*)(p.misc() + (size_t)tok * 64 + feat) = acc[m][n];
                        }
                }
            } else {
#pragma unroll
                for (int m = 0; m < 4; ++m)
#pragma unroll
                    for (int n = 0; n < 4; ++n) {
                        const int tok = row0 + wr * 64 + m * 16 + fr, feat = col0 + wc * 64 + n * 16 + fq * 4;
                        u32x2 w; w.x = pk_bf16(acc[m][n][0], acc[m][n][1]); w.y = pk_bf16(acc[m][n][2], acc[m][n][3]);
                        *(u32x2*)(p.Pb() + (size_t)tok * PCOLS + feat) = w;
                    }
            }
        }
    }
}
struct CmpALoad {
    static constexpr bool NT = false;
    const bf16_t* Pb; int colbase; int row0;
    __device__ __forceinline__ const bf16_t* ptr(int r, int k) const {
        const int rr = row0 + r, bg = rr >> 8, i = rr & 255, b = bg >> 1, g = bg & 1;
        const int l = k >> 6, d = k & 63;
        int tok = 16 * i + l; tok = tok < SEQ ? tok : SEQ - 1;
        return Pb + ((size_t)b * SEQ + tok) * PCOLS + colbase + g * 64 + d;
    }
    __device__ __forceinline__ const bf16_t* pp(int i, int tid, int k) const { return ptr(i * 32 + (tid >> 3), k); }
};

__device__ __forceinline__ float log_sigmoid_f(float x) { return -(fmaxf(-x, 0.f) + log1pf(__expf(-fabsf(x)))); }

__device__ __forceinline__ void gla_cumsum(const Params& p, int tokg0, int h, float* sb, float* sglr, float* swa, float* sqt) {
    const int tid = opaque_tid();
    for (int i = tid; i < 1024; i += 256) { int t = i >> 4, r = i & 15; sglr[i] = p.misc()[(size_t)(tokg0 + t) * 64 + 24 + r]; }
    for (int i = tid; i < 1024; i += 256) { int r = i >> 6, d = i & 63; swa[i] = p.w_a2[r * 256 + h * 64 + d]; }
    __syncthreads();
    const int d = tid & 63, tq = tid >> 6;
    const float ba = p.b_a2[h * 64 + d];
    float w[16];
#pragma unroll
    for (int r = 0; r < 16; ++r) w[r] = swa[r * 64 + d];
    float run = 0.f;
#pragma unroll
    for (int tt = 0; tt < 16; ++tt) {
        const int t = tq * 16 + tt;
        float x = ba;
#pragma unroll
        for (int r = 0; r < 16; ++r) x += sglr[t * 16 + r] * w[r];
        run += log_sigmoid_f(x) * (1.f / 16.f);
        sb[t * 64 + d] = run;
    }
    sqt[tq * 64 + d] = run;
    __syncthreads();
    float off = 0.f;
#pragma unroll
    for (int q = 0; q < 3; ++q) if (q < tq) off += sqt[q * 64 + d];
#pragma unroll
    for (int tt = 0; tt < 16; ++tt) sb[(tq * 16 + tt) * 64 + d] += off;
    __syncthreads();
}

__device__ void gla_a_item(const Params& p, int item, char* smem) {
    const int tid = opaque_tid(), lane = tid & 63, wid = tid >> 6, fr = lane & 15, fq = lane >> 4;
    const int bh = item >> 6, c = item & 63, b = bh >> 2, h = bh & 3;
    const int tok0 = c * 64, tokg0 = b * SEQ + tok0;
    float* sb = (float*)smem; float* sglr = (float*)(smem + 16384); float* swa = (float*)(smem + 20480); float* sqt = (float*)(smem + 24576);
    char* skbT = smem + 25600; char* sVT = smem + 34816;
    gla_cumsum(p, tokg0, h, sb, sglr, swa, sqt);
    {
        const int d = tid & 63, tq = tid >> 6;
        const float bl = sb[63 * 64 + d];
        float v[16];
#pragma unroll
        for (int tt = 0; tt < 16; ++tt) {
            const int s = tq * 16 + tt;
            float k = bf2f(p.Pb()[(size_t)(tokg0 + s) * PCOLS + P_GK + h * 64 + d]);
            v[tt] = k * __expf(bl - sb[s * 64 + d]);
        }
        u32x4 w0, w1;
        w0.x = pk_bf16(v[0], v[1]); w0.y = pk_bf16(v[2], v[3]); w0.z = pk_bf16(v[4], v[5]); w0.w = pk_bf16(v[6], v[7]);
        w1.x = pk_bf16(v[8], v[9]); w1.y = pk_bf16(v[10], v[11]); w1.z = pk_bf16(v[12], v[13]); w1.w = pk_bf16(v[14], v[15]);
        *(u32x4*)(skbT + (d * LDS_ROW + tq * 16) * 2) = w0;
        *(u32x4*)(skbT + (d * LDS_ROW + tq * 16 + 8) * 2) = w1;
        if (tid < 64) p.dec()[(size_t)item * 64 + d] = __expf(bl);
    }
#pragma unroll
    for (int i = 0; i < 4; ++i) {
        const int cidx = tid + 256 * i, e = cidx >> 3, ch = (cidx & 7) * 8;
        *(u32x4*)(sVT + (e * LDS_ROW + ch) * 2) = *(const u32x4*)(p.VgT() + ((size_t)bh * 128 + e) * SEQ + tok0 + ch);
    }
    __syncthreads();
    f32x4 acc[2][4];
#pragma unroll
    for (int m = 0; m < 2; ++m)
#pragma unroll
        for (int n = 0; n < 4; ++n) acc[m][n] = (f32x4){0.f, 0.f, 0.f, 0.f};
#pragma unroll
    for (int ks = 0; ks < 2; ++ks) {
        bf16x8 a[2], bb[4];
#pragma unroll
        for (int m = 0; m < 2; ++m) a[m] = *(const bf16x8*)(sVT + (((wid * 2 + m) * 16 + fr) * LDS_ROW + ks * 32 + fq * 8) * 2);
#pragma unroll
        for (int n = 0; n < 4; ++n) bb[n] = *(const bf16x8*)(skbT + ((n * 16 + fr) * LDS_ROW + ks * 32 + fq * 8) * 2);
#pragma unroll
        for (int m = 0; m < 2; ++m)
#pragma unroll
            for (int n = 0; n < 4; ++n) acc[m][n] = __builtin_amdgcn_mfma_f32_16x16x32_bf16(a[m], bb[n], acc[m][n], 0, 0, 0);
    }
    float* dst = p.dST() + (size_t)item * 8192;
#pragma unroll
    for (int m = 0; m < 2; ++m)
#pragma unroll
        for (int n = 0; n < 4; ++n)
#pragma unroll
            for (int j = 0; j < 4; ++j) dst[((wid * 2 + m) * 16 + fq * 4 + j) * 64 + n * 16 + fr] = acc[m][n][j];
    __syncthreads();
}

__device__ void phase3(const Params& p, char* smem) {
    const int lane = opaque_tid() & 63, wid = opaque_tid() >> 6, wr = wid >> 1, wc = wid & 1, fr = lane & 15, fq = lane >> 4;
    for (int it = blockIdx.x; it < 256; it += gridDim.x) {
        const int kv = it >> 7, mt = (it >> 3) & 15, nt = (it >> 2) & 1, ks = it & 3;
        CmpALoad al{p.Pb(), kv ? P_VC : P_KC, mt * 128};
        RowsBf16 bl{p.w1t() + ((size_t)kv * 256 + nt * 128) * 2048, 2048};
        f32x4 acc[4][4];
        gemm_128<true, 0>(al, bl, ks * 512, 8, smem, acc);
        float* dst = p.cpart() + ((size_t)(kv * 4 + ks) * 2048 + mt * 128) * 256 + nt * 128;
#pragma unroll
        for (int m = 0; m < 4; ++m)
#pragma unroll
            for (int n = 0; n < 4; ++n)
                *(f32x4*)(dst + (size_t)(wr * 64 + m * 16 + fr) * 256 + wc * 64 + n * 16 + fq * 4) = acc[m][n];
    }
    const int first = (blockIdx.x + gridDim.x - (256 % gridDim.x)) % gridDim.x;
    for (int it = first; it < 1024; it += gridDim.x) gla_a_item(p, it, smem);
}

#define C2_ROW 264
__device__ void cmp2_item(const Params& p, int item, char* smem) {
    const int tid = opaque_tid(), lane = tid & 63, wid = tid >> 6, fr = lane & 15, fq = lane >> 4;
    const int kv = item >> 5, r0 = (item & 31) * 64;
    char* sA = smem; char* sB = smem + 64 * C2_ROW * 2;
    const float* b1 = p.bias1() + kv * 256;
#pragma unroll 2
    for (int i = 0; i < 8; ++i) {
        const int cidx = tid + 256 * i, row = cidx >> 5, col = (cidx & 31) * 8;
        f32x4 s0 = *(const f32x4*)(b1 + col), s1 = *(const f32x4*)(b1 + col + 4);
#pragma unroll
        for (int ks = 0; ks < 4; ++ks) {
            const float* src = p.cpart() + ((size_t)(kv * 4 + ks) * 2048 + r0 + row) * 256 + col;
            s0 += *(const f32x4*)src; s1 += *(const f32x4*)(src + 4);
        }
        float o[8];
#pragma unroll
        for (int j = 0; j < 4; ++j) { o[j] = s0[j] / (1.f + __expf(-s0[j])); o[4 + j] = s1[j] / (1.f + __expf(-s1[j])); }
        u32x4 w; w.x = pk_bf16(o[0], o[1]); w.y = pk_bf16(o[2], o[3]); w.z = pk_bf16(o[4], o[5]); w.w = pk_bf16(o[6], o[7]);
        *(u32x4*)(sA + (row * C2_ROW + col) * 2) = w;
        *(u32x4*)(sB + (row * C2_ROW + col) * 2) = *(const u32x4*)(p.w2t() + ((size_t)kv * 64 + row) * 256 + col);
    }
    __syncthreads();
    f32x4 acc[4];
#pragma unroll
    for (int n = 0; n < 4; ++n) acc[n] = (f32x4){0.f, 0.f, 0.f, 0.f};
#pragma unroll
    for (int ks = 0; ks < 8; ++ks) {
        bf16x8 a = *(const bf16x8*)(sA + ((wid * 16 + fr) * C2_ROW + ks * 32 + fq * 8) * 2);
#pragma unroll
        for (int n = 0; n < 4; ++n) {
            bf16x8 bb = *(const bf16x8*)(sB + ((n * 16 + fr) * C2_ROW + ks * 32 + fq * 8) * 2);
            acc[n] = kv ? __builtin_amdgcn_mfma_f32_16x16x32_bf16(a, bb, acc[n], 0, 0, 0)
                        : __builtin_amdgcn_mfma_f32_16x16x32_bf16(bb, a, acc[n], 0, 0, 0);
        }
    }
    if (kv == 0) {
#pragma unroll
        for (int n = 0; n < 4; ++n) {
            u32x2 w; w.x = pk_bf16(acc[n][0], acc[n][1]); w.y = pk_bf16(acc[n][2], acc[n][3]);
            *(u32x2*)(p.kc() + (size_t)(r0 + wid * 16 + fr) * 64 + n * 16 + fq * 4) = w;
        }
    } else {
        const int r = r0 + wid * 16 + fq * 4, bg = r >> 8, i = r & 255;
#pragma unroll
        for (int n = 0; n < 4; ++n) {
            u32x2 w; w.x = pk_bf16(acc[n][0], acc[n][1]); w.y = pk_bf16(acc[n][2], acc[n][3]);
            *(u32x2*)(p.vcT() + ((size_t)bg * 64 + n * 16 + fr) * 256 + i) = w;
        }
    }
    __syncthreads();
}

__device__ void phase4(const Params& p, char* smem) {
    for (int it = blockIdx.x; it < 64; it += gridDim.x) cmp2_item(p, it, smem);
    const int nthreads = gridDim.x * 256;
    for (int idx = blockIdx.x * 256 + opaque_tid(); idx < 16 * 8192; idx += nthreads) {
        const int bh = idx >> 13, ed = idx & 8191, d = idx & 63;
        float S = 0.f;
        for (int c0 = 0; c0 < 64; c0 += 8) {
            float dv[8], dc[8];
#pragma unroll
            for (int u = 0; u < 8; ++u) {
                dv[u] = p.dST()[((size_t)(bh * 64 + c0 + u) << 13) + ed];
                dc[u] = p.dec()[(size_t)(bh * 64 + c0 + u) * 64 + d];
            }
#pragma unroll
            for (int u = 0; u < 8; ++u) {
                p.ST()[((size_t)(bh * 64 + c0 + u) << 13) + ed] = f2bf(S);
                S = dc[u] * S + dv[u];
            }
        }
    }
}
#define KT_BYTES (64 * LDS_ROW * 2)
#define C1_SCALE (0.125f * LOG2E)

#define MASK_BIAS (-2e30f)
__device__ __forceinline__ bf16x8 scale_frag(bf16x8 v, float c) {
    u32x4 u = __builtin_bit_cast(u32x4, v); u32x4 r;
    r.x = pk_bf16(bflo(u.x) * c, bfhi(u.x) * c); r.y = pk_bf16(bflo(u.y) * c, bfhi(u.y) * c);
    r.z = pk_bf16(bflo(u.z) * c, bfhi(u.z) * c); r.w = pk_bf16(bflo(u.w) * c, bfhi(u.w) * c);
    return __builtin_bit_cast(bf16x8, r);
}
__device__ __forceinline__ float max3f(float a, float b, float c) { return fmaxf(fmaxf(a, b), c); }
__device__ __forceinline__ float rowmax4(float x) {
    auto r = __builtin_amdgcn_permlane32_swap(__float_as_uint(x), __float_as_uint(x), false, false);
    float y = fmaxf(__uint_as_float(r[0]), __uint_as_float(r[1]));
    auto q = __builtin_amdgcn_permlane16_swap(__float_as_uint(y), __float_as_uint(y), false, false);
    return fmaxf(__uint_as_float(q[0]), __uint_as_float(q[1]));
}
template <bool PV>
__device__ __forceinline__ void flash_tile(const char* sK0, const char* sVT0, const bf16x8 (&qf)[2][2], float (&m)[2], f32x4 (&l)[2], f32x4 (&o)[2][4],
                                           float dl0, float dstride, float wlim, bool lanevalid, bool needmask, const float (&slope2)[2], int fr, int fq, bool lazy, bf16x8 ones) {
#pragma unroll 1
    for (int half = 0; half < 2; ++half) {
        const char* sK = sK0 + half * 32 * LDS_ROW * 2;
        const char* sVT = sVT0 + half * 32 * 2;
        const float dl = dl0 + dstride * (float)(half * 32);
        bf16x8 kf[2][2], vf[4];
#pragma unroll
        for (int mk = 0; mk < 2; ++mk)
#pragma unroll
            for (int ks = 0; ks < 2; ++ks) kf[mk][ks] = *(const bf16x8*)(sK + ((mk * 16 + fr) * LDS_ROW + ks * 32 + fq * 8) * 2);
        if (PV) {
#pragma unroll
            for (int md = 0; md < 4; ++md) {
                u32x2 lo = *(const u32x2*)(sVT + ((md * 16 + fr) * LDS_ROW + fq * 4) * 2);
                u32x2 hi = *(const u32x2*)(sVT + ((md * 16 + fr) * LDS_ROW + 16 + fq * 4) * 2);
                u32x4 w; w.x = lo.x; w.y = lo.y; w.z = hi.x; w.w = hi.y;
                vf[md] = __builtin_bit_cast(bf16x8, w);
            }
        }
        f32x4 s[2][2];
#pragma unroll
        for (int p = 0; p < 2; ++p) {
            const float mref = lazy ? m[p] : 0.f;
            if (needmask) {
#pragma unroll
                for (int mk = 0; mk < 2; ++mk)
#pragma unroll
                    for (int j = 0; j < 4; ++j) {
                        const float dk = dl + dstride * (float)(mk * 16 + j);
                        const bool ok = lanevalid && (dk <= 0.f) && (dk > wlim);
                        s[p][mk][j] = ok ? (slope2[p] * dk - mref) : MASK_BIAS;
                    }
            } else {
                const float sb = lanevalid ? (slope2[p] * dl - mref) : MASK_BIAS, sd = lanevalid ? slope2[p] * dstride : 0.f;
#pragma unroll
                for (int mk = 0; mk < 2; ++mk)
#pragma unroll
                    for (int j = 0; j < 4; ++j) s[p][mk][j] = sb + sd * (float)(mk * 16 + j);
            }
        }
#pragma unroll
        for (int ks = 0; ks < 2; ++ks)
#pragma unroll
            for (int p = 0; p < 2; ++p)
#pragma unroll
                for (int mk = 0; mk < 2; ++mk) s[p][mk] = __builtin_amdgcn_mfma_f32_16x16x32_bf16(kf[mk][ks], qf[p][ks], s[p][mk], 0, 0, 0);
        float mx[2];
#pragma unroll
        for (int p = 0; p < 2; ++p)
            mx[p] = max3f(max3f(max3f(s[p][0][0], s[p][0][1], s[p][0][2]), s[p][0][3], s[p][1][0]), max3f(s[p][1][1], s[p][1][2], s[p][1][3]), MASK_BIAS);
        if (!lazy) {
            float mn[2];
#pragma unroll
            for (int p = 0; p < 2; ++p) mn[p] = fmaxf(m[p], rowmax4(mx[p]));
            if (__any((mn[0] > m[0]) || (mn[1] > m[1]))) {
#pragma unroll
                for (int p = 0; p < 2; ++p) {
                    const float alpha = __builtin_amdgcn_exp2f(m[p] - mn[p]);
                    l[p] *= alpha;
                    if (PV) {
#pragma unroll
                        for (int md = 0; md < 4; ++md) o[p][md] *= alpha;
                    }
                    m[p] = mn[p];
                }
            }
#pragma unroll
            for (int p = 0; p < 2; ++p)
#pragma unroll
                for (int mk = 0; mk < 2; ++mk)
#pragma unroll
                    for (int j = 0; j < 4; ++j) s[p][mk][j] -= m[p];
        }
        bf16x8 pf[2];
#pragma unroll
        for (int p = 0; p < 2; ++p) {
#pragma unroll
            for (int mk = 0; mk < 2; ++mk)
#pragma unroll
                for (int j = 0; j < 4; ++j) s[p][mk][j] = __builtin_amdgcn_exp2f(s[p][mk][j]);
            u32x4 w;
            w.x = pk_bf16(s[p][0][0], s[p][0][1]); w.y = pk_bf16(s[p][0][2], s[p][0][3]);
            w.z = pk_bf16(s[p][1][0], s[p][1][1]); w.w = pk_bf16(s[p][1][2], s[p][1][3]);
            pf[p] = __builtin_bit_cast(bf16x8, w);
        }
#pragma unroll
        for (int p = 0; p < 2; ++p) l[p] = __builtin_amdgcn_mfma_f32_16x16x32_bf16(ones, pf[p], l[p], 0, 0, 0);
        if (PV) {
#pragma unroll
            for (int md = 0; md < 4; ++md)
#pragma unroll
                for (int p = 0; p < 2; ++p) o[p][md] = __builtin_amdgcn_mfma_f32_16x16x32_bf16(vf[md], pf[p], o[p][md], 0, 0, 0);
        }
        if (lazy) {
            float up[2];
#pragma unroll
            for (int p = 0; p < 2; ++p) up[p] = fmaxf(rowmax4(mx[p]), 0.f);
            if (__any((up[0] > 0.f) || (up[1] > 0.f))) {
#pragma unroll
                for (int p = 0; p < 2; ++p) {
                    const float alpha = __builtin_amdgcn_exp2f(-up[p]);
                    l[p] *= alpha;
                    if (PV) {
#pragma unroll
                        for (int md = 0; md < 4; ++md) o[p][md] *= alpha;
                    }
                    m[p] += up[p];
                }
            }
        }
    }
}
__device__ __forceinline__ float l_total(const f32x4& l, int fr) { return __shfl(l[0], fr); }

__device__ __forceinline__ void imp_tile(const char* sK, const bf16x8 (&qf)[2][2], const float (&m)[2], const float (&linv)[2],
                                         float dl, const float (&slope2)[2], int ct, float* simp, int fr, int fq) {
    bf16x8 kf[4][2];
#pragma unroll
    for (int mk = 0; mk < 4; ++mk)
#pragma unroll
        for (int ks = 0; ks < 2; ++ks) kf[mk][ks] = *(const bf16x8*)(sK + ((mk * 16 + fr) * LDS_ROW + ks * 32 + fq * 8) * 2);
    f32x4 hs[4];
#pragma unroll
    for (int mk = 0; mk < 4; ++mk) hs[mk] = (f32x4){0.f, 0.f, 0.f, 0.f};
#pragma unroll
    for (int p = 0; p < 2; ++p) {
#pragma unroll
        for (int mk = 0; mk < 4; ++mk) {
            f32x4 s;
#pragma unroll
            for (int j = 0; j < 4; ++j) { const float dk = dl + 16.f * (float)(mk * 16 + j); s[j] = (dk <= 0.f) ? slope2[p] * dk : MASK_BIAS; }
#pragma unroll
            for (int ks = 0; ks < 2; ++ks) s = __builtin_amdgcn_mfma_f32_16x16x32_bf16(kf[mk][ks], qf[p][ks], s, 0, 0, 0);
#pragma unroll
            for (int j = 0; j < 4; ++j) hs[mk][j] += __builtin_amdgcn_exp2f(s[j] - m[p]) * linv[p];
        }
    }
#pragma unroll
    for (int mk = 0; mk < 4; ++mk) {
        const int jb = ct * 16 + mk * 4 + fq;
        const float a = hs[mk][0] + hs[mk][1] + hs[mk][2] + 0.5f * hs[mk][3];
        const float bnext = 0.5f * hs[mk][3];
        simp[fr * 64 + jb] += a;
        __builtin_amdgcn_wave_barrier();
        if (jb + 1 < 64) simp[fr * 64 + jb + 1] += bnext;
        __builtin_amdgcn_wave_barrier();
    }
}

struct TileSrc { const bf16_t* k; const bf16_t* v; };
struct TileOff { int k[2], v[2]; };
__device__ __forceinline__ TileOff tile_offsets(int kst, int vst, int tid) {
    TileOff to;
#pragma unroll
    for (int i = 0; i < 2; ++i) { const int c = tid + 256 * i, row = c >> 3, ch = (c & 7) * 8; to.k[i] = row * kst + ch; to.v[i] = row * vst + ch; }
    return to;
}
__device__ __forceinline__ void tile_gload(const TileSrc& ts, const TileOff& to, u32x4 (&rk)[2], u32x4 (&rv)[2]) {
#pragma unroll
    for (int i = 0; i < 2; ++i) {
        rk[i] = *(const u32x4*)(ts.k + to.k[i]);
        rv[i] = *(const u32x4*)(ts.v + to.v[i]);
    }
}
__device__ __forceinline__ void tile_swrite(char* smem, int buf, const u32x4 (&rk)[2], const u32x4 (&rv)[2], int tid) {
    char* sK = smem + buf * 2 * KT_BYTES; char* sV = sK + KT_BYTES;
#pragma unroll
    for (int i = 0; i < 2; ++i) {
        const int c = tid + 256 * i, row = c >> 3, ch = (c & 7) * 8;
        *(u32x4*)(sK + (row * LDS_ROW + ch) * 2) = rk[i];
        *(u32x4*)(sV + (row * LDS_ROW + ch) * 2) = rv[i];
    }
}

__device__ void nsa_cmp_item(const Params& p, int qrev, int bg, char* smem) {
    const int tid = opaque_tid(), lane = tid & 63, wid = tid >> 6, fr = lane & 15, fq = lane >> 4;
    const int qb = 63 - qrev, b = bg >> 1, g = bg & 1;
    const int q0 = qb * 64, t = q0 + wid * 16 + fr;
    const size_t tokg = (size_t)b * SEQ + t;
    float* simp = (float*)(smem + 4 * KT_BYTES) + wid * 1024;
    auto wsb = [&]() __attribute__((always_inline)) { char* w = p.ws; asm volatile("" : "+s"(w)); return w; };
    const unsigned onew = (fr == 0) ? 0x3f803f80u : 0u;
    const bf16x8 ones = __builtin_bit_cast(bf16x8, (u32x4){onew, onew, onew, onew});
    const int ncb = (4 * qb + 3) < NCMP ? (4 * qb + 3) : NCMP;
    const int nct = (ncb + 63) >> 6;
    for (int i = tid; i < 4096; i += 256) ((float*)(smem + 4 * KT_BYTES))[i] = 0.f;
    __syncthreads();
#pragma unroll 1
    for (int hp = 0; hp < 2; ++hp) {
        const int h0 = g * 4 + hp * 2;
        bf16x8 qf[2][2]; float slope2[2];
#pragma unroll
        for (int pp = 0; pp < 2; ++pp) {
            slope2[pp] = exp2f(-(float)(h0 + pp + 1)) * LOG2E;
#pragma unroll
            for (int ks = 0; ks < 2; ++ks)
                qf[pp][ks] = scale_frag(*(const bf16x8*)((const bf16_t*)(wsb() + OFF_Pb) + tokg * PCOLS + P_NQ + (h0 + pp) * 64 + ks * 32 + fq * 8), C1_SCALE);
        }
        float m[2], linv[2]; f32x4 l[2]; f32x4 o[2][4];
#pragma unroll
        for (int pp = 0; pp < 2; ++pp) {
            m[pp] = NEGF; l[pp] = (f32x4){0.f, 0.f, 0.f, 0.f}; linv[pp] = 0.f;
#pragma unroll
            for (int md = 0; md < 4; ++md) o[pp][md] = (f32x4){0.f, 0.f, 0.f, 0.f};
        }
        u32x4 rk[2], rv[2];
        const int n = 2 * nct;
        auto src = [&](int step) __attribute__((always_inline)) {
            const int idx = step < nct ? (nct - 1 - step) : step - nct;
            char* wb = wsb();
            TileSrc ts; ts.k = (const bf16_t*)(wb + OFF_kc) + ((size_t)bg * 256 + idx * 64) * 64;
            ts.v = (const bf16_t*)(wb + OFF_vcT) + (size_t)bg * 64 * 256 + idx * 64;
            return ts;
        };
        const TileOff toff = tile_offsets(64, 256, tid);
        tile_gload(src(0), toff, rk, rv); tile_swrite(smem, 0, rk, rv, tid); __syncthreads();
#pragma unroll 1
        for (int i = 0; i < n; ++i) {
            if (i + 1 < n) tile_gload(src(i + 1), toff, rk, rv);
            __builtin_amdgcn_sched_barrier(0);
            const int idx = i < nct ? (nct - 1 - i) : i - nct;
            const char* sK = smem + (i & 1) * 2 * KT_BYTES; const char* sV = sK + KT_BYTES;
            const float dlc = (float)(16 * (idx * 64 + fq * 4) + 31 - t);
            if (i < nct) {
                const bool cmask = (16 * (idx * 64 + 63) + 31) > q0;
                flash_tile<true>(sK, sV, qf, m, l, o, dlc, 16.f, -1e9f, true, cmask, slope2, fr, fq, i >= 2, ones);
            } else {
                if (i == nct) {
                    size_t tokg_o = tokg; asm volatile("" : "+v"(tokg_o));
                    char* wb = wsb();
#pragma unroll
                    for (int pp = 0; pp < 2; ++pp) {
                        const float inv = 1.f / fmaxf(l_total(l[pp], fr), 1e-30f);
                        linv[pp] = inv;
                        const int h = h0 + pp;
                        const float gl = ((const float*)(wb + OFF_misc))[tokg_o * 64 + h * 3 + 0];
                        const float sc = inv / (1.f + __expf(-gl));
#pragma unroll
                        for (int md = 0; md < 4; ++md) *(f32x4*)((float*)(wb + OFF_mixf) + tokg_o * 512 + h * 64 + md * 16 + fq * 4) = o[pp][md] * sc;
                    }
                }
                imp_tile(sK, qf, m, linv, dlc, slope2, idx, simp, fr, fq);
            }
            __builtin_amdgcn_sched_barrier(0);
            if (i + 1 < n) tile_swrite(smem, (i + 1) & 1, rk, rv, tid);
            __syncthreads();
        }
    }
    {
        const int j = lane;
        const bool forced = (j == 0) || (j == qb) || (j == qb - 1);
        unsigned long long mine = 0ull, wave_union = 0ull;
#pragma unroll 1
        for (int qi = 0; qi < 16; ++qi) {
            const float sc = (j <= qb) ? (simp[qi * 64 + j] + (forced ? 1e4f : 0.f)) : NEGF;
            int rank = 0;
#pragma unroll 4
            for (int j2 = 0; j2 < 64; ++j2) {
                const float s2 = __builtin_bit_cast(float, __builtin_amdgcn_readlane(__builtin_bit_cast(int, sc), j2));
                rank += ((s2 > sc) || (s2 == sc && j2 < j)) ? 1 : 0;
            }
            const unsigned long long msk = __ballot(rank < 16);
            wave_union |= msk;
            if (fr == qi) mine = msk;
        }
        const unsigned long long causal = (qb >= 63) ? ~0ull : ((1ull << (qb + 1)) - 1ull);
        unsigned long long* selm = (unsigned long long*)(wsb() + OFF_selm);
        if (fq == 0) selm[(size_t)g * NTOK + tokg] = mine & causal;
        if (lane == 0) ((unsigned long long*)(wsb() + OFF_selu))[((size_t)bg * 64 + qb) * 4 + wid] = wave_union & causal;
    }
    __syncthreads();
}

__device__ void nsa_sw_item(const Params& p, int qrev, int bg, int hp, char* smem, int mode) {
    const int tid = opaque_tid(), lane = tid & 63, wid = tid >> 6, fr = lane & 15, fq = lane >> 4;
    const int qb = 63 - qrev, b = bg >> 1, g = bg & 1;
    const int q0 = qb * 64, t = q0 + wid * 16 + fr;
    const size_t tokg = (size_t)b * SEQ + t;
    int* slist = (int*)(smem + 4 * KT_BYTES);
    const int h0 = g * 4 + hp * 2;
    auto wsb = [&]() __attribute__((always_inline)) { char* w = p.ws; asm volatile("" : "+s"(w)); return w; };
    bf16x8 qf[2][2]; float slope2[2];
#pragma unroll
    for (int pp = 0; pp < 2; ++pp) {
        slope2[pp] = exp2f(-(float)(h0 + pp + 1)) * LOG2E;
#pragma unroll
        for (int ks = 0; ks < 2; ++ks)
            qf[pp][ks] = scale_frag(*(const bf16x8*)((const bf16_t*)(wsb() + OFF_Pb) + tokg * PCOLS + P_NQ + (h0 + pp) * 64 + ks * 32 + fq * 8), C1_SCALE);
    }
    const unsigned long long mymask = ((const unsigned long long*)(wsb() + OFF_selm))[(size_t)g * NTOK + tokg];
    const unsigned long long* su = (const unsigned long long*)(wsb() + OFF_selu) + ((size_t)bg * 64 + qb) * 4;
    const unsigned long long wave_union = su[wid];
    const unsigned long long un = su[0] | su[1] | su[2] | su[3];
    const int wlo = (qb - 8) > 0 ? (qb - 8) : 0;
    const int nsl = __popcll(un);
    const int n = nsl + (qb - wlo + 1);
    if (tid < 64 && ((un >> tid) & 1ull)) slist[nsl - 1 - __popcll(un & ((1ull << tid) - 1ull))] = tid;
    if (tid >= 64 && tid < 64 + (qb - wlo + 1)) slist[nsl + (tid - 64)] = 256 + (qb - (tid - 64));
    __syncthreads();
    const unsigned onew = (fr == 0) ? 0x3f803f80u : 0u;
    const bf16x8 ones = __builtin_bit_cast(bf16x8, (u32x4){onew, onew, onew, onew});
    float m[2]; f32x4 l[2]; f32x4 o[2][4];
#pragma unroll
    for (int pp = 0; pp < 2; ++pp) {
        m[pp] = NEGF; l[pp] = (f32x4){0.f, 0.f, 0.f, 0.f};
#pragma unroll
        for (int md = 0; md < 4; ++md) o[pp][md] = (f32x4){0.f, 0.f, 0.f, 0.f};
    }
    auto finish_branch = [&](int br) __attribute__((always_inline)) {
        size_t tokg_o = tokg; asm volatile("" : "+v"(tokg_o));
        char* wb = wsb();
#pragma unroll
        for (int pp = 0; pp < 2; ++pp) {
            const float inv = 1.f / fmaxf(l_total(l[pp], fr), 1e-30f);
            const int h = h0 + pp;
            const float gl = ((const float*)(wb + OFF_misc))[tokg_o * 64 + h * 3 + br];
            const float sc = inv / (1.f + __expf(-gl));
#pragma unroll
            for (int md = 0; md < 4; ++md) {
                const size_t eo = tokg_o * 512 + h * 64 + md * 16 + fq * 4;
                f32x4 v = o[pp][md] * sc;
                if (mode != 0) { asm volatile("" :: "v"(v[0]), "v"(v[1]), "v"(v[2]), "v"(v[3])); }
                else if (br == 1) *(f32x4*)((float*)(wb + OFF_mixf2) + eo) = v;
                else { v += *(const f32x4*)((const float*)(wb + OFF_mixf) + eo) + *(const f32x4*)((const float*)(wb + OFF_mixf2) + eo);
                       u32x2 w; w.x = pk_bf16(v[0], v[1]); w.y = pk_bf16(v[2], v[3]); *(u32x2*)((bf16_t*)(wb + OFF_mixb) + tokg_o * 1024 + h * 64 + md * 16 + fq * 4) = w; }
            }
            m[pp] = NEGF; l[pp] = (f32x4){0.f, 0.f, 0.f, 0.f};
#pragma unroll
            for (int md = 0; md < 4; ++md) o[pp][md] = (f32x4){0.f, 0.f, 0.f, 0.f};
        }
    };
    u32x4 rkA[2], rvA[2], rkB[2], rvB[2];
    auto src = [&](int e) __attribute__((always_inline)) {
        const int win = e >> 8, idx = e & 255;
        char* wb = wsb();
        TileSrc ts;
        ts.k = (const bf16_t*)(wb + OFF_Pb) + ((size_t)b * SEQ + idx * 64) * PCOLS + (win ? P_KW : P_KS) + g * 64;
        ts.v = (const bf16_t*)(wb + (win ? OFF_VwT : OFF_VsT)) + (size_t)bg * 64 * SEQ + idx * 64;
        return ts;
    };
    auto step = [&](int i, int buf) __attribute__((always_inline)) {
        const int e = slist[i];
        const int win = e >> 8, idx = e & 255;
        if (i == nsl) finish_branch(1);
        const char* sK = smem + buf * 2 * KT_BYTES; const char* sV = sK + KT_BYTES;
        if (mode != 1 && (win || ((wave_union >> idx) & 1ull))) {
            const bool lv = win ? true : (((mymask >> idx) & 1ull) != 0ull);
            const bool nm = (idx == qb) || (win && idx == qb - 8);
            flash_tile<true>(sK, sV, qf, m, l, o, (float)(idx * 64 + fq * 4 - t), 1.f, win ? -512.f : -1e9f, lv, nm, slope2, fr, fq, (i != 0) && (i != nsl), ones);
        }
    };
#ifdef PROF
    volatile unsigned* sprof = (volatile unsigned*)(smem + 4 * KT_BYTES + 2048);
    if (tid == 0) { sprof[1] = 0u; sprof[2] = 0u; sprof[3] = (unsigned)__builtin_amdgcn_s_memtime(); }
#define PROF_T0 if (tid == 0) sprof[0] = (unsigned)__builtin_amdgcn_s_memtime();
#define PROF_T1 if (tid == 0) { sprof[1] += (unsigned)__builtin_amdgcn_s_memtime() - sprof[0]; sprof[2] += 1u; }
#else
#define PROF_T0
#define PROF_T1
#endif
    const TileOff toff = tile_offsets(PCOLS, SEQ, tid);
    tile_gload(src(slist[0]), toff, rkA, rvA); tile_swrite(smem, 0, rkA, rvA, tid);
    if (n > 1) tile_gload(src(slist[1]), toff, rkA, rvA);
    __syncthreads();
#pragma unroll 1
    for (int i = 0; i < n; i += 2) {
        if (i + 2 < n) tile_gload(src(slist[i + 2]), toff, rkB, rvB);
        __builtin_amdgcn_sched_barrier(0);
        PROF_T0 step(i, 0); PROF_T1
        __builtin_amdgcn_sched_barrier(0);
        if (i + 1 < n) tile_swrite(smem, 1, rkA, rvA, tid);
        __syncthreads();
        if (i + 1 >= n) break;
        if (i + 3 < n) tile_gload(src(slist[i + 3]), toff, rkA, rvA);
        __builtin_amdgcn_sched_barrier(0);
        PROF_T0 step(i + 1, 1); PROF_T1
        __builtin_amdgcn_sched_barrier(0);
        if (i + 2 < n) tile_swrite(smem, 0, rkB, rvB, tid);
        __syncthreads();
    }
    finish_branch(2);
#ifdef PROF
    if (tid == 0) {
        unsigned long long* pw = (unsigned long long*)(p.ws + OFF_counts + 1024);
        atomicAdd(&pw[0], (unsigned long long)sprof[1]); atomicAdd(&pw[1], (unsigned long long)((unsigned)__builtin_amdgcn_s_memtime() - sprof[3])); atomicAdd(&pw[2], (unsigned long long)sprof[2]);
    }
#endif
}

__device__ void gla_c_item(const Params& p, int item, char* smem) {
    const int tid = opaque_tid(), lane = tid & 63, wid = tid >> 6, fr = lane & 15, fq = lane >> 4;
    const int bh = item >> 6, c = item & 63, b = bh >> 2, h = bh & 3;
    const int tok0 = c * 64, tokg0 = b * SEQ + tok0;
    float* sb = (float*)smem; float* sglr = (float*)(smem + 16384); float* swa = (float*)(smem + 20480); float* sqt = (float*)(smem + 24576);
    char* sST = smem;
    char* sQB = smem + 25600; char* sKB = smem + 34816; char* sVT = smem + 44032;
    gla_cumsum(p, tokg0, h, sb, sglr, swa, sqt);
    {
        const int d = tid & 63, tq = tid >> 6;
#pragma unroll 4
        for (int tt = 0; tt < 16; ++tt) {
            const int tk = tq * 16 + tt;
            const float bt = sb[tk * 64 + d];
            const float q = bf2f(p.Pb()[(size_t)(tokg0 + tk) * PCOLS + P_GQ + h * 64 + d]);
            const float k = bf2f(p.Pb()[(size_t)(tokg0 + tk) * PCOLS + P_GK + h * 64 + d]);
            *(bf16_t*)(sQB + (tk * LDS_ROW + d) * 2) = f2bf(q * 0.125f * __expf(bt));
            *(bf16_t*)(sKB + (tk * LDS_ROW + d) * 2) = f2bf(k * __expf(-bt));
        }
    }
#pragma unroll
    for (int i = 0; i < 4; ++i) {
        const int cidx = tid + 256 * i, e = cidx >> 3, ch = (cidx & 7) * 8;
        *(u32x4*)(sVT + (e * LDS_ROW + ch) * 2) = *(const u32x4*)(p.VgT() + ((size_t)bh * 128 + e) * SEQ + tok0 + ch);
    }
    __syncthreads();
#pragma unroll
    for (int i = 0; i < 4; ++i) {
        const int cidx = tid + 256 * i, e = cidx >> 3, ch = (cidx & 7) * 8;
        *(u32x4*)(sST + (e * LDS_ROW + ch) * 2) = *(const u32x4*)(p.ST() + ((size_t)item << 13) + e * 64 + ch);
    }
    __syncthreads();
    bf16x8 qbf[2];
#pragma unroll
    for (int ks = 0; ks < 2; ++ks) qbf[ks] = *(const bf16x8*)(sQB + ((wid * 16 + fr) * LDS_ROW + ks * 32 + fq * 8) * 2);
    f32x4 sa[4];
#pragma unroll
    for (int ms = 0; ms < 4; ++ms) {
        sa[ms] = (f32x4){0.f, 0.f, 0.f, 0.f};
#pragma unroll
        for (int ks = 0; ks < 2; ++ks) {
            bf16x8 a = *(const bf16x8*)(sKB + ((ms * 16 + fr) * LDS_ROW + ks * 32 + fq * 8) * 2);
            sa[ms] = __builtin_amdgcn_mfma_f32_16x16x32_bf16(a, qbf[ks], sa[ms], 0, 0, 0);
        }
#pragma unroll
        for (int j = 0; j < 4; ++j) sa[ms][j] = (ms * 16 + fq * 4 + j <= wid * 16 + fr) ? sa[ms][j] : 0.f;
    }
    bf16x8 pf[2];
#pragma unroll
    for (int kk = 0; kk < 2; ++kk) {
        u32x4 w;
        w.x = pk_bf16(sa[2 * kk][0], sa[2 * kk][1]); w.y = pk_bf16(sa[2 * kk][2], sa[2 * kk][3]);
        w.z = pk_bf16(sa[2 * kk + 1][0], sa[2 * kk + 1][1]); w.w = pk_bf16(sa[2 * kk + 1][2], sa[2 * kk + 1][3]);
        pf[kk] = __builtin_bit_cast(bf16x8, w);
    }
    f32x4 oa[8];
    float sum = 0.f;
#pragma unroll
    for (int me = 0; me < 8; ++me) {
        f32x4 acc = (f32x4){0.f, 0.f, 0.f, 0.f};
#pragma unroll
        for (int ks = 0; ks < 2; ++ks) {
            bf16x8 a = *(const bf16x8*)(sST + ((me * 16 + fr) * LDS_ROW + ks * 32 + fq * 8) * 2);
            acc = __builtin_amdgcn_mfma_f32_16x16x32_bf16(a, qbf[ks], acc, 0, 0, 0);
        }
#pragma unroll
        for (int kk = 0; kk < 2; ++kk) {
            u32x2 lo = *(const u32x2*)(sVT + ((me * 16 + fr) * LDS_ROW + kk * 32 + fq * 4) * 2);
            u32x2 hi = *(const u32x2*)(sVT + ((me * 16 + fr) * LDS_ROW + kk * 32 + 16 + fq * 4) * 2);
            u32x4 w; w.x = lo.x; w.y = lo.y; w.z = hi.x; w.w = hi.y;
            acc = __builtin_amdgcn_mfma_f32_16x16x32_bf16(__builtin_bit_cast(bf16x8, w), pf[kk], acc, 0, 0, 0);
        }
        oa[me] = acc;
        sum += (acc[0] + acc[1]) + (acc[2] + acc[3]);
    }
    sum += __shfl_xor(sum, 16); sum += __shfl_xor(sum, 32);
    const float mu = sum * (1.f / 128.f);
    float var = 0.f;
#pragma unroll
    for (int me = 0; me < 8; ++me)
#pragma unroll
        for (int j = 0; j < 4; ++j) { const float dd = oa[me][j] - mu; var += dd * dd; }
    var += __shfl_xor(var, 16); var += __shfl_xor(var, 32);
    const float rstd = rsqrtf(var * (1.f / 128.f) + 1e-5f);
    const size_t tok = (size_t)tokg0 + wid * 16 + fr;
#pragma unroll
    for (int me = 0; me < 8; ++me) {
        const int e = me * 16 + fq * 4;
        const u32x2 rr = *(const u32x2*)(p.Pb() + tok * PCOLS + P_GR + h * 128 + e);
        const f32x4 nw = *(const f32x4*)(p.norm_w + e);
        float r[4] = {bflo(rr.x), bfhi(rr.x), bflo(rr.y), bfhi(rr.y)};
        float ov[4];
#pragma unroll
        for (int j = 0; j < 4; ++j) ov[j] = (oa[me][j] - mu) * rstd * nw[j] * (r[j] / (1.f + __expf(-r[j])));
        u32x2 w; w.x = pk_bf16(ov[0], ov[1]); w.y = pk_bf16(ov[2], ov[3]);
        *(u32x2*)(p.mixb() + tok * 1024 + 512 + h * 128 + e) = w;
    }
    __syncthreads();
}

#ifndef NSA_REP
#define NSA_REP 1
#endif
#ifndef NSA_MODE2
#define NSA_MODE2 0
#endif
#ifndef GLAC_REP
#define GLAC_REP 1
#endif
__device__ void phase5a(const Params& p, char* smem, int rep) {
    int* sidx = (int*)(smem + GEMM_SMEM - 16);
    for (;;) {
        __syncthreads();
        if (opaque_tid() == 0) *sidx = atomicAdd(&p.counts()[264 + 4 * rep], 1);
        __syncthreads();
        const int it = *sidx;
        if (it >= 512) break;
        nsa_cmp_item(p, it >> 3, it & 7, smem);
    }
    for (;;) {
        __syncthreads();
        if (opaque_tid() == 0) *sidx = atomicAdd(&p.counts()[265 + 4 * rep], 1);
        __syncthreads();
        const int it = *sidx;
        if (it >= 1024 * GLAC_REP) break;
        gla_c_item(p, it & 1023, smem);
    }
}
__device__ void phase5b(const Params& p, char* smem, int rep) {
    int* sidx = (int*)(smem + GEMM_SMEM - 16);
    for (;;) {
        __syncthreads();
        if (opaque_tid() == 0) *sidx = atomicAdd(&p.counts()[266 + 4 * rep], 1);
        __syncthreads();
        const int it = *sidx;
        if (it >= 1024 * NSA_REP) break;
        const int item = it & 1023;
        nsa_sw_item(p, item >> 4, (item >> 1) & 7, item & 1, smem, it >= 1024 ? NSA_MODE2 : 0);
    }
}
__device__ void phase6(const Params& p, char* smem) {
    const int xcd = xcd_of(smem), rank = rank_of(smem), nranks = nranks_of(smem);
    const int lane = opaque_tid() & 63, wid = opaque_tid() >> 6, wr = wid >> 1, wc = wid & 1, fr = lane & 15, fq = lane >> 4;
    for (int it = rank; it < 16 * 8; it += nranks) {
        const int mt = (it / 8) * 8 + xcd, nt = it % 8;
        RowsBf16 al{p.mixb() + (size_t)mt * 128 * 1024, 1024};
        RowsBf16 bl{p.wot() + (size_t)nt * 128 * 1024, 1024};
        f32x4 acc[4][4];
        gemm_128<true, false>(al, bl, 0, 16, smem, acc);
#pragma unroll
        for (int m = 0; m < 4; ++m)
#pragma unroll
            for (int n = 0; n < 4; ++n)
                *(f32x4*)(p.y1() + (size_t)(mt * 128 + wr * 64 + m * 16 + fr) * 1024 + nt * 128 + wc * 64 + n * 16 + fq * 4) = acc[m][n];
    }
}

__device__ void phase7(const Params& p) {
    const int lane = opaque_tid() & 63, gw = blockIdx.x * 4 + (opaque_tid() >> 6), nw = gridDim.x * 4;
    const float alpha = 1.189207115f;
    for (int row0 = gw * 2; row0 < NTOK; row0 += nw * 2) {
        const int b = row0 / SEQ;
        const float* md = p.mod() + b * 6144;
        f32x4 xv[2][4], yv[2][4];
#pragma unroll
        for (int r = 0; r < 2; ++r)
#pragma unroll
            for (int i = 0; i < 4; ++i) {
                const int col = i * 256 + lane * 4;
                xv[r][i] = *(const f32x4*)(p.x + (size_t)(row0 + r) * 1024 + col);
                yv[r][i] = *(const f32x4*)(p.y1() + (size_t)(row0 + r) * 1024 + col);
            }
#pragma unroll
        for (int r = 0; r < 2; ++r) {
            const int row = row0 + r;
            f32x4 v[4]; float s = 0.f;
#pragma unroll
            for (int i = 0; i < 4; ++i) {
                const int col = i * 256 + lane * 4;
                const f32x4 ga = *(const f32x4*)(md + 2048 + col);
#pragma unroll
                for (int j = 0; j < 4; ++j) v[i][j] = alpha * xv[r][i][j] + (1.f + ga[j]) * yv[r][i][j];
                s += (v[i][0] + v[i][1]) + (v[i][2] + v[i][3]);
            }
            float mu = wave_sum(s) * (1.f / 1024.f);
            float q = 0.f;
#pragma unroll
            for (int i = 0; i < 4; ++i)
#pragma unroll
                for (int j = 0; j < 4; ++j) { float d = v[i][j] - mu; q += d * d; }
            float rstd = rsqrtf(wave_sum(q) * (1.f / 1024.f) + 1e-5f);
            s = 0.f;
#pragma unroll
            for (int i = 0; i < 4; ++i) {
                const int col = i * 256 + lane * 4;
                f32x4 g = *(const f32x4*)(p.ln1_g + col), bb = *(const f32x4*)(p.ln1_b + col);
#pragma unroll
                for (int j = 0; j < 4; ++j) v[i][j] = (v[i][j] - mu) * rstd * g[j] + bb[j];
                *(f32x4*)(p.x1() + (size_t)row * 1024 + col) = v[i];
                s += (v[i][0] + v[i][1]) + (v[i][2] + v[i][3]);
            }
            mu = wave_sum(s) * (1.f / 1024.f);
            q = 0.f;
#pragma unroll
            for (int i = 0; i < 4; ++i)
#pragma unroll
                for (int j = 0; j < 4; ++j) { float d = v[i][j] - mu; q += d * d; }
            rstd = rsqrtf(wave_sum(q) * (1.f / 1024.f) + 1e-5f);
#pragma unroll
            for (int i = 0; i < 4; ++i) {
                const int col = i * 256 + lane * 4;
                f32x4 sh = *(const f32x4*)(md + 3072 + col), sc = *(const f32x4*)(md + 4096 + col);
                float o[4];
#pragma unroll
                for (int j = 0; j < 4; ++j) o[j] = (v[i][j] - mu) * rstd * (1.f + sc[j]) + sh[j];
                u32x2 w; w.x = pk_bf16(o[0], o[1]); w.y = pk_bf16(o[2], o[3]);
                *(u32x2*)(p.hb() + (size_t)row * 1024 + col) = w;
            }
        }
    }
}

__device__ void phase8(const Params& p, char* smem) {
    const int lane = opaque_tid() & 63, wid = opaque_tid() >> 6, wr = wid >> 1, wc = wid & 1, fr = lane & 15, fq = lane >> 4;
    for (int it = blockIdx.x; it < 256; it += gridDim.x) {
        const int mt = it >> 1, nt = it & 1;
        RowsBf16 al{p.hb() + (size_t)mt * 128 * 1024, 1024};
        RowsBf16 bl{p.wrt() + (size_t)nt * 128 * 1024, 1024};
        f32x4 acc[4][4];
        gemm_128<true, false>(al, bl, 0, 16, smem, acc);
#pragma unroll
        for (int m = 0; m < 4; ++m)
#pragma unroll
            for (int n = 0; n < 4; ++n)
                *(f32x4*)(p.logits() + (size_t)(mt * 128 + wr * 64 + m * 16 + fr) * 256 + nt * 128 + wc * 64 + n * 16 + fq * 4) = acc[m][n];
    }
}

__device__ void phase9(const Params& p) {
    const int lane = opaque_tid() & 63, gw = blockIdx.x * 4 + (opaque_tid() >> 6), nw = gridDim.x * 4;
    for (int tok = gw; tok < NTOK; tok += nw) {
        float s[4], sb[4];
        const f32x4 lg = *(const f32x4*)(p.logits() + (size_t)tok * 256 + lane * 4);
        const f32x4 rb = *(const f32x4*)(p.rbias + lane * 4);
#pragma unroll
        for (int i = 0; i < 4; ++i) { s[i] = 1.f / (1.f + __expf(-lg[i])); sb[i] = s[i] + rb[i]; }
        float m1 = NEGF, m2 = NEGF;
#pragma unroll
        for (int i = 0; i < 4; ++i) { float v = sb[i]; if (v > m1) { m2 = m1; m1 = v; } else if (v > m2) m2 = v; }
#pragma unroll
        for (int mm = 1; mm < 8; mm <<= 1) {
            float o1 = __shfl_xor(m1, mm), o2 = __shfl_xor(m2, mm);
            float n1 = fmaxf(m1, o1);
            float n2 = fmaxf(fminf(m1, o1), fmaxf(m2, o2));
            m1 = n1; m2 = n2;
        }
        const float gs = m1 + m2;
        const int grp = lane >> 3;
        int grank = 0;
#pragma unroll
        for (int g2 = 0; g2 < 8; ++g2) { float o = __shfl(gs, g2 * 8); if (o > gs || (o == gs && g2 < grp)) ++grank; }
        const bool gsel = grank < 4;
        float cand[4];
#pragma unroll
        for (int i = 0; i < 4; ++i) cand[i] = gsel ? sb[i] : NEGF;
        float wsum = 0.f, myw = 0.f; int mye = 0;
#pragma unroll 1
        for (int k = 0; k < TOPK; ++k) {
            float bv = cand[0]; int bi = 0;
#pragma unroll
            for (int i = 1; i < 4; ++i) if (cand[i] > bv) { bv = cand[i]; bi = i; }
            float gv = bv; int ge = lane * 4 + bi;
#pragma unroll
            for (int mm = 1; mm < 64; mm <<= 1) {
                float ov = __shfl_xor(gv, mm); int oe = __shfl_xor(ge, mm);
                if (ov > gv || (ov == gv && oe < ge)) { gv = ov; ge = oe; }
            }
            float sel_s = 0.f;
            if ((ge >> 2) == lane) {
                const int i = ge & 3;
                sel_s = (i == 0) ? s[0] : (i == 1) ? s[1] : (i == 2) ? s[2] : s[3];
                if (i == 0) cand[0] = -3e38f; else if (i == 1) cand[1] = -3e38f; else if (i == 2) cand[2] = -3e38f; else cand[3] = -3e38f;
            }
            sel_s = __shfl(sel_s, ge >> 2);
            wsum += sel_s;
            if (lane == k) { myw = sel_s; mye = ge; }
        }
        if (lane < TOPK) {
            const int id = tok * NASSIGN + lane;
            p.ew()[id] = myw / wsum * 2.5f;
            const int pos = atomicAdd(&p.counts()[mye], 1);
            p.lists()[(size_t)mye * NTOK + pos] = id;
        } else if (lane == TOPK) {
            p.ew()[tok * NASSIGN + TOPK] = 1.f;
        }
    }
}

struct Rows4 {
    static constexpr bool NT = false;
    const bf16_t *p0, *p1, *p2, *p3; int kmask;
    __device__ __forceinline__ const bf16_t* pp(int i, int tid, int k) const { return (i == 0 ? p0 : i == 1 ? p1 : i == 2 ? p2 : p3) + (k & kmask); }
};
template <int NT_PER>
__device__ __forceinline__ int build_entries(const Params& p, int xcd, int* spre) {
    const int tid = opaque_tid();
    __syncthreads();
    if (tid < 33) {
        int items;
        if (tid < 32) { const int cnt = p.counts()[xcd + 8 * tid]; items = ((cnt + 127) >> 7) * NT_PER; }
        else items = 16 * NT_PER;
        spre[64 + tid] = items;
    }
    __syncthreads();
    if (tid == 0) { int a = 0; for (int i = 0; i < 33; ++i) { spre[i] = a; a += spre[64 + i]; } spre[33] = a; }
    __syncthreads();
    return spre[33];
}

template <int NT_PER>
__device__ __forceinline__ void decode_item(const Params& p, int xcd, const int* spre, int it, int& e, int& nt, int& mtile, int& cnt) {
    int ent = 0;
    for (int i = 1; i < 33; ++i) ent = (it >= spre[i]) ? i : ent;
    const int local = it - spre[ent];
    if (ent < 32) {
        e = xcd + 8 * ent; cnt = p.counts()[e];
        const int mtc = (cnt + 127) >> 7;
        nt = local / mtc; mtile = local % mtc;
    } else {
        e = N_EXP; cnt = NTOK; nt = local >> 4; mtile = (local & 15) * 8 + xcd;
    }
}

#ifndef P10_NT
#define P10_NT 4
#endif
struct BF32GateUpS {
    const float* g; long du;
    __device__ __forceinline__ f32x4 load4(int kk, int r4) const {
        const long sel = ((r4 >> 5) & 1) ? du : 0l;
        return *(const f32x4*)(g + sel + (size_t)(kk & 1023) * 256 + (kk >> 10) * 64 + (r4 >> 6) * 32 + (r4 & 31));
    }
};
__device__ void phase10(const Params& p, char* smem) {
    const int tid = opaque_tid(), xcd = xcd_of(smem), rank = rank_of(smem), nranks = nranks_of(smem);
    const int lane = tid & 63, wid = tid >> 6, wr = wid >> 1, wc = wid & 1, fr = lane & 15, fq = lane >> 4;
    int* srow = (int*)(smem + GEMM_SMEM);
    int* spre = srow + 256;
#ifndef P10_REP
#define P10_REP 1
#endif
    const int total = build_entries<P10_NT>(p, xcd, spre);
#ifdef STAGGER
    for (int i = 0; i < (rank & 3) * STAGGER; ++i) __builtin_amdgcn_s_sleep(32);
#endif
    for (int it0 = rank; it0 < total * P10_REP; it0 += nranks) {
        const int it = it0 % total;
        int e, nt, mtile, cnt;
        decode_item<P10_NT>(p, xcd, spre, it, e, nt, mtile, cnt);
        if (tid < 128) {
            const int pos = mtile * 128 + tid;
            int id = -1;
            if (pos < cnt) id = (e == N_EXP) ? (pos * NASSIGN + TOPK) : p.lists()[(size_t)e * NTOK + pos];
            srow[tid] = id >= 0 ? id / NASSIGN : 0;
            srow[128 + tid] = id;
        }
        __syncthreads();
        Rows4 al; al.kmask = 1023;
        al.p0 = p.hb() + (size_t)srow[(tid >> 3)] * 1024; al.p1 = p.hb() + (size_t)srow[32 + (tid >> 3)] * 1024;
        al.p2 = p.hb() + (size_t)srow[64 + (tid >> 3)] * 1024; al.p3 = p.hb() + (size_t)srow[96 + (tid >> 3)] * 1024;
        const float* Wg = (e == N_EXP) ? p.w_s_gate : p.w_e_gate + (size_t)e * 1024 * 256;
        const float* Wu = (e == N_EXP) ? p.w_s_up : p.w_e_up + (size_t)e * 1024 * 256;
        BF32GateUpS bl{Wg + nt * (256 / P10_NT), (long)(Wu - Wg)};
        f32x4 acc[4][4];
        bf16_t* hidp = p.hid();
        gemm_core<true, true>(al, bl, 0, 16 * (4 / P10_NT), 16, smem, acc, [&](int tl, const f32x4 (&a)[4][4]) __attribute__((always_inline)) {
            const int nt4 = nt * (4 / P10_NT) + tl;
#pragma unroll
            for (int m = 0; m < 4; ++m) {
                const int id = srow[128 + wr * 64 + m * 16 + fr];
                if (id >= 0) {
#pragma unroll
                    for (int n = 0; n < 2; ++n) {
                        float hv[4];
#pragma unroll
                        for (int j = 0; j < 4; ++j) { const float gte = a[m][n][j]; hv[j] = gte / (1.f + __expf(-gte)) * a[m][n + 2][j]; }
                        u32x2 w; w.x = pk_bf16(hv[0], hv[1]); w.y = pk_bf16(hv[2], hv[3]);
                        *(u32x2*)(hidp + (size_t)id * 256 + nt4 * 64 + wc * 32 + n * 16 + fq * 4) = w;
                    }
                }
            }
        });
        __syncthreads();
    }
}

struct DownB {
    const float* base;
    __device__ __forceinline__ f32x4 load4(int kk, int r4) const {
#ifdef NT_B
        return __builtin_nontemporal_load((const f32x4*)(base + (size_t)(kk & 255) * 1024 + (kk >> 8) * 128 + r4));
#else
        return *(const f32x4*)(base + (size_t)(kk & 255) * 1024 + (kk >> 8) * 128 + r4);
#endif
    }
};
struct HidA {
    static constexpr bool NT = true;
    const bf16_t* base; const int* rowidx;
    __device__ __forceinline__ const bf16_t* ptr(int r, int kk) const { return base + (size_t)rowidx[r] * 256 + (kk & 255); }
    __device__ __forceinline__ const bf16_t* pp(int i, int tid, int k) const { return ptr(i * 32 + (tid >> 3), k); }
};
#ifndef P11_NT
#define P11_NT 4
#endif
__device__ void phase11(const Params& p, char* smem) {
    const int tid = opaque_tid(), xcd = xcd_of(smem), rank = rank_of(smem), nranks = nranks_of(smem);
    const int lane = tid & 63, wid = tid >> 6, wr = wid >> 1, wc = wid & 1, fr = lane & 15, fq = lane >> 4;
    int* srow = (int*)(smem + GEMM_SMEM);
    int* spre = srow + 256;
    float* sew = (float*)(srow + 384);
#ifndef P11_REP
#define P11_REP 1
#endif
    const int total = build_entries<P11_NT>(p, xcd, spre);
    for (int it0 = rank; it0 < total * P11_REP; it0 += nranks) {
        const int it = it0 % total;
        int e, nt, mtile, cnt;
        decode_item<P11_NT>(p, xcd, spre, it, e, nt, mtile, cnt);
        if (tid < 128) {
            const int pos = mtile * 128 + tid;
            int id = -1;
            if (pos < cnt) id = (e == N_EXP) ? (pos * NASSIGN + TOPK) : p.lists()[(size_t)e * NTOK + pos];
            srow[tid] = id >= 0 ? id : 0;
            srow[128 + tid] = id;
            sew[tid] = id >= 0 ? p.ew()[id] : 0.f;
        }
        __syncthreads();
        Rows4 al; al.kmask = 255;
        al.p0 = p.hid() + (size_t)srow[(tid >> 3)] * 256; al.p1 = p.hid() + (size_t)srow[32 + (tid >> 3)] * 256;
        al.p2 = p.hid() + (size_t)srow[64 + (tid >> 3)] * 256; al.p3 = p.hid() + (size_t)srow[96 + (tid >> 3)] * 256;
        DownB bl{(e == N_EXP) ? p.w_s_down : p.w_e_down + (size_t)e * 256 * 1024};
        f32x4 acc[4][4];
        bf16_t* outk = p.outk();
        auto epi = [&](int tile, const f32x4 (&a)[4][4]) __attribute__((always_inline)) {
#pragma unroll
            for (int m = 0; m < 4; ++m) {
                const int rr = wr * 64 + m * 16 + fr;
                const int id = srow[128 + rr];
                if (id >= 0) {
                    const float w8 = sew[rr];
#pragma unroll
                    for (int n = 0; n < 4; ++n) {
                        u32x2 w; w.x = pk_bf16(a[m][n][0] * w8, a[m][n][1] * w8); w.y = pk_bf16(a[m][n][2] * w8, a[m][n][3] * w8);
                        *(u32x2*)(outk + (size_t)id * 1024 + tile * 128 + wc * 64 + n * 16 + fq * 4) = w;
                    }
                }
            }
        };
        gemm_core<true, true>(al, bl, nt * (2048 / P11_NT), 32 / P11_NT, 4, smem, acc, [&](int tl, const f32x4 (&a)[4][4]) __attribute__((always_inline)) { epi(nt * (8 / P11_NT) + tl, a); });
        __syncthreads();
    }
}

__device__ void phase12(const Params& p) {
    const int lane = opaque_tid() & 63, gw = blockIdx.x * 4 + (opaque_tid() >> 6), nw = gridDim.x * 4;
    const float alpha = 1.189207115f;
    for (int row = gw; row < NTOK; row += nw) {
        const int b = row / SEQ;
        const float* md = p.mod() + b * 6144;
        float v[16];
#pragma unroll
        for (int i = 0; i < 16; ++i) v[i] = 0.f;
#pragma unroll
        for (int k = 0; k < NASSIGN; ++k) {
#pragma unroll
            for (int cidx = 0; cidx < 2; ++cidx) {
                const u32x4 w = *(const u32x4*)(p.outk() + ((size_t)row * NASSIGN + k) * 1024 + cidx * 512 + lane * 8);
                v[cidx * 8 + 0] += bflo(w.x); v[cidx * 8 + 1] += bfhi(w.x); v[cidx * 8 + 2] += bflo(w.y); v[cidx * 8 + 3] += bfhi(w.y);
                v[cidx * 8 + 4] += bflo(w.z); v[cidx * 8 + 5] += bfhi(w.z); v[cidx * 8 + 6] += bflo(w.w); v[cidx * 8 + 7] += bfhi(w.w);
            }
        }
        float s = 0.f;
#pragma unroll
        for (int cidx = 0; cidx < 2; ++cidx)
#pragma unroll
            for (int hh = 0; hh < 2; ++hh) {
                const int col = cidx * 512 + lane * 8 + hh * 4;
                const f32x4 xv = *(const f32x4*)(p.x1() + (size_t)row * 1024 + col), ga = *(const f32x4*)(md + 5120 + col);
#pragma unroll
                for (int j = 0; j < 4; ++j) { float t = alpha * xv[j] + (1.f + ga[j]) * v[cidx * 8 + hh * 4 + j]; v[cidx * 8 + hh * 4 + j] = t; s += t; }
            }
        const float mu = wave_sum(s) * (1.f / 1024.f);
        float q = 0.f;
#pragma unroll
        for (int i = 0; i < 16; ++i) { float d = v[i] - mu; q += d * d; }
        const float rstd = rsqrtf(wave_sum(q) * (1.f / 1024.f) + 1e-5f);
#pragma unroll
        for (int cidx = 0; cidx < 2; ++cidx)
#pragma unroll
            for (int hh = 0; hh < 2; ++hh) {
                const int col = cidx * 512 + lane * 8 + hh * 4;
                const f32x4 g = *(const f32x4*)(p.ln2_g + col), bb = *(const f32x4*)(p.ln2_b + col);
                f32x4 o;
#pragma unroll
                for (int j = 0; j < 4; ++j) o[j] = (v[cidx * 8 + hh * 4 + j] - mu) * rstd * g[j] + bb[j];
                *(f32x4*)(p.out + (size_t)row * 1024 + col) = o;
            }
    }
}

#define XB_TMO      128
#define XB_XCNT(j)  (256  + 64 * (j))
#define XB_XSUB(j)  (1280 + 64 * (j))
#define XB_XGEN(j)  (2304 + 64 * (j))
#define XB_TOP      3328
#define XB_TOPGEN   3392
#define XCD_BAR_WORDS 3456
#define XB_SPIN_CAP (1u << 22)
#define LAS __attribute__((address_space(3)))
__device__ __forceinline__ unsigned xb_ld(unsigned* p) { return __hip_atomic_load(p, __ATOMIC_RELAXED, __HIP_MEMORY_SCOPE_AGENT); }
__device__ __forceinline__ unsigned xb_add(unsigned* p, unsigned v) { return __hip_atomic_fetch_add(p, v, __ATOMIC_RELAXED, __HIP_MEMORY_SCOPE_AGENT); }
__device__ __forceinline__ unsigned xb_xcc_id() { return (unsigned)__builtin_amdgcn_s_getreg((3 << 11) | 20) & 0xFu; }
#define XB_SPIN(cond, bar) do { unsigned _sp = 0; while (cond) { __builtin_amdgcn_s_sleep(1); \
    if ((++_sp & 255u) == 0u) { if (xb_ld(&(bar)[XB_TMO])) break; if (_sp > XB_SPIN_CAP) { atomicAdd(&(bar)[XB_TMO], 1u); break; } } } } while (0)
struct XcdBarrier { unsigned* bar; unsigned x; volatile LAS unsigned* st; };
__device__ __forceinline__ XcdBarrier xcd_barrier_post(unsigned* bar, volatile LAS unsigned* st) {
    XcdBarrier b; b.bar = bar; b.x = xb_xcc_id(); b.st = st;
    if (opaque_tid() == 0) st[2] = xb_add(&bar[XB_XCNT(b.x)], 1u);
    return b;
}
__device__ __forceinline__ void xcd_barrier_complete(unsigned* bar, unsigned x, unsigned& nloc, unsigned& nx, unsigned& dense) {
    const unsigned G = gridDim.x * gridDim.y * gridDim.z;
    unsigned sum, cnt, mine, below, sp = 0u;
    for (;;) {
        sum = 0u; cnt = 0u; mine = 0u; below = 0u;
#pragma unroll
        for (unsigned j = 0; j < 16; ++j) { const unsigned c = xb_ld(&bar[XB_XCNT(j)]); sum += c; cnt += (c > 0u) ? 1u : 0u; mine = (j == x) ? c : mine; below += (j < x && c > 0u) ? 1u : 0u; }
        if (sum == G) break;
        __builtin_amdgcn_s_sleep(1);
        if ((++sp & 255u) == 0u) { if (xb_ld(&bar[XB_TMO])) break; if (sp > XB_SPIN_CAP) { atomicAdd(&bar[XB_TMO], 1u); break; } }
    }
    nloc = mine > 0u ? mine : 1u; nx = cnt > 0u ? cnt : 1u; dense = below;
}
__device__ __forceinline__ void xcd_barrier(unsigned* bar, volatile LAS unsigned* st) {
    asm volatile("s_waitcnt vmcnt(0)" ::: "memory");
    __syncthreads();
    if (opaque_tid() == 0) {
        __builtin_amdgcn_s_waitcnt(0);
        const unsigned x = st[3];
        unsigned nloc = st[0], nx = st[1];
        if (nloc == 0u) {
            unsigned dense;
            xcd_barrier_complete(bar, x, nloc, nx, dense); st[0] = nloc; st[1] = nx;
            const unsigned use_xcc = (nx == 8u) ? 1u : 0u;
            st[4] = use_xcc ? dense : (blockIdx.x & 7u);
            st[5] = use_xcc ? st[2] : (blockIdx.x >> 3);
            st[6] = use_xcc ? nloc : (gridDim.x >> 3);
        }
        const unsigned old = xb_add(&bar[XB_XSUB(x)], 1u);
        const unsigned gen = old / nloc;
        if (old + 1u == (gen + 1u) * nloc) {
            __builtin_amdgcn_fence(__ATOMIC_RELEASE, "agent");
            asm volatile("s_waitcnt vmcnt(0)" ::: "memory");
            const unsigned og = xb_add(&bar[XB_TOP], 1u);
            const unsigned tg = og / nx;
            if (og + 1u == (tg + 1u) * nx) xb_add(&bar[XB_TOPGEN], 1u);
            else XB_SPIN(xb_ld(&bar[XB_TOPGEN]) == tg, bar);
            __builtin_amdgcn_fence(__ATOMIC_ACQUIRE, "agent");
            xb_add(&bar[XB_XGEN(x)], 1u);
            asm volatile("s_waitcnt vmcnt(0)" ::: "memory");
        } else {
            XB_SPIN(xb_ld(&bar[XB_XGEN(x)]) == gen, bar);
            __builtin_amdgcn_fence(__ATOMIC_ACQUIRE, "agent");
            asm volatile("s_waitcnt vmcnt(0)" ::: "memory");
        }
    }
    __syncthreads();
}

#define MEGA_SMEM (GEMM_SMEM + 2048 + 64)
#define N_PHASES 14
__global__ void __launch_bounds__(256, 2) mega(Params p) {
    extern __shared__ __attribute__((aligned(16))) char smem[];
    volatile LAS unsigned* st = (volatile LAS unsigned*)(smem + GEMM_SMEM + 2048);
    if (p.ph_hi - p.ph_lo > 1) {
        if (opaque_tid() == 0) {
            const unsigned x = xb_xcc_id();
            st[0] = 0u; st[1] = 0u; st[3] = x;
            st[2] = xb_add(&p.bar()[XB_XCNT(x)], 1u);
        }
    } else {
        if (opaque_tid() == 0) { st[0] = gridDim.x >> 3; st[1] = 8u; st[2] = blockIdx.x >> 3; st[3] = blockIdx.x & 7; st[4] = blockIdx.x & 7; st[5] = blockIdx.x >> 3; st[6] = gridDim.x >> 3; }
    }
    __syncthreads();
#ifndef REP_PHASE
#define REP_PHASE -1
#endif
#ifdef PHPROF
#define PH_STAMP(N) if (blockIdx.x == 0 && opaque_tid() == 0) ((unsigned long long*)(p.ws + OFF_counts + 1536))[N] = __builtin_amdgcn_s_memrealtime();
#else
#define PH_STAMP(N)
#endif
#define RUN_PHASE(N, CALL) if (p.ph_lo <= N && N < p.ph_hi) { if (N > p.ph_lo) xcd_barrier(p.bar(), st); PH_STAMP(N) { const int rep = 0; (void)rep; CALL; } \
        if (REP_PHASE == N) { xcd_barrier(p.bar(), st); { const int rep = 1; (void)rep; CALL; } } }
    RUN_PHASE(0, phase0(p, smem))
    RUN_PHASE(1, phase1(p))
    RUN_PHASE(2, phase2(p, smem))
    RUN_PHASE(3, phase3(p, smem))
    RUN_PHASE(4, phase4(p, smem))
    RUN_PHASE(5, phase5a(p, smem, rep))
    RUN_PHASE(6, phase5b(p, smem, rep))
    RUN_PHASE(7, phase6(p, smem))
    RUN_PHASE(8, phase7(p))
    RUN_PHASE(9, phase8(p, smem))
    RUN_PHASE(10, phase9(p))
    RUN_PHASE(11, phase10(p, smem))
    RUN_PHASE(12, phase11(p, smem))
    RUN_PHASE(13, phase12(p))
#ifdef EXTRA_BARRIERS
    for (int i = 0; i < EXTRA_BARRIERS; ++i) xcd_barrier(p.bar(), st);
#endif
    PH_STAMP(14)
    PH_STAMP(15)
}
#if DBG
struct NaiveBufs { float *mod, *h, *proj, *flat, *hidk, *hidv, *kc, *vc, *mix, *ograw, *y, *x1, *logits; };
__device__ __forceinline__ void dbg_pair(int seam, size_t i, const Params& p, const NaiveBufs& nb, float& a, float& b, bool& use) {
    use = true; a = 0.f; b = 0.f;
    switch (seam) {
        case 0: {
            a = nb.mod[i]; b = p.mod()[i]; break; }
        case 1: {
            size_t tok = i / PCOLS; int n = (int)(i % PCOLS);
            int src = win_srccol(n);
            bool transposed = (n >= 896 && n < 1024) || (n >= 1152 && n < 1280) || (n >= 1792 && n < 2304) || n >= 2816;
            if (transposed || src < 0) { use = false; break; }
            a = nb.proj[tok * IN_COLS + src]; b = bf2f(p.Pb()[i]); break; }
        case 2: {
            size_t half = (size_t)BATCH * 128 * SEQ; int which = i >= half; size_t j = which ? i - half : i;
            int t = (int)(j % SEQ); int f = (int)((j / SEQ) % 128); int bb = (int)(j / ((size_t)SEQ * 128));
            a = nb.proj[((size_t)bb * SEQ + t) * IN_COLS + (which ? C_VW : C_VS) + f];
            b = bf2f(which ? p.VwT()[j] : p.VsT()[j]); break; }
        case 3: {
            size_t nv = (size_t)BATCH * 512 * SEQ;
            if (i < nv) { int t = (int)(i % SEQ); int f = (int)((i / SEQ) % 512); int bb = (int)(i / ((size_t)SEQ * 512));
                a = nb.proj[((size_t)bb * SEQ + t) * IN_COLS + C_GV + f]; b = bf2f(p.VgT()[i]); }
            else { size_t j = i - nv; size_t tok = j / 40; int f = (int)(j % 40);
                a = nb.proj[tok * IN_COLS + (f < 24 ? C_NG + f : C_GLR + f - 24)]; b = p.misc()[tok * 64 + f]; }
            break; }
        case 4: {
            size_t nk = (size_t)BATCH * NCMP * 2 * 64;
            size_t j = i < nk ? i : i - nk;
            int d = (int)(j % 64); int g = (int)((j / 64) % 2); int ii = (int)((j / 128) % NCMP); int bb = (int)(j / (128 * NCMP));
            if (i < nk) { a = nb.kc[j]; b = bf2f(p.kc()[((size_t)(bb * 2 + g) * 256 + ii) * 64 + d]); }
            else { a = nb.vc[j]; b = bf2f(p.vcT()[((size_t)(bb * 2 + g) * 64 + d) * 256 + ii]); }
            break; }
        case 5: {
            size_t tok = i / 512; int cidx = (int)(i % 512);
            a = nb.mix[tok * 1024 + cidx]; b = bf2f(p.mixb()[tok * 1024 + cidx]); break; }
        case 6: {
            size_t tok = i / 512; int cidx = (int)(i % 512);
            a = nb.mix[tok * 1024 + 512 + cidx]; b = bf2f(p.mixb()[tok * 1024 + 512 + cidx]); break; }
        case 7: { a = nb.x1[i]; b = p.x1()[i]; break; }
        case 8: { a = nb.logits[i]; b = p.logits()[i]; break; }
    }
}
__global__ __launch_bounds__(256) void dbg_compare(int seam, size_t n, Params p, NaiveBufs nb, float* dbg) {
    __shared__ float red[256];
    float sd = 0.f, sa = 0.f;
    for (size_t i = (size_t)blockIdx.x * 256 + threadIdx.x; i < n; i += (size_t)gridDim.x * 256) {
        float a, b; bool use;
        dbg_pair(seam, i, p, nb, a, b, use);
        if (use) { float d = a - b; if (!(d == d)) d = 1e10f; sd += d * d; sa += a * a; }
    }
    sd = blk_sum(sd, red); sa = blk_sum(sa, red);
    if (threadIdx.x == 0) { atomicAdd(&dbg[2 * seam], sd); atomicAdd(&dbg[2 * seam + 1], sa); }
}
__global__ void dbg_decide(float* dbg, int nseams, int report_seam) {
    float code = 0.f;
    for (int k = 0; k < nseams; ++k) {
        float err = dbg[2 * k] / fmaxf(dbg[2 * k + 1], 1e-30f);
        const float thr = (k == 5) ? 3e-2f : 1e-3f;
        bool bad = !(err < thr);
        if (bad || k == report_seam) {
            float lg = log10f(fmaxf(err, 1e-12f));
            int dgt = (int)floorf(lg) + 6; dgt = dgt < 0 ? 0 : (dgt > 9 ? 9 : dgt);
            code = 100.f * (k + 1) + 10.f * dgt; break;
        }
    }
    dbg[64] = code;
}
__global__ void dbg_apply(const float* dbg, float* out, size_t n) {
    float code = dbg[64];
    if (code <= 0.f) return;
    float cst = sqrtf(code);
    for (size_t i = (size_t)blockIdx.x * 256 + threadIdx.x; i < n; i += (size_t)gridDim.x * 256) out[i] = cst;
}
#endif

#ifdef PROF
__global__ void prof_apply(const unsigned long long* pw, float* out, size_t n, int sel) {
    const double proc = (double)pw[0], tot = (double)pw[1], steps = (double)pw[2];
    float code = 0.f;
    if (sel == 0) code = (float)(100.0 * proc / tot);
    if (sel == 1) code = (float)(tot / steps / 10.0);
    if (sel == 2) code = (float)(proc / steps / 10.0);
    if (sel == 3) code = (float)(steps / 1024.0);
    const float cst = sqrtf(code);
    for (size_t i = (size_t)blockIdx.x * 256 + threadIdx.x; i < n; i += (size_t)gridDim.x * 256) out[i] = cst;
}
#endif
#ifdef PHPROF
__global__ void phase_prof_apply(const unsigned long long* ts, float* out, size_t n, int sel) {
    double us;
    if (sel >= 100) us = (double)(ts[15] - ts[0]) / 100.0;
    else us = (double)(ts[sel + 1] - ts[sel]) / 100.0;
    const float cst = (float)log2(us > 1.0 ? us : 1.0);
    for (size_t i = (size_t)blockIdx.x * 256 + threadIdx.x; i < n; i += (size_t)gridDim.x * 256) out[i] = cst;
}
#endif
extern "C" void kernel_launch(void* const* d_in, const int* in_sizes, int n_in, void* d_out, int out_size,
                              void* d_ws, size_t ws_size, hipStream_t stream) {
    Params p{};
    const float** ins = (const float**)&p;
    for (int i = 0; i < 27; ++i) ins[i] = (const float*)d_in[i];
    p.out = (float*)d_out;

    char* ws = (char*)d_ws;
    p.ws = ws;
    if (WS_TOTAL > ws_size) return;
#if DBG
    size_t off = 0;
    auto alloc = [&](size_t bytes) { char* q = ws + off; off += (bytes + 255) & ~(size_t)255; return q; };
    NaiveBufs nb{};
    nb.mod = (float*)alloc(4 * 6144 * 4);
    nb.h = (float*)alloc((size_t)NTOK * 1024 * 4);
    nb.proj = (float*)alloc((size_t)NTOK * IN_COLS * 4);
    nb.flat = (float*)alloc((size_t)2040 * 2048 * 4);
    nb.hidk = (float*)alloc((size_t)2040 * 256 * 4);
    nb.hidv = (float*)alloc((size_t)2040 * 256 * 4);
    nb.kc = (float*)alloc((size_t)2040 * 64 * 4);
    nb.vc = (float*)alloc((size_t)2040 * 64 * 4);
    nb.mix = (float*)alloc((size_t)NTOK * 1024 * 4);
    nb.ograw = (float*)alloc((size_t)NTOK * 512 * 4);
    nb.y = (float*)alloc((size_t)NTOK * 1024 * 4);
    nb.x1 = (float*)alloc((size_t)NTOK * 1024 * 4);
    nb.logits = (float*)alloc((size_t)NTOK * 256 * 4);
    float* dbg = (float*)alloc(1024);
    if (off > WS_BASE) return;
#endif

    static int grid = 0;
    if (grid == 0) {
        int dev = 0, cus = 0, per_cu = 0;
        (void)hipGetDevice(&dev);
        (void)hipDeviceGetAttribute(&cus, hipDeviceAttributeMultiprocessorCount, dev);
        (void)hipFuncSetAttribute((const void*)mega, hipFuncAttributeMaxDynamicSharedMemorySize, MEGA_SMEM);
        (void)hipOccupancyMaxActiveBlocksPerMultiprocessor(&per_cu, (const void*)mega, 256, MEGA_SMEM);
        per_cu = 2;
        grid = cus * per_cu;
        grid &= ~7;
    }
    (void)hipMemsetAsync(ws + OFF_bar, 0, XCD_BAR_WORDS * 4, stream);

#if DBG
    (void)hipMemsetAsync(dbg, 0, 1024, stream);
    nk_mod<<<dim3(24, 4), 256, 0, stream>>>(p.c, p.w_mod, p.b_mod, nb.mod);
    nk_lnmod<<<NTOK, 256, 0, stream>>>(p.x, nb.mod, 0, 1024, nb.h);
    nk_gemm<<<dim3((IN_COLS + 63) / 64, NTOK / 64), 256, 0, stream>>>(nb.h, 1024, p.w_in, IN_COLS, nb.proj, IN_COLS, NTOK, IN_COLS, 1024);
    nk_flat<<<2040, 256, 0, stream>>>(nb.proj, C_KC, p.pos_k, nb.flat);
    nk_gemm<<<dim3(4, 32), 256, 0, stream>>>(nb.flat, 2048, p.w1_k, 256, nb.hidk, 256, 2040, 256, 2048);
    nk_silu<<<(2040 * 256 + 255) / 256, 256, 0, stream>>>(nb.hidk, 2040 * 256);
    nk_gemm<<<dim3(1, 32), 256, 0, stream>>>(nb.hidk, 256, p.w2_k, 64, nb.kc, 64, 2040, 64, 256);
    nk_flat<<<2040, 256, 0, stream>>>(nb.proj, C_VC, p.pos_v, nb.flat);
    nk_gemm<<<dim3(4, 32), 256, 0, stream>>>(nb.flat, 2048, p.w1_v, 256, nb.hidv, 256, 2040, 256, 2048);
    nk_silu<<<(2040 * 256 + 255) / 256, 256, 0, stream>>>(nb.hidv, 2040 * 256);
    nk_gemm<<<dim3(1, 32), 256, 0, stream>>>(nb.hidv, 256, p.w2_v, 64, nb.vc, 64, 2040, 64, 256);
    nk_nsa<<<NTOK, 256, 0, stream>>>(nb.proj, nb.kc, nb.vc, nb.mix);
    nk_gla<<<64, 256, 0, stream>>>(nb.proj, p.w_a2, p.b_a2, nb.ograw);
    nk_gla_norm<<<NTOK, 256, 0, stream>>>(nb.ograw, nb.proj, p.norm_w, nb.mix);
    nk_gemm<<<dim3(16, NTOK / 64), 256, 0, stream>>>(nb.mix, 1024, p.w_o, 1024, nb.y, 1024, NTOK, 1024, 1024);
    nk_resln<<<NTOK, 256, 0, stream>>>(p.x, nb.y, nb.mod, 2048, p.ln1_g, p.ln1_b, nb.x1);
    nk_lnmod<<<NTOK, 256, 0, stream>>>(nb.x1, nb.mod, 3072, 4096, nb.h);
    nk_gemm<<<dim3(4, NTOK / 64), 256, 0, stream>>>(nb.h, 1024, p.w_router, 256, nb.logits, 256, NTOK, 256, 1024);
    auto cmp = [&](int seam, size_t n) { dbg_compare<<<1024, 256, 0, stream>>>(seam, n, p, nb, dbg); };
#endif

#if SINGLE_LAUNCH
    p.ph_lo = 0; p.ph_hi = N_PHASES;
    mega<<<grid, 256, MEGA_SMEM, stream>>>(p);
#else
    for (int ph = 0; ph < N_PHASES; ++ph) {
        p.ph_lo = ph; p.ph_hi = ph + 1;
        mega<<<grid, 256, MEGA_SMEM, stream>>>(p);
#if DBG
        if (ph == 0) cmp(0, 4 * 6144);
        if (ph == 2) { cmp(1, (size_t)NTOK * PCOLS); cmp(2, (size_t)2 * BATCH * 128 * SEQ); cmp(3, (size_t)BATCH * 512 * SEQ + (size_t)NTOK * 40); }
        if (ph == 4) cmp(4, (size_t)2 * BATCH * NCMP * 128);
        if (ph == 5) { cmp(5, (size_t)NTOK * 512); cmp(6, (size_t)NTOK * 512); }
        if (ph == 7) cmp(7, (size_t)NTOK * 1024);
        if (ph == 8) cmp(8, (size_t)NTOK * 256);
#endif
    }
#endif
#ifdef PHPROF
    phase_prof_apply<<<1024, 256, 0, stream>>>((const unsigned long long*)(ws + OFF_counts + 1536), p.out, (size_t)NTOK * 1024, PHPROF);
#endif
#ifdef PROF
    prof_apply<<<1024, 256, 0, stream>>>((const unsigned long long*)(ws + OFF_counts + 1024), p.out, (size_t)NTOK * 1024, PROF);
#endif
#if DBG
    dbg_decide<<<1, 1, 0, stream>>>(dbg, 9, DBG_REPORT);
    dbg_apply<<<1024, 256, 0, stream>>>(dbg, p.out, (size_t)NTOK * 1024);
#endif
}
```

```cpp
#include <hip/hip_runtime.h>
#include <hip/hip_bf16.h>
#include <stdint.h>

#define D_MODEL 1024
#define BATCH 4
#define SEQ 4096
#define NTOK (BATCH * SEQ)
#define IN_COLS 2856
#define NCMP 255
#define NEGF (-1e30f)
#define C_NQ 0
#define C_KC 512
#define C_VC 640
#define C_KS 768
#define C_VS 896
#define C_KW 1024
#define C_VW 1152
#define C_NG 1280
#define C_GQ 1304
#define C_GK 1560
#define C_GV 1816
#define C_GLR 2328
#define C_GR 2344
#define N_EXP 256
#define TOPK 8

__device__ __forceinline__ float siluf(float x) { return x / (1.f + __expf(-x)); }
__device__ __forceinline__ float sigmoidf_(float x) { return 1.f / (1.f + __expf(-x)); }

__device__ __forceinline__ float blk_sum(float v, float* red) {
    int t = threadIdx.x;
    __syncthreads();
    red[t] = v; __syncthreads();
    for (int s = 128; s > 0; s >>= 1) { if (t < s) red[t] += red[t + s]; __syncthreads(); }
    float r = red[0];
    return r;
}
__device__ __forceinline__ float blk_max(float v, float* red) {
    int t = threadIdx.x;
    __syncthreads();
    red[t] = v; __syncthreads();
    for (int s = 128; s > 0; s >>= 1) { if (t < s) red[t] = fmaxf(red[t], red[t + s]); __syncthreads(); }
    float r = red[0];
    return r;
}

#define DBG 0
#define SINGLE_LAUNCH 1
#define DBG_REPORT -1
#define REP_PHASE -1
#if DBG
__global__ __launch_bounds__(256) void nk_mod(const float* c, const float* w_mod, const float* b_mod, float* mod) {
    int j = blockIdx.x * 256 + threadIdx.x; int b = blockIdx.y;
    float acc = b_mod[j];
    for (int k = 0; k < D_MODEL; ++k) acc += siluf(c[b * D_MODEL + k]) * w_mod[(size_t)k * 6144 + j];
    mod[b * 6144 + j] = acc;
}

__global__ __launch_bounds__(256) void nk_lnmod(const float* x, const float* mod, int sh_off, int sc_off, float* out) {
    __shared__ float red[256];
    int row = blockIdx.x; int b = row / SEQ; int t = threadIdx.x;
    const float* xr = x + (size_t)row * D_MODEL;
    float v[4]; float s = 0.f;
    for (int i = 0; i < 4; ++i) { v[i] = xr[t + 256 * i]; s += v[i]; }
    float mu = blk_sum(s, red) * (1.f / D_MODEL);
    float q = 0.f;
    for (int i = 0; i < 4; ++i) { float d = v[i] - mu; q += d * d; }
    float var = blk_sum(q, red) * (1.f / D_MODEL);
    float rstd = rsqrtf(var + 1e-5f);
    for (int i = 0; i < 4; ++i) {
        int col = t + 256 * i;
        out[(size_t)row * D_MODEL + col] = (v[i] - mu) * rstd * (1.f + mod[b * 6144 + sc_off + col]) + mod[b * 6144 + sh_off + col];
    }
}

__global__ __launch_bounds__(256) void nk_resln(const float* x, const float* y, const float* mod, int ga_off, const float* g, const float* bb, float* out) {
    __shared__ float red[256];
    int row = blockIdx.x; int b = row / SEQ; int t = threadIdx.x;
    const float alpha = 1.189207115f;
    float v[4]; float s = 0.f;
    for (int i = 0; i < 4; ++i) {
        int col = t + 256 * i;
        v[i] = alpha * x[(size_t)row * D_MODEL + col] + (1.f + mod[b * 6144 + ga_off + col]) * y[(size_t)row * D_MODEL + col];
        s += v[i];
    }
    float mu = blk_sum(s, red) * (1.f / D_MODEL);
    float q = 0.f;
    for (int i = 0; i < 4; ++i) { float d = v[i] - mu; q += d * d; }
    float var = blk_sum(q, red) * (1.f / D_MODEL);
    float rstd = rsqrtf(var + 1e-5f);
    for (int i = 0; i < 4; ++i) {
        int col = t + 256 * i;
        out[(size_t)row * D_MODEL + col] = (v[i] - mu) * rstd * g[col] + bb[col];
    }
}

__global__ __launch_bounds__(256) void nk_gemm(const float* A, int lda, const float* B, int ldb, float* C, int ldc, int M, int N, int K) {
    __shared__ float sA[16][64 + 1];
    __shared__ float sB[16][64 + 1];
    int tx = threadIdx.x & 15, ty = threadIdx.x >> 4;
    int m0 = blockIdx.y * 64, n0 = blockIdx.x * 64;
    float acc[4][4];
    for (int i = 0; i < 4; ++i) for (int j = 0; j < 4; ++j) acc[i][j] = 0.f;
    for (int k0 = 0; k0 < K; k0 += 16) {
        for (int e = threadIdx.x; e < 1024; e += 256) {
            int r = e >> 4, kk = e & 15;
            int gm = m0 + r;
            sA[kk][r] = (gm < M) ? A[(size_t)gm * lda + k0 + kk] : 0.f;
            int kb = e >> 6, nn = e & 63;
            int gn = n0 + nn;
            sB[kb][nn] = (gn < N) ? B[(size_t)(k0 + kb) * ldb + gn] : 0.f;
        }
        __syncthreads();
#pragma unroll
        for (int kk = 0; kk < 16; ++kk) {
            float a[4], bv[4];
#pragma unroll
            for (int i = 0; i < 4; ++i) a[i] = sA[kk][ty * 4 + i];
#pragma unroll
            for (int j = 0; j < 4; ++j) bv[j] = sB[kk][tx * 4 + j];
#pragma unroll
            for (int i = 0; i < 4; ++i)
#pragma unroll
                for (int j = 0; j < 4; ++j) acc[i][j] += a[i] * bv[j];
        }
        __syncthreads();
    }
#pragma unroll
    for (int i = 0; i < 4; ++i)
#pragma unroll
        for (int j = 0; j < 4; ++j) {
            int gm = m0 + ty * 4 + i, gn = n0 + tx * 4 + j;
            if (gm < M && gn < N) C[(size_t)gm * ldc + gn] = acc[i][j];
        }
}

__global__ __launch_bounds__(256) void nk_flat(const float* proj, int col0, const float* pos, float* flat) {
    int r = blockIdx.x;
    int g = r & 1; int bi = r >> 1; int i = bi % NCMP; int b = bi / NCMP;
    for (int e = threadIdx.x; e < 2048; e += 256) {
        int l = e >> 6, d = e & 63;
        flat[(size_t)r * 2048 + e] = proj[((size_t)b * SEQ + 16 * i + l) * IN_COLS + col0 + g * 64 + d] + pos[l * 64 + d];
    }
}
__global__ void nk_silu(float* x, int n) { int i = blockIdx.x * 256 + threadIdx.x; if (i < n) x[i] = siluf(x[i]); }

__global__ __launch_bounds__(256) void nk_nsa(const float* proj, const float* kc, const float* vc, float* mix) {
    __shared__ float sq[8][64];
    __shared__ float sp[1024];
    __shared__ float red[256];
    __shared__ float simp[64];
    __shared__ float sscore[64];
    __shared__ int sidx[16];
    __shared__ float sout[8][64];
    __shared__ float spart[4][64];
    const int tid = threadIdx.x;
    const int bt = blockIdx.x; const int b = bt / SEQ, t = bt % SEQ;
    const float* prow = proj + (size_t)bt * IN_COLS;
    for (int e = tid; e < 512; e += 256) { sq[e >> 6][e & 63] = prow[C_NQ + e] * 0.125f; sout[e >> 6][e & 63] = 0.f; }
    __syncthreads();
    const int tblk = t >> 6;
    const int dd = tid & 63, part = tid >> 6;
    for (int g = 0; g < 2; ++g) {
        if (tid < 64) simp[tid] = 0.f;
        __syncthreads();
        for (int hp = 0; hp < 4; ++hp) {
            int h = g * 4 + hp;
            float slope = exp2f(-(float)(h + 1));
            float s = NEGF; bool valid = false;
            if (tid < NCMP) {
                int ce = 16 * tid + 31;
                valid = (t >= ce);
                if (valid) {
                    const float* kr = kc + (((size_t)b * NCMP + tid) * 2 + g) * 64;
                    float a = 0.f;
                    for (int d = 0; d < 64; ++d) a += sq[h][d] * kr[d];
                    s = a - slope * (float)(t - ce);
                }
            }
            float m = blk_max(s, red);
            float e = valid ? __expf(s - m) : 0.f;
            float sum = blk_sum(e, red);
            float p = e / fmaxf(sum, 1e-30f);
            __syncthreads();
            sp[tid] = p;
            __syncthreads();
            float a = 0.f;
            for (int i = part; i < NCMP; i += 4) a += sp[i] * vc[(((size_t)b * NCMP + i) * 2 + g) * 64 + dd];
            spart[part][dd] = a;
            __syncthreads();
            if (tid < 64) {
                float o = spart[0][tid] + spart[1][tid] + spart[2][tid] + spart[3][tid];
                float gate = sigmoidf_(prow[C_NG + h * 3 + 0]);
                sout[h][tid] += gate * o;
                int j = tid;
                float im = sp[4 * j] + sp[4 * j + 1] + sp[4 * j + 2] + 0.5f * sp[4 * j + 3] + (j > 0 ? 0.5f * sp[4 * j - 1] : 0.f);
                simp[j] += im;
            }
            __syncthreads();
        }
        if (tid < 64) {
            int j = tid;
            bool forced = (j == 0) || (j == tblk) || (j == tblk - 1);
            sscore[j] = (j <= tblk) ? (simp[j] + (forced ? 1e4f : 0.f)) : NEGF;
        }
        __syncthreads();
        if (tid < 64) {
            int j = tid; float sj = sscore[j]; int rank = 0;
            for (int j2 = 0; j2 < 64; ++j2) { float s2 = sscore[j2]; if (s2 > sj || (s2 == sj && j2 < j)) ++rank; }
            if (rank < 16) sidx[rank] = j;
        }
        __syncthreads();
        for (int hp = 0; hp < 4; ++hp) {
            int h = g * 4 + hp;
            float slope = exp2f(-(float)(h + 1));
            float sv[4]; bool vl[4]; float mx = NEGF;
            for (int r = 0; r < 4; ++r) {
                int kk = tid + 256 * r;
                int kpos = sidx[kk >> 6] * 64 + (kk & 63);
                vl[r] = (kpos <= t);
                sv[r] = NEGF;
                if (vl[r]) {
                    const float* kr = proj + ((size_t)b * SEQ + kpos) * IN_COLS + C_KS + g * 64;
                    float a = 0.f;
                    for (int d = 0; d < 64; ++d) a += sq[h][d] * kr[d];
                    sv[r] = a - slope * (float)(t - kpos);
                }
                mx = fmaxf(mx, sv[r]);
            }
            float m = blk_max(mx, red);
            float es = 0.f; float ev[4];
            for (int r = 0; r < 4; ++r) { ev[r] = vl[r] ? __expf(sv[r] - m) : 0.f; es += ev[r]; }
            float sum = blk_sum(es, red);
            float inv = 1.f / fmaxf(sum, 1e-30f);
            __syncthreads();
            for (int r = 0; r < 4; ++r) sp[tid + 256 * r] = ev[r] * inv;
            __syncthreads();
            float a = 0.f;
            for (int kk = part; kk < 1024; kk += 4) {
                float p = sp[kk];
                if (p != 0.f) {
                    int kpos = sidx[kk >> 6] * 64 + (kk & 63);
                    a += p * proj[((size_t)b * SEQ + kpos) * IN_COLS + C_VS + g * 64 + dd];
                }
            }
            spart[part][dd] = a;
            __syncthreads();
            if (tid < 64) {
                float o = spart[0][tid] + spart[1][tid] + spart[2][tid] + spart[3][tid];
                float gate = sigmoidf_(prow[C_NG + h * 3 + 1]);
                sout[h][tid] += gate * o;
            }
            __syncthreads();
        }
        for (int hp = 0; hp < 4; ++hp) {
            int h = g * 4 + hp;
            float slope = exp2f(-(float)(h + 1));
            float sv[2]; bool vl[2]; float mx = NEGF;
            for (int r = 0; r < 2; ++r) {
                int kk = tid + 256 * r;
                int kpos = t - 511 + kk;
                vl[r] = (kpos >= 0);
                sv[r] = NEGF;
                if (vl[r]) {
                    const float* kr = proj + ((size_t)b * SEQ + kpos) * IN_COLS + C_KW + g * 64;
                    float a = 0.f;
                    for (int d = 0; d < 64; ++d) a += sq[h][d] * kr[d];
                    sv[r] = a - slope * (float)(t - kpos);
                }
                mx = fmaxf(mx, sv[r]);
            }
            float m = blk_max(mx, red);
            float es = 0.f; float ev[2];
            for (int r = 0; r < 2; ++r) { ev[r] = vl[r] ? __expf(sv[r] - m) : 0.f; es += ev[r]; }
            float sum = blk_sum(es, red);
            float inv = 1.f / fmaxf(sum, 1e-30f);
            __syncthreads();
            for (int r = 0; r < 2; ++r) sp[tid + 256 * r] = ev[r] * inv;
            __syncthreads();
            float a = 0.f;
            for (int kk = part; kk < 512; kk += 4) {
                float p = sp[kk];
                if (p != 0.f) {
                    int kpos = t - 511 + kk;
                    a += p * proj[((size_t)b * SEQ + kpos) * IN_COLS + C_VW + g * 64 + dd];
                }
            }
            spart[part][dd] = a;
            __syncthreads();
            if (tid < 64) {
                float o = spart[0][tid] + spart[1][tid] + spart[2][tid] + spart[3][tid];
                float gate = sigmoidf_(prow[C_NG + h * 3 + 2]);
                sout[h][tid] += gate * o;
            }
            __syncthreads();
        }
    }
    for (int e = tid; e < 512; e += 256) mix[(size_t)bt * D_MODEL + e] = sout[e >> 6][e & 63];
}

__global__ __launch_bounds__(256) void nk_gla(const float* proj, const float* w_a2, const float* b_a2, float* ograw) {
    __shared__ float sqv[64], skv[64], sav[64];
    __shared__ float red[8][32];
    const int tid = threadIdx.x;
    const int es = blockIdx.x & 3, bh = blockIdx.x >> 2, h = bh & 3, b = bh >> 2;
    const int e = tid & 31, dg = tid >> 5;
    float S[8];
    for (int i = 0; i < 8; ++i) S[i] = 0.f;
    for (int t = 0; t < SEQ; ++t) {
        const float* prow = proj + ((size_t)b * SEQ + t) * IN_COLS;
        if (tid < 64) {
            int d = tid;
            sqv[d] = prow[C_GQ + h * 64 + d] * 0.125f;
            skv[d] = prow[C_GK + h * 64 + d];
            float x = b_a2[h * 64 + d];
            for (int r = 0; r < 16; ++r) x += prow[C_GLR + r] * w_a2[r * 256 + h * 64 + d];
            float ls = -(fmaxf(-x, 0.f) + log1pf(__expf(-fabsf(x))));
            sav[d] = __expf(ls * (1.f / 16.f));
        }
        __syncthreads();
        float v = prow[C_GV + h * 128 + es * 32 + e];
        float part = 0.f;
        for (int i = 0; i < 8; ++i) {
            int d = dg * 8 + i;
            S[i] = sav[d] * S[i] + skv[d] * v;
            part += sqv[d] * S[i];
        }
        red[dg][e] = part;
        __syncthreads();
        if (tid < 32) {
            float o = 0.f;
            for (int i = 0; i < 8; ++i) o += red[i][tid];
            ograw[((size_t)b * SEQ + t) * 512 + h * 128 + es * 32 + tid] = o;
        }
    }
}
__global__ __launch_bounds__(256) void nk_gla_norm(const float* ograw, const float* proj, const float* norm_w, float* mix) {
    int wid = (blockIdx.x * 256 + threadIdx.x) >> 6; int lane = threadIdx.x & 63;
    int tok = wid >> 2, h = wid & 3;
    const float* o = ograw + (size_t)tok * 512 + h * 128;
    float a = o[lane], c = o[lane + 64];
    float s = a + c;
    for (int m = 32; m > 0; m >>= 1) s += __shfl_xor(s, m);
    float mu = s * (1.f / 128.f);
    float q = (a - mu) * (a - mu) + (c - mu) * (c - mu);
    for (int m = 32; m > 0; m >>= 1) q += __shfl_xor(q, m);
    float rstd = rsqrtf(q * (1.f / 128.f) + 1e-5f);
    const float* r = proj + (size_t)tok * IN_COLS + C_GR + h * 128;
    mix[(size_t)tok * D_MODEL + 512 + h * 128 + lane] = (a - mu) * rstd * norm_w[lane] * siluf(r[lane]);
    mix[(size_t)tok * D_MODEL + 512 + h * 128 + lane + 64] = (c - mu) * rstd * norm_w[lane + 64] * siluf(r[lane + 64]);
}

__global__ __launch_bounds__(256) void nk_route(const float* logits, const float* rbias, int* eidx, float* ew, int* counts, int* lists) {
    int wid = (blockIdx.x * 256 + threadIdx.x) >> 6; int lane = threadIdx.x & 63;
    int tok = wid;
    float s[4], sb[4];
    for (int i = 0; i < 4; ++i) { float l = logits[(size_t)tok * 256 + lane * 4 + i]; s[i] = 1.f / (1.f + __expf(-l)); sb[i] = s[i] + rbias[lane * 4 + i]; }
    float m1 = NEGF, m2 = NEGF;
    for (int i = 0; i < 4; ++i) { float v = sb[i]; if (v > m1) { m2 = m1; m1 = v; } else if (v > m2) m2 = v; }
    for (int m = 1; m < 8; m <<= 1) {
        float o1 = __shfl_xor(m1, m), o2 = __shfl_xor(m2, m);
        float n1 = fmaxf(m1, o1);
        float n2 = fmaxf(fminf(m1, o1), fmaxf(m2, o2));
        m1 = n1; m2 = n2;
    }
    float gs = m1 + m2;
    int grp = lane >> 3;
    int grank = 0;
    for (int g2 = 0; g2 < 8; ++g2) { float o = __shfl(gs, g2 * 8); if (o > gs || (o == gs && g2 < grp)) ++grank; }
    bool gsel = grank < 4;
    float cand[4];
    for (int i = 0; i < 4; ++i) cand[i] = gsel ? sb[i] : NEGF;
    float wsum = 0.f; float myw = 0.f; int mye = 0;
    for (int k = 0; k < TOPK; ++k) {
        float bv = cand[0]; int bi = 0;
        for (int i = 1; i < 4; ++i) if (cand[i] > bv) { bv = cand[i]; bi = i; }
        int be = lane * 4 + bi;
        float gv = bv; int ge = be;
        for (int m = 1; m < 64; m <<= 1) {
            float ov = __shfl_xor(gv, m); int oe = __shfl_xor(ge, m);
            if (ov > gv || (ov == gv && oe < ge)) { gv = ov; ge = oe; }
        }
        float sel_s = 0.f;
        if ((ge >> 2) == lane) {
            int i = ge & 3;
            sel_s = (i == 0) ? s[0] : (i == 1) ? s[1] : (i == 2) ? s[2] : s[3];
            if (i == 0) cand[0] = -3e38f; else if (i == 1) cand[1] = -3e38f; else if (i == 2) cand[2] = -3e38f; else cand[3] = -3e38f;
        }
        sel_s = __shfl(sel_s, ge >> 2);
        wsum += sel_s;
        if (lane == k) { myw = sel_s; mye = ge; }
    }
    if (lane < TOPK) {
        float w = myw / wsum * 2.5f;
        eidx[tok * 8 + lane] = mye; ew[tok * 8 + lane] = w;
        int pos = atomicAdd(&counts[mye], 1);
        lists[(size_t)mye * NTOK + pos] = tok * 8 + lane;
    }
}

__global__ __launch_bounds__(256) void nk_moe(const float* h2, const float* wg, const float* wu, const float* wd,
                                              const float* sg, const float* su, const float* sd,
                                              const int* counts, const int* lists, const float* ew, float* acc) {
    __shared__ float sh[8][D_MODEL];
    __shared__ float shid[8][256];
    __shared__ int stok[8]; __shared__ float sw[8];
    const int e = blockIdx.y, chunk = blockIdx.x, tid = threadIdx.x;
    const int cnt = (e == N_EXP) ? NTOK : counts[e];
    if (chunk * 8 >= cnt) return;
    const float* Wg = (e == N_EXP) ? sg : wg + (size_t)e * D_MODEL * 256;
    const float* Wu = (e == N_EXP) ? su : wu + (size_t)e * D_MODEL * 256;
    const float* Wd = (e == N_EXP) ? sd : wd + (size_t)e * 256 * D_MODEL;
    if (tid < 8) {
        int p = chunk * 8 + tid;
        if (p < cnt) {
            if (e == N_EXP) { stok[tid] = p; sw[tid] = 1.f; }
            else { int id = lists[(size_t)e * NTOK + p]; stok[tid] = id >> 3; sw[tid] = ew[id]; }
        } else { stok[tid] = -1; sw[tid] = 0.f; }
    }
    __syncthreads();
    for (int m = 0; m < 8; ++m) {
        int tk = stok[m];
        for (int k = tid; k < D_MODEL; k += 256) sh[m][k] = (tk >= 0) ? h2[(size_t)tk * D_MODEL + k] : 0.f;
    }
    __syncthreads();
    float ag[8], au[8];
#pragma unroll
    for (int m = 0; m < 8; ++m) { ag[m] = 0.f; au[m] = 0.f; }
    for (int k = 0; k < D_MODEL; ++k) {
        float g = Wg[(size_t)k * 256 + tid], u = Wu[(size_t)k * 256 + tid];
#pragma unroll
        for (int m = 0; m < 8; ++m) { float hv = sh[m][k]; ag[m] += hv * g; au[m] += hv * u; }
    }
#pragma unroll
    for (int m = 0; m < 8; ++m) shid[m][tid] = siluf(ag[m]) * au[m];
    __syncthreads();
    for (int jj = 0; jj < 4; ++jj) {
        int j = tid + 256 * jj;
        float ao[8];
#pragma unroll
        for (int m = 0; m < 8; ++m) ao[m] = 0.f;
        for (int n = 0; n < 256; ++n) {
            float w = Wd[(size_t)n * D_MODEL + j];
#pragma unroll
            for (int m = 0; m < 8; ++m) ao[m] += shid[m][n] * w;
        }
#pragma unroll
        for (int m = 0; m < 8; ++m) { int tk = stok[m]; if (tk >= 0) atomicAdd(&acc[(size_t)tk * D_MODEL + j], ao[m] * sw[m]); }
    }
}

#endif
typedef unsigned short bf16_t;
typedef short bf16x8 __attribute__((ext_vector_type(8)));
typedef float f32x4 __attribute__((ext_vector_type(4)));
typedef unsigned u32x4 __attribute__((ext_vector_type(4)));
typedef unsigned u32x2 __attribute__((ext_vector_type(2)));

#define PCOLS 2944
#define P_NQ 0
#define P_KC 512
#define P_VC 640
#define P_KS 768
#define P_VS 896
#define P_KW 1024
#define P_VW 1152
#define P_GQ 1280
#define P_GK 1536
#define P_GV 1792
#define P_GR 2304
#define P_MISC 2816
#define NASSIGN 9
#define LOG2E 1.4426950408889634f

typedef float f32x2_t __attribute__((ext_vector_type(2)));
typedef __bf16 bf16x2_t __attribute__((ext_vector_type(2)));
__device__ __forceinline__ unsigned pk_bf16(float lo, float hi) { const f32x2_t v = {lo, hi}; return __builtin_bit_cast(unsigned, __builtin_convertvector(v, bf16x2_t)); }
__device__ __forceinline__ float bflo(unsigned u) { return __uint_as_float(u << 16); }
__device__ __forceinline__ float bfhi(unsigned u) { return __uint_as_float(u & 0xffff0000u); }
__device__ __forceinline__ float bf2f(bf16_t v) { return __uint_as_float(((unsigned)v) << 16); }
__device__ __forceinline__ int opaque_tid() { int t = threadIdx.x; asm volatile("" : "+v"(t)); return t; }
__device__ __forceinline__ bf16_t f2bf(float f) { return (bf16_t)(pk_bf16(f, 0.f) & 0xffffu); }

#if DBG
#define WS_BASE ((size_t)560 << 20)
#else
#define WS_BASE ((size_t)0)
#endif
#define WS_ALIGN(x) (((size_t)(x) + 255) & ~(size_t)255)
constexpr size_t OFF_mod = WS_BASE;
constexpr size_t OFF_bias1 = OFF_mod + WS_ALIGN(4*6144*4);
constexpr size_t OFF_wint = OFF_bias1 + WS_ALIGN(2*256*4);
constexpr size_t OFF_wot = OFF_wint + WS_ALIGN((size_t)PCOLS*1024*2);
constexpr size_t OFF_wrt = OFF_wot + WS_ALIGN((size_t)1024*1024*2);
constexpr size_t OFF_w1t = OFF_wrt + WS_ALIGN((size_t)256*1024*2);
constexpr size_t OFF_w2t = OFF_w1t + WS_ALIGN((size_t)2*256*2048*2);
constexpr size_t OFF_hb = OFF_w2t + WS_ALIGN((size_t)2*64*256*2);
constexpr size_t OFF_Pb = OFF_hb + WS_ALIGN((size_t)NTOK*1024*2);
constexpr size_t OFF_VsT = OFF_Pb + WS_ALIGN((size_t)NTOK*PCOLS*2);
constexpr size_t OFF_VwT = OFF_VsT + WS_ALIGN((size_t)BATCH*128*SEQ*2);
constexpr size_t OFF_VgT = OFF_VwT + WS_ALIGN((size_t)BATCH*128*SEQ*2);
constexpr size_t OFF_misc = OFF_VgT + WS_ALIGN((size_t)BATCH*512*SEQ*2);
constexpr size_t OFF_cpart = OFF_misc + WS_ALIGN((size_t)NTOK*64*4);
constexpr size_t OFF_kc = OFF_cpart + WS_ALIGN((size_t)2*4*2048*256*4);
constexpr size_t OFF_vcT = OFF_kc + WS_ALIGN((size_t)8*256*64*2);
constexpr size_t OFF_dST = OFF_vcT + WS_ALIGN((size_t)8*64*256*2);
constexpr size_t OFF_dec = OFF_dST + WS_ALIGN((size_t)16*64*8192*4);
constexpr size_t OFF_ST = OFF_dec + WS_ALIGN((size_t)16*64*64*4);
constexpr size_t OFF_mixf = OFF_ST + WS_ALIGN((size_t)16*64*8192*2);
constexpr size_t OFF_mixb = OFF_mixf + WS_ALIGN((size_t)NTOK*512*4);
constexpr size_t OFF_y1 = OFF_mixb + WS_ALIGN((size_t)NTOK*1024*2);
constexpr size_t OFF_x1 = OFF_y1 + WS_ALIGN((size_t)NTOK*1024*4);
constexpr size_t OFF_logits = OFF_x1 + WS_ALIGN((size_t)NTOK*1024*4);
constexpr size_t OFF_ew = OFF_logits + WS_ALIGN((size_t)NTOK*256*4);
constexpr size_t OFF_counts = OFF_ew + WS_ALIGN((size_t)NTOK*NASSIGN*4);
constexpr size_t OFF_lists = OFF_counts + WS_ALIGN(512*4);
constexpr size_t OFF_bar = OFF_lists + WS_ALIGN((size_t)N_EXP*NTOK*4);
constexpr size_t OFF_hid = OFF_bar + WS_ALIGN(4096*4);
constexpr size_t OFF_outk = OFF_hid + WS_ALIGN((size_t)NTOK*NASSIGN*256*2);
constexpr size_t OFF_selm = OFF_outk + WS_ALIGN((size_t)NTOK*NASSIGN*1024*2);
constexpr size_t OFF_selu = OFF_selm + WS_ALIGN((size_t)NTOK*2*8);
constexpr size_t OFF_mixf2 = OFF_selu + WS_ALIGN((size_t)8*64*4*8);
constexpr size_t WS_TOTAL = OFF_mixf2 + WS_ALIGN((size_t)NTOK*512*4);
struct Params {
    const float *x, *c, *w_mod, *b_mod, *w_in, *pos_k, *w1_k, *w2_k, *pos_v, *w1_v, *w2_v, *w_a2, *b_a2, *norm_w, *w_o, *ln1_g, *ln1_b,
        *w_router, *rbias, *w_e_gate, *w_e_up, *w_e_down, *w_s_gate, *w_s_up, *w_s_down, *ln2_g, *ln2_b;
    float* out;
    char* ws;
    int ph_lo, ph_hi;
    __device__ __forceinline__ float* mod() const { return (float*)(ws + OFF_mod); }
    __device__ __forceinline__ float* bias1() const { return (float*)(ws + OFF_bias1); }
    __device__ __forceinline__ bf16_t* wint() const { return (bf16_t*)(ws + OFF_wint); }
    __device__ __forceinline__ bf16_t* wot() const { return (bf16_t*)(ws + OFF_wot); }
    __device__ __forceinline__ bf16_t* wrt() const { return (bf16_t*)(ws + OFF_wrt); }
    __device__ __forceinline__ bf16_t* w1t() const { return (bf16_t*)(ws + OFF_w1t); }
    __device__ __forceinline__ bf16_t* w2t() const { return (bf16_t*)(ws + OFF_w2t); }
    __device__ __forceinline__ bf16_t* hb() const { return (bf16_t*)(ws + OFF_hb); }
    __device__ __forceinline__ bf16_t* Pb() const { return (bf16_t*)(ws + OFF_Pb); }
    __device__ __forceinline__ bf16_t* VsT() const { return (bf16_t*)(ws + OFF_VsT); }
    __device__ __forceinline__ bf16_t* VwT() const { return (bf16_t*)(ws + OFF_VwT); }
    __device__ __forceinline__ bf16_t* VgT() const { return (bf16_t*)(ws + OFF_VgT); }
    __device__ __forceinline__ float* misc() const { return (float*)(ws + OFF_misc); }
    __device__ __forceinline__ float* cpart() const { return (float*)(ws + OFF_cpart); }
    __device__ __forceinline__ bf16_t* kc() const { return (bf16_t*)(ws + OFF_kc); }
    __device__ __forceinline__ bf16_t* vcT() const { return (bf16_t*)(ws + OFF_vcT); }
    __device__ __forceinline__ float* dST() const { return (float*)(ws + OFF_dST); }
    __device__ __forceinline__ float* dec() const { return (float*)(ws + OFF_dec); }
    __device__ __forceinline__ bf16_t* ST() const { return (bf16_t*)(ws + OFF_ST); }
    __device__ __forceinline__ float* mixf() const { return (float*)(ws + OFF_mixf); }
    __device__ __forceinline__ bf16_t* mixb() const { return (bf16_t*)(ws + OFF_mixb); }
    __device__ __forceinline__ float* y1() const { return (float*)(ws + OFF_y1); }
    __device__ __forceinline__ float* x1() const { return (float*)(ws + OFF_x1); }
    __device__ __forceinline__ float* logits() const { return (float*)(ws + OFF_logits); }
    __device__ __forceinline__ float* ew() const { return (float*)(ws + OFF_ew); }
    __device__ __forceinline__ int* counts() const { return (int*)(ws + OFF_counts); }
    __device__ __forceinline__ int* lists() const { return (int*)(ws + OFF_lists); }
    __device__ __forceinline__ unsigned* bar() const { return (unsigned*)(ws + OFF_bar); }
    __device__ __forceinline__ bf16_t* hid() const { return (bf16_t*)(ws + OFF_hid); }
    __device__ __forceinline__ bf16_t* outk() const { return (bf16_t*)(ws + OFF_outk); }
};

#define LDS_ROW 72
#define TILE_BYTES 16384
#define GEMM_SMEM 69632
__device__ __forceinline__ int swz_key(int row) { return ((row >> 2) & 1) | ((((row >> 1) ^ (row >> 3)) & 1) << 1) | ((((row >> 2) ^ (row >> 4)) & 1) << 2); }
__device__ __forceinline__ int swz_off(int row, int chunk) { return row * 128 + ((chunk ^ swz_key(row)) << 4); }
typedef __attribute__((address_space(3))) unsigned lds_u32;

struct RowsBf16 {
    static constexpr bool NT = false;
    const bf16_t* base; size_t stride;
    __device__ __forceinline__ const bf16_t* ptr(int r, int k) const { return base + (size_t)r * stride + k; }
    __device__ __forceinline__ const bf16_t* pp(int i, int tid, int k) const { return ptr(i * 32 + (tid >> 3), k); }
};
struct GatherBf16 {
    static constexpr bool NT = true;
    const bf16_t* base; size_t stride; const int* rowidx;
    __device__ __forceinline__ const bf16_t* ptr(int r, int k) const { return base + (size_t)rowidx[r] * stride + k; }
    __device__ __forceinline__ const bf16_t* pp(int i, int tid, int k) const { return ptr(i * 32 + (tid >> 3), k); }
};
struct BF32Plain {
    const float* base; size_t ld;
    __device__ __forceinline__ f32x4 load4(int k, int r4) const { return *(const f32x4*)(base + (size_t)k * ld + r4); }
};
struct BF32GateUp {
    const float* g; long du; size_t ld;
    __device__ __forceinline__ f32x4 load4(int k, int r4) const {
        const long sel = ((r4 >> 5) & 1) ? du : 0l;
#ifdef NT_B
        return __builtin_nontemporal_load((const f32x4*)(g + sel + (size_t)k * ld + (r4 >> 6) * 32 + (r4 & 31)));
#else
        return *(const f32x4*)(g + sel + (size_t)k * ld + (r4 >> 6) * 32 + (r4 & 31));
#endif
    }
};

template <class L>
__device__ __forceinline__ void bf16_piece_load(u32x4& r, const L& ld, int k0, int i, int tid) { r = *(const u32x4*)ld.pp(i, tid, k0 + ((tid & 7) << 3)); }
__device__ __forceinline__ void bf16_piece_write(const u32x4& r, char* tile, int i, int tid) { *(u32x4*)(tile + swz_off(i * 32 + (tid >> 3), tid & 7)) = r; }
template <int J0, class BL>
__device__ __forceinline__ void f32_rows_load(f32x4 (&r)[8], const BL& bl, int k0, int tid) {
    const int kg = (tid >> 5) * 8, n4 = (tid & 31) * 4;
#pragma unroll
    for (int j = 0; j < 4; ++j) r[J0 + j] = bl.load4(k0 + kg + J0 + j, n4);
}
template <int I>
__device__ __forceinline__ void f32_col_write(const f32x4 (&r)[8], char* tile, int tid) {
    const int kgc = tid >> 5, n4 = (tid & 31) * 4;
    u32x4 w;
    w.x = pk_bf16(r[0][I], r[1][I]); w.y = pk_bf16(r[2][I], r[3][I]);
    w.z = pk_bf16(r[4][I], r[5][I]); w.w = pk_bf16(r[6][I], r[7][I]);
    *(u32x4*)(tile + swz_off(n4 + I, kgc)) = w;
}

#ifdef USE_SETPRIO
#define SETPRIO_HI __builtin_amdgcn_s_setprio(1);
#define SETPRIO_LO __builtin_amdgcn_s_setprio(0);
#else
#define SETPRIO_HI
#define SETPRIO_LO
#endif
template <bool SWAP, bool BF32, class AL, class BL, class EPI>
__device__ __forceinline__ void gemm_core(const AL& al, const BL& bl, int k_begin, int nk, int nkt, char* smem, f32x4 (&acc)[4][4], EPI&& epi) {
    const int tid = opaque_tid(), lane = tid & 63, wid = tid >> 6, wr = wid >> 1, wc = wid & 1, fr = lane & 15, fq = lane >> 4;
#pragma unroll
    for (int m = 0; m < 4; ++m)
#pragma unroll
        for (int n = 0; n < 4; ++n) acc[m][n] = (f32x4){0.f, 0.f, 0.f, 0.f};
    u32x4 ra[4]; u32x4 rb[4]; f32x4 rbf[8];
#pragma unroll
    for (int i = 0; i < 4; ++i) { bf16_piece_load(ra[i], al, k_begin, i, tid); if constexpr (!BF32) bf16_piece_load(rb[i], bl, k_begin, i, tid); }
    if constexpr (BF32) { f32_rows_load<0>(rbf, bl, k_begin, tid); f32_rows_load<4>(rbf, bl, k_begin, tid); }
#pragma unroll
    for (int i = 0; i < 4; ++i) { bf16_piece_write(ra[i], smem, i, tid); if constexpr (!BF32) bf16_piece_write(rb[i], smem + TILE_BYTES, i, tid); }
    if constexpr (BF32) { f32_col_write<0>(rbf, smem + TILE_BYTES, tid); f32_col_write<1>(rbf, smem + TILE_BYTES, tid); f32_col_write<2>(rbf, smem + TILE_BYTES, tid); f32_col_write<3>(rbf, smem + TILE_BYTES, tid); }
    if (nk > 1) {
#pragma unroll
        for (int i = 0; i < 4; ++i) { bf16_piece_load(ra[i], al, k_begin + 64, i, tid); if constexpr (!BF32) bf16_piece_load(rb[i], bl, k_begin + 64, i, tid); }
        if constexpr (BF32) { f32_rows_load<0>(rbf, bl, k_begin + 64, tid); f32_rows_load<4>(rbf, bl, k_begin + 64, tid); }
    }
    __syncthreads();
    int tile = 0, kin = 0;
    for (int kt = 0; kt < nk; ++kt) {
        const char* sA = smem + (kt & 1) * 2 * TILE_BYTES; const char* sB = sA + TILE_BYTES;
        char* nA = smem + ((kt & 1) ^ 1) * 2 * TILE_BYTES; char* nB = nA + TILE_BYTES;
        const bool w1 = kt + 1 < nk, l2 = kt + 2 < nk;
        const int k2 = k_begin + (kt + 2) * 64;
        bf16x8 a[2][4], b[2][4];
#pragma unroll
        for (int ks = 0; ks < 2; ++ks) {
#pragma unroll
            for (int m = 0; m < 4; ++m) a[ks][m] = *(const bf16x8*)(sA + swz_off(wr * 64 + m * 16 + fr, ks * 4 + fq));
#pragma unroll
            for (int n = 0; n < 4; ++n) b[ks][n] = *(const bf16x8*)(sB + swz_off(wc * 64 + n * 16 + fr, ks * 4 + fq));
        }
#define GEMM_GROUP(G) { \
            constexpr int ks = (G) >> 1, m0 = ((G) & 1) * 2; \
            __builtin_amdgcn_sched_barrier(0); \
            SETPRIO_HI \
            _Pragma("unroll") for (int m = m0; m < m0 + 2; ++m) \
            _Pragma("unroll") for (int n = 0; n < 4; ++n) \
                acc[m][n] = SWAP ? __builtin_amdgcn_mfma_f32_16x16x32_bf16(b[ks][n], a[ks][m], acc[m][n], 0, 0, 0) \
                                 : __builtin_amdgcn_mfma_f32_16x16x32_bf16(a[ks][m], b[ks][n], acc[m][n], 0, 0, 0); \
            SETPRIO_LO \
            __builtin_amdgcn_sched_barrier(0); \
            if (w1) bf16_piece_write(ra[G], nA, G, tid); \
            if (l2) bf16_piece_load(ra[G], al, k2, G, tid); \
            if constexpr (BF32) { \
                if constexpr ((G) == 0) { if (w1) { f32_col_write<0>(rbf, nB, tid); f32_col_write<1>(rbf, nB, tid); } } \
                if constexpr ((G) == 1) { if (w1) { f32_col_write<2>(rbf, nB, tid); f32_col_write<3>(rbf, nB, tid); } } \
                if constexpr ((G) == 2) { if (l2) f32_rows_load<0>(rbf, bl, k2, tid); } \
                if constexpr ((G) == 3) { if (l2) f32_rows_load<4>(rbf, bl, k2, tid); } \
            } else { \
                if (w1) bf16_piece_write(rb[G], nB, G, tid); \
                if (l2) bf16_piece_load(rb[G], bl, k2, G, tid); \
            } }
        GEMM_GROUP(0) GEMM_GROUP(1) GEMM_GROUP(2) GEMM_GROUP(3)
#undef GEMM_GROUP
        kin += 1;
        if (kin == nkt && kt + 1 < nk) {
            epi(tile, acc);
            tile += 1; kin = 0;
#pragma unroll
            for (int m = 0; m < 4; ++m)
#pragma unroll
                for (int n = 0; n < 4; ++n) acc[m][n] = (f32x4){0.f, 0.f, 0.f, 0.f};
        }
        __syncthreads();
    }
    epi(tile, acc);
}
struct NoEpi { __device__ __forceinline__ void operator()(int, const f32x4 (&)[4][4]) const {} };
template <bool SWAP, bool BF32, class AL, class BL>
__device__ __forceinline__ void gemm_128(const AL& al, const BL& bl, int k_begin, int nk, char* smem, f32x4 (&acc)[4][4]) {
    gemm_core<SWAP, BF32>(al, bl, k_begin, nk, nk, smem, acc, NoEpi());
}

__device__ __forceinline__ int xcd_of(const char* smem) { return (int)(((const unsigned*)(smem + GEMM_SMEM + 2048))[4] & 7u); }
__device__ __forceinline__ int rank_of(const char* smem) { return (int)((const unsigned*)(smem + GEMM_SMEM + 2048))[5]; }
__device__ __forceinline__ int nranks_of(const char* smem) { int n = (int)((const unsigned*)(smem + GEMM_SMEM + 2048))[6]; return n > 0 ? n : 1; }
template <int NB, bool SILU>
__device__ __forceinline__ void gemv_item(const float* in, const float* W, int ldw, const float* bias, float* out, int ldo, int K, int col0, float* sm) {
    const int tid = opaque_tid();
    for (int i = tid; i < NB * K; i += 256) { float v = in[i]; sm[i] = SILU ? v / (1.f + __expf(-v)) : v; }
    __syncthreads();
    float acc[NB];
#pragma unroll
    for (int b = 0; b < NB; ++b) acc[b] = 0.f;
    const int kq = tid >> 6, cl = tid & 63; const int kb = kq * (K / 4);
    for (int k = kb; k < kb + K / 4; k += 16) {
        float w[16];
#pragma unroll
        for (int u = 0; u < 16; ++u) w[u] = W[(size_t)(k + u) * ldw + col0 + cl];
#pragma unroll
        for (int u = 0; u < 16; ++u)
#pragma unroll
            for (int b = 0; b < NB; ++b) acc[b] += sm[b * K + k + u] * w[u];
    }
    float* red = sm + NB * K;
#pragma unroll
    for (int b = 0; b < NB; ++b) red[(kq * NB + b) * 64 + cl] = acc[b];
    __syncthreads();
    if (tid < 64 * NB) {
        int b = tid >> 6, cc = tid & 63;
        float s = red[(0 * NB + b) * 64 + cc] + red[(1 * NB + b) * 64 + cc] + red[(2 * NB + b) * 64 + cc] + red[(3 * NB + b) * 64 + cc];
        out[b * ldo + col0 + cc] = s + (bias ? bias[col0 + cc] : 0.f);
    }
    __syncthreads();
}

__device__ __forceinline__ int win_srccol(int n) {
    if (n < 1280) return n;
    if (n < 2304) return n + 24;
    if (n < 2816) return n + 40;
    if (n < 2840) return n - 2816 + 1280;
    if (n < 2856) return n - 2840 + 2328;
    return -1;
}
template <bool PERM>
__device__ __forceinline__ void transpose_item(const float* W, int ldw, int K, bf16_t* out, int k0, int n0, float* sm) {
    const int tid = opaque_tid();
    f32x4 v[4];
#pragma unroll
    for (int i = 0; i < 4; ++i) {
        const int c = tid + 256 * i, kk = c >> 4, nn = (c & 15) * 4;
        const int src = PERM ? win_srccol(n0 + nn) : (n0 + nn);
        v[i] = (src >= 0) ? *(const f32x4*)(W + (size_t)(k0 + kk) * ldw + src) : (f32x4){0.f, 0.f, 0.f, 0.f};
    }
#pragma unroll
    for (int i = 0; i < 4; ++i) {
        const int c = tid + 256 * i, kk = c >> 4, nn = (c & 15) * 4;
#pragma unroll
        for (int j = 0; j < 4; ++j) sm[(nn + j) * 65 + kk] = v[i][j];
    }
    __syncthreads();
#pragma unroll
    for (int i = 0; i < 2; ++i) {
        const int c = tid + 256 * i, nn = c >> 3, kc = (c & 7) * 8;
        const float* r = sm + nn * 65 + kc;
        u32x4 w;
        w.x = pk_bf16(r[0], r[1]); w.y = pk_bf16(r[2], r[3]); w.z = pk_bf16(r[4], r[5]); w.w = pk_bf16(r[6], r[7]);
        *(u32x4*)(out + (size_t)(n0 + nn) * K + k0 + kc) = w;
    }
    __syncthreads();
}

__device__ void phase0(const Params& p, char* smem) {
    float* sm = (float*)smem;
    const int nb = gridDim.x, bid = blockIdx.x;
    const int I_MOD = 96, I_B1 = 8, I_WIN = 16 * 46, I_WO = 256, I_WR = 64, I_W1 = 2 * 32 * 4, I_W2 = 2 * 4;
    const int total = I_MOD + I_B1 + I_WIN + I_WO + I_WR + I_W1 + I_W2;
    if (bid == 0 && opaque_tid() < 64) p.counts()[264 + opaque_tid()] = 0;
    if (bid == 1) for (int i = opaque_tid(); i < 264; i += 256) p.counts()[i] = 0;
    for (int it = bid; it < total; it += nb) {
        int i = it;
        if (i < I_MOD) { gemv_item<4, true>(p.c, p.w_mod, 6144, p.b_mod, p.mod(), 6144, 1024, i * 64, sm); continue; }
        i -= I_MOD;
        if (i < I_B1) { int kv = i >> 2; gemv_item<1, false>(kv ? p.pos_v : p.pos_k, kv ? p.w1_v : p.w1_k, 256, nullptr, p.bias1() + kv * 256, 256, 2048, (i & 3) * 64, sm); continue; }
        i -= I_B1;
        if (i < I_WIN) { transpose_item<true>(p.w_in, IN_COLS, 1024, p.wint(), (i % 16) * 64, (i / 16) * 64, sm); continue; }
        i -= I_WIN;
        if (i < I_WO) { transpose_item<false>(p.w_o, 1024, 1024, p.wot(), (i % 16) * 64, (i / 16) * 64, sm); continue; }
        i -= I_WO;
        if (i < I_WR) { transpose_item<false>(p.w_router, 256, 1024, p.wrt(), (i % 16) * 64, (i / 16) * 64, sm); continue; }
        i -= I_WR;
        if (i < I_W1) { int kv = i >> 7; int j = i & 127; transpose_item<false>(kv ? p.w1_v : p.w1_k, 256, 2048, p.w1t() + (size_t)kv * 256 * 2048, (j % 32) * 64, (j / 32) * 64, sm); continue; }
        i -= I_W1;
        { int kv = i >> 2; int j = i & 3; transpose_item<false>(kv ? p.w2_v : p.w2_k, 64, 256, p.w2t() + (size_t)kv * 64 * 256, j * 64, 0, sm); }
    }
}

__device__ __forceinline__ float wave_sum(float v) {
#pragma unroll
    for (int m = 32; m > 0; m >>= 1) v += __shfl_xor(v, m);
    return v;
}
__device__ void phase1(const Params& p) {
    const int lane = opaque_tid() & 63, gw = blockIdx.x * 4 + (opaque_tid() >> 6), nw = gridDim.x * 4;
    for (int row0 = gw * 2; row0 < NTOK; row0 += nw * 2) {
        f32x4 v[2][4]; float s[2];
#pragma unroll
        for (int r = 0; r < 2; ++r) {
            const float* xr = p.x + (size_t)(row0 + r) * D_MODEL;
            s[r] = 0.f;
#pragma unroll
            for (int i = 0; i < 4; ++i) v[r][i] = *(const f32x4*)(xr + i * 256 + lane * 4);
        }
        const int b = row0 / SEQ;
        const float* md = p.mod() + b * 6144;
#pragma unroll
        for (int r = 0; r < 2; ++r) {
#pragma unroll
            for (int i = 0; i < 4; ++i) s[r] += (v[r][i][0] + v[r][i][1]) + (v[r][i][2] + v[r][i][3]);
            const float mu = wave_sum(s[r]) * (1.f / D_MODEL);
            float q = 0.f;
#pragma unroll
            for (int i = 0; i < 4; ++i)
#pragma unroll
                for (int j = 0; j < 4; ++j) { float d = v[r][i][j] - mu; q += d * d; }
            const float rstd = rsqrtf(wave_sum(q) * (1.f / D_MODEL) + 1e-5f);
#pragma unroll
            for (int i = 0; i < 4; ++i) {
                const int col = i * 256 + lane * 4;
                f32x4 sh = *(const f32x4*)(md + 0 + col), sc = *(const f32x4*)(md + 1024 + col);
                float o[4];
#pragma unroll
                for (int j = 0; j < 4; ++j) o[j] = (v[r][i][j] - mu) * rstd * (1.f + sc[j]) + sh[j];
                u32x2 w; w.x = pk_bf16(o[0], o[1]); w.y = pk_bf16(o[2], o[3]);
                *(u32x2*)(p.hb() + (size_t)(row0 + r) * D_MODEL + col) = w;
            }
        }
    }
}

__device__ void phase2(const Params& p, char* smem) {
    const int xcd = xcd_of(smem), rank = rank_of(smem), nranks = nranks_of(smem);
    const int lane = opaque_tid() & 63, wid = opaque_tid() >> 6, wr = wid >> 1, wc = wid & 1, fr = lane & 15, fq = lane >> 4;
#ifndef P2_REP
#define P2_REP 1
#endif
    for (int it0 = rank; it0 < 16 * 23 * P2_REP; it0 += nranks) {
        const int it = it0 % (16 * 23);
        const int mt = (it / 23) * 8 + xcd, nt = it % 23;
        const int row0 = mt * 128, col0 = nt * 128;
        RowsBf16 al{p.hb() + (size_t)row0 * D_MODEL, D_MODEL};
        RowsBf16 bl{p.wint() + (size_t)col0 * D_MODEL, D_MODEL};
        f32x4 acc[4][4];
        const bool transposed = (nt == 7) || (nt == 9) || (nt >= 14 && nt < 18);
        if (transposed) {
            gemm_128<false, false>(al, bl, 0, 16, smem, acc);
            const int b = row0 / SEQ, t0 = row0 % SEQ;
            bf16_t* base; int rows_per;
            if (nt == 7) base = p.VsT() + (size_t)b * 128 * SEQ;
            else if (nt == 9) base = p.VwT() + (size_t)b * 128 * SEQ;
            else base = p.VgT() + ((size_t)b * 4 + (nt - 14)) * 128 * SEQ;
            (void)rows_per;
#pragma unroll
            for (int m = 0; m < 4; ++m)
#pragma unroll
                for (int n = 0; n < 4; ++n) {
                    const int feat = wc * 64 + n * 16 + fr, tok = t0 + wr * 64 + m * 16 + fq * 4;
                    u32x2 w; w.x = pk_bf16(acc[m][n][0], acc[m][n][1]); w.y = pk_bf16(acc[m][n][2], acc[m][n][3]);
                    *(u32x2*)(base + (size_t)feat * SEQ + tok) = w;
                }
        } else {
            gemm_128<true, false>(al, bl, 0, 16, smem, acc);
            if (nt == 22) {
                if (wc == 0) {
#pragma unroll
                    for (int m = 0; m < 4; ++m)
#pragma unroll
                        for (int n = 0; n < 4; ++n) {
                            const int tok = row0 + wr * 64 + m * 16 + fr, feat = n * 16 + fq * 4;
                            *(f32x4*)(p.misc() + (size_t)tok * 64 + feat) = acc[m][n];
                        }
                }
            } else {
#pragma unroll
                for (int m = 0; m < 4; ++m)
#pragma unroll
                    for (int n = 0; n < 4; ++n) {
                        const int tok = row0 + wr * 64 + m * 16 + fr, feat = col0 + wc * 64 + n * 16 + fq * 4;
                        u32x2 w; w.x = pk_bf16(acc[m][n][0], acc[m][n][1]); w.y = pk_bf16(acc[m][n][2], acc[m][n][3]);
                        *(u32x2*)(p.Pb() + (size_t)tok * PCOLS + feat) = w;
                    }
            }
        }
    }
}
struct CmpALoad {
    static constexpr bool NT = false;
    const bf16_t* Pb; int colbase; int row0;
    __device__ __forceinline__ const bf16_t* ptr(int r, int k) const {
        const int rr = row0 + r, bg = rr >> 8, i = rr & 255, b = bg >> 1, g = bg & 1;
        const int l = k >> 6, d = k & 63;
        int tok = 16 * i + l; tok = tok < SEQ ? tok : SEQ - 1;
        return Pb + ((size_t)b * SEQ + tok) * PCOLS + colbase + g * 64 + d;
    }
    __device__ __forceinline__ const bf16_t* pp(int i, int tid, int k) const { return ptr(i * 32 + (tid >> 3), k); }
};

__device__ __forceinline__ float log_sigmoid_f(float x) { return -(fmaxf(-x, 0.f) + log1pf(__expf(-fabsf(x)))); }

__device__ __forceinline__ void gla_cumsum(const Params& p, int tokg0, int h, float* sb, float* sglr, float* swa, float* sqt) {
    const int tid = opaque_tid();
    for (int i = tid; i < 1024; i += 256) { int t = i >> 4, r = i & 15; sglr[i] = p.misc()[(size_t)(tokg0 + t) * 64 + 24 + r]; }
    for (int i = tid; i < 1024; i += 256) { int r = i >> 6, d = i & 63; swa[i] = p.w_a2[r * 256 + h * 64 + d]; }
    __syncthreads();
    const int d = tid & 63, tq = tid >> 6;
    const float ba = p.b_a2[h * 64 + d];
    float w[16];
#pragma unroll
    for (int r = 0; r < 16; ++r) w[r] = swa[r * 64 + d];
    float run = 0.f;
#pragma unroll
    for (int tt = 0; tt < 16; ++tt) {
        const int t = tq * 16 + tt;
        float x = ba;
#pragma unroll
        for (int r = 0; r < 16; ++r) x += sglr[t * 16 + r] * w[r];
        run += log_sigmoid_f(x) * (1.f / 16.f);
        sb[t * 64 + d] = run;
    }
    sqt[tq * 64 + d] = run;
    __syncthreads();
    float off = 0.f;
#pragma unroll
    for (int q = 0; q < 3; ++q) if (q < tq) off += sqt[q * 64 + d];
#pragma unroll
    for (int tt = 0; tt < 16; ++tt) sb[(tq * 16 + tt) * 64 + d] += off;
    __syncthreads();
}

__device__ void gla_a_item(const Params& p, int item, char* smem) {
    const int tid = opaque_tid(), lane = tid & 63, wid = tid >> 6, fr = lane & 15, fq = lane >> 4;
    const int bh = item >> 6, c = item & 63, b = bh >> 2, h = bh & 3;
    const int tok0 = c * 64, tokg0 = b * SEQ + tok0;
    float* sb = (float*)smem; float* sglr = (float*)(smem + 16384); float* swa = (float*)(smem + 20480); float* sqt = (float*)(smem + 24576);
    char* skbT = smem + 25600; char* sVT = smem + 34816;
    gla_cumsum(p, tokg0, h, sb, sglr, swa, sqt);
    {
        const int d = tid & 63, tq = tid >> 6;
        const float bl = sb[63 * 64 + d];
        float v[16];
#pragma unroll
        for (int tt = 0; tt < 16; ++tt) {
            const int s = tq * 16 + tt;
            float k = bf2f(p.Pb()[(size_t)(tokg0 + s) * PCOLS + P_GK + h * 64 + d]);
            v[tt] = k * __expf(bl - sb[s * 64 + d]);
        }
        u32x4 w0, w1;
        w0.x = pk_bf16(v[0], v[1]); w0.y = pk_bf16(v[2], v[3]); w0.z = pk_bf16(v[4], v[5]); w0.w = pk_bf16(v[6], v[7]);
        w1.x = pk_bf16(v[8], v[9]); w1.y = pk_bf16(v[10], v[11]); w1.z = pk_bf16(v[12], v[13]); w1.w = pk_bf16(v[14], v[15]);
        *(u32x4*)(skbT + (d * LDS_ROW + tq * 16) * 2) = w0;
        *(u32x4*)(skbT + (d * LDS_ROW + tq * 16 + 8) * 2) = w1;
        if (tid < 64) p.dec()[(size_t)item * 64 + d] = __expf(bl);
    }
#pragma unroll
    for (int i = 0; i < 4; ++i) {
        const int cidx = tid + 256 * i, e = cidx >> 3, ch = (cidx & 7) * 8;
        *(u32x4*)(sVT + (e * LDS_ROW + ch) * 2) = *(const u32x4*)(p.VgT() + ((size_t)bh * 128 + e) * SEQ + tok0 + ch);
    }
    __syncthreads();
    f32x4 acc[2][4];
#pragma unroll
    for (int m = 0; m < 2; ++m)
#pragma unroll
        for (int n = 0; n < 4; ++n) acc[m][n] = (f32x4){0.f, 0.f, 0.f, 0.f};
#pragma unroll
    for (int ks = 0; ks < 2; ++ks) {
        bf16x8 a[2], bb[4];
#pragma unroll
        for (int m = 0; m < 2; ++m) a[m] = *(const bf16x8*)(sVT + (((wid * 2 + m) * 16 + fr) * LDS_ROW + ks * 32 + fq * 8) * 2);
#pragma unroll
        for (int n = 0; n < 4; ++n) bb[n] = *(const bf16x8*)(skbT + ((n * 16 + fr) * LDS_ROW + ks * 32 + fq * 8) * 2);
#pragma unroll
        for (int m = 0; m < 2; ++m)
#pragma unroll
            for (int n = 0; n < 4; ++n) acc[m][n] = __builtin_amdgcn_mfma_f32_16x16x32_bf16(a[m], bb[n], acc[m][n], 0, 0, 0);
    }
    float* dst = p.dST() + (size_t)item * 8192;
#pragma unroll
    for (int m = 0; m < 2; ++m)
#pragma unroll
        for (int n = 0; n < 4; ++n)
#pragma unroll
            for (int j = 0; j < 4; ++j) dst[((wid * 2 + m) * 16 + fq * 4 + j) * 64 + n * 16 + fr] = acc[m][n][j];
    __syncthreads();
}

__device__ void phase3(const Params& p, char* smem) {
    const int lane = opaque_tid() & 63, wid = opaque_tid() >> 6, wr = wid >> 1, wc = wid & 1, fr = lane & 15, fq = lane >> 4;
    for (int it = blockIdx.x; it < 256; it += gridDim.x) {
        const int kv = it >> 7, mt = (it >> 3) & 15, nt = (it >> 2) & 1, ks = it & 3;
        CmpALoad al{p.Pb(), kv ? P_VC : P_KC, mt * 128};
        RowsBf16 bl{p.w1t() + ((size_t)kv * 256 + nt * 128) * 2048, 2048};
        f32x4 acc[4][4];
        gemm_128<true, 0>(al, bl, ks * 512, 8, smem, acc);
        float* dst = p.cpart() + ((size_t)(kv * 4 + ks) * 2048 + mt * 128) * 256 + nt * 128;
#pragma unroll
        for (int m = 0; m < 4; ++m)
#pragma unroll
            for (int n = 0; n < 4; ++n)
                *(f32x4*)(dst + (size_t)(wr * 64 + m * 16 + fr) * 256 + wc * 64 + n * 16 + fq * 4) = acc[m][n];
    }
    const int first = (blockIdx.x + gridDim.x - (256 % gridDim.x)) % gridDim.x;
    for (int it = first; it < 1024; it += gridDim.x) gla_a_item(p, it, smem);
}

#define C2_ROW 264
__device__ void cmp2_item(const Params& p, int item, char* smem) {
    const int tid = opaque_tid(), lane = tid & 63, wid = tid >> 6, fr = lane & 15, fq = lane >> 4;
    const int kv = item >> 5, r0 = (item & 31) * 64;
    char* sA = smem; char* sB = smem + 64 * C2_ROW * 2;
    const float* b1 = p.bias1() + kv * 256;
#pragma unroll 2
    for (int i = 0; i < 8; ++i) {
        const int cidx = tid + 256 * i, row = cidx >> 5, col = (cidx & 31) * 8;
        f32x4 s0 = *(const f32x4*)(b1 + col), s1 = *(const f32x4*)(b1 + col + 4);
#pragma unroll
        for (int ks = 0; ks < 4; ++ks) {
            const float* src = p.cpart() + ((size_t)(kv * 4 + ks) * 2048 + r0 + row) * 256 + col;
            s0 += *(const f32x4*)src; s1 += *(const f32x4*)(src + 4);
        }
        float o[8];
#pragma unroll
        for (int j = 0; j < 4; ++j) { o[j] = s0[j] / (1.f + __expf(-s0[j])); o[4 + j] = s1[j] / (1.f + __expf(-s1[j])); }
        u32x4 w; w.x = pk_bf16(o[0], o[1]); w.y = pk_bf16(o[2], o[3]); w.z = pk_bf16(o[4], o[5]); w.w = pk_bf16(o[6], o[7]);
        *(u32x4*)(sA + (row * C2_ROW + col) * 2) = w;
        *(u32x4*)(sB + (row * C2_ROW + col) * 2) = *(const u32x4*)(p.w2t() + ((size_t)kv * 64 + row) * 256 + col);
    }
    __syncthreads();
    f32x4 acc[4];
#pragma unroll
    for (int n = 0; n < 4; ++n) acc[n] = (f32x4){0.f, 0.f, 0.f, 0.f};
#pragma unroll
    for (int ks = 0; ks < 8; ++ks) {
        bf16x8 a = *(const bf16x8*)(sA + ((wid * 16 + fr) * C2_ROW + ks * 32 + fq * 8) * 2);
#pragma unroll
        for (int n = 0; n < 4; ++n) {
            bf16x8 bb = *(const bf16x8*)(sB + ((n * 16 + fr) * C2_ROW + ks * 32 + fq * 8) * 2);
            acc[n] = kv ? __builtin_amdgcn_mfma_f32_16x16x32_bf16(a, bb, acc[n], 0, 0, 0)
                        : __builtin_amdgcn_mfma_f32_16x16x32_bf16(bb, a, acc[n], 0, 0, 0);
        }
    }
    if (kv == 0) {
#pragma unroll
        for (int n = 0; n < 4; ++n) {
            u32x2 w; w.x = pk_bf16(acc[n][0], acc[n][1]); w.y = pk_bf16(acc[n][2], acc[n][3]);
            *(u32x2*)(p.kc() + (size_t)(r0 + wid * 16 + fr) * 64 + n * 16 + fq * 4) = w;
        }
    } else {
        const int r = r0 + wid * 16 + fq * 4, bg = r >> 8, i = r & 255;
#pragma unroll
        for (int n = 0; n < 4; ++n) {
            u32x2 w; w.x = pk_bf16(acc[n][0], acc[n][1]); w.y = pk_bf16(acc[n][2], acc[n][3]);
            *(u32x2*)(p.vcT() + ((size_t)bg * 64 + n * 16 + fr) * 256 + i) = w;
        }
    }
    __syncthreads();
}

__device__ void phase4(const Params& p, char* smem) {
    for (int it = blockIdx.x; it < 64; it += gridDim.x) cmp2_item(p, it, smem);
    const int nthreads = gridDim.x * 256;
    for (int idx = blockIdx.x * 256 + opaque_tid(); idx < 16 * 8192; idx += nthreads) {
        const int bh = idx >> 13, ed = idx & 8191, d = idx & 63;
        float S = 0.f;
        for (int c0 = 0; c0 < 64; c0 += 8) {
            float dv[8], dc[8];
#pragma unroll
            for (int u = 0; u < 8; ++u) {
                dv[u] = p.dST()[((size_t)(bh * 64 + c0 + u) << 13) + ed];
                dc[u] = p.dec()[(size_t)(bh * 64 + c0 + u) * 64 + d];
            }
#pragma unroll
            for (int u = 0; u < 8; ++u) {
                p.ST()[((size_t)(bh * 64 + c0 + u) << 13) + ed] = f2bf(S);
                S = dc[u] * S + dv[u];
            }
        }
    }
}
#define KT_BYTES (64 * LDS_ROW * 2)
#define C1_SCALE (0.125f * LOG2E)

#define MASK_BIAS (-2e30f)
__device__ __forceinline__ bf16x8 scale_frag(bf16x8 v, float c) {
    u32x4 u = __builtin_bit_cast(u32x4, v); u32x4 r;
    r.x = pk_bf16(bflo(u.x) * c, bfhi(u.x) * c); r.y = pk_bf16(bflo(u.y) * c, bfhi(u.y) * c);
    r.z = pk_bf16(bflo(u.z) * c, bfhi(u.z) * c); r.w = pk_bf16(bflo(u.w) * c, bfhi(u.w) * c);
    return __builtin_bit_cast(bf16x8, r);
}
__device__ __forceinline__ float max3f(float a, float b, float c) { return fmaxf(fmaxf(a, b), c); }
__device__ __forceinline__ float rowmax4(float x) {
    auto r = __builtin_amdgcn_permlane32_swap(__float_as_uint(x), __float_as_uint(x), false, false);
    float y = fmaxf(__uint_as_float(r[0]), __uint_as_float(r[1]));
    auto q = __builtin_amdgcn_permlane16_swap(__float_as_uint(y), __float_as_uint(y), false, false);
    return fmaxf(__uint_as_float(q[0]), __uint_as_float(q[1]));
}
template <bool PV>
__device__ __forceinline__ void flash_tile(const char* sK0, const char* sVT0, const bf16x8 (&qf)[2][2], float (&m)[2], f32x4 (&l)[2], f32x4 (&o)[2][4],
                                           float dl0, float dstride, float wlim, bool lanevalid, bool needmask, const float (&slope2)[2], int fr, int fq, bool lazy, bf16x8 ones) {
#pragma unroll 1
    for (int half = 0; half < 2; ++half) {
        const char* sK = sK0 + half * 32 * LDS_ROW * 2;
        const char* sVT = sVT0 + half * 32 * 2;
        const float dl = dl0 + dstride * (float)(half * 32);
        bf16x8 kf[2][2], vf[4];
#pragma unroll
        for (int mk = 0; mk < 2; ++mk)
#pragma unroll
            for (int ks = 0; ks < 2; ++ks) kf[mk][ks] = *(const bf16x8*)(sK + ((mk * 16 + fr) * LDS_ROW + ks * 32 + fq * 8) * 2);
        if (PV) {
#pragma unroll
            for (int md = 0; md < 4; ++md) {
                u32x2 lo = *(const u32x2*)(sVT + ((md * 16 + fr) * LDS_ROW + fq * 4) * 2);
                u32x2 hi = *(const u32x2*)(sVT + ((md * 16 + fr) * LDS_ROW + 16 + fq * 4) * 2);
                u32x4 w; w.x = lo.x; w.y = lo.y; w.z = hi.x; w.w = hi.y;
                vf[md] = __builtin_bit_cast(bf16x8, w);
            }
        }
        f32x4 s[2][2];
#pragma unroll
        for (int p = 0; p < 2; ++p) {
            const float mref = lazy ? m[p] : 0.f;
            if (needmask) {
#pragma unroll
                for (int mk = 0; mk < 2; ++mk)
#pragma unroll
                    for (int j = 0; j < 4; ++j) {
                        const float dk = dl + dstride * (float)(mk * 16 + j);
                        const bool ok = lanevalid && (dk <= 0.f) && (dk > wlim);
                        s[p][mk][j] = ok ? (slope2[p] * dk - mref) : MASK_BIAS;
                    }
            } else {
                const float sb = lanevalid ? (slope2[p] * dl - mref) : MASK_BIAS, sd = lanevalid ? slope2[p] * dstride : 0.f;
#pragma unroll
                for (int mk = 0; mk < 2; ++mk)
#pragma unroll
                    for (int j = 0; j < 4; ++j) s[p][mk][j] = sb + sd * (float)(mk * 16 + j);
            }
        }
#pragma unroll
        for (int ks = 0; ks < 2; ++ks)
#pragma unroll
            for (int p = 0; p < 2; ++p)
#pragma unroll
                for (int mk = 0; mk < 2; ++mk) s[p][mk] = __builtin_amdgcn_mfma_f32_16x16x32_bf16(kf[mk][ks], qf[p][ks], s[p][mk], 0, 0, 0);
        float mx[2];
#pragma unroll
        for (int p = 0; p < 2; ++p)
            mx[p] = max3f(max3f(max3f(s[p][0][0], s[p][0][1], s[p][0][2]), s[p][0][3], s[p][1][0]), max3f(s[p][1][1], s[p][1][2], s[p][1][3]), MASK_BIAS);
        if (!lazy) {
            float mn[2];
#pragma unroll
            for (int p = 0; p < 2; ++p) mn[p] = fmaxf(m[p], rowmax4(mx[p]));
            if (__any((mn[0] > m[0]) || (mn[1] > m[1]))) {
#pragma unroll
                for (int p = 0; p < 2; ++p) {
                    const float alpha = __builtin_amdgcn_exp2f(m[p] - mn[p]);
                    l[p] *= alpha;
                    if (PV) {
#pragma unroll
                        for (int md = 0; md < 4; ++md) o[p][md] *= alpha;
                    }
                    m[p] = mn[p];
                }
            }
#pragma unroll
            for (int p = 0; p < 2; ++p)
#pragma unroll
                for (int mk = 0; mk < 2; ++mk)
#pragma unroll
                    for (int j = 0; j < 4; ++j) s[p][mk][j] -= m[p];
        }
        bf16x8 pf[2];
#pragma unroll
        for (int p = 0; p < 2; ++p) {
#pragma unroll
            for (int mk = 0; mk < 2; ++mk)
#pragma unroll
                for (int j = 0; j < 4; ++j) s[p][mk][j] = __builtin_amdgcn_exp2f(s[p][mk][j]);
            u32x4 w;
            w.x = pk_bf16(s[p][0][0], s[p][0][1]); w.y = pk_bf16(s[p][0][2], s[p][0][3]);
            w.z = pk_bf16(s[p][1][0], s[p][1][1]); w.w = pk_bf16(s[p][1][2], s[p][1][3]);
            pf[p] = __builtin_bit_cast(bf16x8, w);
        }
#pragma unroll
        for (int p = 0; p < 2; ++p) l[p] = __builtin_amdgcn_mfma_f32_16x16x32_bf16(ones, pf[p], l[p], 0, 0, 0);
        if (PV) {
#pragma unroll
            for (int md = 0; md < 4; ++md)
#pragma unroll
                for (int p = 0; p < 2; ++p) o[p][md] = __builtin_amdgcn_mfma_f32_16x16x32_bf16(vf[md], pf[p], o[p][md], 0, 0, 0);
        }
        if (lazy) {
            float up[2];
#pragma unroll
            for (int p = 0; p < 2; ++p) up[p] = fmaxf(rowmax4(mx[p]), 0.f);
            if (__any((up[0] > 0.f) || (up[1] > 0.f))) {
#pragma unroll
                for (int p = 0; p < 2; ++p) {
                    const float alpha = __builtin_amdgcn_exp2f(-up[p]);
                    l[p] *= alpha;
                    if (PV) {
#pragma unroll
                        for (int md = 0; md < 4; ++md) o[p][md] *= alpha;
                    }
                    m[p] += up[p];
                }
            }
        }
    }
}
__device__ __forceinline__ float l_total(const f32x4& l, int fr) { return __shfl(l[0], fr); }

__device__ __forceinline__ void imp_tile(const char* sK, const bf16x8 (&qf)[2][2], const float (&m)[2], const float (&linv)[2],
                                         float dl, const float (&slope2)[2], int ct, float* simp, int fr, int fq) {
    bf16x8 kf[4][2];
#pragma unroll
    for (int mk = 0; mk < 4; ++mk)
#pragma unroll
        for (int ks = 0; ks < 2; ++ks) kf[mk][ks] = *(const bf16x8*)(sK + ((mk * 16 + fr) * LDS_ROW + ks * 32 + fq * 8) * 2);
    f32x4 hs[4];
#pragma unroll
    for (int mk = 0; mk < 4; ++mk) hs[mk] = (f32x4){0.f, 0.f, 0.f, 0.f};
#pragma unroll
    for (int p = 0; p < 2; ++p) {
#pragma unroll
        for (int mk = 0; mk < 4; ++mk) {
            f32x4 s;
#pragma unroll
            for (int j = 0; j < 4; ++j) { const float dk = dl + 16.f * (float)(mk * 16 + j); s[j] = (dk <= 0.f) ? slope2[p] * dk : MASK_BIAS; }
#pragma unroll
            for (int ks = 0; ks < 2; ++ks) s = __builtin_amdgcn_mfma_f32_16x16x32_bf16(kf[mk][ks], qf[p][ks], s, 0, 0, 0);
#pragma unroll
            for (int j = 0; j < 4; ++j) hs[mk][j] += __builtin_amdgcn_exp2f(s[j] - m[p]) * linv[p];
        }
    }
#pragma unroll
    for (int mk = 0; mk < 4; ++mk) {
        const int jb = ct * 16 + mk * 4 + fq;
        const float a = hs[mk][0] + hs[mk][1] + hs[mk][2] + 0.5f * hs[mk][3];
        const float bnext = 0.5f * hs[mk][3];
        simp[fr * 64 + jb] += a;
        __builtin_amdgcn_wave_barrier();
        if (jb + 1 < 64) simp[fr * 64 + jb + 1] += bnext;
        __builtin_amdgcn_wave_barrier();
    }
}

struct TileSrc { const bf16_t* k; const bf16_t* v; };
struct TileOff { int k[2], v[2]; };
__device__ __forceinline__ TileOff tile_offsets(int kst, int vst, int tid) {
    TileOff to;
#pragma unroll
    for (int i = 0; i < 2; ++i) { const int c = tid + 256 * i, row = c >> 3, ch = (c & 7) * 8; to.k[i] = row * kst + ch; to.v[i] = row * vst + ch; }
    return to;
}
__device__ __forceinline__ void tile_gload(const TileSrc& ts, const TileOff& to, u32x4 (&rk)[2], u32x4 (&rv)[2]) {
#pragma unroll
    for (int i = 0; i < 2; ++i) {
        rk[i] = *(const u32x4*)(ts.k + to.k[i]);
        rv[i] = *(const u32x4*)(ts.v + to.v[i]);
    }
}
__device__ __forceinline__ void tile_swrite(char* smem, int buf, const u32x4 (&rk)[2], const u32x4 (&rv)[2], int tid) {
    char* sK = smem + buf * 2 * KT_BYTES; char* sV = sK + KT_BYTES;
#pragma unroll
    for (int i = 0; i < 2; ++i) {
        const int c = tid + 256 * i, row = c >> 3, ch = (c & 7) * 8;
        *(u32x4*)(sK + (row * LDS_ROW + ch) * 2) = rk[i];
        *(u32x4*)(sV + (row * LDS_ROW + ch) * 2) = rv[i];
    }
}

__device__ void nsa_cmp_item(const Params& p, int qrev, int bg, char* smem) {
    const int tid = opaque_tid(), lane = tid & 63, wid = tid >> 6, fr = lane & 15, fq = lane >> 4;
    const int qb = 63 - qrev, b = bg >> 1, g = bg & 1;
    const int q0 = qb * 64, t = q0 + wid * 16 + fr;
    const size_t tokg = (size_t)b * SEQ + t;
    float* simp = (float*)(smem + 4 * KT_BYTES) + wid * 1024;
    auto wsb = [&]() __attribute__((always_inline)) { char* w = p.ws; asm volatile("" : "+s"(w)); return w; };
    const unsigned onew = (fr == 0) ? 0x3f803f80u : 0u;
    const bf16x8 ones = __builtin_bit_cast(bf16x8, (u32x4){onew, onew, onew, onew});
    const int ncb = (4 * qb + 3) < NCMP ? (4 * qb + 3) : NCMP;
    const int nct = (ncb + 63) >> 6;
    for (int i = tid; i < 4096; i += 256) ((float*)(smem + 4 * KT_BYTES))[i] = 0.f;
    __syncthreads();
#pragma unroll 1
    for (int hp = 0; hp < 2; ++hp) {
        const int h0 = g * 4 + hp * 2;
        bf16x8 qf[2][2]; float slope2[2];
#pragma unroll
        for (int pp = 0; pp < 2; ++pp) {
            slope2[pp] = exp2f(-(float)(h0 + pp + 1)) * LOG2E;
#pragma unroll
            for (int ks = 0; ks < 2; ++ks)
                qf[pp][ks] = scale_frag(*(const bf16x8*)((const bf16_t*)(wsb() + OFF_Pb) + tokg * PCOLS + P_NQ + (h0 + pp) * 64 + ks * 32 + fq * 8), C1_SCALE);
        }
        float m[2], linv[2]; f32x4 l[2]; f32x4 o[2][4];
#pragma unroll
        for (int pp = 0; pp < 2; ++pp) {
            m[pp] = NEGF; l[pp] = (f32x4){0.f, 0.f, 0.f, 0.f}; linv[pp] = 0.f;
#pragma unroll
            for (int md = 0; md < 4; ++md) o[pp][md] = (f32x4){0.f, 0.f, 0.f, 0.f};
        }
        u32x4 rk[2], rv[2];
        const int n = 2 * nct;
        auto src = [&](int step) __attribute__((always_inline)) {
            const int idx = step < nct ? (nct - 1 - step) : step - nct;
            char* wb = wsb();
            TileSrc ts; ts.k = (const bf16_t*)(wb + OFF_kc) + ((size_t)bg * 256 + idx * 64) * 64;
            ts.v = (const bf16_t*)(wb + OFF_vcT) + (size_t)bg * 64 * 256 + idx * 64;
            return ts;
        };
        const TileOff toff = tile_offsets(64, 256, tid);
        tile_gload(src(0), toff, rk, rv); tile_swrite(smem, 0, rk, rv, tid); __syncthreads();
#pragma unroll 1
        for (int i = 0; i < n; ++i) {
            if (i + 1 < n) tile_gload(src(i + 1), toff, rk, rv);
            __builtin_amdgcn_sched_barrier(0);
            const int idx = i < nct ? (nct - 1 - i) : i - nct;
            const char* sK = smem + (i & 1) * 2 * KT_BYTES; const char* sV = sK + KT_BYTES;
            const float dlc = (float)(16 * (idx * 64 + fq * 4) + 31 - t);
            if (i < nct) {
                const bool cmask = (16 * (idx * 64 + 63) + 31) > q0;
                flash_tile<true>(sK, sV, qf, m, l, o, dlc, 16.f, -1e9f, true, cmask, slope2, fr, fq, i >= 2, ones);
            } else {
                if (i == nct) {
                    size_t tokg_o = tokg; asm volatile("" : "+v"(tokg_o));
                    char* wb = wsb();
#pragma unroll
                    for (int pp = 0; pp < 2; ++pp) {
                        const float inv = 1.f / fmaxf(l_total(l[pp], fr), 1e-30f);
                        linv[pp] = inv;
                        const int h = h0 + pp;
                        const float gl = ((const float*)(wb + OFF_misc))[tokg_o * 64 + h * 3 + 0];
                        const float sc = inv / (1.f + __expf(-gl));
#pragma unroll
                        for (int md = 0; md < 4; ++md) *(f32x4*)((float*)(wb + OFF_mixf) + tokg_o * 512 + h * 64 + md * 16 + fq * 4) = o[pp][md] * sc;
                    }
                }
                imp_tile(sK, qf, m, linv, dlc, slope2, idx, simp, fr, fq);
            }
            __builtin_amdgcn_sched_barrier(0);
            if (i + 1 < n) tile_swrite(smem, (i + 1) & 1, rk, rv, tid);
            __syncthreads();
        }
    }
    {
        const int j = lane;
        const bool forced = (j == 0) || (j == qb) || (j == qb - 1);
        unsigned long long mine = 0ull, wave_union = 0ull;
#pragma unroll 1
        for (int qi = 0; qi < 16; ++qi) {
            const float sc = (j <= qb) ? (simp[qi * 64 + j] + (forced ? 1e4f : 0.f)) : NEGF;
            int rank = 0;
#pragma unroll 4
            for (int j2 = 0; j2 < 64; ++j2) {
                const float s2 = __builtin_bit_cast(float, __builtin_amdgcn_readlane(__builtin_bit_cast(int, sc), j2));
                rank += ((s2 > sc) || (s2 == sc && j2 < j)) ? 1 : 0;
            }
            const unsigned long long msk = __ballot(rank < 16);
            wave_union |= msk;
            if (fr == qi) mine = msk;
        }
        const unsigned long long causal = (qb >= 63) ? ~0ull : ((1ull << (qb + 1)) - 1ull);
        unsigned long long* selm = (unsigned long long*)(wsb() + OFF_selm);
        if (fq == 0) selm[(size_t)g * NTOK + tokg] = mine & causal;
        if (lane == 0) ((unsigned long long*)(wsb() + OFF_selu))[((size_t)bg * 64 + qb) * 4 + wid] = wave_union & causal;
    }
    __syncthreads();
}

__device__ void nsa_sw_item(const Params& p, int qrev, int bg, int hp, char* smem, int mode) {
    const int tid = opaque_tid(), lane = tid & 63, wid = tid >> 6, fr = lane & 15, fq = lane >> 4;
    const int qb = 63 - qrev, b = bg >> 1, g = bg & 1;
    const int q0 = qb * 64, t = q0 + wid * 16 + fr;
    const size_t tokg = (size_t)b * SEQ + t;
    int* slist = (int*)(smem + 4 * KT_BYTES);
    const int h0 = g * 4 + hp * 2;
    auto wsb = [&]() __attribute__((always_inline)) { char* w = p.ws; asm volatile("" : "+s"(w)); return w; };
    bf16x8 qf[2][2]; float slope2[2];
#pragma unroll
    for (int pp = 0; pp < 2; ++pp) {
        slope2[pp] = exp2f(-(float)(h0 + pp + 1)) * LOG2E;
#pragma unroll
        for (int ks = 0; ks < 2; ++ks)
            qf[pp][ks] = scale_frag(*(const bf16x8*)((const bf16_t*)(wsb() + OFF_Pb) + tokg * PCOLS + P_NQ + (h0 + pp) * 64 + ks * 32 + fq * 8), C1_SCALE);
    }
    const unsigned long long mymask = ((const unsigned long long*)(wsb() + OFF_selm))[(size_t)g * NTOK + tokg];
    const unsigned long long* su = (const unsigned long long*)(wsb() + OFF_selu) + ((size_t)bg * 64 + qb) * 4;
    const unsigned long long wave_union = su[wid];
    const unsigned long long un = su[0] | su[1] | su[2] | su[3];
    const int wlo = (qb - 8) > 0 ? (qb - 8) : 0;
    const int nsl = __popcll(un);
    const int n = nsl + (qb - wlo + 1);
    if (tid < 64 && ((un >> tid) & 1ull)) slist[nsl - 1 - __popcll(un & ((1ull << tid) - 1ull))] = tid;
    if (tid >= 64 && tid < 64 + (qb - wlo + 1)) slist[nsl + (tid - 64)] = 256 + (qb - (tid - 64));
    __syncthreads();
    const unsigned onew = (fr == 0) ? 0x3f803f80u : 0u;
    const bf16x8 ones = __builtin_bit_cast(bf16x8, (u32x4){onew, onew, onew, onew});
    float m[2]; f32x4 l[2]; f32x4 o[2][4];
#pragma unroll
    for (int pp = 0; pp < 2; ++pp) {
        m[pp] = NEGF; l[pp] = (f32x4){0.f, 0.f, 0.f, 0.f};
#pragma unroll
        for (int md = 0; md < 4; ++md) o[pp][md] = (f32x4){0.f, 0.f, 0.f, 0.f};
    }
    auto finish_branch = [&](int br) __attribute__((always_inline)) {
        size_t tokg_o = tokg; asm volatile("" : "+v"(tokg_o));
        char* wb = wsb();
#pragma unroll
        for (int pp = 0; pp < 2; ++pp) {
            const float inv = 1.f / fmaxf(l_total(l[pp], fr), 1e-30f);
            const int h = h0 + pp;
            const float gl = ((const float*)(wb + OFF_misc))[tokg_o * 64 + h * 3 + br];
            const float sc = inv / (1.f + __expf(-gl));
#pragma unroll
            for (int md = 0; md < 4; ++md) {
                const size_t eo = tokg_o * 512 + h * 64 + md * 16 + fq * 4;
                f32x4 v = o[pp][md] * sc;
                if (mode != 0) { asm volatile("" :: "v"(v[0]), "v"(v[1]), "v"(v[2]), "v"(v[3])); }
                else if (br == 1) *(f32x4*)((float*)(wb + OFF_mixf2) + eo) = v;
                else { v += *(const f32x4*)((const float*)(wb + OFF_mixf) + eo) + *(const f32x4*)((const float*)(wb + OFF_mixf2) + eo);
                       u32x2 w; w.x = pk_bf16(v[0], v[1]); w.y = pk_bf16(v[2], v[3]); *(u32x2*)((bf16_t*)(wb + OFF_mixb) + tokg_o * 1024 + h * 64 + md * 16 + fq * 4) = w; }
            }
            m[pp] = NEGF; l[pp] = (f32x4){0.f, 0.f, 0.f, 0.f};
#pragma unroll
            for (int md = 0; md < 4; ++md) o[pp][md] = (f32x4){0.f, 0.f, 0.f, 0.f};
        }
    };
    u32x4 rkA[2], rvA[2], rkB[2], rvB[2];
    auto src = [&](int e) __attribute__((always_inline)) {
        const int win = e >> 8, idx = e & 255;
        char* wb = wsb();
        TileSrc ts;
        ts.k = (const bf16_t*)(wb + OFF_Pb) + ((size_t)b * SEQ + idx * 64) * PCOLS + (win ? P_KW : P_KS) + g * 64;
        ts.v = (const bf16_t*)(wb + (win ? OFF_VwT : OFF_VsT)) + (size_t)bg * 64 * SEQ + idx * 64;
        return ts;
    };
    auto step = [&](int i, int buf) __attribute__((always_inline)) {
        const int e = slist[i];
        const int win = e >> 8, idx = e & 255;
        if (i == nsl) finish_branch(1);
        const char* sK = smem + buf * 2 * KT_BYTES; const char* sV = sK + KT_BYTES;
        if (mode != 1 && (win || ((wave_union >> idx) & 1ull))) {
            const bool lv = win ? true : (((mymask >> idx) & 1ull) != 0ull);
            const bool nm = (idx == qb) || (win && idx == qb - 8);
            flash_tile<true>(sK, sV, qf, m, l, o, (float)(idx * 64 + fq * 4 - t), 1.f, win ? -512.f : -1e9f, lv, nm, slope2, fr, fq, (i != 0) && (i != nsl), ones);
        }
    };
#ifdef PROF
    volatile unsigned* sprof = (volatile unsigned*)(smem + 4 * KT_BYTES + 2048);
    if (tid == 0) { sprof[1] = 0u; sprof[2] = 0u; sprof[3] = (unsigned)__builtin_amdgcn_s_memtime(); }
#define PROF_T0 if (tid == 0) sprof[0] = (unsigned)__builtin_amdgcn_s_memtime();
#define PROF_T1 if (tid == 0) { sprof[1] += (unsigned)__builtin_amdgcn_s_memtime() - sprof[0]; sprof[2] += 1u; }
#else
#define PROF_T0
#define PROF_T1
#endif
    const TileOff toff = tile_offsets(PCOLS, SEQ, tid);
    tile_gload(src(slist[0]), toff, rkA, rvA); tile_swrite(smem, 0, rkA, rvA, tid);
    if (n > 1) tile_gload(src(slist[1]), toff, rkA, rvA);
    __syncthreads();
#pragma unroll 1
    for (int i = 0; i < n; i += 2) {
        if (i + 2 < n) tile_gload(src(slist[i + 2]), toff, rkB, rvB);
        __builtin_amdgcn_sched_barrier(0);
        PROF_T0 step(i, 0); PROF_T1
        __builtin_amdgcn_sched_barrier(0);
        if (i + 1 < n) tile_swrite(smem, 1, rkA, rvA, tid);
        __syncthreads();
        if (i + 1 >= n) break;
        if (i + 3 < n) tile_gload(src(slist[i + 3]), toff, rkA, rvA);
        __builtin_amdgcn_sched_barrier(0);
        PROF_T0 step(i + 1, 1); PROF_T1
        __builtin_amdgcn_sched_barrier(0);
        if (i + 2 < n) tile_swrite(smem, 0, rkB, rvB, tid);
        __syncthreads();
    }
    finish_branch(2);
#ifdef PROF
    if (tid == 0) {
        unsigned long long* pw = (unsigned long long*)(p.ws + OFF_counts + 1024);
        atomicAdd(&pw[0], (unsigned long long)sprof[1]); atomicAdd(&pw[1], (unsigned long long)((unsigned)__builtin_amdgcn_s_memtime() - sprof[3])); atomicAdd(&pw[2], (unsigned long long)sprof[2]);
    }
#endif
}

__device__ void gla_c_item(const Params& p, int item, char* smem) {
    const int tid = opaque_tid(), lane = tid & 63, wid = tid >> 6, fr = lane & 15, fq = lane >> 4;
    const int bh = item >> 6, c = item & 63, b = bh >> 2, h = bh & 3;
    const int tok0 = c * 64, tokg0 = b * SEQ + tok0;
    float* sb = (float*)smem; float* sglr = (float*)(smem + 16384); float* swa = (float*)(smem + 20480); float* sqt = (float*)(smem + 24576);
    char* sST = smem;
    char* sQB = smem + 25600; char* sKB = smem + 34816; char* sVT = smem + 44032;
    gla_cumsum(p, tokg0, h, sb, sglr, swa, sqt);
    {
        const int d = tid & 63, tq = tid >> 6;
#pragma unroll 4
        for (int tt = 0; tt < 16; ++tt) {
            const int tk = tq * 16 + tt;
            const float bt = sb[tk * 64 + d];
            const float q = bf2f(p.Pb()[(size_t)(tokg0 + tk) * PCOLS + P_GQ + h * 64 + d]);
            const float k = bf2f(p.Pb()[(size_t)(tokg0 + tk) * PCOLS + P_GK + h * 64 + d]);
            *(bf16_t*)(sQB + (tk * LDS_ROW + d) * 2) = f2bf(q * 0.125f * __expf(bt));
            *(bf16_t*)(sKB + (tk * LDS_ROW + d) * 2) = f2bf(k * __expf(-bt));
        }
    }
#pragma unroll
    for (int i = 0; i < 4; ++i) {
        const int cidx = tid + 256 * i, e = cidx >> 3, ch = (cidx & 7) * 8;
        *(u32x4*)(sVT + (e * LDS_ROW + ch) * 2) = *(const u32x4*)(p.VgT() + ((size_t)bh * 128 + e) * SEQ + tok0 + ch);
    }
    __syncthreads();
#pragma unroll
    for (int i = 0; i < 4; ++i) {
        const int cidx = tid + 256 * i, e = cidx >> 3, ch = (cidx & 7) * 8;
        *(u32x4*)(sST + (e * LDS_ROW + ch) * 2) = *(const u32x4*)(p.ST() + ((size_t)item << 13) + e * 64 + ch);
    }
    __syncthreads();
    bf16x8 qbf[2];
#pragma unroll
    for (int ks = 0; ks < 2; ++ks) qbf[ks] = *(const bf16x8*)(sQB + ((wid * 16 + fr) * LDS_ROW + ks * 32 + fq * 8) * 2);
    f32x4 sa[4];
#pragma unroll
    for (int ms = 0; ms < 4; ++ms) {
        sa[ms] = (f32x4){0.f, 0.f, 0.f, 0.f};
#pragma unroll
        for (int ks = 0; ks < 2; ++ks) {
            bf16x8 a = *(const bf16x8*)(sKB + ((ms * 16 + fr) * LDS_ROW + ks * 32 + fq * 8) * 2);
            sa[ms] = __builtin_amdgcn_mfma_f32_16x16x32_bf16(a, qbf[ks], sa[ms], 0, 0, 0);
        }
#pragma unroll
        for (int j = 0; j < 4; ++j) sa[ms][j] = (ms * 16 + fq * 4 + j <= wid * 16 + fr) ? sa[ms][j] : 0.f;
    }
    bf16x8 pf[2];
#pragma unroll
    for (int kk = 0; kk < 2; ++kk) {
        u32x4 w;
        w.x = pk_bf16(sa[2 * kk][0], sa[2 * kk][1]); w.y = pk_bf16(sa[2 * kk][2], sa[2 * kk][3]);
        w.z = pk_bf16(sa[2 * kk + 1][0], sa[2 * kk + 1][1]); w.w = pk_bf16(sa[2 * kk + 1][2], sa[2 * kk + 1][3]);
        pf[kk] = __builtin_bit_cast(bf16x8, w);
    }
    f32x4 oa[8];
    float sum = 0.f;
#pragma unroll
    for (int me = 0; me < 8; ++me) {
        f32x4 acc = (f32x4){0.f, 0.f, 0.f, 0.f};
#pragma unroll
        for (int ks = 0; ks < 2; ++ks) {
            bf16x8 a = *(const bf16x8*)(sST + ((me * 16 + fr) * LDS_ROW + ks * 32 + fq * 8) * 2);
            acc = __builtin_amdgcn_mfma_f32_16x16x32_bf16(a, qbf[ks], acc, 0, 0, 0);
        }
#pragma unroll
        for (int kk = 0; kk < 2; ++kk) {
            u32x2 lo = *(const u32x2*)(sVT + ((me * 16 + fr) * LDS_ROW + kk * 32 + fq * 4) * 2);
            u32x2 hi = *(const u32x2*)(sVT + ((me * 16 + fr) * LDS_ROW + kk * 32 + 16 + fq * 4) * 2);
            u32x4 w; w.x = lo.x; w.y = lo.y; w.z = hi.x; w.w = hi.y;
            acc = __builtin_amdgcn_mfma_f32_16x16x32_bf16(__builtin_bit_cast(bf16x8, w), pf[kk], acc, 0, 0, 0);
        }
        oa[me] = acc;
        sum += (acc[0] + acc[1]) + (acc[2] + acc[3]);
    }
    sum += __shfl_xor(sum, 16); sum += __shfl_xor(sum, 32);
    const float mu = sum * (1.f / 128.f);
    float var = 0.f;
#pragma unroll
    for (int me = 0; me < 8; ++me)
#pragma unroll
        for (int j = 0; j < 4; ++j) { const float dd = oa[me][j] - mu; var += dd * dd; }
    var += __shfl_xor(var, 16); var += __shfl_xor(var, 32);
    const float rstd = rsqrtf(var * (1.f / 128.f) + 1e-5f);
    const size_t tok = (size_t)tokg0 + wid * 16 + fr;
#pragma unroll
    for (int me = 0; me < 8; ++me) {
        const int e = me * 16 + fq * 4;
        const u32x2 rr = *(const u32x2*)(p.Pb() + tok * PCOLS + P_GR + h * 128 + e);
        const f32x4 nw = *(const f32x4*)(p.norm_w + e);
        float r[4] = {bflo(rr.x), bfhi(rr.x), bflo(rr.y), bfhi(rr.y)};
        float ov[4];
#pragma unroll
        for (int j = 0; j < 4; ++j) ov[j] = (oa[me][j] - mu) * rstd * nw[j] * (r[j] / (1.f + __expf(-r[j])));
        u32x2 w; w.x = pk_bf16(ov[0], ov[1]); w.y = pk_bf16(ov[2], ov[3]);
        *(u32x2*)(p.mixb() + tok * 1024 + 512 + h * 128 + e) = w;
    }
    __syncthreads();
}

#ifndef NSA_REP
#define NSA_REP 1
#endif
#ifndef NSA_MODE2
#define NSA_MODE2 0
#endif
#ifndef GLAC_REP
#define GLAC_REP 1
#endif
__device__ void phase5a(const Params& p, char* smem, int rep) {
    int* sidx = (int*)(smem + GEMM_SMEM - 16);
    for (;;) {
        __syncthreads();
        if (opaque_tid() == 0) *sidx = atomicAdd(&p.counts()[264 + 4 * rep], 1);
        __syncthreads();
        const int it = *sidx;
        if (it >= 512) break;
        nsa_cmp_item(p, it >> 3, it & 7, smem);
    }
    for (;;) {
        __syncthreads();
        if (opaque_tid() == 0) *sidx = atomicAdd(&p.counts()[265 + 4 * rep], 1);
        __syncthreads();
        const int it = *sidx;
        if (it >= 1024 * GLAC_REP) break;
        gla_c_item(p, it & 1023, smem);
    }
}
__device__ void phase5b(const Params& p, char* smem, int rep) {
    int* sidx = (int*)(smem + GEMM_SMEM - 16);
    for (;;) {
        __syncthreads();
        if (opaque_tid() == 0) *sidx = atomicAdd(&p.counts()[266 + 4 * rep], 1);
        __syncthreads();
        const int it = *sidx;
        if (it >= 1024 * NSA_REP) break;
        const int item = it & 1023;
        nsa_sw_item(p, item >> 4, (item >> 1) & 7, item & 1, smem, it >= 1024 ? NSA_MODE2 : 0);
    }
}
__device__ void phase6(const Params& p, char* smem) {
    const int xcd = xcd_of(smem), rank = rank_of(smem), nranks = nranks_of(smem);
    const int lane = opaque_tid() & 63, wid = opaque_tid() >> 6, wr = wid >> 1, wc = wid & 1, fr = lane & 15, fq = lane >> 4;
    for (int it = rank; it < 16 * 8; it += nranks) {
        const int mt = (it / 8) * 8 + xcd, nt = it % 8;
        RowsBf16 al{p.mixb() + (size_t)mt * 128 * 1024, 1024};
        RowsBf16 bl{p.wot() + (size_t)nt * 128 * 1024, 1024};
        f32x4 acc[4][4];
        gemm_128<true, false>(al, bl, 0, 16, smem, acc);
#pragma unroll
        for (int m = 0; m < 4; ++m)
#pragma unroll
            for (int n = 0; n < 4; ++n)
                *(f32x4*)(p.y1() + (size_t)(mt * 128 + wr * 64 + m * 16 + fr) * 1024 + nt * 128 + wc * 64 + n * 16 + fq * 4) = acc[m][n];
    }
}

__device__ void phase7(const Params& p) {
    const int lane = opaque_tid() & 63, gw = blockIdx.x * 4 + (opaque_tid() >> 6), nw = gridDim.x * 4;
    const float alpha = 1.189207115f;
    for (int row0 = gw * 2; row0 < NTOK; row0 += nw * 2) {
        const int b = row0 / SEQ;
        const float* md = p.mod() + b * 6144;
        f32x4 xv[2][4], yv[2][4];
#pragma unroll
        for (int r = 0; r < 2; ++r)
#pragma unroll
            for (int i = 0; i < 4; ++i) {
                const int col = i * 256 + lane * 4;
                xv[r][i] = *(const f32x4*)(p.x + (size_t)(row0 + r) * 1024 + col);
                yv[r][i] = *(const f32x4*)(p.y1() + (size_t)(row0 + r) * 1024 + col);
            }
#pragma unroll
        for (int r = 0; r < 2; ++r) {
            const int row = row0 + r;
            f32x4 v[4]; float s = 0.f;
#pragma unroll
            for (int i = 0; i < 4; ++i) {
                const int col = i * 256 + lane * 4;
                const f32x4 ga = *(const f32x4*)(md + 2048 + col);
#pragma unroll
                for (int j = 0; j < 4; ++j) v[i][j] = alpha * xv[r][i][j] + (1.f + ga[j]) * yv[r][i][j];
                s += (v[i][0] + v[i][1]) + (v[i][2] + v[i][3]);
            }
            float mu = wave_sum(s) * (1.f / 1024.f);
            float q = 0.f;
#pragma unroll
            for (int i = 0; i < 4; ++i)
#pragma unroll
                for (int j = 0; j < 4; ++j) { float d = v[i][j] - mu; q += d * d; }
            float rstd = rsqrtf(wave_sum(q) * (1.f / 1024.f) + 1e-5f);
            s = 0.f;
#pragma unroll
            for (int i = 0; i < 4; ++i) {
                const int col = i * 256 + lane * 4;
                f32x4 g = *(const f32x4*)(p.ln1_g + col), bb = *(const f32x4*)(p.ln1_b + col);
#pragma unroll
                for (int j = 0; j < 4; ++j) v[i][j] = (v[i][j] - mu) * rstd * g[j] + bb[j];
                *(f32x4*)(p.x1() + (size_t)row * 1024 + col) = v[i];
                s += (v[i][0] + v[i][1]) + (v[i][2] + v[i][3]);
            }
            mu = wave_sum(s) * (1.f / 1024.f);
            q = 0.f;
#pragma unroll
            for (int i = 0; i < 4; ++i)
#pragma unroll
                for (int j = 0; j < 4; ++j) { float d = v[i][j] - mu; q += d * d; }
            rstd = rsqrtf(wave_sum(q) * (1.f / 1024.f) + 1e-5f);
#pragma unroll
            for (int i = 0; i < 4; ++i) {
                const int col = i * 256 + lane * 4;
                f32x4 sh = *(const f32x4*)(md + 3072 + col), sc = *(const f32x4*)(md + 4096 + col);
                float o[4];
#pragma unroll
                for (int j = 0; j < 4; ++j) o[j] = (v[i][j] - mu) * rstd * (1.f + sc[j]) + sh[j];
                u32x2 w; w.x = pk_bf16(o[0], o[1]); w.y = pk_bf16(o[2], o[3]);
                *(u32x2*)(p.hb() + (size_t)row * 1024 + col) = w;
            }
        }
    }
}

__device__ void phase8(const Params& p, char* smem) {
    const int lane = opaque_tid() & 63, wid = opaque_tid() >> 6, wr = wid >> 1, wc = wid & 1, fr = lane & 15, fq = lane >> 4;
    for (int it = blockIdx.x; it < 256; it += gridDim.x) {
        const int mt = it >> 1, nt = it & 1;
        RowsBf16 al{p.hb() + (size_t)mt * 128 * 1024, 1024};
        RowsBf16 bl{p.wrt() + (size_t)nt * 128 * 1024, 1024};
        f32x4 acc[4][4];
        gemm_128<true, false>(al, bl, 0, 16, smem, acc);
#pragma unroll
        for (int m = 0; m < 4; ++m)
#pragma unroll
            for (int n = 0; n < 4; ++n)
                *(f32x4*)(p.logits() + (size_t)(mt * 128 + wr * 64 + m * 16 + fr) * 256 + nt * 128 + wc * 64 + n * 16 + fq * 4) = acc[m][n];
    }
}

__device__ void phase9(const Params& p) {
    const int lane = opaque_tid() & 63, gw = blockIdx.x * 4 + (opaque_tid() >> 6), nw = gridDim.x * 4;
    for (int tok = gw; tok < NTOK; tok += nw) {
        float s[4], sb[4];
        const f32x4 lg = *(const f32x4*)(p.logits() + (size_t)tok * 256 + lane * 4);
        const f32x4 rb = *(const f32x4*)(p.rbias + lane * 4);
#pragma unroll
        for (int i = 0; i < 4; ++i) { s[i] = 1.f / (1.f + __expf(-lg[i])); sb[i] = s[i] + rb[i]; }
        float m1 = NEGF, m2 = NEGF;
#pragma unroll
        for (int i = 0; i < 4; ++i) { float v = sb[i]; if (v > m1) { m2 = m1; m1 = v; } else if (v > m2) m2 = v; }
#pragma unroll
        for (int mm = 1; mm < 8; mm <<= 1) {
            float o1 = __shfl_xor(m1, mm), o2 = __shfl_xor(m2, mm);
            float n1 = fmaxf(m1, o1);
            float n2 = fmaxf(fminf(m1, o1), fmaxf(m2, o2));
            m1 = n1; m2 = n2;
        }
        const float gs = m1 + m2;
        const int grp = lane >> 3;
        int grank = 0;
#pragma unroll
        for (int g2 = 0; g2 < 8; ++g2) { float o = __shfl(gs, g2 * 8); if (o > gs || (o == gs && g2 < grp)) ++grank; }
        const bool gsel = grank < 4;
        float cand[4];
#pragma unroll
        for (int i = 0; i < 4; ++i) cand[i] = gsel ? sb[i] : NEGF;
        float wsum = 0.f, myw = 0.f; int mye = 0;
#pragma unroll 1
        for (int k = 0; k < TOPK; ++k) {
            float bv = cand[0]; int bi = 0;
#pragma unroll
            for (int i = 1; i < 4; ++i) if (cand[i] > bv) { bv = cand[i]; bi = i; }
            float gv = bv; int ge = lane * 4 + bi;
#pragma unroll
            for (int mm = 1; mm < 64; mm <<= 1) {
                float ov = __shfl_xor(gv, mm); int oe = __shfl_xor(ge, mm);
                if (ov > gv || (ov == gv && oe < ge)) { gv = ov; ge = oe; }
            }
            float sel_s = 0.f;
            if ((ge >> 2) == lane) {
                const int i = ge & 3;
                sel_s = (i == 0) ? s[0] : (i == 1) ? s[1] : (i == 2) ? s[2] : s[3];
                if (i == 0) cand[0] = -3e38f; else if (i == 1) cand[1] = -3e38f; else if (i == 2) cand[2] = -3e38f; else cand[3] = -3e38f;
            }
            sel_s = __shfl(sel_s, ge >> 2);
            wsum += sel_s;
            if (lane == k) { myw = sel_s; mye = ge; }
        }
        if (lane < TOPK) {
            const int id = tok * NASSIGN + lane;
            p.ew()[id] = myw / wsum * 2.5f;
            const int pos = atomicAdd(&p.counts()[mye], 1);
            p.lists()[(size_t)mye * NTOK + pos] = id;
        } else if (lane == TOPK) {
            p.ew()[tok * NASSIGN + TOPK] = 1.f;
        }
    }
}

struct Rows4 {
    static constexpr bool NT = false;
    const bf16_t *p0, *p1, *p2, *p3; int kmask;
    __device__ __forceinline__ const bf16_t* pp(int i, int tid, int k) const { return (i == 0 ? p0 : i == 1 ? p1 : i == 2 ? p2 : p3) + (k & kmask); }
};
template <int NT_PER>
__device__ __forceinline__ int build_entries(const Params& p, int xcd, int* spre) {
    const int tid = opaque_tid();
    __syncthreads();
    if (tid < 33) {
        int items;
        if (tid < 32) { const int cnt = p.counts()[xcd + 8 * tid]; items = ((cnt + 127) >> 7) * NT_PER; }
        else items = 16 * NT_PER;
        spre[64 + tid] = items;
    }
    __syncthreads();
    if (tid == 0) { int a = 0; for (int i = 0; i < 33; ++i) { spre[i] = a; a += spre[64 + i]; } spre[33] = a; }
    __syncthreads();
    return spre[33];
}

template <int NT_PER>
__device__ __forceinline__ void decode_item(const Params& p, int xcd, const int* spre, int it, int& e, int& nt, int& mtile, int& cnt) {
    int ent = 0;
    for (int i = 1; i < 33; ++i) ent = (it >= spre[i]) ? i : ent;
    const int local = it - spre[ent];
    if (ent < 32) {
        e = xcd + 8 * ent; cnt = p.counts()[e];
        const int mtc = (cnt + 127) >> 7;
        nt = local / mtc; mtile = local % mtc;
    } else {
        e = N_EXP; cnt = NTOK; nt = local >> 4; mtile = (local & 15) * 8 + xcd;
    }
}

#ifndef P10_NT
#define P10_NT 4
#endif
struct BF32GateUpS {
    const float* g; long du;
    __device__ __forceinline__ f32x4 load4(int kk, int r4) const {
        const long sel = ((r4 >> 5) & 1) ? du : 0l;
        return *(const f32x4*)(g + sel + (size_t)(kk & 1023) * 256 + (kk >> 10) * 64 + (r4 >> 6) * 32 + (r4 & 31));
    }
};
__device__ void phase10(const Params& p, char* smem) {
    const int tid = opaque_tid(), xcd = xcd_of(smem), rank = rank_of(smem), nranks = nranks_of(smem);
    const int lane = tid & 63, wid = tid >> 6, wr = wid >> 1, wc = wid & 1, fr = lane & 15, fq = lane >> 4;
    int* srow = (int*)(smem + GEMM_SMEM);
    int* spre = srow + 256;
#ifndef P10_REP
#define P10_REP 1
#endif
    const int total = build_entries<P10_NT>(p, xcd, spre);
#ifdef STAGGER
    for (int i = 0; i < (rank & 3) * STAGGER; ++i) __builtin_amdgcn_s_sleep(32);
#endif
    for (int it0 = rank; it0 < total * P10_REP; it0 += nranks) {
        const int it = it0 % total;
        int e, nt, mtile, cnt;
        decode_item<P10_NT>(p, xcd, spre, it, e, nt, mtile, cnt);
        if (tid < 128) {
            const int pos = mtile * 128 + tid;
            int id = -1;
            if (pos < cnt) id = (e == N_EXP) ? (pos * NASSIGN + TOPK) : p.lists()[(size_t)e * NTOK + pos];
            srow[tid] = id >= 0 ? id / NASSIGN : 0;
            srow[128 + tid] = id;
        }
        __syncthreads();
        Rows4 al; al.kmask = 1023;
        al.p0 = p.hb() + (size_t)srow[(tid >> 3)] * 1024; al.p1 = p.hb() + (size_t)srow[32 + (tid >> 3)] * 1024;
        al.p2 = p.hb() + (size_t)srow[64 + (tid >> 3)] * 1024; al.p3 = p.hb() + (size_t)srow[96 + (tid >> 3)] * 1024;
        const float* Wg = (e == N_EXP) ? p.w_s_gate : p.w_e_gate + (size_t)e * 1024 * 256;
        const float* Wu = (e == N_EXP) ? p.w_s_up : p.w_e_up + (size_t)e * 1024 * 256;
        BF32GateUpS bl{Wg + nt * (256 / P10_NT), (long)(Wu - Wg)};
        f32x4 acc[4][4];
        bf16_t* hidp = p.hid();
        gemm_core<true, true>(al, bl, 0, 16 * (4 / P10_NT), 16, smem, acc, [&](int tl, const f32x4 (&a)[4][4]) __attribute__((always_inline)) {
            const int nt4 = nt * (4 / P10_NT) + tl;
#pragma unroll
            for (int m = 0; m < 4; ++m) {
                const int id = srow[128 + wr * 64 + m * 16 + fr];
                if (id >= 0) {
#pragma unroll
                    for (int n = 0; n < 2; ++n) {
                        float hv[4];
#pragma unroll
                        for (int j = 0; j < 4; ++j) { const float gte = a[m][n][j]; hv[j] = gte / (1.f + __expf(-gte)) * a[m][n + 2][j]; }
                        u32x2 w; w.x = pk_bf16(hv[0], hv[1]); w.y = pk_bf16(hv[2], hv[3]);
                        *(u32x2*)(hidp + (size_t)id * 256 + nt4 * 64 + wc * 32 + n * 16 + fq * 4) = w;
                    }
                }
            }
        });
        __syncthreads();
    }
}

struct DownB {
    const float* base;
    __device__ __forceinline__ f32x4 load4(int kk, int r4) const {
#ifdef NT_B
        return __builtin_nontemporal_load((const f32x4*)(base + (size_t)(kk & 255) * 1024 + (kk >> 8) * 128 + r4));
#else
        return *(const f32x4*)(base + (size_t)(kk & 255) * 1024 + (kk >> 8) * 128 + r4);
#endif
    }
};
struct HidA {
    static constexpr bool NT = true;
    const bf16_t* base; const int* rowidx;
    __device__ __forceinline__ const bf16_t* ptr(int r, int kk) const { return base + (size_t)rowidx[r] * 256 + (kk & 255); }
    __device__ __forceinline__ const bf16_t* pp(int i, int tid, int k) const { return ptr(i * 32 + (tid >> 3), k); }
};
#ifndef P11_NT
#define P11_NT 4
#endif
__device__ void phase11(const Params& p, char* smem) {
    const int tid = opaque_tid(), xcd = xcd_of(smem), rank = rank_of(smem), nranks = nranks_of(smem);
    const int lane = tid & 63, wid = tid >> 6, wr = wid >> 1, wc = wid & 1, fr = lane & 15, fq = lane >> 4;
    int* srow = (int*)(smem + GEMM_SMEM);
    int* spre = srow + 256;
    float* sew = (float*)(srow + 384);
#ifndef P11_REP
#define P11_REP 1
#endif
    const int total = build_entries<P11_NT>(p, xcd, spre);
    for (int it0 = rank; it0 < total * P11_REP; it0 += nranks) {
        const int it = it0 % total;
        int e, nt, mtile, cnt;
        decode_item<P11_NT>(p, xcd, spre, it, e, nt, mtile, cnt);
        if (tid < 128) {
            const int pos = mtile * 128 + tid;
            int id = -1;
            if (pos < cnt) id = (e == N_EXP) ? (pos * NASSIGN + TOPK) : p.lists()[(size_t)e * NTOK + pos];
            srow[tid] = id >= 0 ? id : 0;
            srow[128 + tid] = id;
            sew[tid] = id >= 0 ? p.ew()[id] : 0.f;
        }
        __syncthreads();
        Rows4 al; al.kmask = 255;
        al.p0 = p.hid() + (size_t)srow[(tid >> 3)] * 256; al.p1 = p.hid() + (size_t)srow[32 + (tid >> 3)] * 256;
        al.p2 = p.hid() + (size_t)srow[64 + (tid >> 3)] * 256; al.p3 = p.hid() + (size_t)srow[96 + (tid >> 3)] * 256;
        DownB bl{(e == N_EXP) ? p.w_s_down : p.w_e_down + (size_t)e * 256 * 1024};
        f32x4 acc[4][4];
        bf16_t* outk = p.outk();
        auto epi = [&](int tile, const f32x4 (&a)[4][4]) __attribute__((always_inline)) {
#pragma unroll
            for (int m = 0; m < 4; ++m) {
                const int rr = wr * 64 + m * 16 + fr;
                const int id = srow[128 + rr];
                if (id >= 0) {
                    const float w8 = sew[rr];
#pragma unroll
                    for (int n = 0; n < 4; ++n) {
                        u32x2 w; w.x = pk_bf16(a[m][n][0] * w8, a[m][n][1] * w8); w.y = pk_bf16(a[m][n][2] * w8, a[m][n][3] * w8);
                        *(u32x2*)(outk + (size_t)id * 1024 + tile * 128 + wc * 64 + n * 16 + fq * 4) = w;
                    }
                }
            }
        };
        gemm_core<true, true>(al, bl, nt * (2048 / P11_NT), 32 / P11_NT, 4, smem, acc, [&](int tl, const f32x4 (&a)[4][4]) __attribute__((always_inline)) { epi(nt * (8 / P11_NT) + tl, a); });
        __syncthreads();
    }
}

__device__ void phase12(const Params& p) {
    const int lane = opaque_tid() & 63, gw = blockIdx.x * 4 + (opaque_tid() >> 6), nw = gridDim.x * 4;
    const float alpha = 1.189207115f;
    for (int row = gw; row < NTOK; row += nw) {
        const int b = row / SEQ;
        const float* md = p.mod() + b * 6144;
        float v[16];
#pragma unroll
        for (int i = 0; i < 16; ++i) v[i] = 0.f;
#pragma unroll
        for (int k = 0; k < NASSIGN; ++k) {
#pragma unroll
            for (int cidx = 0; cidx < 2; ++cidx) {
                const u32x4 w = *(const u32x4*)(p.outk() + ((size_t)row * NASSIGN + k) * 1024 + cidx * 512 + lane * 8);
                v[cidx * 8 + 0] += bflo(w.x); v[cidx * 8 + 1] += bfhi(w.x); v[cidx * 8 + 2] += bflo(w.y); v[cidx * 8 + 3] += bfhi(w.y);
                v[cidx * 8 + 4] += bflo(w.z); v[cidx * 8 + 5] += bfhi(w.z); v[cidx * 8 + 6] += bflo(w.w); v[cidx * 8 + 7] += bfhi(w.w);
            }
        }
        float s = 0.f;
#pragma unroll
        for (int cidx = 0; cidx < 2; ++cidx)
#pragma unroll
            for (int hh = 0; hh < 2; ++hh) {
                const int col = cidx * 512 + lane * 8 + hh * 4;
                const f32x4 xv = *(const f32x4*)(p.x1() + (size_t)row * 1024 + col), ga = *(const f32x4*)(md + 5120 + col);
#pragma unroll
                for (int j = 0; j < 4; ++j) { float t = alpha * xv[j] + (1.f + ga[j]) * v[cidx * 8 + hh * 4 + j]; v[cidx * 8 + hh * 4 + j] = t; s += t; }
            }
        const float mu = wave_sum(s) * (1.f / 1024.f);
        float q = 0.f;
#pragma unroll
        for (int i = 0; i < 16; ++i) { float d = v[i] - mu; q += d * d; }
        const float rstd = rsqrtf(wave_sum(q) * (1.f / 1024.f) + 1e-5f);
#pragma unroll
        for (int cidx = 0; cidx < 2; ++cidx)
#pragma unroll
            for (int hh = 0; hh < 2; ++hh) {
                const int col = cidx * 512 + lane * 8 + hh * 4;
                const f32x4 g = *(const f32x4*)(p.ln2_g + col), bb = *(const f32x4*)(p.ln2_b + col);
                f32x4 o;
#pragma unroll
                for (int j = 0; j < 4; ++j) o[j] = (v[cidx * 8 + hh * 4 + j] - mu) * rstd * g[j] + bb[j];
                *(f32x4*)(p.out + (size_t)row * 1024 + col) = o;
            }
    }
}

#define XB_TMO      128
#define XB_XCNT(j)  (256  + 64 * (j))
#define XB_XSUB(j)  (1280 + 64 * (j))
#define XB_XGEN(j)  (2304 + 64 * (j))
#define XB_TOP      3328
#define XB_TOPGEN   3392
#define XCD_BAR_WORDS 3456
#define XB_SPIN_CAP (1u << 22)
#define LAS __attribute__((address_space(3)))
__device__ __forceinline__ unsigned xb_ld(unsigned* p) { return __hip_atomic_load(p, __ATOMIC_RELAXED, __HIP_MEMORY_SCOPE_AGENT); }
__device__ __forceinline__ unsigned xb_add(unsigned* p, unsigned v) { return __hip_atomic_fetch_add(p, v, __ATOMIC_RELAXED, __HIP_MEMORY_SCOPE_AGENT); }
__device__ __forceinline__ unsigned xb_xcc_id() { return (unsigned)__builtin_amdgcn_s_getreg((3 << 11) | 20) & 0xFu; }
#define XB_SPIN(cond, bar) do { unsigned _sp = 0; while (cond) { __builtin_amdgcn_s_sleep(1); \
    if ((++_sp & 255u) == 0u) { if (xb_ld(&(bar)[XB_TMO])) break; if (_sp > XB_SPIN_CAP) { atomicAdd(&(bar)[XB_TMO], 1u); break; } } } } while (0)
struct XcdBarrier { unsigned* bar; unsigned x; volatile LAS unsigned* st; };
__device__ __forceinline__ XcdBarrier xcd_barrier_post(unsigned* bar, volatile LAS unsigned* st) {
    XcdBarrier b; b.bar = bar; b.x = xb_xcc_id(); b.st = st;
    if (opaque_tid() == 0) st[2] = xb_add(&bar[XB_XCNT(b.x)], 1u);
    return b;
}
__device__ __forceinline__ void xcd_barrier_complete(unsigned* bar, unsigned x, unsigned& nloc, unsigned& nx, unsigned& dense) {
    const unsigned G = gridDim.x * gridDim.y * gridDim.z;
    unsigned sum, cnt, mine, below, sp = 0u;
    for (;;) {
        sum = 0u; cnt = 0u; mine = 0u; below = 0u;
#pragma unroll
        for (unsigned j = 0; j < 16; ++j) { const unsigned c = xb_ld(&bar[XB_XCNT(j)]); sum += c; cnt += (c > 0u) ? 1u : 0u; mine = (j == x) ? c : mine; below += (j < x && c > 0u) ? 1u : 0u; }
        if (sum == G) break;
        __builtin_amdgcn_s_sleep(1);
        if ((++sp & 255u) == 0u) { if (xb_ld(&bar[XB_TMO])) break; if (sp > XB_SPIN_CAP) { atomicAdd(&bar[XB_TMO], 1u); break; } }
    }
    nloc = mine > 0u ? mine : 1u; nx = cnt > 0u ? cnt : 1u; dense = below;
}
__device__ __forceinline__ void xcd_barrier(unsigned* bar, volatile LAS unsigned* st) {
    asm volatile("s_waitcnt vmcnt(0)" ::: "memory");
    __syncthreads();
    if (opaque_tid() == 0) {
        __builtin_amdgcn_s_waitcnt(0);
        const unsigned x = st[3];
        unsigned nloc = st[0], nx = st[1];
        if (nloc == 0u) {
            unsigned dense;
            xcd_barrier_complete(bar, x, nloc, nx, dense); st[0] = nloc; st[1] = nx;
            const unsigned use_xcc = (nx == 8u) ? 1u : 0u;
            st[4] = use_xcc ? dense : (blockIdx.x & 7u);
            st[5] = use_xcc ? st[2] : (blockIdx.x >> 3);
            st[6] = use_xcc ? nloc : (gridDim.x >> 3);
        }
        const unsigned old = xb_add(&bar[XB_XSUB(x)], 1u);
        const unsigned gen = old / nloc;
        if (old + 1u == (gen + 1u) * nloc) {
            __builtin_amdgcn_fence(__ATOMIC_RELEASE, "agent");
            asm volatile("s_waitcnt vmcnt(0)" ::: "memory");
            const unsigned og = xb_add(&bar[XB_TOP], 1u);
            const unsigned tg = og / nx;
            if (og + 1u == (tg + 1u) * nx) xb_add(&bar[XB_TOPGEN], 1u);
            else XB_SPIN(xb_ld(&bar[XB_TOPGEN]) == tg, bar);
            __builtin_amdgcn_fence(__ATOMIC_ACQUIRE, "agent");
            xb_add(&bar[XB_XGEN(x)], 1u);
            asm volatile("s_waitcnt vmcnt(0)" ::: "memory");
        } else {
            XB_SPIN(xb_ld(&bar[XB_XGEN(x)]) == gen, bar);
            __builtin_amdgcn_fence(__ATOMIC_ACQUIRE, "agent");
            asm volatile("s_waitcnt vmcnt(0)" ::: "memory");
        }
    }
    __syncthreads();
}

#define MEGA_SMEM (GEMM_SMEM + 2048 + 64)
#define N_PHASES 14
__global__ void __launch_bounds__(256, 2) mega(Params p) {
    extern __shared__ __attribute__((aligned(16))) char smem[];
    volatile LAS unsigned* st = (volatile LAS unsigned*)(smem + GEMM_SMEM + 2048);
    if (p.ph_hi - p.ph_lo > 1) {
        if (opaque_tid() == 0) {
            const unsigned x = xb_xcc_id();
            st[0] = 0u; st[1] = 0u; st[3] = x;
            st[2] = xb_add(&p.bar()[XB_XCNT(x)], 1u);
        }
    } else {
        if (opaque_tid() == 0) { st[0] = gridDim.x >> 3; st[1] = 8u; st[2] = blockIdx.x >> 3; st[3] = blockIdx.x & 7; st[4] = blockIdx.x & 7; st[5] = blockIdx.x >> 3; st[6] = gridDim.x >> 3; }
    }
    __syncthreads();
#ifndef REP_PHASE
#define REP_PHASE -1
#endif
#ifdef PHPROF
#define PH_STAMP(N) if (blockIdx.x == 0 && opaque_tid() == 0) ((unsigned long long*)(p.ws + OFF_counts + 1536))[N] = __builtin_amdgcn_s_memrealtime();
#else
#define PH_STAMP(N)
#endif
#define RUN_PHASE(N, CALL) if (p.ph_lo <= N && N < p.ph_hi) { if (N > p.ph_lo) xcd_barrier(p.bar(), st); PH_STAMP(N) { const int rep = 0; (void)rep; CALL; } \
        if (REP_PHASE == N) { xcd_barrier(p.bar(), st); { const int rep = 1; (void)rep; CALL; } } }
    RUN_PHASE(0, phase0(p, smem))
    RUN_PHASE(1, phase1(p))
    RUN_PHASE(2, phase2(p, smem))
    RUN_PHASE(3, phase3(p, smem))
    RUN_PHASE(4, phase4(p, smem))
    RUN_PHASE(5, phase5a(p, smem, rep))
    RUN_PHASE(6, phase5b(p, smem, rep))
    RUN_PHASE(7, phase6(p, smem))
    RUN_PHASE(8, phase7(p))
    RUN_PHASE(9, phase8(p, smem))
    RUN_PHASE(10, phase9(p))
    RUN_PHASE(11, phase10(p, smem))
    RUN_PHASE(12, phase11(p, smem))
    RUN_PHASE(13, phase12(p))
#ifdef EXTRA_BARRIERS
    for (int i = 0; i < EXTRA_BARRIERS; ++i) xcd_barrier(p.bar(), st);
#endif
    PH_STAMP(14)
    PH_STAMP(15)
}
#if DBG
struct NaiveBufs { float *mod, *h, *proj, *flat, *hidk, *hidv, *kc, *vc, *mix, *ograw, *y, *x1, *logits; };
__device__ __forceinline__ void dbg_pair(int seam, size_t i, const Params& p, const NaiveBufs& nb, float& a, float& b, bool& use) {
    use = true; a = 0.f; b = 0.f;
    switch (seam) {
        case 0: {
            a = nb.mod[i]; b = p.mod()[i]; break; }
        case 1: {
            size_t tok = i / PCOLS; int n = (int)(i % PCOLS);
            int src = win_srccol(n);
            bool transposed = (n >= 896 && n < 1024) || (n >= 1152 && n < 1280) || (n >= 1792 && n < 2304) || n >= 2816;
            if (transposed || src < 0) { use = false; break; }
            a = nb.proj[tok * IN_COLS + src]; b = bf2f(p.Pb()[i]); break; }
        case 2: {
            size_t half = (size_t)BATCH * 128 * SEQ; int which = i >= half; size_t j = which ? i - half : i;
            int t = (int)(j % SEQ); int f = (int)((j / SEQ) % 128); int bb = (int)(j / ((size_t)SEQ * 128));
            a = nb.proj[((size_t)bb * SEQ + t) * IN_COLS + (which ? C_VW : C_VS) + f];
            b = bf2f(which ? p.VwT()[j] : p.VsT()[j]); break; }
        case 3: {
            size_t nv = (size_t)BATCH * 512 * SEQ;
            if (i < nv) { int t = (int)(i % SEQ); int f = (int)((i / SEQ) % 512); int bb = (int)(i / ((size_t)SEQ * 512));
                a = nb.proj[((size_t)bb * SEQ + t) * IN_COLS + C_GV + f]; b = bf2f(p.VgT()[i]); }
            else { size_t j = i - nv; size_t tok = j / 40; int f = (int)(j % 40);
                a = nb.proj[tok * IN_COLS + (f < 24 ? C_NG + f : C_GLR + f - 24)]; b = p.misc()[tok * 64 + f]; }
            break; }
        case 4: {
            size_t nk = (size_t)BATCH * NCMP * 2 * 64;
            size_t j = i < nk ? i : i - nk;
            int d = (int)(j % 64); int g = (int)((j / 64) % 2); int ii = (int)((j / 128) % NCMP); int bb = (int)(j / (128 * NCMP));
            if (i < nk) { a = nb.kc[j]; b = bf2f(p.kc()[((size_t)(bb * 2 + g) * 256 + ii) * 64 + d]); }
            else { a = nb.vc[j]; b = bf2f(p.vcT()[((size_t)(bb * 2 + g) * 64 + d) * 256 + ii]); }
            break; }
        case 5: {
            size_t tok = i / 512; int cidx = (int)(i % 512);
            a = nb.mix[tok * 1024 + cidx]; b = bf2f(p.mixb()[tok * 1024 + cidx]); break; }
        case 6: {
            size_t tok = i / 512; int cidx = (int)(i % 512);
            a = nb.mix[tok * 1024 + 512 + cidx]; b = bf2f(p.mixb()[tok * 1024 + 512 + cidx]); break; }
        case 7: { a = nb.x1[i]; b = p.x1()[i]; break; }
        case 8: { a = nb.logits[i]; b = p.logits()[i]; break; }
    }
}
__global__ __launch_bounds__(256) void dbg_compare(int seam, size_t n, Params p, NaiveBufs nb, float* dbg) {
    __shared__ float red[256];
    float sd = 0.f, sa = 0.f;
    for (size_t i = (size_t)blockIdx.x * 256 + threadIdx.x; i < n; i += (size_t)gridDim.x * 256) {
        float a, b; bool use;
        dbg_pair(seam, i, p, nb, a, b, use);
        if (use) { float d = a - b; if (!(d == d)) d = 1e10f; sd += d * d; sa += a * a; }
    }
    sd = blk_sum(sd, red); sa = blk_sum(sa, red);
    if (threadIdx.x == 0) { atomicAdd(&dbg[2 * seam], sd); atomicAdd(&dbg[2 * seam + 1], sa); }
}
__global__ void dbg_decide(float* dbg, int nseams, int report_seam) {
    float code = 0.f;
    for (int k = 0; k < nseams; ++k) {
        float err = dbg[2 * k] / fmaxf(dbg[2 * k + 1], 1e-30f);
        const float thr = (k == 5) ? 3e-2f : 1e-3f;
        bool bad = !(err < thr);
        if (bad || k == report_seam) {
            float lg = log10f(fmaxf(err, 1e-12f));
            int dgt = (int)floorf(lg) + 6; dgt = dgt < 0 ? 0 : (dgt > 9 ? 9 : dgt);
            code = 100.f * (k + 1) + 10.f * dgt; break;
        }
    }
    dbg[64] = code;
}
__global__ void dbg_apply(const float* dbg, float* out, size_t n) {
    float code = dbg[64];
    if (code <= 0.f) return;
    float cst = sqrtf(code);
    for (size_t i = (size_t)blockIdx.x * 256 + threadIdx.x; i < n; i += (size_t)gridDim.x * 256) out[i] = cst;
}
#endif

#ifdef PROF
__global__ void prof_apply(const unsigned long long* pw, float* out, size_t n, int sel) {
    const double proc = (double)pw[0], tot = (double)pw[1], steps = (double)pw[2];
    float code = 0.f;
    if (sel == 0) code = (float)(100.0 * proc / tot);
    if (sel == 1) code = (float)(tot / steps / 10.0);
    if (sel == 2) code = (float)(proc / steps / 10.0);
    if (sel == 3) code = (float)(steps / 1024.0);
    const float cst = sqrtf(code);
    for (size_t i = (size_t)blockIdx.x * 256 + threadIdx.x; i < n; i += (size_t)gridDim.x * 256) out[i] = cst;
}
#endif
#ifdef PHPROF
__global__ void phase_prof_apply(const unsigned long long* ts, float* out, size_t n, int sel) {
    double us;
    if (sel >= 100) us = (double)(ts[15] - ts[0]) / 100.0;
    else us = (double)(ts[sel + 1] - ts[sel]) / 100.0;
    const float cst = (float)log2(us > 1.0 ? us : 1.0);
    for (size_t i = (size_t)blockIdx.x * 256 + threadIdx.x; i < n; i += (size_t)gridDim.x * 256) out[i] = cst;
}
#endif
extern "C" void kernel_launch(void* const* d_in, const int* in_sizes, int n_in, void* d_out, int out_size,
                              void* d_ws, size_t ws_size, hipStream_t stream) {
    Params p{};
    const float** ins = (const float**)&p;
    for (int i = 0; i < 27; ++i) ins[i] = (const float*)d_in[i];
    p.out = (float*)d_out;

    char* ws = (char*)d_ws;
    p.ws = ws;
    if (WS_TOTAL > ws_size) return;
#if DBG
    size_t off = 0;
    auto alloc = [&](size_t bytes) { char* q = ws + off; off += (bytes + 255) & ~(size_t)255; return q; };
    NaiveBufs nb{};
    nb.mod = (float*)alloc(4 * 6144 * 4);
    nb.h = (float*)alloc((size_t)NTOK * 1024 * 4);
    nb.proj = (float*)alloc((size_t)NTOK * IN_COLS * 4);
    nb.flat = (float*)alloc((size_t)2040 * 2048 * 4);
    nb.hidk = (float*)alloc((size_t)2040 * 256 * 4);
    nb.hidv = (float*)alloc((size_t)2040 * 256 * 4);
    nb.kc = (float*)alloc((size_t)2040 * 64 * 4);
    nb.vc = (float*)alloc((size_t)2040 * 64 * 4);
    nb.mix = (float*)alloc((size_t)NTOK * 1024 * 4);
    nb.ograw = (float*)alloc((size_t)NTOK * 512 * 4);
    nb.y = (float*)alloc((size_t)NTOK * 1024 * 4);
    nb.x1 = (float*)alloc((size_t)NTOK * 1024 * 4);
    nb.logits = (float*)alloc((size_t)NTOK * 256 * 4);
    float* dbg = (float*)alloc(1024);
    if (off > WS_BASE) return;
#endif

    static int grid = 0;
    if (grid == 0) {
        int dev = 0, cus = 0, per_cu = 0;
        (void)hipGetDevice(&dev);
        (void)hipDeviceGetAttribute(&cus, hipDeviceAttributeMultiprocessorCount, dev);
        (void)hipFuncSetAttribute((const void*)mega, hipFuncAttributeMaxDynamicSharedMemorySize, MEGA_SMEM);
        (void)hipOccupancyMaxActiveBlocksPerMultiprocessor(&per_cu, (const void*)mega, 256, MEGA_SMEM);
        if (per_cu > 2) per_cu = 2;
        if (per_cu < 1) per_cu = 1;
        grid = cus * per_cu;
        grid &= ~7;
    }
    (void)hipMemsetAsync(ws + OFF_bar, 0, XCD_BAR_WORDS * 4, stream);

#if DBG
    (void)hipMemsetAsync(dbg, 0, 1024, stream);
    nk_mod<<<dim3(24, 4), 256, 0, stream>>>(p.c, p.w_mod, p.b_mod, nb.mod);
    nk_lnmod<<<NTOK, 256, 0, stream>>>(p.x, nb.mod, 0, 1024, nb.h);
    nk_gemm<<<dim3((IN_COLS + 63) / 64, NTOK / 64), 256, 0, stream>>>(nb.h, 1024, p.w_in, IN_COLS, nb.proj, IN_COLS, NTOK, IN_COLS, 1024);
    nk_flat<<<2040, 256, 0, stream>>>(nb.proj, C_KC, p.pos_k, nb.flat);
    nk_gemm<<<dim3(4, 32), 256, 0, stream>>>(nb.flat, 2048, p.w1_k, 256, nb.hidk, 256, 2040, 256, 2048);
    nk_silu<<<(2040 * 256 + 255) / 256, 256, 0, stream>>>(nb.hidk, 2040 * 256);
    nk_gemm<<<dim3(1, 32), 256, 0, stream>>>(nb.hidk, 256, p.w2_k, 64, nb.kc, 64, 2040, 64, 256);
    nk_flat<<<2040, 256, 0, stream>>>(nb.proj, C_VC, p.pos_v, nb.flat);
    nk_gemm<<<dim3(4, 32), 256, 0, stream>>>(nb.flat, 2048, p.w1_v, 256, nb.hidv, 256, 2040, 256, 2048);
    nk_silu<<<(2040 * 256 + 255) / 256, 256, 0, stream>>>(nb.hidv, 2040 * 256);
    nk_gemm<<<dim3(1, 32), 256, 0, stream>>>(nb.hidv, 256, p.w2_v, 64, nb.vc, 64, 2040, 64, 256);
    nk_nsa<<<NTOK, 256, 0, stream>>>(nb.proj, nb.kc, nb.vc, nb.mix);
    nk_gla<<<64, 256, 0, stream>>>(nb.proj, p.w_a2, p.b_a2, nb.ograw);
    nk_gla_norm<<<NTOK, 256, 0, stream>>>(nb.ograw, nb.proj, p.norm_w, nb.mix);
    nk_gemm<<<dim3(16, NTOK / 64), 256, 0, stream>>>(nb.mix, 1024, p.w_o, 1024, nb.y, 1024, NTOK, 1024, 1024);
    nk_resln<<<NTOK, 256, 0, stream>>>(p.x, nb.y, nb.mod, 2048, p.ln1_g, p.ln1_b, nb.x1);
    nk_lnmod<<<NTOK, 256, 0, stream>>>(nb.x1, nb.mod, 3072, 4096, nb.h);
    nk_gemm<<<dim3(4, NTOK / 64), 256, 0, stream>>>(nb.h, 1024, p.w_router, 256, nb.logits, 256, NTOK, 256, 1024);
    auto cmp = [&](int seam, size_t n) { dbg_compare<<<1024, 256, 0, stream>>>(seam, n, p, nb, dbg); };
#endif

#if SINGLE_LAUNCH
    p.ph_lo = 0; p.ph_hi = N_PHASES;
    mega<<<grid, 256, MEGA_SMEM, stream>>>(p);
#else
    for (int ph = 0; ph < N_PHASES; ++ph) {
        p.ph_lo = ph; p.ph_hi = ph + 1;
        mega<<<grid, 256, MEGA_SMEM, stream>>>(p);
#if DBG
        if (ph == 0) cmp(0, 4 * 6144);
        if (ph == 2) { cmp(1, (size_t)NTOK * PCOLS); cmp(2, (size_t)2 * BATCH * 128 * SEQ); cmp(3, (size_t)BATCH * 512 * SEQ + (size_t)NTOK * 40); }
        if (ph == 4) cmp(4, (size_t)2 * BATCH * NCMP * 128);
        if (ph == 5) { cmp(5, (size_t)NTOK * 512); cmp(6, (size_t)NTOK * 512); }
        if (ph == 7) cmp(7, (size_t)NTOK * 1024);
        if (ph == 8) cmp(8, (size_t)NTOK * 256);
#endif
    }
#endif
#ifdef PHPROF
    phase_prof_apply<<<1024, 256, 0, stream>>>((const unsigned long long*)(ws + OFF_counts + 1536), p.out, (size_t)NTOK * 1024, PHPROF);
#endif
#ifdef PROF
    prof_apply<<<1024, 256, 0, stream>>>((const unsigned long long*)(ws + OFF_counts + 1024), p.out, (size_t)NTOK * 1024, PROF);
#endif
#if DBG
    dbg_decide<<<1, 1, 0, stream>>>(dbg, 9, DBG_REPORT);
    dbg_apply<<<1024, 256, 0, stream>>>(dbg, p.out, (size_t)NTOK * 1024);
#endif
}
```

```cpp
#include <hip/hip_runtime.h>
#include <hip/hip_bf16.h>
#include <stdint.h>

#define D_MODEL 1024
#define BATCH 4
#define SEQ 4096
#define NTOK (BATCH * SEQ)
#define IN_COLS 2856
#define NCMP 255
#define NEGF (-1e30f)
#define C_NQ 0
#define C_KC 512
#define C_VC 640
#define C_KS 768
#define C_VS 896
#define C_KW 1024
#define C_VW 1152
#define C_NG 1280
#define C_GQ 1304
#define C_GK 1560
#define C_GV 1816
#define C_GLR 2328
#define C_GR 2344
#define N_EXP 256
#define TOPK 8

__device__ __forceinline__ float siluf(float x) { return x / (1.f + __expf(-x)); }
__device__ __forceinline__ float sigmoidf_(float x) { return 1.f / (1.f + __expf(-x)); }

__device__ __forceinline__ float blk_sum(float v, float* red) {
    int t = threadIdx.x;
    __syncthreads();
    red[t] = v; __syncthreads();
    for (int s = 128; s > 0; s >>= 1) { if (t < s) red[t] += red[t + s]; __syncthreads(); }
    float r = red[0];
    return r;
}
__device__ __forceinline__ float blk_max(float v, float* red) {
    int t = threadIdx.x;
    __syncthreads();
    red[t] = v; __syncthreads();
    for (int s = 128; s > 0; s >>= 1) { if (t < s) red[t] = fmaxf(red[t], red[t + s]); __syncthreads(); }
    float r = red[0];
    return r;
}

#define DBG 0
#define SINGLE_LAUNCH 1
#define DBG_REPORT -1
#define REP_PHASE -1
#if DBG
__global__ __launch_bounds__(256) void nk_mod(const float* c, const float* w_mod, const float* b_mod, float* mod) {
    int j = blockIdx.x * 256 + threadIdx.x; int b = blockIdx.y;
    float acc = b_mod[j];
    for (int k = 0; k < D_MODEL; ++k) acc += siluf(c[b * D_MODEL + k]) * w_mod[(size_t)k * 6144 + j];
    mod[b * 6144 + j] = acc;
}

__global__ __launch_bounds__(256) void nk_lnmod(const float* x, const float* mod, int sh_off, int sc_off, float* out) {
    __shared__ float red[256];
    int row = blockIdx.x; int b = row / SEQ; int t = threadIdx.x;
    const float* xr = x + (size_t)row * D_MODEL;
    float v[4]; float s = 0.f;
    for (int i = 0; i < 4; ++i) { v[i] = xr[t + 256 * i]; s += v[i]; }
    float mu = blk_sum(s, red) * (1.f / D_MODEL);
    float q = 0.f;
    for (int i = 0; i < 4; ++i) { float d = v[i] - mu; q += d * d; }
    float var = blk_sum(q, red) * (1.f / D_MODEL);
    float rstd = rsqrtf(var + 1e-5f);
    for (int i = 0; i < 4; ++i) {
        int col = t + 256 * i;
        out[(size_t)row * D_MODEL + col] = (v[i] - mu) * rstd * (1.f + mod[b * 6144 + sc_off + col]) + mod[b * 6144 + sh_off + col];
    }
}

__global__ __launch_bounds__(256) void nk_resln(const float* x, const float* y, const float* mod, int ga_off, const float* g, const float* bb, float* out) {
    __shared__ float red[256];
    int row = blockIdx.x; int b = row / SEQ; int t = threadIdx.x;
    const float alpha = 1.189207115f;
    float v[4]; float s = 0.f;
    for (int i = 0; i < 4; ++i) {
        int col = t + 256 * i;
        v[i] = alpha * x[(size_t)row * D_MODEL + col] + (1.f + mod[b * 6144 + ga_off + col]) * y[(size_t)row * D_MODEL + col];
        s += v[i];
    }
    float mu = blk_sum(s, red) * (1.f / D_MODEL);
    float q = 0.f;
    for (int i = 0; i < 4; ++i) { float d = v[i] - mu; q += d * d; }
    float var = blk_sum(q, red) * (1.f / D_MODEL);
    float rstd = rsqrtf(var + 1e-5f);
    for (int i = 0; i < 4; ++i) {
        int col = t + 256 * i;
        out[(size_t)row * D_MODEL + col] = (v[i] - mu) * rstd * g[col] + bb[col];
    }
}

__global__ __launch_bounds__(256) void nk_gemm(const float* A, int lda, const float* B, int ldb, float* C, int ldc, int M, int N, int K) {
    __shared__ float sA[16][64 + 1];
    __shared__ float sB[16][64 + 1];
    int tx = threadIdx.x & 15, ty = threadIdx.x >> 4;
    int m0 = blockIdx.y * 64, n0 = blockIdx.x * 64;
    float acc[4][4];
    for (int i = 0; i < 4; ++i) for (int j = 0; j < 4; ++j) acc[i][j] = 0.f;
    for (int k0 = 0; k0 < K; k0 += 16) {
        for (int e = threadIdx.x; e < 1024; e += 256) {
            int r = e >> 4, kk = e & 15;
            int gm = m0 + r;
            sA[kk][r] = (gm < M) ? A[(size_t)gm * lda + k0 + kk] : 0.f;
            int kb = e >> 6, nn = e & 63;
            int gn = n0 + nn;
            sB[kb][nn] = (gn < N) ? B[(size_t)(k0 + kb) * ldb + gn] : 0.f;
        }
        __syncthreads();
#pragma unroll
        for (int kk = 0; kk < 16; ++kk) {
            float a[4], bv[4];
#pragma unroll
            for (int i = 0; i < 4; ++i) a[i] = sA[kk][ty * 4 + i];
#pragma unroll
            for (int j = 0; j < 4; ++j) bv[j] = sB[kk][tx * 4 + j];
#pragma unroll
            for (int i = 0; i < 4; ++i)
#pragma unroll
                for (int j = 0; j < 4; ++j) acc[i][j] += a[i] * bv[j];
        }
        __syncthreads();
    }
#pragma unroll
    for (int i = 0; i < 4; ++i)
#pragma unroll
        for (int j = 0; j < 4; ++j) {
            int gm = m0 + ty * 4 + i, gn = n0 + tx * 4 + j;
            if (gm < M && gn < N) C[(size_t)gm * ldc + gn] = acc[i][j];
        }
}

__global__ __launch_bounds__(256) void nk_flat(const float* proj, int col0, const float* pos, float* flat) {
    int r = blockIdx.x;
    int g = r & 1; int bi = r >> 1; int i = bi % NCMP; int b = bi / NCMP;
    for (int e = threadIdx.x; e < 2048; e += 256) {
        int l = e >> 6, d = e & 63;
        flat[(size_t)r * 2048 + e] = proj[((size_t)b * SEQ + 16 * i + l) * IN_COLS + col0 + g * 64 + d] + pos[l * 64 + d];
    }
}
__global__ void nk_silu(float* x, int n) { int i = blockIdx.x * 256 + threadIdx.x; if (i < n) x[i] = siluf(x[i]); }

__global__ __launch_bounds__(256) void nk_nsa(const float* proj, const float* kc, const float* vc, float* mix) {
    __shared__ float sq[8][64];
    __shared__ float sp[1024];
    __shared__ float red[256];
    __shared__ float simp[64];
    __shared__ float sscore[64];
    __shared__ int sidx[16];
    __shared__ float sout[8][64];
    __shared__ float spart[4][64];
    const int tid = threadIdx.x;
    const int bt = blockIdx.x; const int b = bt / SEQ, t = bt % SEQ;
    const float* prow = proj + (size_t)bt * IN_COLS;
    for (int e = tid; e < 512; e += 256) { sq[e >> 6][e & 63] = prow[C_NQ + e] * 0.125f; sout[e >> 6][e & 63] = 0.f; }
    __syncthreads();
    const int tblk = t >> 6;
    const int dd = tid & 63, part = tid >> 6;
    for (int g = 0; g < 2; ++g) {
        if (tid < 64) simp[tid] = 0.f;
        __syncthreads();
        for (int hp = 0; hp < 4; ++hp) {
            int h = g * 4 + hp;
            float slope = exp2f(-(float)(h + 1));
            float s = NEGF; bool valid = false;
            if (tid < NCMP) {
                int ce = 16 * tid + 31;
                valid = (t >= ce);
                if (valid) {
                    const float* kr = kc + (((size_t)b * NCMP + tid) * 2 + g) * 64;
                    float a = 0.f;
                    for (int d = 0; d < 64; ++d) a += sq[h][d] * kr[d];
                    s = a - slope * (float)(t - ce);
                }
            }
            float m = blk_max(s, red);
            float e = valid ? __expf(s - m) : 0.f;
            float sum = blk_sum(e, red);
            float p = e / fmaxf(sum, 1e-30f);
            __syncthreads();
            sp[tid] = p;
            __syncthreads();
            float a = 0.f;
            for (int i = part; i < NCMP; i += 4) a += sp[i] * vc[(((size_t)b * NCMP + i) * 2 + g) * 64 + dd];
            spart[part][dd] = a;
            __syncthreads();
            if (tid < 64) {
                float o = spart[0][tid] + spart[1][tid] + spart[2][tid] + spart[3][tid];
                float gate = sigmoidf_(prow[C_NG + h * 3 + 0]);
                sout[h][tid] += gate * o;
                int j = tid;
                float im = sp[4 * j] + sp[4 * j + 1] + sp[4 * j + 2] + 0.5f * sp[4 * j + 3] + (j > 0 ? 0.5f * sp[4 * j - 1] : 0.f);
                simp[j] += im;
            }
            __syncthreads();
        }
        if (tid < 64) {
            int j = tid;
            bool forced = (j == 0) || (j == tblk) || (j == tblk - 1);
            sscore[j] = (j <= tblk) ? (simp[j] + (forced ? 1e4f : 0.f)) : NEGF;
        }
        __syncthreads();
        if (tid < 64) {
            int j = tid; float sj = sscore[j]; int rank = 0;
            for (int j2 = 0; j2 < 64; ++j2) { float s2 = sscore[j2]; if (s2 > sj || (s2 == sj && j2 < j)) ++rank; }
            if (rank < 16) sidx[rank] = j;
        }
        __syncthreads();
        for (int hp = 0; hp < 4; ++hp) {
            int h = g * 4 + hp;
            float slope = exp2f(-(float)(h + 1));
            float sv[4]; bool vl[4]; float mx = NEGF;
            for (int r = 0; r < 4; ++r) {
                int kk = tid + 256 * r;
                int kpos = sidx[kk >> 6] * 64 + (kk & 63);
                vl[r] = (kpos <= t);
                sv[r] = NEGF;
                if (vl[r]) {
                    const float* kr = proj + ((size_t)b * SEQ + kpos) * IN_COLS + C_KS + g * 64;
                    float a = 0.f;
                    for (int d = 0; d < 64; ++d) a += sq[h][d] * kr[d];
                    sv[r] = a - slope * (float)(t - kpos);
                }
                mx = fmaxf(mx, sv[r]);
            }
            float m = blk_max(mx, red);
            float es = 0.f; float ev[4];
            for (int r = 0; r < 4; ++r) { ev[r] = vl[r] ? __expf(sv[r] - m) : 0.f; es += ev[r]; }
            float sum = blk_sum(es, red);
            float inv = 1.f / fmaxf(sum, 1e-30f);
            __syncthreads();
            for (int r = 0; r < 4; ++r) sp[tid + 256 * r] = ev[r] * inv;
            __syncthreads();
            float a = 0.f;
            for (int kk = part; kk < 1024; kk += 4) {
                float p = sp[kk];
                if (p != 0.f) {
                    int kpos = sidx[kk >> 6] * 64 + (kk & 63);
                    a += p * proj[((size_t)b * SEQ + kpos) * IN_COLS + C_VS + g * 64 + dd];
                }
            }
            spart[part][dd] = a;
            __syncthreads();
            if (tid < 64) {
                float o = spart[0][tid] + spart[1][tid] + spart[2][tid] + spart[3][tid];
                float gate = sigmoidf_(prow[C_NG + h * 3 + 1]);
                sout[h][tid] += gate * o;
            }
            __syncthreads();
        }
        for (int hp = 0; hp < 4; ++hp) {
            int h = g * 4 + hp;
            float slope = exp2f(-(float)(h + 1));
            float sv[2]; bool vl[2]; float mx = NEGF;
            for (int r = 0; r < 2; ++r) {
                int kk = tid + 256 * r;
                int kpos = t - 511 + kk;
                vl[r] = (kpos >= 0);
                sv[r] = NEGF;
                if (vl[r]) {
                    const float* kr = proj + ((size_t)b * SEQ + kpos) * IN_COLS + C_KW + g * 64;
                    float a = 0.f;
                    for (int d = 0; d < 64; ++d) a += sq[h][d] * kr[d];
                    sv[r] = a - slope * (float)(t - kpos);
                }
                mx = fmaxf(mx, sv[r]);
            }
            float m = blk_max(mx, red);
            float es = 0.f; float ev[2];
            for (int r = 0; r < 2; ++r) { ev[r] = vl[r] ? __expf(sv[r] - m) : 0.f; es += ev[r]; }
            float sum = blk_sum(es, red);
            float inv = 1.f / fmaxf(sum, 1e-30f);
            __syncthreads();
            for (int r = 0; r < 2; ++r) sp[tid + 256 * r] = ev[r] * inv;
            __syncthreads();
            float a = 0.f;
            for (int kk = part; kk < 512; kk += 4) {
                float p = sp[kk];
                if (p != 0.f) {
                    int kpos = t - 511 + kk;
                    a += p * proj[((size_t)b * SEQ + kpos) * IN_COLS + C_VW + g * 64 + dd];
                }
            }
            spart[part][dd] = a;
            __syncthreads();
            if (tid < 64) {
                float o = spart[0][tid] + spart[1][tid] + spart[2][tid] + spart[3][tid];
                float gate = sigmoidf_(prow[C_NG + h * 3 + 2]);
                sout[h][tid] += gate * o;
            }
            __syncthreads();
        }
    }
    for (int e = tid; e < 512; e += 256) mix[(size_t)bt * D_MODEL + e] = sout[e >> 6][e & 63];
}

__global__ __launch_bounds__(256) void nk_gla(const float* proj, const float* w_a2, const float* b_a2, float* ograw) {
    __shared__ float sqv[64], skv[64], sav[64];
    __shared__ float red[8][32];
    const int tid = threadIdx.x;
    const int es = blockIdx.x & 3, bh = blockIdx.x >> 2, h = bh & 3, b = bh >> 2;
    const int e = tid & 31, dg = tid >> 5;
    float S[8];
    for (int i = 0; i < 8; ++i) S[i] = 0.f;
    for (int t = 0; t < SEQ; ++t) {
        const float* prow = proj + ((size_t)b * SEQ + t) * IN_COLS;
        if (tid < 64) {
            int d = tid;
            sqv[d] = prow[C_GQ + h * 64 + d] * 0.125f;
            skv[d] = prow[C_GK + h * 64 + d];
            float x = b_a2[h * 64 + d];
            for (int r = 0; r < 16; ++r) x += prow[C_GLR + r] * w_a2[r * 256 + h * 64 + d];
            float ls = -(fmaxf(-x, 0.f) + log1pf(__expf(-fabsf(x))));
            sav[d] = __expf(ls * (1.f / 16.f));
        }
        __syncthreads();
        float v = prow[C_GV + h * 128 + es * 32 + e];
        float part = 0.f;
        for (int i = 0; i < 8; ++i) {
            int d = dg * 8 + i;
            S[i] = sav[d] * S[i] + skv[d] * v;
            part += sqv[d] * S[i];
        }
        red[dg][e] = part;
        __syncthreads();
        if (tid < 32) {
            float o = 0.f;
            for (int i = 0; i < 8; ++i) o += red[i][tid];
            ograw[((size_t)b * SEQ + t) * 512 + h * 128 + es * 32 + tid] = o;
        }
    }
}
__global__ __launch_bounds__(256) void nk_gla_norm(const float* ograw, const float* proj, const float* norm_w, float* mix) {
    int wid = (blockIdx.x * 256 + threadIdx.x) >> 6; int lane = threadIdx.x & 63;
    int tok = wid >> 2, h = wid & 3;
    const float* o = ograw + (size_t)tok * 512 + h * 128;
    float a = o[lane], c = o[lane + 64];
    float s = a + c;
    for (int m = 32; m > 0; m >>= 1) s += __shfl_xor(s, m);
    float mu = s * (1.f / 128.f);
    float q = (a - mu) * (a - mu) + (c - mu) * (c - mu);
    for (int m = 32; m > 0; m >>= 1) q += __shfl_xor(q, m);
    float rstd = rsqrtf(q * (1.f / 128.f) + 1e-5f);
    const float* r = proj + (size_t)tok * IN_COLS + C_GR + h * 128;
    mix[(size_t)tok * D_MODEL + 512 + h * 128 + lane] = (a - mu) * rstd * norm_w[lane] * siluf(r[lane]);
    mix[(size_t)tok * D_MODEL + 512 + h * 128 + lane + 64] = (c - mu) * rstd * norm_w[lane + 64] * siluf(r[lane + 64]);
}

__global__ __launch_bounds__(256) void nk_route(const float* logits, const float* rbias, int* eidx, float* ew, int* counts, int* lists) {
    int wid = (blockIdx.x * 256 + threadIdx.x) >> 6; int lane = threadIdx.x & 63;
    int tok = wid;
    float s[4], sb[4];
    for (int i = 0; i < 4; ++i) { float l = logits[(size_t)tok * 256 + lane * 4 + i]; s[i] = 1.f / (1.f + __expf(-l)); sb[i] = s[i] + rbias[lane * 4 + i]; }
    float m1 = NEGF, m2 = NEGF;
    for (int i = 0; i < 4; ++i) { float v = sb[i]; if (v > m1) { m2 = m1; m1 = v; } else if (v > m2) m2 = v; }
    for (int m = 1; m < 8; m <<= 1) {
        float o1 = __shfl_xor(m1, m), o2 = __shfl_xor(m2, m);
        float n1 = fmaxf(m1, o1);
        float n2 = fmaxf(fminf(m1, o1), fmaxf(m2, o2));
        m1 = n1; m2 = n2;
    }
    float gs = m1 + m2;
    int grp = lane >> 3;
    int grank = 0;
    for (int g2 = 0; g2 < 8; ++g2) { float o = __shfl(gs, g2 * 8); if (o > gs || (o == gs && g2 < grp)) ++grank; }
    bool gsel = grank < 4;
    float cand[4];
    for (int i = 0; i < 4; ++i) cand[i] = gsel ? sb[i] : NEGF;
    float wsum = 0.f; float myw = 0.f; int mye = 0;
    for (int k = 0; k < TOPK; ++k) {
        float bv = cand[0]; int bi = 0;
        for (int i = 1; i < 4; ++i) if (cand[i] > bv) { bv = cand[i]; bi = i; }
        int be = lane * 4 + bi;
        float gv = bv; int ge = be;
        for (int m = 1; m < 64; m <<= 1) {
            float ov = __shfl_xor(gv, m); int oe = __shfl_xor(ge, m);
            if (ov > gv || (ov == gv && oe < ge)) { gv = ov; ge = oe; }
        }
        float sel_s = 0.f;
        if ((ge >> 2) == lane) {
            int i = ge & 3;
            sel_s = (i == 0) ? s[0] : (i == 1) ? s[1] : (i == 2) ? s[2] : s[3];
            if (i == 0) cand[0] = -3e38f; else if (i == 1) cand[1] = -3e38f; else if (i == 2) cand[2] = -3e38f; else cand[3] = -3e38f;
        }
        sel_s = __shfl(sel_s, ge >> 2);
        wsum += sel_s;
        if (lane == k) { myw = sel_s; mye = ge; }
    }
    if (lane < TOPK) {
        float w = myw / wsum * 2.5f;
        eidx[tok * 8 + lane] = mye; ew[tok * 8 + lane] = w;
        int pos = atomicAdd(&counts[mye], 1);
        lists[(size_t)mye * NTOK + pos] = tok * 8 + lane;
    }
}

__global__ __launch_bounds__(256) void nk_moe(const float* h2, const float* wg, const float* wu, const float* wd,
                                              const float* sg, const float* su, const float* sd,
                                              const int* counts, const int* lists, const float* ew, float* acc) {
    __shared__ float sh[8][D_MODEL];
    __shared__ float shid[8][256];
    __shared__ int stok[8]; __shared__ float sw[8];
    const int e = blockIdx.y, chunk = blockIdx.x, tid = threadIdx.x;
    const int cnt = (e == N_EXP) ? NTOK : counts[e];
    if (chunk * 8 >= cnt) return;
    const float* Wg = (e == N_EXP) ? sg : wg + (size_t)e * D_MODEL * 256;
    const float* Wu = (e == N_EXP) ? su : wu + (size_t)e * D_MODEL * 256;
    const float* Wd = (e == N_EXP) ? sd : wd + (size_t)e * 256 * D_MODEL;
    if (tid < 8) {
        int p = chunk * 8 + tid;
        if (p < cnt) {
            if (e == N_EXP) { stok[tid] = p; sw[tid] = 1.f; }
            else { int id = lists[(size_t)e * NTOK + p]; stok[tid] = id >> 3; sw[tid] = ew[id]; }
        } else { stok[tid] = -1; sw[tid] = 0.f; }
    }
    __syncthreads();
    for (int m = 0; m < 8; ++m) {
        int tk = stok[m];
        for (int k = tid; k < D_MODEL; k += 256) sh[m][k] = (tk >= 0) ? h2[(size_t)tk * D_MODEL + k] : 0.f;
    }
    __syncthreads();
    float ag[8], au[8];
#pragma unroll
    for (int m = 0; m < 8; ++m) { ag[m] = 0.f; au[m] = 0.f; }
    for (int k = 0; k < D_MODEL; ++k) {
        float g = Wg[(size_t)k * 256 + tid], u = Wu[(size_t)k * 256 + tid];
#pragma unroll
        for (int m = 0; m < 8; ++m) { float hv = sh[m][k]; ag[m] += hv * g; au[m] += hv * u; }
    }
#pragma unroll
    for (int m = 0; m < 8; ++m) shid[m][tid] = siluf(ag[m]) * au[m];
    __syncthreads();
    for (int jj = 0; jj < 4; ++jj) {
        int j = tid + 256 * jj;
        float ao[8];
#pragma unroll
        for (int m = 0; m < 8; ++m) ao[m] = 0.f;
        for (int n = 0; n < 256; ++n) {
            float w = Wd[(size_t)n * D_MODEL + j];
#pragma unroll
            for (int m = 0; m < 8; ++m) ao[m] += shid[m][n] * w;
        }
#pragma unroll
        for (int m = 0; m < 8; ++m) { int tk = stok[m]; if (tk >= 0) atomicAdd(&acc[(size_t)tk * D_MODEL + j], ao[m] * sw[m]); }
    }
}

#endif
typedef unsigned short bf16_t;
typedef short bf16x8 __attribute__((ext_vector_type(8)));
typedef float f32x4 __attribute__((ext_vector_type(4)));
typedef unsigned u32x4 __attribute__((ext_vector_type(4)));
typedef unsigned u32x2 __attribute__((ext_vector_type(2)));

#define PCOLS 2944
#define P_NQ 0
#define P_KC 512
#define P_VC 640
#define P_KS 768
#define P_VS 896
#define P_KW 1024
#define P_VW 1152
#define P_GQ 1280
#define P_GK 1536
#define P_GV 1792
#define P_GR 2304
#define P_MISC 2816
#define NASSIGN 9
#define LOG2E 1.4426950408889634f

typedef float f32x2_t __attribute__((ext_vector_type(2)));
typedef __bf16 bf16x2_t __attribute__((ext_vector_type(2)));
__device__ __forceinline__ unsigned pk_bf16(float lo, float hi) { const f32x2_t v = {lo, hi}; return __builtin_bit_cast(unsigned, __builtin_convertvector(v, bf16x2_t)); }
__device__ __forceinline__ float bflo(unsigned u) { return __uint_as_float(u << 16); }
__device__ __forceinline__ float bfhi(unsigned u) { return __uint_as_float(u & 0xffff0000u); }
__device__ __forceinline__ float bf2f(bf16_t v) { return __uint_as_float(((unsigned)v) << 16); }
__device__ __forceinline__ int opaque_tid() { int t = threadIdx.x; asm volatile("" : "+v"(t)); return t; }
__device__ __forceinline__ bf16_t f2bf(float f) { return (bf16_t)(pk_bf16(f, 0.f) & 0xffffu); }

#if DBG
#define WS_BASE ((size_t)560 << 20)
#else
#define WS_BASE ((size_t)0)
#endif
#define WS_ALIGN(x) (((size_t)(x) + 255) & ~(size_t)255)
constexpr size_t OFF_mod = WS_BASE;
constexpr size_t OFF_bias1 = OFF_mod + WS_ALIGN(4*6144*4);
constexpr size_t OFF_wint = OFF_bias1 + WS_ALIGN(2*256*4);
constexpr size_t OFF_wot = OFF_wint + WS_ALIGN((size_t)PCOLS*1024*2);
constexpr size_t OFF_wrt = OFF_wot + WS_ALIGN((size_t)1024*1024*2);
constexpr size_t OFF_w1t = OFF_wrt + WS_ALIGN((size_t)256*1024*2);
constexpr size_t OFF_w2t = OFF_w1t + WS_ALIGN((size_t)2*256*2048*2);
constexpr size_t OFF_hb = OFF_w2t + WS_ALIGN((size_t)2*64*256*2);
constexpr size_t OFF_Pb = OFF_hb + WS_ALIGN((size_t)NTOK*1024*2);
constexpr size_t OFF_VsT = OFF_Pb + WS_ALIGN((size_t)NTOK*PCOLS*2);
constexpr size_t OFF_VwT = OFF_VsT + WS_ALIGN((size_t)BATCH*128*SEQ*2);
constexpr size_t OFF_VgT = OFF_VwT + WS_ALIGN((size_t)BATCH*128*SEQ*2);
constexpr size_t OFF_misc = OFF_VgT + WS_ALIGN((size_t)BATCH*512*SEQ*2);
constexpr size_t OFF_cpart = OFF_misc + WS_ALIGN((size_t)NTOK*64*4);
constexpr size_t OFF_kc = OFF_cpart + WS_ALIGN((size_t)2*4*2048*256*4);
constexpr size_t OFF_vcT = OFF_kc + WS_ALIGN((size_t)8*256*64*2);
constexpr size_t OFF_dST = OFF_vcT + WS_ALIGN((size_t)8*64*256*2);
constexpr size_t OFF_dec = OFF_dST + WS_ALIGN((size_t)16*64*8192*4);
constexpr size_t OFF_ST = OFF_dec + WS_ALIGN((size_t)16*64*64*4);
constexpr size_t OFF_mixf = OFF_ST + WS_ALIGN((size_t)16*64*8192*2);
constexpr size_t OFF_mixb = OFF_mixf + WS_ALIGN((size_t)NTOK*512*4);
constexpr size_t OFF_y1 = OFF_mixb + WS_ALIGN((size_t)NTOK*1024*2);
constexpr size_t OFF_x1 = OFF_y1 + WS_ALIGN((size_t)NTOK*1024*4);
constexpr size_t OFF_logits = OFF_x1 + WS_ALIGN((size_t)NTOK*1024*4);
constexpr size_t OFF_ew = OFF_logits + WS_ALIGN((size_t)NTOK*256*4);
constexpr size_t OFF_counts = OFF_ew + WS_ALIGN((size_t)NTOK*NASSIGN*4);
constexpr size_t OFF_lists = OFF_counts + WS_ALIGN(512*4);
constexpr size_t OFF_bar = OFF_lists + WS_ALIGN((size_t)N_EXP*NTOK*4);
constexpr size_t OFF_hid = OFF_bar + WS_ALIGN(4096*4);
constexpr size_t OFF_outk = OFF_hid + WS_ALIGN((size_t)NTOK*NASSIGN*256*2);
constexpr size_t OFF_selm = OFF_outk + WS_ALIGN((size_t)NTOK*NASSIGN*1024*2);
constexpr size_t OFF_selu = OFF_selm + WS_ALIGN((size_t)NTOK*2*8);
constexpr size_t OFF_mixf2 = OFF_selu + WS_ALIGN((size_t)8*64*4*8);
constexpr size_t WS_TOTAL = OFF_mixf2 + WS_ALIGN((size_t)NTOK*512*4);
struct Params {
    const float *x, *c, *w_mod, *b_mod, *w_in, *pos_k, *w1_k, *w2_k, *pos_v, *w1_v, *w2_v, *w_a2, *b_a2, *norm_w, *w_o, *ln1_g, *ln1_b,
        *w_router, *rbias, *w_e_gate, *w_e_up, *w_e_down, *w_s_gate, *w_s_up, *w_s_down, *ln2_g, *ln2_b;
    float* out;
    char* ws;
    int ph_lo, ph_hi;
    __device__ __forceinline__ float* mod() const { return (float*)(ws + OFF_mod); }
    __device__ __forceinline__ float* bias1() const { return (float*)(ws + OFF_bias1); }
    __device__ __forceinline__ bf16_t* wint() const { return (bf16_t*)(ws + OFF_wint); }
    __device__ __forceinline__ bf16_t* wot() const { return (bf16_t*)(ws + OFF_wot); }
    __device__ __forceinline__ bf16_t* wrt() const { return (bf16_t*)(ws + OFF_wrt); }
    __device__ __forceinline__ bf16_t* w1t() const { return (bf16_t*)(ws + OFF_w1t); }
    __device__ __forceinline__ bf16_t* w2t() const { return (bf16_t*)(ws + OFF_w2t); }
    __device__ __forceinline__ bf16_t* hb() const { return (bf16_t*)(ws + OFF_hb); }
    __device__ __forceinline__ bf16_t* Pb() const { return (bf16_t*)(ws + OFF_Pb); }
    __device__ __forceinline__ bf16_t* VsT() const { return (bf16_t*)(ws + OFF_VsT); }
    __device__ __forceinline__ bf16_t* VwT() const { return (bf16_t*)(ws + OFF_VwT); }
    __device__ __forceinline__ bf16_t* VgT() const { return (bf16_t*)(ws + OFF_VgT); }
    __device__ __forceinline__ float* misc() const { return (float*)(ws + OFF_misc); }
    __device__ __forceinline__ float* cpart() const { return (float*)(ws + OFF_cpart); }
    __device__ __forceinline__ bf16_t* kc() const { return (bf16_t*)(ws + OFF_kc); }
    __device__ __forceinline__ bf16_t* vcT() const { return (bf16_t*)(ws + OFF_vcT); }
    __device__ __forceinline__ float* dST() const { return (float*)(ws + OFF_dST); }
    __device__ __forceinline__ float* dec() const { return (float*)(ws + OFF_dec); }
    __device__ __forceinline__ bf16_t* ST() const { return (bf16_t*)(ws + OFF_ST); }
    __device__ __forceinline__ float* mixf() const { return (float*)(ws + OFF_mixf); }
    __device__ __forceinline__ bf16_t* mixb() const { return (bf16_t*)(ws + OFF_mixb); }
    __device__ __forceinline__ float* y1() const { return (float*)(ws + OFF_y1); }
    __device__ __forceinline__ float* x1() const { return (float*)(ws + OFF_x1); }
    __device__ __forceinline__ float* logits() const { return (float*)(ws + OFF_logits); }
    __device__ __forceinline__ float* ew() const { return (float*)(ws + OFF_ew); }
    __device__ __forceinline__ int* counts() const { return (int*)(ws + OFF_counts); }
    __device__ __forceinline__ int* lists() const { return (int*)(ws + OFF_lists); }
    __device__ __forceinline__ unsigned* bar() const { return (unsigned*)(ws + OFF_bar); }
    __device__ __forceinline__ bf16_t* hid() const { return (bf16_t*)(ws + OFF_hid); }
    __device__ __forceinline__ bf16_t* outk() const { return (bf16_t*)(ws + OFF_outk); }
};

#define LDS_ROW 72
#define TILE_BYTES 16384
#define GEMM_SMEM 69632
__device__ __forceinline__ int swz_key(int row) { return ((row >> 2) & 1) | ((((row >> 1) ^ (row >> 3)) & 1) << 1) | ((((row >> 2) ^ (row >> 4)) & 1) << 2); }
__device__ __forceinline__ int swz_off(int row, int chunk) { return row * 128 + ((chunk ^ swz_key(row)) << 4); }
typedef __attribute__((address_space(3))) unsigned lds_u32;

struct RowsBf16 {
    static constexpr bool NT = false;
    const bf16_t* base; size_t stride;
    __device__ __forceinline__ const bf16_t* ptr(int r, int k) const { return base + (size_t)r * stride + k; }
    __device__ __forceinline__ const bf16_t* pp(int i, int tid, int k) const { return ptr(i * 32 + (tid >> 3), k); }
};
struct GatherBf16 {
    static constexpr bool NT = true;
    const bf16_t* base; size_t stride; const int* rowidx;
    __device__ __forceinline__ const bf16_t* ptr(int r, int k) const { return base + (size_t)rowidx[r] * stride + k; }
    __device__ __forceinline__ const bf16_t* pp(int i, int tid, int k) const { return ptr(i * 32 + (tid >> 3), k); }
};
struct BF32Plain {
    const float* base; size_t ld;
    __device__ __forceinline__ f32x4 load4(int k, int r4) const { return *(const f32x4*)(base + (size_t)k * ld + r4); }
};
struct BF32GateUp {
    const float* g; long du; size_t ld;
    __device__ __forceinline__ f32x4 load4(int k, int r4) const {
        const long sel = ((r4 >> 5) & 1) ? du : 0l;
#ifdef NT_B
        return __builtin_nontemporal_load((const f32x4*)(g + sel + (size_t)k * ld + (r4 >> 6) * 32 + (r4 & 31)));
#else
        return *(const f32x4*)(g + sel + (size_t)k * ld + (r4 >> 6) * 32 + (r4 & 31));
#endif
    }
};

template <class L>
__device__ __forceinline__ void bf16_piece_load(u32x4& r, const L& ld, int k0, int i, int tid) { r = *(const u32x4*)ld.pp(i, tid, k0 + ((tid & 7) << 3)); }
__device__ __forceinline__ void bf16_piece_write(const u32x4& r, char* tile, int i, int tid) { *(u32x4*)(tile + swz_off(i * 32 + (tid >> 3), tid & 7)) = r; }
template <int J0, class BL>
__device__ __forceinline__ void f32_rows_load(f32x4 (&r)[8], const BL& bl, int k0, int tid) {
    const int kg = (tid >> 5) * 8, n4 = (tid & 31) * 4;
#pragma unroll
    for (int j = 0; j < 4; ++j) r[J0 + j] = bl.load4(k0 + kg + J0 + j, n4);
}
template <int I>
__device__ __forceinline__ void f32_col_write(const f32x4 (&r)[8], char* tile, int tid) {
    const int kgc = tid >> 5, n4 = (tid & 31) * 4;
    u32x4 w;
    w.x = pk_bf16(r[0][I], r[1][I]); w.y = pk_bf16(r[2][I], r[3][I]);
    w.z = pk_bf16(r[4][I], r[5][I]); w.w = pk_bf16(r[6][I], r[7][I]);
    *(u32x4*)(tile + swz_off(n4 + I, kgc)) = w;
}

#ifdef USE_SETPRIO
#define SETPRIO_HI __builtin_amdgcn_s_setprio(1);
#define SETPRIO_LO __builtin_amdgcn_s_setprio(0);
#else
#define SETPRIO_HI
#define SETPRIO_LO
#endif
template <bool SWAP, bool BF32, class AL, class BL, class EPI>
__device__ __forceinline__ void gemm_core(const AL& al, const BL& bl, int k_begin, int nk, int nkt, char* smem, f32x4 (&acc)[4][4], EPI&& epi) {
    const int tid = opaque_tid(), lane = tid & 63, wid = tid >> 6, wr = wid >> 1, wc = wid & 1, fr = lane & 15, fq = lane >> 4;
#pragma unroll
    for (int m = 0; m < 4; ++m)
#pragma unroll
        for (int n = 0; n < 4; ++n) acc[m][n] = (f32x4){0.f, 0.f, 0.f, 0.f};
    u32x4 ra[4]; u32x4 rb[4]; f32x4 rbf[8];
#pragma unroll
    for (int i = 0; i < 4; ++i) { bf16_piece_load(ra[i], al, k_begin, i, tid); if constexpr (!BF32) bf16_piece_load(rb[i], bl, k_begin, i, tid); }
    if constexpr (BF32) { f32_rows_load<0>(rbf, bl, k_begin, tid); f32_rows_load<4>(rbf, bl, k_begin, tid); }
#pragma unroll
    for (int i = 0; i < 4; ++i) { bf16_piece_write(ra[i], smem, i, tid); if constexpr (!BF32) bf16_piece_write(rb[i], smem + TILE_BYTES, i, tid); }
    if constexpr (BF32) { f32_col_write<0>(rbf, smem + TILE_BYTES, tid); f32_col_write<1>(rbf, smem + TILE_BYTES, tid); f32_col_write<2>(rbf, smem + TILE_BYTES, tid); f32_col_write<3>(rbf, smem + TILE_BYTES, tid); }
    if (nk > 1) {
#pragma unroll
        for (int i = 0; i < 4; ++i) { bf16_piece_load(ra[i], al, k_begin + 64, i, tid); if constexpr (!BF32) bf16_piece_load(rb[i], bl, k_begin + 64, i, tid); }
        if constexpr (BF32) { f32_rows_load<0>(rbf, bl, k_begin + 64, tid); f32_rows_load<4>(rbf, bl, k_begin + 64, tid); }
    }
    __syncthreads();
    int tile = 0, kin = 0;
    for (int kt = 0; kt < nk; ++kt) {
        const char* sA = smem + (kt & 1) * 2 * TILE_BYTES; const char* sB = sA + TILE_BYTES;
        char* nA = smem + ((kt & 1) ^ 1) * 2 * TILE_BYTES; char* nB = nA + TILE_BYTES;
        const bool w1 = kt + 1 < nk, l2 = kt + 2 < nk;
        const int k2 = k_begin + (kt + 2) * 64;
        bf16x8 a[2][4], b[2][4];
#pragma unroll
        for (int ks = 0; ks < 2; ++ks) {
#pragma unroll
            for (int m = 0; m < 4; ++m) a[ks][m] = *(const bf16x8*)(sA + swz_off(wr * 64 + m * 16 + fr, ks * 4 + fq));
#pragma unroll
            for (int n = 0; n < 4; ++n) b[ks][n] = *(const bf16x8*)(sB + swz_off(wc * 64 + n * 16 + fr, ks * 4 + fq));
        }
#define GEMM_GROUP(G) { \
            constexpr int ks = (G) >> 1, m0 = ((G) & 1) * 2; \
            __builtin_amdgcn_sched_barrier(0); \
            SETPRIO_HI \
            _Pragma("unroll") for (int m = m0; m < m0 + 2; ++m) \
            _Pragma("unroll") for (int n = 0; n < 4; ++n) \
                acc[m][n] = SWAP ? __builtin_amdgcn_mfma_f32_16x16x32_bf16(b[ks][n], a[ks][m], acc[m][n], 0, 0, 0) \
                                 : __builtin_amdgcn_mfma_f32_16x16x32_bf16(a[ks][m], b[ks][n], acc[m][n], 0, 0, 0); \
            SETPRIO_LO \
            __builtin_amdgcn_sched_barrier(0); \
            if (w1) bf16_piece_write(ra[G], nA, G, tid); \
            if (l2) bf16_piece_load(ra[G], al, k2, G, tid); \
            if constexpr (BF32) { \
                if constexpr ((G) == 0) { if (w1) { f32_col_write<0>(rbf, nB, tid); f32_col_write<1>(rbf, nB, tid); } } \
                if constexpr ((G) == 1) { if (w1) { f32_col_write<2>(rbf, nB, tid); f32_col_write<3>(rbf, nB, tid); } } \
                if constexpr ((G) == 2) { if (l2) f32_rows_load<0>(rbf, bl, k2, tid); } \
                if constexpr ((G) == 3) { if (l2) f32_rows_load<4>(rbf, bl, k2, tid); } \
            } else { \
                if (w1) bf16_piece_write(rb[G], nB, G, tid); \
                if (l2) bf16_piece_load(rb[G], bl, k2, G, tid); \
            } }
        GEMM_GROUP(0) GEMM_GROUP(1) GEMM_GROUP(2) GEMM_GROUP(3)
#undef GEMM_GROUP
        kin += 1;
        if (kin == nkt && kt + 1 < nk) {
            epi(tile, acc);
            tile += 1; kin = 0;
#pragma unroll
            for (int m = 0; m < 4; ++m)
#pragma unroll
                for (int n = 0; n < 4; ++n) acc[m][n] = (f32x4){0.f, 0.f, 0.f, 0.f};
        }
        __syncthreads();
    }
    epi(tile, acc);
}
struct NoEpi { __device__ __forceinline__ void operator()(int, const f32x4 (&)[4][4]) const {} };
template <bool SWAP, bool BF32, class AL, class BL>
__device__ __forceinline__ void gemm_128(const AL& al, const BL& bl, int k_begin, int nk, char* smem, f32x4 (&acc)[4][4]) {
    gemm_core<SWAP, BF32>(al, bl, k_begin, nk, nk, smem, acc, NoEpi());
}

__device__ __forceinline__ int xcd_of(const char* smem) { return (int)(((const unsigned*)(smem + GEMM_SMEM + 2048))[4] & 7u); }
__device__ __forceinline__ int rank_of(const char* smem) { return (int)((const unsigned*)(smem + GEMM_SMEM + 2048))[5]; }
__device__ __forceinline__ int nranks_of(const char* smem) { int n = (int)((const unsigned*)(smem + GEMM_SMEM + 2048))[6]; return n > 0 ? n : 1; }
template <int NB, bool SILU>
__device__ __forceinline__ void gemv_item(const float* in, const float* W, int ldw, const float* bias, float* out, int ldo, int K, int col0, float* sm) {
    const int tid = opaque_tid();
    for (int i = tid; i < NB * K; i += 256) { float v = in[i]; sm[i] = SILU ? v / (1.f + __expf(-v)) : v; }
    __syncthreads();
    float acc[NB];
#pragma unroll
    for (int b = 0; b < NB; ++b) acc[b] = 0.f;
    const int kq = tid >> 6, cl = tid & 63; const int kb = kq * (K / 4);
    for (int k = kb; k < kb + K / 4; k += 16) {
        float w[16];
#pragma unroll
        for (int u = 0; u < 16; ++u) w[u] = W[(size_t)(k + u) * ldw + col0 + cl];
#pragma unroll
        for (int u = 0; u < 16; ++u)
#pragma unroll
            for (int b = 0; b < NB; ++b) acc[b] += sm[b * K + k + u] * w[u];
    }
    float* red = sm + NB * K;
#pragma unroll
    for (int b = 0; b < NB; ++b) red[(kq * NB + b) * 64 + cl] = acc[b];
    __syncthreads();
    if (tid < 64 * NB) {
        int b = tid >> 6, cc = tid & 63;
        float s = red[(0 * NB + b) * 64 + cc] + red[(1 * NB + b) * 64 + cc] + red[(2 * NB + b) * 64 + cc] + red[(3 * NB + b) * 64 + cc];
        out[b * ldo + col0 + cc] = s + (bias ? bias[col0 + cc] : 0.f);
    }
    __syncthreads();
}

__device__ __forceinline__ int win_srccol(int n) {
    if (n < 1280) return n;
    if (n < 2304) return n + 24;
    if (n < 2816) return n + 40;
    if (n < 2840) return n - 2816 + 1280;
    if (n < 2856) return n - 2840 + 2328;
    return -1;
}
template <bool PERM>
__device__ __forceinline__ void transpose_item(const float* W, int ldw, int K, bf16_t* out, int k0, int n0, float* sm) {
    const int tid = opaque_tid();
    f32x4 v[4];
#pragma unroll
    for (int i = 0; i < 4; ++i) {
        const int c = tid + 256 * i, kk = c >> 4, nn = (c & 15) * 4;
        const int src = PERM ? win_srccol(n0 + nn) : (n0 + nn);
        v[i] = (src >= 0) ? *(const f32x4*)(W + (size_t)(k0 + kk) * ldw + src) : (f32x4){0.f, 0.f, 0.f, 0.f};
    }
#pragma unroll
    for (int i = 0; i < 4; ++i) {
        const int c = tid + 256 * i, kk = c >> 4, nn = (c & 15) * 4;
#pragma unroll
        for (int j = 0; j < 4; ++j) sm[(nn + j) * 65 + kk] = v[i][j];
    }
    __syncthreads();
#pragma unroll
    for (int i = 0; i < 2; ++i) {
        const int c = tid + 256 * i, nn = c >> 3, kc = (c & 7) * 8;
        const float* r = sm + nn * 65 + kc;
        u32x4 w;
        w.x = pk_bf16(r[0], r[1]); w.y = pk_bf16(r[2], r[3]); w.z = pk_bf16(r[4], r[5]); w.w = pk_bf16(r[6], r[7]);
        *(u32x4*)(out + (size_t)(n0 + nn) * K + k0 + kc) = w;
    }
    __syncthreads();
}

__device__ void phase0(const Params& p, char* smem) {
    float* sm = (float*)smem;
    const int nb = gridDim.x, bid = blockIdx.x;
    const int I_MOD = 96, I_B1 = 8, I_WIN = 16 * 46, I_WO = 256, I_WR = 64, I_W1 = 2 * 32 * 4, I_W2 = 2 * 4;
    const int total = I_MOD + I_B1 + I_WIN + I_WO + I_WR + I_W1 + I_W2;
    if (bid == 0 && opaque_tid() < 64) p.counts()[264 + opaque_tid()] = 0;
    if (bid == 1) for (int i = opaque_tid(); i < 264; i += 256) p.counts()[i] = 0;
    for (int it = bid; it < total; it += nb) {
        int i = it;
        if (i < I_MOD) { gemv_item<4, true>(p.c, p.w_mod, 6144, p.b_mod, p.mod(), 6144, 1024, i * 64, sm); continue; }
        i -= I_MOD;
        if (i < I_B1) { int kv = i >> 2; gemv_item<1, false>(kv ? p.pos_v : p.pos_k, kv ? p.w1_v : p.w1_k, 256, nullptr, p.bias1() + kv * 256, 256, 2048, (i & 3) * 64, sm); continue; }
        i -= I_B1;
        if (i < I_WIN) { transpose_item<true>(p.w_in, IN_COLS, 1024, p.wint(), (i % 16) * 64, (i / 16) * 64, sm); continue; }
        i -= I_WIN;
        if (i < I_WO) { transpose_item<false>(p.w_o, 1024, 1024, p.wot(), (i % 16) * 64, (i / 16) * 64, sm); continue; }
        i -= I_WO;
        if (i < I_WR) { transpose_item<false>(p.w_router, 256, 1024, p.wrt(), (i % 16) * 64, (i / 16) * 64, sm); continue; }
        i -= I_WR;
        if (i < I_W1) { int kv = i >> 7; int j = i & 127; transpose_item<false>(kv ? p.w1_v : p.w1_k, 256, 2048, p.w1t() + (size_t)kv * 256 * 2048, (j % 32) * 64, (j / 32) * 64, sm); continue; }
        i -= I_W1;
        { int kv = i >> 2; int j = i & 3; transpose_item<false>(kv ? p.w2_v : p.w2_k, 64, 256, p.w2t() + (size_t)kv * 64 * 256, j * 64, 0, sm); }
    }
}

__device__ __forceinline__ float wave_sum(float v) {
#pragma unroll
    for (int m = 32; m > 0; m >>= 1) v += __shfl_xor(v, m);
    return v;
}
__device__ void phase1(const Params& p) {
    const int lane = opaque_tid() & 63, gw = blockIdx.x * 4 + (opaque_tid() >> 6), nw = gridDim.x * 4;
    for (int row0 = gw * 2; row0 < NTOK; row0 += nw * 2) {
        f32x4 v[2][4]; float s[2];
#pragma unroll
        for (int r = 0; r < 2; ++r) {
            const float* xr = p.x + (size_t)(row0 + r) * D_MODEL;
            s[r] = 0.f;
#pragma unroll
            for (int i = 0; i < 4; ++i) v[r][i] = *(const f32x4*)(xr + i * 256 + lane * 4);
        }
        const int b = row0 / SEQ;
        const float* md = p.mod() + b * 6144;
#pragma unroll
        for (int r = 0; r < 2; ++r) {
#pragma unroll
            for (int i = 0; i < 4; ++i) s[r] += (v[r][i][0] + v[r][i][1]) + (v[r][i][2] + v[r][i][3]);
            const float mu = wave_sum(s[r]) * (1.f / D_MODEL);
            float q = 0.f;
#pragma unroll
            for (int i = 0; i < 4; ++i)
#pragma unroll
                for (int j = 0; j < 4; ++j) { float d = v[r][i][j] - mu; q += d * d; }
            const float rstd = rsqrtf(wave_sum(q) * (1.f / D_MODEL) + 1e-5f);
#pragma unroll
            for (int i = 0; i < 4; ++i) {
                const int col = i * 256 + lane * 4;
                f32x4 sh = *(const f32x4*)(md + 0 + col), sc = *(const f32x4*)(md + 1024 + col);
                float o[4];
#pragma unroll
                for (int j = 0; j < 4; ++j) o[j] = (v[r][i][j] - mu) * rstd * (1.f + sc[j]) + sh[j];
                u32x2 w; w.x = pk_bf16(o[0], o[1]); w.y = pk_bf16(o[2], o[3]);
                *(u32x2*)(p.hb() + (size_t)(row0 + r) * D_MODEL + col) = w;
            }
        }
    }
}

__device__ void phase2(const Params& p, char* smem) {
    const int xcd = xcd_of(smem), rank = rank_of(smem), nranks = nranks_of(smem);
    const int lane = opaque_tid() & 63, wid = opaque_tid() >> 6, wr = wid >> 1, wc = wid & 1, fr = lane & 15, fq = lane >> 4;
#ifndef P2_REP
#define P2_REP 1
#endif
    for (int it0 = rank; it0 < 16 * 23 * P2_REP; it0 += nranks) {
        const int it = it0 % (16 * 23);
        const int mt = (it / 23) * 8 + xcd, nt = it % 23;
        const int row0 = mt * 128, col0 = nt * 128;
        RowsBf16 al{p.hb() + (size_t)row0 * D_MODEL, D_MODEL};
        RowsBf16 bl{p.wint() + (size_t)col0 * D_MODEL, D_MODEL};
        f32x4 acc[4][4];
        const bool transposed = (nt == 7) || (nt == 9) || (nt >= 14 && nt < 18);
        if (transposed) {
            gemm_128<false, false>(al, bl, 0, 16, smem, acc);
            const int b = row0 / SEQ, t0 = row0 % SEQ;
            bf16_t* base; int rows_per;
            if (nt == 7) base = p.VsT() + (size_t)b * 128 * SEQ;
            else if (nt == 9) base = p.VwT() + (size_t)b * 128 * SEQ;
            else base = p.VgT() + ((size_t)b * 4 + (nt - 14)) * 128 * SEQ;
            (void)rows_per;
#pragma unroll
            for (int m = 0; m < 4; ++m)
#pragma unroll
                for (int n = 0; n < 4; ++n) {
                    const int feat = wc * 64 + n * 16 + fr, tok = t0 + wr * 64 + m * 16 + fq * 4;
                    u32x2 w; w.x = pk_bf16(acc[m][n][0], acc[m][n][1]); w.y = pk_bf16(acc[m][n][2], acc[m][n][3]);
                    *(u32x2*)(base + (size_t)feat * SEQ + tok) = w;
                }
        } else {
            gemm_128<true, false>(al, bl, 0, 16, smem, acc);
            if (nt == 22) {
                if (wc == 0) {
#pragma unroll
                    for (int m = 0; m < 4; ++m)
#pragma unroll
                        for (int n = 0; n < 4; ++n) {
                            const int tok = row0 + wr * 64 + m * 16 + fr, feat = n * 16 + fq * 4;
                            *(f32x4*)(p.misc() + (size_t)tok * 64 + feat) = acc[m][n];
                        }
                }
            } else {
#pragma unroll
                for (int m = 0; m < 4; ++m)
#pragma unroll
                    for (int n = 0; n < 4; ++n) {
                        const int tok = row0 + wr * 64 + m * 16 + fr, feat = col0 + wc * 64 + n * 16 + fq * 4;
                        u32x2 w; w.x = pk_bf16(acc[m][n][0], acc[m][n][1]); w.y = pk_bf16(acc[m][n][2], acc[m][n][3]);
                        *(u32x2*)(p.Pb() + (size_t)tok * PCOLS + feat) = w;
                    }
            }
        }
    }
}
struct CmpALoad {
    static constexpr bool NT = false;
    const bf16_t* Pb; int colbase; int row0;
    __device__ __forceinline__ const bf16_t* ptr(int r, int k) const {
        const int rr = row0 + r, bg = rr >> 8, i = rr & 255, b = bg >> 1, g = bg & 1;
        const int l = k >> 6, d = k & 63;
        int tok = 16 * i + l; tok = tok < SEQ ? tok : SEQ - 1;
        return Pb + ((size_t)b * SEQ + tok) * PCOLS + colbase + g * 64 + d;
    }
    __device__ __forceinline__ const bf16_t* pp(int i, int tid, int k) const { return ptr(i * 32 + (tid >> 3), k); }
};

__device__ __forceinline__ float log_sigmoid_f(float x) { return -(fmaxf(-x, 0.f) + __logf(1.f + __expf(-fabsf(x)))); }

__device__ __forceinline__ void gla_cumsum(const Params& p, int tokg0, int h, float* sb, float* sglr, float* swa, float* sqt) {
    const int tid = opaque_tid();
    for (int i = tid; i < 1024; i += 256) { int t = i >> 4, r = i & 15; sglr[i] = p.misc()[(size_t)(tokg0 + t) * 64 + 24 + r]; }
    for (int i = tid; i < 1024; i += 256) { int r = i >> 6, d = i & 63; swa[i] = p.w_a2[r * 256 + h * 64 + d]; }
    __syncthreads();
    const int d = tid & 63, tq = tid >> 6;
    const float ba = p.b_a2[h * 64 + d];
    float w[16];
#pragma unroll
    for (int r = 0; r < 16; ++r) w[r] = swa[r * 64 + d];
    float run = 0.f;
#pragma unroll
    for (int tt = 0; tt < 16; ++tt) {
        const int t = tq * 16 + tt;
        float x = ba;
#pragma unroll
        for (int r = 0; r < 16; ++r) x += sglr[t * 16 + r] * w[r];
        run += log_sigmoid_f(x) * (1.f / 16.f);
        sb[t * 64 + d] = run;
    }
    sqt[tq * 64 + d] = run;
    __syncthreads();
    float off = 0.f;
#pragma unroll
    for (int q = 0; q < 3; ++q) if (q < tq) off += sqt[q * 64 + d];
#pragma unroll
    for (int tt = 0; tt < 16; ++tt) sb[(tq * 16 + tt) * 64 + d] += off;
    __syncthreads();
}

__device__ void gla_a_item(const Params& p, int item, char* smem) {
    const int tid = opaque_tid(), lane = tid & 63, wid = tid >> 6, fr = lane & 15, fq = lane >> 4;
    const int bh = item >> 6, c = item & 63, b = bh >> 2, h = bh & 3;
    const int tok0 = c * 64, tokg0 = b * SEQ + tok0;
    float* sb = (float*)smem; float* sglr = (float*)(smem + 16384); float* swa = (float*)(smem + 20480); float* sqt = (float*)(smem + 24576);
    char* skbT = smem + 25600; char* sVT = smem + 34816;
    gla_cumsum(p, tokg0, h, sb, sglr, swa, sqt);
    {
        const int d = tid & 63, tq = tid >> 6;
        const float bl = sb[63 * 64 + d];
        float v[16];
#pragma unroll
        for (int tt = 0; tt < 16; ++tt) {
            const int s = tq * 16 + tt;
            float k = bf2f(p.Pb()[(size_t)(tokg0 + s) * PCOLS + P_GK + h * 64 + d]);
            v[tt] = k * __expf(bl - sb[s * 64 + d]);
        }
        u32x4 w0, w1;
        w0.x = pk_bf16(v[0], v[1]); w0.y = pk_bf16(v[2], v[3]); w0.z = pk_bf16(v[4], v[5]); w0.w = pk_bf16(v[6], v[7]);
        w1.x = pk_bf16(v[8], v[9]); w1.y = pk_bf16(v[10], v[11]); w1.z = pk_bf16(v[12], v[13]); w1.w = pk_bf16(v[14], v[15]);
        *(u32x4*)(skbT + (d * LDS_ROW + tq * 16) * 2) = w0;
        *(u32x4*)(skbT + (d * LDS_ROW + tq * 16 + 8) * 2) = w1;
        if (tid < 64) p.dec()[(size_t)item * 64 + d] = __expf(bl);
    }
#pragma unroll
    for (int i = 0; i < 4; ++i) {
        const int cidx = tid + 256 * i, e = cidx >> 3, ch = (cidx & 7) * 8;
        *(u32x4*)(sVT + (e * LDS_ROW + ch) * 2) = *(const u32x4*)(p.VgT() + ((size_t)bh * 128 + e) * SEQ + tok0 + ch);
    }
    __syncthreads();
    f32x4 acc[2][4];
#pragma unroll
    for (int m = 0; m < 2; ++m)
#pragma unroll
        for (int n = 0; n < 4; ++n) acc[m][n] = (f32x4){0.f, 0.f, 0.f, 0.f};
#pragma unroll
    for (int ks = 0; ks < 2; ++ks) {
        bf16x8 a[2], bb[4];
#pragma unroll
        for (int m = 0; m < 2; ++m) a[m] = *(const bf16x8*)(sVT + (((wid * 2 + m) * 16 + fr) * LDS_ROW + ks * 32 + fq * 8) * 2);
#pragma unroll
        for (int n = 0; n < 4; ++n) bb[n] = *(const bf16x8*)(skbT + ((n * 16 + fr) * LDS_ROW + ks * 32 + fq * 8) * 2);
#pragma unroll
        for (int m = 0; m < 2; ++m)
#pragma unroll
            for (int n = 0; n < 4; ++n) acc[m][n] = __builtin_amdgcn_mfma_f32_16x16x32_bf16(a[m], bb[n], acc[m][n], 0, 0, 0);
    }
    float* dst = p.dST() + (size_t)item * 8192;
#pragma unroll
    for (int m = 0; m < 2; ++m)
#pragma unroll
        for (int n = 0; n < 4; ++n)
#pragma unroll
            for (int j = 0; j < 4; ++j) dst[((wid * 2 + m) * 16 + fq * 4 + j) * 64 + n * 16 + fr] = acc[m][n][j];
    __syncthreads();
}

__device__ void phase3(const Params& p, char* smem) {
    const int lane = opaque_tid() & 63, wid = opaque_tid() >> 6, wr = wid >> 1, wc = wid & 1, fr = lane & 15, fq = lane >> 4;
    for (int it = blockIdx.x; it < 256; it += gridDim.x) {
        const int kv = it >> 7, mt = (it >> 3) & 15, nt = (it >> 2) & 1, ks = it & 3;
        CmpALoad al{p.Pb(), kv ? P_VC : P_KC, mt * 128};
        RowsBf16 bl{p.w1t() + ((size_t)kv * 256 + nt * 128) * 2048, 2048};
        f32x4 acc[4][4];
        gemm_128<true, 0>(al, bl, ks * 512, 8, smem, acc);
        float* dst = p.cpart() + ((size_t)(kv * 4 + ks) * 2048 + mt * 128) * 256 + nt * 128;
#pragma unroll
        for (int m = 0; m < 4; ++m)
#pragma unroll
            for (int n = 0; n < 4; ++n)
                *(f32x4*)(dst + (size_t)(wr * 64 + m * 16 + fr) * 256 + wc * 64 + n * 16 + fq * 4) = acc[m][n];
    }
    const int first = (blockIdx.x + gridDim.x - (256 % gridDim.x)) % gridDim.x;
    for (int it = first; it < 1024; it += gridDim.x) gla_a_item(p, it, smem);
}

#define C2_ROW 264
__device__ void cmp2_item(const Params& p, int item, char* smem) {
    const int tid = opaque_tid(), lane = tid & 63, wid = tid >> 6, fr = lane & 15, fq = lane >> 4;
    const int kv = item >> 5, r0 = (item & 31) * 64;
    char* sA = smem; char* sB = smem + 64 * C2_ROW * 2;
    const float* b1 = p.bias1() + kv * 256;
#pragma unroll 2
    for (int i = 0; i < 8; ++i) {
        const int cidx = tid + 256 * i, row = cidx >> 5, col = (cidx & 31) * 8;
        f32x4 s0 = *(const f32x4*)(b1 + col), s1 = *(const f32x4*)(b1 + col + 4);
#pragma unroll
        for (int ks = 0; ks < 4; ++ks) {
            const float* src = p.cpart() + ((size_t)(kv * 4 + ks) * 2048 + r0 + row) * 256 + col;
            s0 += *(const f32x4*)src; s1 += *(const f32x4*)(src + 4);
        }
        float o[8];
#pragma unroll
        for (int j = 0; j < 4; ++j) { o[j] = s0[j] / (1.f + __expf(-s0[j])); o[4 + j] = s1[j] / (1.f + __expf(-s1[j])); }
        u32x4 w; w.x = pk_bf16(o[0], o[1]); w.y = pk_bf16(o[2], o[3]); w.z = pk_bf16(o[4], o[5]); w.w = pk_bf16(o[6], o[7]);
        *(u32x4*)(sA + (row * C2_ROW + col) * 2) = w;
        *(u32x4*)(sB + (row * C2_ROW + col) * 2) = *(const u32x4*)(p.w2t() + ((size_t)kv * 64 + row) * 256 + col);
    }
    __syncthreads();
    f32x4 acc[4];
#pragma unroll
    for (int n = 0; n < 4; ++n) acc[n] = (f32x4){0.f, 0.f, 0.f, 0.f};
#pragma unroll
    for (int ks = 0; ks < 8; ++ks) {
        bf16x8 a = *(const bf16x8*)(sA + ((wid * 16 + fr) * C2_ROW + ks * 32 + fq * 8) * 2);
#pragma unroll
        for (int n = 0; n < 4; ++n) {
            bf16x8 bb = *(const bf16x8*)(sB + ((n * 16 + fr) * C2_ROW + ks * 32 + fq * 8) * 2);
            acc[n] = kv ? __builtin_amdgcn_mfma_f32_16x16x32_bf16(a, bb, acc[n], 0, 0, 0)
                        : __builtin_amdgcn_mfma_f32_16x16x32_bf16(bb, a, acc[n], 0, 0, 0);
        }
    }
    if (kv == 0) {
#pragma unroll
        for (int n = 0; n < 4; ++n) {
            u32x2 w; w.x = pk_bf16(acc[n][0], acc[n][1]); w.y = pk_bf16(acc[n][2], acc[n][3]);
            *(u32x2*)(p.kc() + (size_t)(r0 + wid * 16 + fr) * 64 + n * 16 + fq * 4) = w;
        }
    } else {
        const int r = r0 + wid * 16 + fq * 4, bg = r >> 8, i = r & 255;
#pragma unroll
        for (int n = 0; n < 4; ++n) {
            u32x2 w; w.x = pk_bf16(acc[n][0], acc[n][1]); w.y = pk_bf16(acc[n][2], acc[n][3]);
            *(u32x2*)(p.vcT() + ((size_t)bg * 64 + n * 16 + fr) * 256 + i) = w;
        }
    }
    __syncthreads();
}

__device__ void phase4(const Params& p, char* smem) {
    for (int it = blockIdx.x; it < 64; it += gridDim.x) cmp2_item(p, it, smem);
    const int nthreads = gridDim.x * 256;
    for (int idx = blockIdx.x * 256 + opaque_tid(); idx < 16 * 8192; idx += nthreads) {
        const int bh = idx >> 13, ed = idx & 8191, d = idx & 63;
        float S = 0.f;
        for (int c0 = 0; c0 < 64; c0 += 8) {
            float dv[8], dc[8];
#pragma unroll
            for (int u = 0; u < 8; ++u) {
                dv[u] = p.dST()[((size_t)(bh * 64 + c0 + u) << 13) + ed];
                dc[u] = p.dec()[(size_t)(bh * 64 + c0 + u) * 64 + d];
            }
#pragma unroll
            for (int u = 0; u < 8; ++u) {
                p.ST()[((size_t)(bh * 64 + c0 + u) << 13) + ed] = f2bf(S);
                S = dc[u] * S + dv[u];
            }
        }
    }
}
#define KT_BYTES (64 * LDS_ROW * 2)
#define C1_SCALE (0.125f * LOG2E)

#define MASK_BIAS (-2e30f)
__device__ __forceinline__ bf16x8 scale_frag(bf16x8 v, float c) {
    u32x4 u = __builtin_bit_cast(u32x4, v); u32x4 r;
    r.x = pk_bf16(bflo(u.x) * c, bfhi(u.x) * c); r.y = pk_bf16(bflo(u.y) * c, bfhi(u.y) * c);
    r.z = pk_bf16(bflo(u.z) * c, bfhi(u.z) * c); r.w = pk_bf16(bflo(u.w) * c, bfhi(u.w) * c);
    return __builtin_bit_cast(bf16x8, r);
}
__device__ __forceinline__ float max3f(float a, float b, float c) { return fmaxf(fmaxf(a, b), c); }
__device__ __forceinline__ float rowmax4(float x) {
    auto r = __builtin_amdgcn_permlane32_swap(__float_as_uint(x), __float_as_uint(x), false, false);
    float y = fmaxf(__uint_as_float(r[0]), __uint_as_float(r[1]));
    auto q = __builtin_amdgcn_permlane16_swap(__float_as_uint(y), __float_as_uint(y), false, false);
    return fmaxf(__uint_as_float(q[0]), __uint_as_float(q[1]));
}
template <bool PV>
__device__ __forceinline__ void flash_tile(const char* sK0, const char* sVT0, const bf16x8 (&qf)[2][2], float (&m)[2], f32x4 (&l)[2], f32x4 (&o)[2][4],
                                           float dl0, float dstride, float wlim, bool lanevalid, bool needmask, const float (&slope2)[2], int fr, int fq, bool lazy, bf16x8 ones) {
#pragma unroll 1
    for (int half = 0; half < 2; ++half) {
        const char* sK = sK0 + half * 32 * LDS_ROW * 2;
        const char* sVT = sVT0 + half * 32 * 2;
        const float dl = dl0 + dstride * (float)(half * 32);
        bf16x8 kf[2][2], vf[4];
#pragma unroll
        for (int mk = 0; mk < 2; ++mk)
#pragma unroll
            for (int ks = 0; ks < 2; ++ks) kf[mk][ks] = *(const bf16x8*)(sK + ((mk * 16 + fr) * LDS_ROW + ks * 32 + fq * 8) * 2);
        if (PV) {
#pragma unroll
            for (int md = 0; md < 4; ++md) {
                u32x2 lo = *(const u32x2*)(sVT + ((md * 16 + fr) * LDS_ROW + fq * 4) * 2);
                u32x2 hi = *(const u32x2*)(sVT + ((md * 16 + fr) * LDS_ROW + 16 + fq * 4) * 2);
                u32x4 w; w.x = lo.x; w.y = lo.y; w.z = hi.x; w.w = hi.y;
                vf[md] = __builtin_bit_cast(bf16x8, w);
            }
        }
        f32x4 s[2][2];
#pragma unroll
        for (int p = 0; p < 2; ++p) {
            const float mref = lazy ? m[p] : 0.f;
            if (needmask) {
#pragma unroll
                for (int mk = 0; mk < 2; ++mk)
#pragma unroll
                    for (int j = 0; j < 4; ++j) {
                        const float dk = dl + dstride * (float)(mk * 16 + j);
                        const bool ok = lanevalid && (dk <= 0.f) && (dk > wlim);
                        s[p][mk][j] = ok ? (slope2[p] * dk - mref) : MASK_BIAS;
                    }
            } else {
                const float sb = lanevalid ? (slope2[p] * dl - mref) : MASK_BIAS, sd = lanevalid ? slope2[p] * dstride : 0.f;
#pragma unroll
                for (int mk = 0; mk < 2; ++mk)
#pragma unroll
                    for (int j = 0; j < 4; ++j) s[p][mk][j] = sb + sd * (float)(mk * 16 + j);
            }
        }
#pragma unroll
        for (int ks = 0; ks < 2; ++ks)
#pragma unroll
            for (int p = 0; p < 2; ++p)
#pragma unroll
                for (int mk = 0; mk < 2; ++mk) s[p][mk] = __builtin_amdgcn_mfma_f32_16x16x32_bf16(kf[mk][ks], qf[p][ks], s[p][mk], 0, 0, 0);
        float mx[2];
#pragma unroll
        for (int p = 0; p < 2; ++p)
            mx[p] = max3f(max3f(max3f(s[p][0][0], s[p][0][1], s[p][0][2]), s[p][0][3], s[p][1][0]), max3f(s[p][1][1], s[p][1][2], s[p][1][3]), MASK_BIAS);
        if (!lazy) {
            float mn[2];
#pragma unroll
            for (int p = 0; p < 2; ++p) mn[p] = fmaxf(m[p], rowmax4(mx[p]));
            if (__any((mn[0] > m[0]) || (mn[1] > m[1]))) {
#pragma unroll
                for (int p = 0; p < 2; ++p) {
                    const float alpha = __builtin_amdgcn_exp2f(m[p] - mn[p]);
                    l[p] *= alpha;
                    if (PV) {
#pragma unroll
                        for (int md = 0; md < 4; ++md) o[p][md] *= alpha;
                    }
                    m[p] = mn[p];
                }
            }
#pragma unroll
            for (int p = 0; p < 2; ++p)
#pragma unroll
                for (int mk = 0; mk < 2; ++mk)
#pragma unroll
                    for (int j = 0; j < 4; ++j) s[p][mk][j] -= m[p];
        }
        bf16x8 pf[2];
#pragma unroll
        for (int p = 0; p < 2; ++p) {
#pragma unroll
            for (int mk = 0; mk < 2; ++mk)
#pragma unroll
                for (int j = 0; j < 4; ++j) s[p][mk][j] = __builtin_amdgcn_exp2f(s[p][mk][j]);
            u32x4 w;
            w.x = pk_bf16(s[p][0][0], s[p][0][1]); w.y = pk_bf16(s[p][0][2], s[p][0][3]);
            w.z = pk_bf16(s[p][1][0], s[p][1][1]); w.w = pk_bf16(s[p][1][2], s[p][1][3]);
            pf[p] = __builtin_bit_cast(bf16x8, w);
        }
#pragma unroll
        for (int p = 0; p < 2; ++p) l[p] = __builtin_amdgcn_mfma_f32_16x16x32_bf16(ones, pf[p], l[p], 0, 0, 0);
        if (PV) {
#pragma unroll
            for (int md = 0; md < 4; ++md)
#pragma unroll
                for (int p = 0; p < 2; ++p) o[p][md] = __builtin_amdgcn_mfma_f32_16x16x32_bf16(vf[md], pf[p], o[p][md], 0, 0, 0);
        }
        if (lazy) {
            float up[2];
#pragma unroll
            for (int p = 0; p < 2; ++p) up[p] = fmaxf(rowmax4(mx[p]), 0.f);
            if (__any((up[0] > 0.f) || (up[1] > 0.f))) {
#pragma unroll
                for (int p = 0; p < 2; ++p) {
                    const float alpha = __builtin_amdgcn_exp2f(-up[p]);
                    l[p] *= alpha;
                    if (PV) {
#pragma unroll
                        for (int md = 0; md < 4; ++md) o[p][md] *= alpha;
                    }
                    m[p] += up[p];
                }
            }
        }
    }
}
__device__ __forceinline__ float l_total(const f32x4& l, int fr) { return __shfl(l[0], fr); }

__device__ __forceinline__ void imp_tile(const char* sK, const bf16x8 (&qf)[2][2], const float (&m)[2], const float (&linv)[2],
                                         float dl, const float (&slope2)[2], int ct, float* simp, int fr, int fq) {
    bf16x8 kf[4][2];
#pragma unroll
    for (int mk = 0; mk < 4; ++mk)
#pragma unroll
        for (int ks = 0; ks < 2; ++ks) kf[mk][ks] = *(const bf16x8*)(sK + ((mk * 16 + fr) * LDS_ROW + ks * 32 + fq * 8) * 2);
    f32x4 hs[4];
#pragma unroll
    for (int mk = 0; mk < 4; ++mk) hs[mk] = (f32x4){0.f, 0.f, 0.f, 0.f};
#pragma unroll
    for (int p = 0; p < 2; ++p) {
#pragma unroll
        for (int mk = 0; mk < 4; ++mk) {
            f32x4 s;
#pragma unroll
            for (int j = 0; j < 4; ++j) { const float dk = dl + 16.f * (float)(mk * 16 + j); s[j] = (dk <= 0.f) ? slope2[p] * dk : MASK_BIAS; }
#pragma unroll
            for (int ks = 0; ks < 2; ++ks) s = __builtin_amdgcn_mfma_f32_16x16x32_bf16(kf[mk][ks], qf[p][ks], s, 0, 0, 0);
#pragma unroll
            for (int j = 0; j < 4; ++j) hs[mk][j] += __builtin_amdgcn_exp2f(s[j] - m[p]) * linv[p];
        }
    }
#pragma unroll
    for (int mk = 0; mk < 4; ++mk) {
        const int jb = ct * 16 + mk * 4 + fq;
        const float a = hs[mk][0] + hs[mk][1] + hs[mk][2] + 0.5f * hs[mk][3];
        const float bnext = 0.5f * hs[mk][3];
        simp[fr * 64 + jb] += a;
        __builtin_amdgcn_wave_barrier();
        if (jb + 1 < 64) simp[fr * 64 + jb + 1] += bnext;
        __builtin_amdgcn_wave_barrier();
    }
}

struct TileSrc { const bf16_t* k; const bf16_t* v; };
struct TileOff { int k[2], v[2]; };
__device__ __forceinline__ TileOff tile_offsets(int kst, int vst, int tid) {
    TileOff to;
#pragma unroll
    for (int i = 0; i < 2; ++i) { const int c = tid + 256 * i, row = c >> 3, ch = (c & 7) * 8; to.k[i] = row * kst + ch; to.v[i] = row * vst + ch; }
    return to;
}
__device__ __forceinline__ void tile_gload(const TileSrc& ts, const TileOff& to, u32x4 (&rk)[2], u32x4 (&rv)[2]) {
#pragma unroll
    for (int i = 0; i < 2; ++i) {
        rk[i] = *(const u32x4*)(ts.k + to.k[i]);
        rv[i] = *(const u32x4*)(ts.v + to.v[i]);
    }
}
__device__ __forceinline__ void tile_swrite(char* smem, int buf, const u32x4 (&rk)[2], const u32x4 (&rv)[2], int tid) {
    char* sK = smem + buf * 2 * KT_BYTES; char* sV = sK + KT_BYTES;
#pragma unroll
    for (int i = 0; i < 2; ++i) {
        const int c = tid + 256 * i, row = c >> 3, ch = (c & 7) * 8;
        *(u32x4*)(sK + (row * LDS_ROW + ch) * 2) = rk[i];
        *(u32x4*)(sV + (row * LDS_ROW + ch) * 2) = rv[i];
    }
}

__device__ void nsa_cmp_item(const Params& p, int qrev, int bg, char* smem) {
    const int tid = opaque_tid(), lane = tid & 63, wid = tid >> 6, fr = lane & 15, fq = lane >> 4;
    const int qb = 63 - qrev, b = bg >> 1, g = bg & 1;
    const int q0 = qb * 64, t = q0 + wid * 16 + fr;
    const size_t tokg = (size_t)b * SEQ + t;
    float* simp = (float*)(smem + 4 * KT_BYTES) + wid * 1024;
    auto wsb = [&]() __attribute__((always_inline)) { char* w = p.ws; asm volatile("" : "+s"(w)); return w; };
    const unsigned onew = (fr == 0) ? 0x3f803f80u : 0u;
    const bf16x8 ones = __builtin_bit_cast(bf16x8, (u32x4){onew, onew, onew, onew});
    const int ncb = (4 * qb + 3) < NCMP ? (4 * qb + 3) : NCMP;
    const int nct = (ncb + 63) >> 6;
    for (int i = tid; i < 4096; i += 256) ((float*)(smem + 4 * KT_BYTES))[i] = 0.f;
    __syncthreads();
#pragma unroll 1
    for (int hp = 0; hp < 2; ++hp) {
        const int h0 = g * 4 + hp * 2;
        bf16x8 qf[2][2]; float slope2[2];
#pragma unroll
        for (int pp = 0; pp < 2; ++pp) {
            slope2[pp] = exp2f(-(float)(h0 + pp + 1)) * LOG2E;
#pragma unroll
            for (int ks = 0; ks < 2; ++ks)
                qf[pp][ks] = scale_frag(*(const bf16x8*)((const bf16_t*)(wsb() + OFF_Pb) + tokg * PCOLS + P_NQ + (h0 + pp) * 64 + ks * 32 + fq * 8), C1_SCALE);
        }
        float m[2], linv[2]; f32x4 l[2]; f32x4 o[2][4];
#pragma unroll
        for (int pp = 0; pp < 2; ++pp) {
            m[pp] = NEGF; l[pp] = (f32x4){0.f, 0.f, 0.f, 0.f}; linv[pp] = 0.f;
#pragma unroll
            for (int md = 0; md < 4; ++md) o[pp][md] = (f32x4){0.f, 0.f, 0.f, 0.f};
        }
        u32x4 rk[2], rv[2];
        const int n = 2 * nct;
        auto src = [&](int step) __attribute__((always_inline)) {
            const int idx = step < nct ? (nct - 1 - step) : step - nct;
            char* wb = wsb();
            TileSrc ts; ts.k = (const bf16_t*)(wb + OFF_kc) + ((size_t)bg * 256 + idx * 64) * 64;
            ts.v = (const bf16_t*)(wb + OFF_vcT) + (size_t)bg * 64 * 256 + idx * 64;
            return ts;
        };
        const TileOff toff = tile_offsets(64, 256, tid);
        tile_gload(src(0), toff, rk, rv); tile_swrite(smem, 0, rk, rv, tid); __syncthreads();
#pragma unroll 1
        for (int i = 0; i < n; ++i) {
            if (i + 1 < n) tile_gload(src(i + 1), toff, rk, rv);
            __builtin_amdgcn_sched_barrier(0);
            const int idx = i < nct ? (nct - 1 - i) : i - nct;
            const char* sK = smem + (i & 1) * 2 * KT_BYTES; const char* sV = sK + KT_BYTES;
            const float dlc = (float)(16 * (idx * 64 + fq * 4) + 31 - t);
            if (i < nct) {
                const bool cmask = (16 * (idx * 64 + 63) + 31) > q0;
                flash_tile<true>(sK, sV, qf, m, l, o, dlc, 16.f, -1e9f, true, cmask, slope2, fr, fq, i >= 2, ones);
            } else {
                if (i == nct) {
                    size_t tokg_o = tokg; asm volatile("" : "+v"(tokg_o));
                    char* wb = wsb();
#pragma unroll
                    for (int pp = 0; pp < 2; ++pp) {
                        const float inv = 1.f / fmaxf(l_total(l[pp], fr), 1e-30f);
                        linv[pp] = inv;
                        const int h = h0 + pp;
                        const float gl = ((const float*)(wb + OFF_misc))[tokg_o * 64 + h * 3 + 0];
                        const float sc = inv / (1.f + __expf(-gl));
#pragma unroll
                        for (int md = 0; md < 4; ++md) *(f32x4*)((float*)(wb + OFF_mixf) + tokg_o * 512 + h * 64 + md * 16 + fq * 4) = o[pp][md] * sc;
                    }
                }
                imp_tile(sK, qf, m, linv, dlc, slope2, idx, simp, fr, fq);
            }
            __builtin_amdgcn_sched_barrier(0);
            if (i + 1 < n) tile_swrite(smem, (i + 1) & 1, rk, rv, tid);
            __syncthreads();
        }
    }
    {
        const int j = lane;
        const bool forced = (j == 0) || (j == qb) || (j == qb - 1);
        unsigned long long mine = 0ull, wave_union = 0ull;
#pragma unroll 1
        for (int qi = 0; qi < 16; ++qi) {
            const float sc = (j <= qb) ? (simp[qi * 64 + j] + (forced ? 1e4f : 0.f)) : NEGF;
            int rank = 0;
#pragma unroll 4
            for (int j2 = 0; j2 < 64; ++j2) {
                const float s2 = __builtin_bit_cast(float, __builtin_amdgcn_readlane(__builtin_bit_cast(int, sc), j2));
                rank += ((s2 > sc) || (s2 == sc && j2 < j)) ? 1 : 0;
            }
            const unsigned long long msk = __ballot(rank < 16);
            wave_union |= msk;
            if (fr == qi) mine = msk;
        }
        const unsigned long long causal = (qb >= 63) ? ~0ull : ((1ull << (qb + 1)) - 1ull);
        unsigned long long* selm = (unsigned long long*)(wsb() + OFF_selm);
        if (fq == 0) selm[(size_t)g * NTOK + tokg] = mine & causal;
        if (lane == 0) ((unsigned long long*)(wsb() + OFF_selu))[((size_t)bg * 64 + qb) * 4 + wid] = wave_union & causal;
    }
    __syncthreads();
}

__device__ void nsa_sw_item(const Params& p, int qrev, int bg, int hp, char* smem, int mode) {
    const int tid = opaque_tid(), lane = tid & 63, wid = tid >> 6, fr = lane & 15, fq = lane >> 4;
    const int qb = 63 - qrev, b = bg >> 1, g = bg & 1;
    const int q0 = qb * 64, t = q0 + wid * 16 + fr;
    const size_t tokg = (size_t)b * SEQ + t;
    int* slist = (int*)(smem + 4 * KT_BYTES);
    const int h0 = g * 4 + hp * 2;
    auto wsb = [&]() __attribute__((always_inline)) { char* w = p.ws; asm volatile("" : "+s"(w)); return w; };
    bf16x8 qf[2][2]; float slope2[2];
#pragma unroll
    for (int pp = 0; pp < 2; ++pp) {
        slope2[pp] = exp2f(-(float)(h0 + pp + 1)) * LOG2E;
#pragma unroll
        for (int ks = 0; ks < 2; ++ks)
            qf[pp][ks] = scale_frag(*(const bf16x8*)((const bf16_t*)(wsb() + OFF_Pb) + tokg * PCOLS + P_NQ + (h0 + pp) * 64 + ks * 32 + fq * 8), C1_SCALE);
    }
    const unsigned long long mymask = ((const unsigned long long*)(wsb() + OFF_selm))[(size_t)g * NTOK + tokg];
    const unsigned long long* su = (const unsigned long long*)(wsb() + OFF_selu) + ((size_t)bg * 64 + qb) * 4;
    const unsigned long long wave_union = su[wid];
    const unsigned long long un = su[0] | su[1] | su[2] | su[3];
    const int wlo = (qb - 8) > 0 ? (qb - 8) : 0;
    const int nsl = __popcll(un);
    const int n = nsl + (qb - wlo + 1);
    if (tid < 64 && ((un >> tid) & 1ull)) slist[nsl - 1 - __popcll(un & ((1ull << tid) - 1ull))] = tid;
    if (tid >= 64 && tid < 64 + (qb - wlo + 1)) slist[nsl + (tid - 64)] = 256 + (qb - (tid - 64));
    __syncthreads();
    const unsigned onew = (fr == 0) ? 0x3f803f80u : 0u;
    const bf16x8 ones = __builtin_bit_cast(bf16x8, (u32x4){onew, onew, onew, onew});
    float m[2]; f32x4 l[2]; f32x4 o[2][4];
#pragma unroll
    for (int pp = 0; pp < 2; ++pp) {
        m[pp] = NEGF; l[pp] = (f32x4){0.f, 0.f, 0.f, 0.f};
#pragma unroll
        for (int md = 0; md < 4; ++md) o[pp][md] = (f32x4){0.f, 0.f, 0.f, 0.f};
    }
    auto finish_branch = [&](int br) __attribute__((always_inline)) {
        size_t tokg_o = tokg; asm volatile("" : "+v"(tokg_o));
        char* wb = wsb();
#pragma unroll
        for (int pp = 0; pp < 2; ++pp) {
            const float inv = 1.f / fmaxf(l_total(l[pp], fr), 1e-30f);
            const int h = h0 + pp;
            const float gl = ((const float*)(wb + OFF_misc))[tokg_o * 64 + h * 3 + br];
            const float sc = inv / (1.f + __expf(-gl));
#pragma unroll
            for (int md = 0; md < 4; ++md) {
                const size_t eo = tokg_o * 512 + h * 64 + md * 16 + fq * 4;
                f32x4 v = o[pp][md] * sc;
                if (mode != 0) { asm volatile("" :: "v"(v[0]), "v"(v[1]), "v"(v[2]), "v"(v[3])); }
                else if (br == 1) *(f32x4*)((float*)(wb + OFF_mixf2) + eo) = v;
                else { v += *(const f32x4*)((const float*)(wb + OFF_mixf) + eo) + *(const f32x4*)((const float*)(wb + OFF_mixf2) + eo);
                       u32x2 w; w.x = pk_bf16(v[0], v[1]); w.y = pk_bf16(v[2], v[3]); *(u32x2*)((bf16_t*)(wb + OFF_mixb) + tokg_o * 1024 + h * 64 + md * 16 + fq * 4) = w; }
            }
            m[pp] = NEGF; l[pp] = (f32x4){0.f, 0.f, 0.f, 0.f};
#pragma unroll
            for (int md = 0; md < 4; ++md) o[pp][md] = (f32x4){0.f, 0.f, 0.f, 0.f};
        }
    };
    u32x4 rkA[2], rvA[2], rkB[2], rvB[2];
    auto src = [&](int e) __attribute__((always_inline)) {
        const int win = e >> 8, idx = e & 255;
        char* wb = wsb();
        TileSrc ts;
        ts.k = (const bf16_t*)(wb + OFF_Pb) + ((size_t)b * SEQ + idx * 64) * PCOLS + (win ? P_KW : P_KS) + g * 64;
        ts.v = (const bf16_t*)(wb + (win ? OFF_VwT : OFF_VsT)) + (size_t)bg * 64 * SEQ + idx * 64;
        return ts;
    };
    auto step = [&](int i, int buf) __attribute__((always_inline)) {
        const int e = slist[i];
        const int win = e >> 8, idx = e & 255;
        if (i == nsl) finish_branch(1);
        const char* sK = smem + buf * 2 * KT_BYTES; const char* sV = sK + KT_BYTES;
        if (mode != 1 && (win || ((wave_union >> idx) & 1ull))) {
            const bool lv = win ? true : (((mymask >> idx) & 1ull) != 0ull);
            const bool nm = (idx == qb) || (win && idx == qb - 8);
            flash_tile<true>(sK, sV, qf, m, l, o, (float)(idx * 64 + fq * 4 - t), 1.f, win ? -512.f : -1e9f, lv, nm, slope2, fr, fq, (i != 0) && (i != nsl), ones);
        }
    };
#ifdef PROF
    volatile unsigned* sprof = (volatile unsigned*)(smem + 4 * KT_BYTES + 2048);
    if (tid == 0) { sprof[1] = 0u; sprof[2] = 0u; sprof[3] = (unsigned)__builtin_amdgcn_s_memtime(); }
#define PROF_T0 if (tid == 0) sprof[0] = (unsigned)__builtin_amdgcn_s_memtime();
#define PROF_T1 if (tid == 0) { sprof[1] += (unsigned)__builtin_amdgcn_s_memtime() - sprof[0]; sprof[2] += 1u; }
#else
#define PROF_T0
#define PROF_T1
#endif
    const TileOff toff = tile_offsets(PCOLS, SEQ, tid);
    tile_gload(src(slist[0]), toff, rkA, rvA); tile_swrite(smem, 0, rkA, rvA, tid);
    if (n > 1) tile_gload(src(slist[1]), toff, rkA, rvA);
    __syncthreads();
#pragma unroll 1
    for (int i = 0; i < n; i += 2) {
        if (i + 2 < n) tile_gload(src(slist[i + 2]), toff, rkB, rvB);
        __builtin_amdgcn_sched_barrier(0);
        PROF_T0 step(i, 0); PROF_T1
        __builtin_amdgcn_sched_barrier(0);
        if (i + 1 < n) tile_swrite(smem, 1, rkA, rvA, tid);
        __syncthreads();
        if (i + 1 >= n) break;
        if (i + 3 < n) tile_gload(src(slist[i + 3]), toff, rkA, rvA);
        __builtin_amdgcn_sched_barrier(0);
        PROF_T0 step(i + 1, 1); PROF_T1
        __builtin_amdgcn_sched_barrier(0);
        if (i + 2 < n) tile_swrite(smem, 0, rkB, rvB, tid);
        __syncthreads();
    }
    finish_branch(2);
#ifdef PROF
    if (tid == 0) {
        unsigned long long* pw = (unsigned long long*)(p.ws + OFF_counts + 1024);
        atomicAdd(&pw[0], (unsigned long long)sprof[1]); atomicAdd(&pw[1], (unsigned long long)((unsigned)__builtin_amdgcn_s_memtime() - sprof[3])); atomicAdd(&pw[2], (unsigned long long)sprof[2]);
    }
#endif
}

__device__ void gla_c_item(const Params& p, int item, char* smem) {
    const int tid = opaque_tid(), lane = tid & 63, wid = tid >> 6, fr = lane & 15, fq = lane >> 4;
    const int bh = item >> 6, c = item & 63, b = bh >> 2, h = bh & 3;
    const int tok0 = c * 64, tokg0 = b * SEQ + tok0;
    float* sb = (float*)smem; float* sglr = (float*)(smem + 16384); float* swa = (float*)(smem + 20480); float* sqt = (float*)(smem + 24576);
    char* sST = smem;
    char* sQB = smem + 25600; char* sKB = smem + 34816; char* sVT = smem + 44032;
    gla_cumsum(p, tokg0, h, sb, sglr, swa, sqt);
    {
        const int d = tid & 63, tq = tid >> 6;
#pragma unroll 4
        for (int tt = 0; tt < 16; ++tt) {
            const int tk = tq * 16 + tt;
            const float bt = sb[tk * 64 + d];
            const float q = bf2f(p.Pb()[(size_t)(tokg0 + tk) * PCOLS + P_GQ + h * 64 + d]);
            const float k = bf2f(p.Pb()[(size_t)(tokg0 + tk) * PCOLS + P_GK + h * 64 + d]);
            *(bf16_t*)(sQB + (tk * LDS_ROW + d) * 2) = f2bf(q * 0.125f * __expf(bt));
            *(bf16_t*)(sKB + (tk * LDS_ROW + d) * 2) = f2bf(k * __expf(-bt));
        }
    }
#pragma unroll
    for (int i = 0; i < 4; ++i) {
        const int cidx = tid + 256 * i, e = cidx >> 3, ch = (cidx & 7) * 8;
        *(u32x4*)(sVT + (e * LDS_ROW + ch) * 2) = *(const u32x4*)(p.VgT() + ((size_t)bh * 128 + e) * SEQ + tok0 + ch);
    }
    __syncthreads();
#pragma unroll
    for (int i = 0; i < 4; ++i) {
        const int cidx = tid + 256 * i, e = cidx >> 3, ch = (cidx & 7) * 8;
        *(u32x4*)(sST + (e * LDS_ROW + ch) * 2) = *(const u32x4*)(p.ST() + ((size_t)item << 13) + e * 64 + ch);
    }
    __syncthreads();
    bf16x8 qbf[2];
#pragma unroll
    for (int ks = 0; ks < 2; ++ks) qbf[ks] = *(const bf16x8*)(sQB + ((wid * 16 + fr) * LDS_ROW + ks * 32 + fq * 8) * 2);
    f32x4 sa[4];
#pragma unroll
    for (int ms = 0; ms < 4; ++ms) {
        sa[ms] = (f32x4){0.f, 0.f, 0.f, 0.f};
#pragma unroll
        for (int ks = 0; ks < 2; ++ks) {
            bf16x8 a = *(const bf16x8*)(sKB + ((ms * 16 + fr) * LDS_ROW + ks * 32 + fq * 8) * 2);
            sa[ms] = __builtin_amdgcn_mfma_f32_16x16x32_bf16(a, qbf[ks], sa[ms], 0, 0, 0);
        }
#pragma unroll
        for (int j = 0; j < 4; ++j) sa[ms][j] = (ms * 16 + fq * 4 + j <= wid * 16 + fr) ? sa[ms][j] : 0.f;
    }
    bf16x8 pf[2];
#pragma unroll
    for (int kk = 0; kk < 2; ++kk) {
        u32x4 w;
        w.x = pk_bf16(sa[2 * kk][0], sa[2 * kk][1]); w.y = pk_bf16(sa[2 * kk][2], sa[2 * kk][3]);
        w.z = pk_bf16(sa[2 * kk + 1][0], sa[2 * kk + 1][1]); w.w = pk_bf16(sa[2 * kk + 1][2], sa[2 * kk + 1][3]);
        pf[kk] = __builtin_bit_cast(bf16x8, w);
    }
    f32x4 oa[8];
    float sum = 0.f;
#pragma unroll
    for (int me = 0; me < 8; ++me) {
        f32x4 acc = (f32x4){0.f, 0.f, 0.f, 0.f};
#pragma unroll
        for (int ks = 0; ks < 2; ++ks) {
            bf16x8 a = *(const bf16x8*)(sST + ((me * 16 + fr) * LDS_ROW + ks * 32 + fq * 8) * 2);
            acc = __builtin_amdgcn_mfma_f32_16x16x32_bf16(a, qbf[ks], acc, 0, 0, 0);
        }
#pragma unroll
        for (int kk = 0; kk < 2; ++kk) {
            u32x2 lo = *(const u32x2*)(sVT + ((me * 16 + fr) * LDS_ROW + kk * 32 + fq * 4) * 2);
            u32x2 hi = *(const u32x2*)(sVT + ((me * 16 + fr) * LDS_ROW + kk * 32 + 16 + fq * 4) * 2);
            u32x4 w; w.x = lo.x; w.y = lo.y; w.z = hi.x; w.w = hi.y;
            acc = __builtin_amdgcn_mfma_f32_16x16x32_bf16(__builtin_bit_cast(bf16x8, w), pf[kk], acc, 0, 0, 0);
        }
        oa[me] = acc;
        sum += (acc[0] + acc[1]) + (acc[2] + acc[3]);
    }
    sum += __shfl_xor(sum, 16); sum += __shfl_xor(sum, 32);
    const float mu = sum * (1.f / 128.f);
    float var = 0.f;
#pragma unroll
    for (int me = 0; me < 8; ++me)
#pragma unroll
        for (int j = 0; j < 4; ++j) { const float dd = oa[me][j] - mu; var += dd * dd; }
    var += __shfl_xor(var, 16); var += __shfl_xor(var, 32);
    const float rstd = rsqrtf(var * (1.f / 128.f) + 1e-5f);
    const size_t tok = (size_t)tokg0 + wid * 16 + fr;
#pragma unroll
    for (int me = 0; me < 8; ++me) {
        const int e = me * 16 + fq * 4;
        const u32x2 rr = *(const u32x2*)(p.Pb() + tok * PCOLS + P_GR + h * 128 + e);
        const f32x4 nw = *(const f32x4*)(p.norm_w + e);
        float r[4] = {bflo(rr.x), bfhi(rr.x), bflo(rr.y), bfhi(rr.y)};
        float ov[4];
#pragma unroll
        for (int j = 0; j < 4; ++j) ov[j] = (oa[me][j] - mu) * rstd * nw[j] * (r[j] / (1.f + __expf(-r[j])));
        u32x2 w; w.x = pk_bf16(ov[0], ov[1]); w.y = pk_bf16(ov[2], ov[3]);
        *(u32x2*)(p.mixb() + tok * 1024 + 512 + h * 128 + e) = w;
    }
    __syncthreads();
}

#ifndef NSA_REP
#define NSA_REP 1
#endif
#ifndef NSA_MODE2
#define NSA_MODE2 0
#endif
#ifndef GLAC_REP
#define GLAC_REP 1
#endif
__device__ void phase5a(const Params& p, char* smem, int rep) {
    int* sidx = (int*)(smem + GEMM_SMEM - 16);
    for (;;) {
        __syncthreads();
        if (opaque_tid() == 0) *sidx = atomicAdd(&p.counts()[264 + 4 * rep], 1);
        __syncthreads();
        const int it = *sidx;
        if (it >= 512) break;
        nsa_cmp_item(p, it >> 3, it & 7, smem);
    }
    for (;;) {
        __syncthreads();
        if (opaque_tid() == 0) *sidx = atomicAdd(&p.counts()[265 + 4 * rep], 1);
        __syncthreads();
        const int it = *sidx;
        if (it >= 1024 * GLAC_REP) break;
        gla_c_item(p, it & 1023, smem);
    }
}
__device__ void phase5b(const Params& p, char* smem, int rep) {
    int* sidx = (int*)(smem + GEMM_SMEM - 16);
    for (;;) {
        __syncthreads();
        if (opaque_tid() == 0) *sidx = atomicAdd(&p.counts()[266 + 4 * rep], 1);
        __syncthreads();
        const int it = *sidx;
        if (it >= 1024 * NSA_REP) break;
        const int item = it & 1023;
        nsa_sw_item(p, item >> 4, (item >> 1) & 7, item & 1, smem, it >= 1024 ? NSA_MODE2 : 0);
    }
}
__device__ void phase6(const Params& p, char* smem) {
    const int xcd = xcd_of(smem), rank = rank_of(smem), nranks = nranks_of(smem);
    const int lane = opaque_tid() & 63, wid = opaque_tid() >> 6, wr = wid >> 1, wc = wid & 1, fr = lane & 15, fq = lane >> 4;
    for (int it = rank; it < 16 * 8; it += nranks) {
        const int mt = (it / 8) * 8 + xcd, nt = it % 8;
        RowsBf16 al{p.mixb() + (size_t)mt * 128 * 1024, 1024};
        RowsBf16 bl{p.wot() + (size_t)nt * 128 * 1024, 1024};
        f32x4 acc[4][4];
        gemm_128<true, false>(al, bl, 0, 16, smem, acc);
#pragma unroll
        for (int m = 0; m < 4; ++m)
#pragma unroll
            for (int n = 0; n < 4; ++n)
                *(f32x4*)(p.y1() + (size_t)(mt * 128 + wr * 64 + m * 16 + fr) * 1024 + nt * 128 + wc * 64 + n * 16 + fq * 4) = acc[m][n];
    }
}

__device__ void phase7(const Params& p) {
    const int lane = opaque_tid() & 63, gw = blockIdx.x * 4 + (opaque_tid() >> 6), nw = gridDim.x * 4;
    const float alpha = 1.189207115f;
    for (int row0 = gw * 2; row0 < NTOK; row0 += nw * 2) {
        const int b = row0 / SEQ;
        const float* md = p.mod() + b * 6144;
        f32x4 xv[2][4], yv[2][4];
#pragma unroll
        for (int r = 0; r < 2; ++r)
#pragma unroll
            for (int i = 0; i < 4; ++i) {
                const int col = i * 256 + lane * 4;
                xv[r][i] = *(const f32x4*)(p.x + (size_t)(row0 + r) * 1024 + col);
                yv[r][i] = *(const f32x4*)(p.y1() + (size_t)(row0 + r) * 1024 + col);
            }
#pragma unroll
        for (int r = 0; r < 2; ++r) {
            const int row = row0 + r;
            f32x4 v[4]; float s = 0.f;
#pragma unroll
            for (int i = 0; i < 4; ++i) {
                const int col = i * 256 + lane * 4;
                const f32x4 ga = *(const f32x4*)(md + 2048 + col);
#pragma unroll
                for (int j = 0; j < 4; ++j) v[i][j] = alpha * xv[r][i][j] + (1.f + ga[j]) * yv[r][i][j];
                s += (v[i][0] + v[i][1]) + (v[i][2] + v[i][3]);
            }
            float mu = wave_sum(s) * (1.f / 1024.f);
            float q = 0.f;
#pragma unroll
            for (int i = 0; i < 4; ++i)
#pragma unroll
                for (int j = 0; j < 4; ++j) { float d = v[i][j] - mu; q += d * d; }
            float rstd = rsqrtf(wave_sum(q) * (1.f / 1024.f) + 1e-5f);
            s = 0.f;
#pragma unroll
            for (int i = 0; i < 4; ++i) {
                const int col = i * 256 + lane * 4;
                f32x4 g = *(const f32x4*)(p.ln1_g + col), bb = *(const f32x4*)(p.ln1_b + col);
#pragma unroll
                for (int j = 0; j < 4; ++j) v[i][j] = (v[i][j] - mu) * rstd * g[j] + bb[j];
                *(f32x4*)(p.x1() + (size_t)row * 1024 + col) = v[i];
                s += (v[i][0] + v[i][1]) + (v[i][2] + v[i][3]);
            }
            mu = wave_sum(s) * (1.f / 1024.f);
            q = 0.f;
#pragma unroll
            for (int i = 0; i < 4; ++i)
#pragma unroll
                for (int j = 0; j < 4; ++j) { float d = v[i][j] - mu; q += d * d; }
            rstd = rsqrtf(wave_sum(q) * (1.f / 1024.f) + 1e-5f);
#pragma unroll
            for (int i = 0; i < 4; ++i) {
                const int col = i * 256 + lane * 4;
                f32x4 sh = *(const f32x4*)(md + 3072 + col), sc = *(const f32x4*)(md + 4096 + col);
                float o[4];
#pragma unroll
                for (int j = 0; j < 4; ++j) o[j] = (v[i][j] - mu) * rstd * (1.f + sc[j]) + sh[j];
                u32x2 w; w.x = pk_bf16(o[0], o[1]); w.y = pk_bf16(o[2], o[3]);
                *(u32x2*)(p.hb() + (size_t)row * 1024 + col) = w;
            }
        }
    }
}

__device__ void phase8(const Params& p, char* smem) {
    const int lane = opaque_tid() & 63, wid = opaque_tid() >> 6, wr = wid >> 1, wc = wid & 1, fr = lane & 15, fq = lane >> 4;
    for (int it = blockIdx.x; it < 256; it += gridDim.x) {
        const int mt = it >> 1, nt = it & 1;
        RowsBf16 al{p.hb() + (size_t)mt * 128 * 1024, 1024};
        RowsBf16 bl{p.wrt() + (size_t)nt * 128 * 1024, 1024};
        f32x4 acc[4][4];
        gemm_128<true, false>(al, bl, 0, 16, smem, acc);
#pragma unroll
        for (int m = 0; m < 4; ++m)
#pragma unroll
            for (int n = 0; n < 4; ++n)
                *(f32x4*)(p.logits() + (size_t)(mt * 128 + wr * 64 + m * 16 + fr) * 256 + nt * 128 + wc * 64 + n * 16 + fq * 4) = acc[m][n];
    }
}

__device__ void phase9(const Params& p) {
    const int lane = opaque_tid() & 63, gw = blockIdx.x * 4 + (opaque_tid() >> 6), nw = gridDim.x * 4;
    for (int tok = gw; tok < NTOK; tok += nw) {
        float s[4], sb[4];
        const f32x4 lg = *(const f32x4*)(p.logits() + (size_t)tok * 256 + lane * 4);
        const f32x4 rb = *(const f32x4*)(p.rbias + lane * 4);
#pragma unroll
        for (int i = 0; i < 4; ++i) { s[i] = 1.f / (1.f + __expf(-lg[i])); sb[i] = s[i] + rb[i]; }
        float m1 = NEGF, m2 = NEGF;
#pragma unroll
        for (int i = 0; i < 4; ++i) { float v = sb[i]; if (v > m1) { m2 = m1; m1 = v; } else if (v > m2) m2 = v; }
#pragma unroll
        for (int mm = 1; mm < 8; mm <<= 1) {
            float o1 = __shfl_xor(m1, mm), o2 = __shfl_xor(m2, mm);
            float n1 = fmaxf(m1, o1);
            float n2 = fmaxf(fminf(m1, o1), fmaxf(m2, o2));
            m1 = n1; m2 = n2;
        }
        const float gs = m1 + m2;
        const int grp = lane >> 3;
        int grank = 0;
#pragma unroll
        for (int g2 = 0; g2 < 8; ++g2) { float o = __shfl(gs, g2 * 8); if (o > gs || (o == gs && g2 < grp)) ++grank; }
        const bool gsel = grank < 4;
        float cand[4];
#pragma unroll
        for (int i = 0; i < 4; ++i) cand[i] = gsel ? sb[i] : NEGF;
        float wsum = 0.f, myw = 0.f; int mye = 0;
#pragma unroll 1
        for (int k = 0; k < TOPK; ++k) {
            float bv = cand[0]; int bi = 0;
#pragma unroll
            for (int i = 1; i < 4; ++i) if (cand[i] > bv) { bv = cand[i]; bi = i; }
            float gv = bv; int ge = lane * 4 + bi;
#pragma unroll
            for (int mm = 1; mm < 64; mm <<= 1) {
                float ov = __shfl_xor(gv, mm); int oe = __shfl_xor(ge, mm);
                if (ov > gv || (ov == gv && oe < ge)) { gv = ov; ge = oe; }
            }
            float sel_s = 0.f;
            if ((ge >> 2) == lane) {
                const int i = ge & 3;
                sel_s = (i == 0) ? s[0] : (i == 1) ? s[1] : (i == 2) ? s[2] : s[3];
                if (i == 0) cand[0] = -3e38f; else if (i == 1) cand[1] = -3e38f; else if (i == 2) cand[2] = -3e38f; else cand[3] = -3e38f;
            }
            sel_s = __shfl(sel_s, ge >> 2);
            wsum += sel_s;
            if (lane == k) { myw = sel_s; mye = ge; }
        }
        if (lane < TOPK) {
            const int id = tok * NASSIGN + lane;
            p.ew()[id] = myw / wsum * 2.5f;
            const int pos = atomicAdd(&p.counts()[mye], 1);
            p.lists()[(size_t)mye * NTOK + pos] = id;
        } else if (lane == TOPK) {
            p.ew()[tok * NASSIGN + TOPK] = 1.f;
        }
    }
}

struct Rows4 {
    static constexpr bool NT = false;
    const bf16_t *p0, *p1, *p2, *p3; int kmask;
    __device__ __forceinline__ const bf16_t* pp(int i, int tid, int k) const { return (i == 0 ? p0 : i == 1 ? p1 : i == 2 ? p2 : p3) + (k & kmask); }
};
template <int NT_PER>
__device__ __forceinline__ int build_entries(const Params& p, int xcd, int* spre) {
    const int tid = opaque_tid();
    __syncthreads();
    if (tid < 33) {
        int items;
        if (tid < 32) { const int cnt = p.counts()[xcd + 8 * tid]; items = ((cnt + 127) >> 7) * NT_PER; }
        else items = 16 * NT_PER;
        spre[64 + tid] = items;
    }
    __syncthreads();
    if (tid == 0) { int a = 0; for (int i = 0; i < 33; ++i) { spre[i] = a; a += spre[64 + i]; } spre[33] = a; }
    __syncthreads();
    return spre[33];
}

template <int NT_PER>
__device__ __forceinline__ void decode_item(const Params& p, int xcd, const int* spre, int it, int& e, int& nt, int& mtile, int& cnt) {
    int ent = 0;
    for (int i = 1; i < 33; ++i) ent = (it >= spre[i]) ? i : ent;
    const int local = it - spre[ent];
    if (ent < 32) {
        e = xcd + 8 * ent; cnt = p.counts()[e];
        const int mtc = (cnt + 127) >> 7;
        nt = local / mtc; mtile = local % mtc;
    } else {
        e = N_EXP; cnt = NTOK; nt = local >> 4; mtile = (local & 15) * 8 + xcd;
    }
}

#ifndef P10_NT
#define P10_NT 4
#endif
struct BF32GateUpS {
    const float* g; long du;
    __device__ __forceinline__ f32x4 load4(int kk, int r4) const {
        const long sel = ((r4 >> 5) & 1) ? du : 0l;
        return *(const f32x4*)(g + sel + (size_t)(kk & 1023) * 256 + (kk >> 10) * 64 + (r4 >> 6) * 32 + (r4 & 31));
    }
};
__device__ void phase10(const Params& p, char* smem) {
    const int tid = opaque_tid(), xcd = xcd_of(smem), rank = rank_of(smem), nranks = nranks_of(smem);
    const int lane = tid & 63, wid = tid >> 6, wr = wid >> 1, wc = wid & 1, fr = lane & 15, fq = lane >> 4;
    int* srow = (int*)(smem + GEMM_SMEM);
    int* spre = srow + 256;
#ifndef P10_REP
#define P10_REP 1
#endif
    const int total = build_entries<P10_NT>(p, xcd, spre);
#ifdef STAGGER
    for (int i = 0; i < (rank & 3) * STAGGER; ++i) __builtin_amdgcn_s_sleep(32);
#endif
    for (int it0 = rank; it0 < total * P10_REP; it0 += nranks) {
        const int it = it0 % total;
        int e, nt, mtile, cnt;
        decode_item<P10_NT>(p, xcd, spre, it, e, nt, mtile, cnt);
        if (tid < 128) {
            const int pos = mtile * 128 + tid;
            int id = -1;
            if (pos < cnt) id = (e == N_EXP) ? (pos * NASSIGN + TOPK) : p.lists()[(size_t)e * NTOK + pos];
            srow[tid] = id >= 0 ? id / NASSIGN : 0;
            srow[128 + tid] = id;
        }
        __syncthreads();
        Rows4 al; al.kmask = 1023;
        al.p0 = p.hb() + (size_t)srow[(tid >> 3)] * 1024; al.p1 = p.hb() + (size_t)srow[32 + (tid >> 3)] * 1024;
        al.p2 = p.hb() + (size_t)srow[64 + (tid >> 3)] * 1024; al.p3 = p.hb() + (size_t)srow[96 + (tid >> 3)] * 1024;
        const float* Wg = (e == N_EXP) ? p.w_s_gate : p.w_e_gate + (size_t)e * 1024 * 256;
        const float* Wu = (e == N_EXP) ? p.w_s_up : p.w_e_up + (size_t)e * 1024 * 256;
        BF32GateUpS bl{Wg + nt * (256 / P10_NT), (long)(Wu - Wg)};
        f32x4 acc[4][4];
        bf16_t* hidp = p.hid();
        gemm_core<true, true>(al, bl, 0, 16 * (4 / P10_NT), 16, smem, acc, [&](int tl, const f32x4 (&a)[4][4]) __attribute__((always_inline)) {
            const int nt4 = nt * (4 / P10_NT) + tl;
#pragma unroll
            for (int m = 0; m < 4; ++m) {
                const int id = srow[128 + wr * 64 + m * 16 + fr];
                if (id >= 0) {
#pragma unroll
                    for (int n = 0; n < 2; ++n) {
                        float hv[4];
#pragma unroll
                        for (int j = 0; j < 4; ++j) { const float gte = a[m][n][j]; hv[j] = gte / (1.f + __expf(-gte)) * a[m][n + 2][j]; }
                        u32x2 w; w.x = pk_bf16(hv[0], hv[1]); w.y = pk_bf16(hv[2], hv[3]);
                        *(u32x2*)(hidp + (size_t)id * 256 + nt4 * 64 + wc * 32 + n * 16 + fq * 4) = w;
                    }
                }
            }
        });
        __syncthreads();
    }
}

struct DownB {
    const float* base;
    __device__ __forceinline__ f32x4 load4(int kk, int r4) const {
#ifdef NT_B
        return __builtin_nontemporal_load((const f32x4*)(base + (size_t)(kk & 255) * 1024 + (kk >> 8) * 128 + r4));
#else
        return *(const f32x4*)(base + (size_t)(kk & 255) * 1024 + (kk >> 8) * 128 + r4);
#endif
    }
};
struct HidA {
    static constexpr bool NT = true;
    const bf16_t* base; const int* rowidx;
    __device__ __forceinline__ const bf16_t* ptr(int r, int kk) const { return base + (size_t)rowidx[r] * 256 + (kk & 255); }
    __device__ __forceinline__ const bf16_t* pp(int i, int tid, int k) const { return ptr(i * 32 + (tid >> 3), k); }
};
#ifndef P11_NT
#define P11_NT 4
#endif
__device__ void phase11(const Params& p, char* smem) {
    const int tid = opaque_tid(), xcd = xcd_of(smem), rank = rank_of(smem), nranks = nranks_of(smem);
    const int lane = tid & 63, wid = tid >> 6, wr = wid >> 1, wc = wid & 1, fr = lane & 15, fq = lane >> 4;
    int* srow = (int*)(smem + GEMM_SMEM);
    int* spre = srow + 256;
    float* sew = (float*)(srow + 384);
#ifndef P11_REP
#define P11_REP 1
#endif
    const int total = build_entries<P11_NT>(p, xcd, spre);
    for (int it0 = rank; it0 < total * P11_REP; it0 += nranks) {
        const int it = it0 % total;
        int e, nt, mtile, cnt;
        decode_item<P11_NT>(p, xcd, spre, it, e, nt, mtile, cnt);
        if (tid < 128) {
            const int pos = mtile * 128 + tid;
            int id = -1;
            if (pos < cnt) id = (e == N_EXP) ? (pos * NASSIGN + TOPK) : p.lists()[(size_t)e * NTOK + pos];
            srow[tid] = id >= 0 ? id : 0;
            srow[128 + tid] = id;
            sew[tid] = id >= 0 ? p.ew()[id] : 0.f;
        }
        __syncthreads();
        Rows4 al; al.kmask = 255;
        al.p0 = p.hid() + (size_t)srow[(tid >> 3)] * 256; al.p1 = p.hid() + (size_t)srow[32 + (tid >> 3)] * 256;
        al.p2 = p.hid() + (size_t)srow[64 + (tid >> 3)] * 256; al.p3 = p.hid() + (size_t)srow[96 + (tid >> 3)] * 256;
        DownB bl{(e == N_EXP) ? p.w_s_down : p.w_e_down + (size_t)e * 256 * 1024};
        f32x4 acc[4][4];
        bf16_t* outk = p.outk();
        auto epi = [&](int tile, const f32x4 (&a)[4][4]) __attribute__((always_inline)) {
#pragma unroll
            for (int m = 0; m < 4; ++m) {
                const int rr = wr * 64 + m * 16 + fr;
                const int id = srow[128 + rr];
                if (id >= 0) {
                    const float w8 = sew[rr];
#pragma unroll
                    for (int n = 0; n < 4; ++n) {
                        u32x2 w; w.x = pk_bf16(a[m][n][0] * w8, a[m][n][1] * w8); w.y = pk_bf16(a[m][n][2] * w8, a[m][n][3] * w8);
                        *(u32x2*)(outk + (size_t)id * 1024 + tile * 128 + wc * 64 + n * 16 + fq * 4) = w;
                    }
                }
            }
        };
        gemm_core<true, true>(al, bl, nt * (2048 / P11_NT), 32 / P11_NT, 4, smem, acc, [&](int tl, const f32x4 (&a)[4][4]) __attribute__((always_inline)) { epi(nt * (8 / P11_NT) + tl, a); });
        __syncthreads();
    }
}

__device__ void phase12(const Params& p) {
    const int lane = opaque_tid() & 63, gw = blockIdx.x * 4 + (opaque_tid() >> 6), nw = gridDim.x * 4;
    const float alpha = 1.189207115f;
    for (int row = gw; row < NTOK; row += nw) {
        const int b = row / SEQ;
        const float* md = p.mod() + b * 6144;
        float v[16];
#pragma unroll
        for (int i = 0; i < 16; ++i) v[i] = 0.f;
#pragma unroll
        for (int k = 0; k < NASSIGN; ++k) {
#pragma unroll
            for (int cidx = 0; cidx < 2; ++cidx) {
                const u32x4 w = *(const u32x4*)(p.outk() + ((size_t)row * NASSIGN + k) * 1024 + cidx * 512 + lane * 8);
                v[cidx * 8 + 0] += bflo(w.x); v[cidx * 8 + 1] += bfhi(w.x); v[cidx * 8 + 2] += bflo(w.y); v[cidx * 8 + 3] += bfhi(w.y);
                v[cidx * 8 + 4] += bflo(w.z); v[cidx * 8 + 5] += bfhi(w.z); v[cidx * 8 + 6] += bflo(w.w); v[cidx * 8 + 7] += bfhi(w.w);
            }
        }
        float s = 0.f;
#pragma unroll
        for (int cidx = 0; cidx < 2; ++cidx)
#pragma unroll
            for (int hh = 0; hh < 2; ++hh) {
                const int col = cidx * 512 + lane * 8 + hh * 4;
                const f32x4 xv = *(const f32x4*)(p.x1() + (size_t)row * 1024 + col), ga = *(const f32x4*)(md + 5120 + col);
#pragma unroll
                for (int j = 0; j < 4; ++j) { float t = alpha * xv[j] + (1.f + ga[j]) * v[cidx * 8 + hh * 4 + j]; v[cidx * 8 + hh * 4 + j] = t; s += t; }
            }
        const float mu = wave_sum(s) * (1.f / 1024.f);
        float q = 0.f;
#pragma unroll
        for (int i = 0; i < 16; ++i) { float d = v[i] - mu; q += d * d; }
        const float rstd = rsqrtf(wave_sum(q) * (1.f / 1024.f) + 1e-5f);
#pragma unroll
        for (int cidx = 0; cidx < 2; ++cidx)
#pragma unroll
            for (int hh = 0; hh < 2; ++hh) {
                const int col = cidx * 512 + lane * 8 + hh * 4;
                const f32x4 g = *(const f32x4*)(p.ln2_g + col), bb = *(const f32x4*)(p.ln2_b + col);
                f32x4 o;
#pragma unroll
                for (int j = 0; j < 4; ++j) o[j] = (v[cidx * 8 + hh * 4 + j] - mu) * rstd * g[j] + bb[j];
                *(f32x4*)(p.out + (size_t)row * 1024 + col) = o;
            }
    }
}

#define XB_TMO      128
#define XB_XCNT(j)  (256  + 64 * (j))
#define XB_XSUB(j)  (1280 + 64 * (j))
#define XB_XGEN(j)  (2304 + 64 * (j))
#define XB_TOP      3328
#define XB_TOPGEN   3392
#define XCD_BAR_WORDS 3456
#define XB_SPIN_CAP (1u << 22)
#define LAS __attribute__((address_space(3)))
__device__ __forceinline__ unsigned xb_ld(unsigned* p) { return __hip_atomic_load(p, __ATOMIC_RELAXED, __HIP_MEMORY_SCOPE_AGENT); }
__device__ __forceinline__ unsigned xb_add(unsigned* p, unsigned v) { return __hip_atomic_fetch_add(p, v, __ATOMIC_RELAXED, __HIP_MEMORY_SCOPE_AGENT); }
__device__ __forceinline__ unsigned xb_xcc_id() { return (unsigned)__builtin_amdgcn_s_getreg((3 << 11) | 20) & 0xFu; }
#define XB_SPIN(cond, bar) do { unsigned _sp = 0; while (cond) { __builtin_amdgcn_s_sleep(1); \
    if ((++_sp & 255u) == 0u) { if (xb_ld(&(bar)[XB_TMO])) break; if (_sp > XB_SPIN_CAP) { atomicAdd(&(bar)[XB_TMO], 1u); break; } } } } while (0)
struct XcdBarrier { unsigned* bar; unsigned x; volatile LAS unsigned* st; };
__device__ __forceinline__ XcdBarrier xcd_barrier_post(unsigned* bar, volatile LAS unsigned* st) {
    XcdBarrier b; b.bar = bar; b.x = xb_xcc_id(); b.st = st;
    if (opaque_tid() == 0) st[2] = xb_add(&bar[XB_XCNT(b.x)], 1u);
    return b;
}
__device__ __forceinline__ void xcd_barrier_complete(unsigned* bar, unsigned x, unsigned& nloc, unsigned& nx, unsigned& dense) {
    const unsigned G = gridDim.x * gridDim.y * gridDim.z;
    unsigned sum, cnt, mine, below, sp = 0u;
    for (;;) {
        sum = 0u; cnt = 0u; mine = 0u; below = 0u;
#pragma unroll
        for (unsigned j = 0; j < 16; ++j) { const unsigned c = xb_ld(&bar[XB_XCNT(j)]); sum += c; cnt += (c > 0u) ? 1u : 0u; mine = (j == x) ? c : mine; below += (j < x && c > 0u) ? 1u : 0u; }
        if (sum == G) break;
        __builtin_amdgcn_s_sleep(1);
        if ((++sp & 255u) == 0u) { if (xb_ld(&bar[XB_TMO])) break; if (sp > XB_SPIN_CAP) { atomicAdd(&bar[XB_TMO], 1u); break; } }
    }
    nloc = mine > 0u ? mine : 1u; nx = cnt > 0u ? cnt : 1u; dense = below;
}
__device__ __forceinline__ void xcd_barrier(unsigned* bar, volatile LAS unsigned* st) {
    asm volatile("s_waitcnt vmcnt(0)" ::: "memory");
    __syncthreads();
    if (opaque_tid() == 0) {
        __builtin_amdgcn_s_waitcnt(0);
        const unsigned x = st[3];
        unsigned nloc = st[0], nx = st[1];
        if (nloc == 0u) {
            unsigned dense;
            xcd_barrier_complete(bar, x, nloc, nx, dense); st[0] = nloc; st[1] = nx;
            const unsigned use_xcc = (nx == 8u) ? 1u : 0u;
            st[4] = use_xcc ? dense : (blockIdx.x & 7u);
            st[5] = use_xcc ? st[2] : (blockIdx.x >> 3);
            st[6] = use_xcc ? nloc : (gridDim.x >> 3);
        }
        const unsigned old = xb_add(&bar[XB_XSUB(x)], 1u);
        const unsigned gen = old / nloc;
        if (old + 1u == (gen + 1u) * nloc) {
            __builtin_amdgcn_fence(__ATOMIC_RELEASE, "agent");
            asm volatile("s_waitcnt vmcnt(0)" ::: "memory");
            const unsigned og = xb_add(&bar[XB_TOP], 1u);
            const unsigned tg = og / nx;
            if (og + 1u == (tg + 1u) * nx) xb_add(&bar[XB_TOPGEN], 1u);
            else XB_SPIN(xb_ld(&bar[XB_TOPGEN]) == tg, bar);
            __builtin_amdgcn_fence(__ATOMIC_ACQUIRE, "agent");
            xb_add(&bar[XB_XGEN(x)], 1u);
            asm volatile("s_waitcnt vmcnt(0)" ::: "memory");
        } else {
            XB_SPIN(xb_ld(&bar[XB_XGEN(x)]) == gen, bar);
            __builtin_amdgcn_fence(__ATOMIC_ACQUIRE, "agent");
            asm volatile("s_waitcnt vmcnt(0)" ::: "memory");
        }
    }
    __syncthreads();
}

#define MEGA_SMEM (GEMM_SMEM + 2048 + 64)
#define N_PHASES 14
__global__ void __launch_bounds__(256, 2) mega(Params p) {
    extern __shared__ __attribute__((aligned(16))) char smem[];
    volatile LAS unsigned* st = (volatile LAS unsigned*)(smem + GEMM_SMEM + 2048);
    if (p.ph_hi - p.ph_lo > 1) {
        if (opaque_tid() == 0) {
            const unsigned x = xb_xcc_id();
            st[0] = 0u; st[1] = 0u; st[3] = x;
            st[2] = xb_add(&p.bar()[XB_XCNT(x)], 1u);
        }
    } else {
        if (opaque_tid() == 0) { st[0] = gridDim.x >> 3; st[1] = 8u; st[2] = blockIdx.x >> 3; st[3] = blockIdx.x & 7; st[4] = blockIdx.x & 7; st[5] = blockIdx.x >> 3; st[6] = gridDim.x >> 3; }
    }
    __syncthreads();
#ifndef REP_PHASE
#define REP_PHASE -1
#endif
#ifdef PHPROF
#define PH_STAMP(N) if (blockIdx.x == 0 && opaque_tid() == 0) ((unsigned long long*)(p.ws + OFF_counts + 1536))[N] = __builtin_amdgcn_s_memrealtime();
#else
#define PH_STAMP(N)
#endif
#define RUN_PHASE(N, CALL) if (p.ph_lo <= N && N < p.ph_hi) { if (N > p.ph_lo) xcd_barrier(p.bar(), st); PH_STAMP(N) { const int rep = 0; (void)rep; CALL; } \
        if (REP_PHASE == N) { xcd_barrier(p.bar(), st); { const int rep = 1; (void)rep; CALL; } } }
    RUN_PHASE(0, phase0(p, smem))
    RUN_PHASE(1, phase1(p))
    RUN_PHASE(2, phase2(p, smem))
    RUN_PHASE(3, phase3(p, smem))
    RUN_PHASE(4, phase4(p, smem))
    RUN_PHASE(5, phase5a(p, smem, rep))
    RUN_PHASE(6, phase5b(p, smem, rep))
    RUN_PHASE(7, phase6(p, smem))
    RUN_PHASE(8, phase7(p))
    RUN_PHASE(9, phase8(p, smem))
    RUN_PHASE(10, phase9(p))
    RUN_PHASE(11, phase10(p, smem))
    RUN_PHASE(12, phase11(p, smem))
    RUN_PHASE(13, phase12(p))
#ifdef EXTRA_BARRIERS
    for (int i = 0; i < EXTRA_BARRIERS; ++i) xcd_barrier(p.bar(), st);
#endif
    PH_STAMP(14)
    PH_STAMP(15)
}
#if DBG
struct NaiveBufs { float *mod, *h, *proj, *flat, *hidk, *hidv, *kc, *vc, *mix, *ograw, *y, *x1, *logits; };
__device__ __forceinline__ void dbg_pair(int seam, size_t i, const Params& p, const NaiveBufs& nb, float& a, float& b, bool& use) {
    use = true; a = 0.f; b = 0.f;
    switch (seam) {
        case 0: {
            a = nb.mod[i]; b = p.mod()[i]; break; }
        case 1: {
            size_t tok = i / PCOLS; int n = (int)(i % PCOLS);
            int src = win_srccol(n);
            bool transposed = (n >= 896 && n < 1024) || (n >= 1152 && n < 1280) || (n >= 1792 && n < 2304) || n >= 2816;
            if (transposed || src < 0) { use = false; break; }
            a = nb.proj[tok * IN_COLS + src]; b = bf2f(p.Pb()[i]); break; }
        case 2: {
            size_t half = (size_t)BATCH * 128 * SEQ; int which = i >= half; size_t j = which ? i - half : i;
            int t = (int)(j % SEQ); int f = (int)((j / SEQ) % 128); int bb = (int)(j / ((size_t)SEQ * 128));
            a = nb.proj[((size_t)bb * SEQ + t) * IN_COLS + (which ? C_VW : C_VS) + f];
            b = bf2f(which ? p.VwT()[j] : p.VsT()[j]); break; }
        case 3: {
            size_t nv = (size_t)BATCH * 512 * SEQ;
            if (i < nv) { int t = (int)(i % SEQ); int f = (int)((i / SEQ) % 512); int bb = (int)(i / ((size_t)SEQ * 512));
                a = nb.proj[((size_t)bb * SEQ + t) * IN_COLS + C_GV + f]; b = bf2f(p.VgT()[i]); }
            else { size_t j = i - nv; size_t tok = j / 40; int f = (int)(j % 40);
                a = nb.proj[tok * IN_COLS + (f < 24 ? C_NG + f : C_GLR + f - 24)]; b = p.misc()[tok * 64 + f]; }
            break; }
        case 4: {
            size_t nk = (size_t)BATCH * NCMP * 2 * 64;
            size_t j = i < nk ? i : i - nk;
            int d = (int)(j % 64); int g = (int)((j / 64) % 2); int ii = (int)((j / 128) % NCMP); int bb = (int)(j / (128 * NCMP));
            if (i < nk) { a = nb.kc[j]; b = bf2f(p.kc()[((size_t)(bb * 2 + g) * 256 + ii) * 64 + d]); }
            else { a = nb.vc[j]; b = bf2f(p.vcT()[((size_t)(bb * 2 + g) * 64 + d) * 256 + ii]); }
            break; }
        case 5: {
            size_t tok = i / 512; int cidx = (int)(i % 512);
            a = nb.mix[tok * 1024 + cidx]; b = bf2f(p.mixb()[tok * 1024 + cidx]); break; }
        case 6: {
            size_t tok = i / 512; int cidx = (int)(i % 512);
            a = nb.mix[tok * 1024 + 512 + cidx]; b = bf2f(p.mixb()[tok * 1024 + 512 + cidx]); break; }
        case 7: { a = nb.x1[i]; b = p.x1()[i]; break; }
        case 8: { a = nb.logits[i]; b = p.logits()[i]; break; }
    }
}
__global__ __launch_bounds__(256) void dbg_compare(int seam, size_t n, Params p, NaiveBufs nb, float* dbg) {
    __shared__ float red[256];
    float sd = 0.f, sa = 0.f;
    for (size_t i = (size_t)blockIdx.x * 256 + threadIdx.x; i < n; i += (size_t)gridDim.x * 256) {
        float a, b; bool use;
        dbg_pair(seam, i, p, nb, a, b, use);
        if (use) { float d = a - b; if (!(d == d)) d = 1e10f; sd += d * d; sa += a * a; }
    }
    sd = blk_sum(sd, red); sa = blk_sum(sa, red);
    if (threadIdx.x == 0) { atomicAdd(&dbg[2 * seam], sd); atomicAdd(&dbg[2 * seam + 1], sa); }
}
__global__ void dbg_decide(float* dbg, int nseams, int report_seam) {
    float code = 0.f;
    for (int k = 0; k < nseams; ++k) {
        float err = dbg[2 * k] / fmaxf(dbg[2 * k + 1], 1e-30f);
        const float thr = (k == 5) ? 3e-2f : 1e-3f;
        bool bad = !(err < thr);
        if (bad || k == report_seam) {
            float lg = log10f(fmaxf(err, 1e-12f));
            int dgt = (int)floorf(lg) + 6; dgt = dgt < 0 ? 0 : (dgt > 9 ? 9 : dgt);
            code = 100.f * (k + 1) + 10.f * dgt; break;
        }
    }
    dbg[64] = code;
}
__global__ void dbg_apply(const float* dbg, float* out, size_t n) {
    float code = dbg[64];
    if (code <= 0.f) return;
    float cst = sqrtf(code);
    for (size_t i = (size_t)blockIdx.x * 256 + threadIdx.x; i < n; i += (size_t)gridDim.x * 256) out[i] = cst;
}
#endif

#ifdef PROF
__global__ void prof_apply(const unsigned long long* pw, float* out, size_t n, int sel) {
    const double proc = (double)pw[0], tot = (double)pw[1], steps = (double)pw[2];
    float code = 0.f;
    if (sel == 0) code = (float)(100.0 * proc / tot);
    if (sel == 1) code = (float)(tot / steps / 10.0);
    if (sel == 2) code = (float)(proc / steps / 10.0);
    if (sel == 3) code = (float)(steps / 1024.0);
    const float cst = sqrtf(code);
    for (size_t i = (size_t)blockIdx.x * 256 + threadIdx.x; i < n; i += (size_t)gridDim.x * 256) out[i] = cst;
}
#endif
#ifdef PHPROF
__global__ void phase_prof_apply(const unsigned long long* ts, float* out, size_t n, int sel) {
    double us;
    if (sel >= 100) us = (double)(ts[15] - ts[0]) / 100.0;
    else us = (double)(ts[sel + 1] - ts[sel]) / 100.0;
    const float cst = (float)log2(us > 1.0 ? us : 1.0);
    for (size_t i = (size_t)blockIdx.x * 256 + threadIdx.x; i < n; i += (size_t)gridDim.x * 256) out[i] = cst;
}
#endif
extern "C" void kernel_launch(void* const* d_in, const int* in_sizes, int n_in, void* d_out, int out_size,
                              void* d_ws, size_t ws_size, hipStream_t stream) {
    Params p{};
    const float** ins = (const float**)&p;
    for (int i = 0; i < 27; ++i) ins[i] = (const float*)d_in[i];
    p.out = (float*)d_out;

    char* ws = (char*)d_ws;
    p.ws = ws;
    if (WS_TOTAL > ws_size) return;
#if DBG
    size_t off = 0;
    auto alloc = [&](size_t bytes) { char* q = ws + off; off += (bytes + 255) & ~(size_t)255; return q; };
    NaiveBufs nb{};
    nb.mod = (float*)alloc(4 * 6144 * 4);
    nb.h = (float*)alloc((size_t)NTOK * 1024 * 4);
    nb.proj = (float*)alloc((size_t)NTOK * IN_COLS * 4);
    nb.flat = (float*)alloc((size_t)2040 * 2048 * 4);
    nb.hidk = (float*)alloc((size_t)2040 * 256 * 4);
    nb.hidv = (float*)alloc((size_t)2040 * 256 * 4);
    nb.kc = (float*)alloc((size_t)2040 * 64 * 4);
    nb.vc = (float*)alloc((size_t)2040 * 64 * 4);
    nb.mix = (float*)alloc((size_t)NTOK * 1024 * 4);
    nb.ograw = (float*)alloc((size_t)NTOK * 512 * 4);
    nb.y = (float*)alloc((size_t)NTOK * 1024 * 4);
    nb.x1 = (float*)alloc((size_t)NTOK * 1024 * 4);
    nb.logits = (float*)alloc((size_t)NTOK * 256 * 4);
    float* dbg = (float*)alloc(1024);
    if (off > WS_BASE) return;
#endif

    static int grid = 0;
    if (grid == 0) {
        int dev = 0, cus = 0, per_cu = 0;
        (void)hipGetDevice(&dev);
        (void)hipDeviceGetAttribute(&cus, hipDeviceAttributeMultiprocessorCount, dev);
        (void)hipFuncSetAttribute((const void*)mega, hipFuncAttributeMaxDynamicSharedMemorySize, MEGA_SMEM);
        (void)hipOccupancyMaxActiveBlocksPerMultiprocessor(&per_cu, (const void*)mega, 256, MEGA_SMEM);
        if (per_cu > 2) per_cu = 2;
        if (per_cu < 1) per_cu = 1;
        grid = cus * per_cu;
        grid &= ~7;
    }
    (void)hipMemsetAsync(ws + OFF_bar, 0, XCD_BAR_WORDS * 4, stream);

#if DBG
    (void)hipMemsetAsync(dbg, 0, 1024, stream);
    nk_mod<<<dim3(24, 4), 256, 0, stream>>>(p.c, p.w_mod, p.b_mod, nb.mod);
    nk_lnmod<<<NTOK, 256, 0, stream>>>(p.x, nb.mod, 0, 1024, nb.h);
    nk_gemm<<<dim3((IN_COLS + 63) / 64, NTOK / 64), 256, 0, stream>>>(nb.h, 1024, p.w_in, IN_COLS, nb.proj, IN_COLS, NTOK, IN_COLS, 1024);
    nk_flat<<<2040, 256, 0, stream>>>(nb.proj, C_KC, p.pos_k, nb.flat);
    nk_gemm<<<dim3(4, 32), 256, 0, stream>>>(nb.flat, 2048, p.w1_k, 256, nb.hidk, 256, 2040, 256, 2048);
    nk_silu<<<(2040 * 256 + 255) / 256, 256, 0, stream>>>(nb.hidk, 2040 * 256);
    nk_gemm<<<dim3(1, 32), 256, 0, stream>>>(nb.hidk, 256, p.w2_k, 64, nb.kc, 64, 2040, 64, 256);
    nk_flat<<<2040, 256, 0, stream>>>(nb.proj, C_VC, p.pos_v, nb.flat);
    nk_gemm<<<dim3(4, 32), 256, 0, stream>>>(nb.flat, 2048, p.w1_v, 256, nb.hidv, 256, 2040, 256, 2048);
    nk_silu<<<(2040 * 256 + 255) / 256, 256, 0, stream>>>(nb.hidv, 2040 * 256);
    nk_gemm<<<dim3(1, 32), 256, 0, stream>>>(nb.hidv, 256, p.w2_v, 64, nb.vc, 64, 2040, 64, 256);
    nk_nsa<<<NTOK, 256, 0, stream>>>(nb.proj, nb.kc, nb.vc, nb.mix);
    nk_gla<<<64, 256, 0, stream>>>(nb.proj, p.w_a2, p.b_a2, nb.ograw);
    nk_gla_norm<<<NTOK, 256, 0, stream>>>(nb.ograw, nb.proj, p.norm_w, nb.mix);
    nk_gemm<<<dim3(16, NTOK / 64), 256, 0, stream>>>(nb.mix, 1024, p.w_o, 1024, nb.y, 1024, NTOK, 1024, 1024);
    nk_resln<<<NTOK, 256, 0, stream>>>(p.x, nb.y, nb.mod, 2048, p.ln1_g, p.ln1_b, nb.x1);
    nk_lnmod<<<NTOK, 256, 0, stream>>>(nb.x1, nb.mod, 3072, 4096, nb.h);
    nk_gemm<<<dim3(4, NTOK / 64), 256, 0, stream>>>(nb.h, 1024, p.w_router, 256, nb.logits, 256, NTOK, 256, 1024);
    auto cmp = [&](int seam, size_t n) { dbg_compare<<<1024, 256, 0, stream>>>(seam, n, p, nb, dbg); };
#endif

#if SINGLE_LAUNCH
    p.ph_lo = 0; p.ph_hi = N_PHASES;
    mega<<<grid, 256, MEGA_SMEM, stream>>>(p);
#else
    for (int ph = 0; ph < N_PHASES; ++ph) {
        p.ph_lo = ph; p.ph_hi = ph + 1;
        mega<<<grid, 256, MEGA_SMEM, stream>>>(p);
#if DBG
        if (ph == 0) cmp(0, 4 * 6144);
        if (ph == 2) { cmp(1, (size_t)NTOK * PCOLS); cmp(2, (size_t)2 * BATCH * 128 * SEQ); cmp(3, (size_t)BATCH * 512 * SEQ + (size_t)NTOK * 40); }
        if (ph == 4) cmp(4, (size_t)2 * BATCH * NCMP * 128);
        if (ph == 5) { cmp(5, (size_t)NTOK * 512); cmp(6, (size_t)NTOK * 512); }
        if (ph == 7) cmp(7, (size_t)NTOK * 1024);
        if (ph == 8) cmp(8, (size_t)NTOK * 256);
#endif
    }
#endif
#ifdef PHPROF
    phase_prof_apply<<<1024, 256, 0, stream>>>((const unsigned long long*)(ws + OFF_counts + 1536), p.out, (size_t)NTOK * 1024, PHPROF);
#endif
#ifdef PROF
    prof_apply<<<1024, 256, 0, stream>>>((const unsigned long long*)(ws + OFF_counts + 1024), p.out, (size_t)NTOK * 1024, PROF);
#endif
#if DBG
    dbg_decide<<<1, 1, 0, stream>>>(dbg, 9, DBG_REPORT);
    dbg_apply<<<1024, 256, 0, stream>>>(dbg, p.out, (size_t)NTOK * 1024);
#endif
}
```

```cpp
#include <hip/hip_runtime.h>
#include <hip/hip_bf16.h>
#include <stdint.h>

#define D_MODEL 1024
#define BATCH 4
#define SEQ 4096
#define NTOK (BATCH * SEQ)
#define IN_COLS 2856
#define NCMP 255
#define NEGF (-1e30f)
#define C_NQ 0
#define C_KC 512
#define C_VC 640
#define C_KS 768
#define C_VS 896
#define C_KW 1024
#define C_VW 1152
#define C_NG 1280
#define C_GQ 1304
#define C_GK 1560
#define C_GV 1816
#define C_GLR 2328
#define C_GR 2344
#define N_EXP 256
#define TOPK 8

__device__ __forceinline__ float siluf(float x) { return x / (1.f + __expf(-x)); }
__device__ __forceinline__ float sigmoidf_(float x) { return 1.f / (1.f + __expf(-x)); }

__device__ __forceinline__ float blk_sum(float v, float* red) {
    int t = threadIdx.x;
    __syncthreads();
    red[t] = v; __syncthreads();
    for (int s = 128; s > 0; s >>= 1) { if (t < s) red[t] += red[t + s]; __syncthreads(); }
    float r = red[0];
    return r;
}
__device__ __forceinline__ float blk_max(float v, float* red) {
    int t = threadIdx.x;
    __syncthreads();
    red[t] = v; __syncthreads();
    for (int s = 128; s > 0; s >>= 1) { if (t < s) red[t] = fmaxf(red[t], red[t + s]); __syncthreads(); }
    float r = red[0];
    return r;
}

#define DBG 0
#define SINGLE_LAUNCH 1
#define DBG_REPORT -1
#define REP_PHASE -1
#if DBG
__global__ __launch_bounds__(256) void nk_mod(const float* c, const float* w_mod, const float* b_mod, float* mod) {
    int j = blockIdx.x * 256 + threadIdx.x; int b = blockIdx.y;
    float acc = b_mod[j];
    for (int k = 0; k < D_MODEL; ++k) acc += siluf(c[b * D_MODEL + k]) * w_mod[(size_t)k * 6144 + j];
    mod[b * 6144 + j] = acc;
}

__global__ __launch_bounds__(256) void nk_lnmod(const float* x, const float* mod, int sh_off, int sc_off, float* out) {
    __shared__ float red[256];
    int row = blockIdx.x; int b = row / SEQ; int t = threadIdx.x;
    const float* xr = x + (size_t)row * D_MODEL;
    float v[4]; float s = 0.f;
    for (int i = 0; i < 4; ++i) { v[i] = xr[t + 256 * i]; s += v[i]; }
    float mu = blk_sum(s, red) * (1.f / D_MODEL);
    float q = 0.f;
    for (int i = 0; i < 4; ++i) { float d = v[i] - mu; q += d * d; }
    float var = blk_sum(q, red) * (1.f / D_MODEL);
    float rstd = rsqrtf(var + 1e-5f);
    for (int i = 0; i < 4; ++i) {
        int col = t + 256 * i;
        out[(size_t)row * D_MODEL + col] = (v[i] - mu) * rstd * (1.f + mod[b * 6144 + sc_off + col]) + mod[b * 6144 + sh_off + col];
    }
}

__global__ __launch_bounds__(256) void nk_resln(const float* x, const float* y, const float* mod, int ga_off, const float* g, const float* bb, float* out) {
    __shared__ float red[256];
    int row = blockIdx.x; int b = row / SEQ; int t = threadIdx.x;
    const float alpha = 1.189207115f;
    float v[4]; float s = 0.f;
    for (int i = 0; i < 4; ++i) {
        int col = t + 256 * i;
        v[i] = alpha * x[(size_t)row * D_MODEL + col] + (1.f + mod[b * 6144 + ga_off + col]) * y[(size_t)row * D_MODEL + col];
        s += v[i];
    }
    float mu = blk_sum(s, red) * (1.f / D_MODEL);
    float q = 0.f;
    for (int i = 0; i < 4; ++i) { float d = v[i] - mu; q += d * d; }
    float var = blk_sum(q, red) * (1.f / D_MODEL);
    float rstd = rsqrtf(var + 1e-5f);
    for (int i = 0; i < 4; ++i) {
        int col = t + 256 * i;
        out[(size_t)row * D_MODEL + col] = (v[i] - mu) * rstd * g[col] + bb[col];
    }
}

__global__ __launch_bounds__(256) void nk_gemm(const float* A, int lda, const float* B, int ldb, float* C, int ldc, int M, int N, int K) {
    __shared__ float sA[16][64 + 1];
    __shared__ float sB[16][64 + 1];
    int tx = threadIdx.x & 15, ty = threadIdx.x >> 4;
    int m0 = blockIdx.y * 64, n0 = blockIdx.x * 64;
    float acc[4][4];
    for (int i = 0; i < 4; ++i) for (int j = 0; j < 4; ++j) acc[i][j] = 0.f;
    for (int k0 = 0; k0 < K; k0 += 16) {
        for (int e = threadIdx.x; e < 1024; e += 256) {
            int r = e >> 4, kk = e & 15;
            int gm = m0 + r;
            sA[kk][r] = (gm < M) ? A[(size_t)gm * lda + k0 + kk] : 0.f;
            int kb = e >> 6, nn = e & 63;
            int gn = n0 + nn;
            sB[kb][nn] = (gn < N) ? B[(size_t)(k0 + kb) * ldb + gn] : 0.f;
        }
        __syncthreads();
#pragma unroll
        for (int kk = 0; kk < 16; ++kk) {
            float a[4], bv[4];
#pragma unroll
            for (int i = 0; i < 4; ++i) a[i] = sA[kk][ty * 4 + i];
#pragma unroll
            for (int j = 0; j < 4; ++j) bv[j] = sB[kk][tx * 4 + j];
#pragma unroll
            for (int i = 0; i < 4; ++i)
#pragma unroll
                for (int j = 0; j < 4; ++j) acc[i][j] += a[i] * bv[j];
        }
        __syncthreads();
    }
#pragma unroll
    for (int i = 0; i < 4; ++i)
#pragma unroll
        for (int j = 0; j < 4; ++j) {
            int gm = m0 + ty * 4 + i, gn = n0 + tx * 4 + j;
            if (gm < M && gn < N) C[(size_t)gm * ldc + gn] = acc[i][j];
        }
}

__global__ __launch_bounds__(256) void nk_flat(const float* proj, int col0, const float* pos, float* flat) {
    int r = blockIdx.x;
    int g = r & 1; int bi = r >> 1; int i = bi % NCMP; int b = bi / NCMP;
    for (int e = threadIdx.x; e < 2048; e += 256) {
        int l = e >> 6, d = e & 63;
        flat[(size_t)r * 2048 + e] = proj[((size_t)b * SEQ + 16 * i + l) * IN_COLS + col0 + g * 64 + d] + pos[l * 64 + d];
    }
}
__global__ void nk_silu(float* x, int n) { int i = blockIdx.x * 256 + threadIdx.x; if (i < n) x[i] = siluf(x[i]); }

__global__ __launch_bounds__(256) void nk_nsa(const float* proj, const float* kc, const float* vc, float* mix) {
    __shared__ float sq[8][64];
    __shared__ float sp[1024];
    __shared__ float red[256];
    __shared__ float simp[64];
    __shared__ float sscore[64];
    __shared__ int sidx[16];
    __shared__ float sout[8][64];
    __shared__ float spart[4][64];
    const int tid = threadIdx.x;
    const int bt = blockIdx.x; const int b = bt / SEQ, t = bt % SEQ;
    const float* prow = proj + (size_t)bt * IN_COLS;
    for (int e = tid; e < 512; e += 256) { sq[e >> 6][e & 63] = prow[C_NQ + e] * 0.125f; sout[e >> 6][e & 63] = 0.f; }
    __syncthreads();
    const int tblk = t >> 6;
    const int dd = tid & 63, part = tid >> 6;
    for (int g = 0; g < 2; ++g) {
        if (tid < 64) simp[tid] = 0.f;
        __syncthreads();
        for (int hp = 0; hp < 4; ++hp) {
            int h = g * 4 + hp;
            float slope = exp2f(-(float)(h + 1));
            float s = NEGF; bool valid = false;
            if (tid < NCMP) {
                int ce = 16 * tid + 31;
                valid = (t >= ce);
                if (valid) {
                    const float* kr = kc + (((size_t)b * NCMP + tid) * 2 + g) * 64;
                    float a = 0.f;
                    for (int d = 0; d < 64; ++d) a += sq[h][d] * kr[d];
                    s = a - slope * (float)(t - ce);
                }
            }
            float m = blk_max(s, red);
            float e = valid ? __expf(s - m) : 0.f;
            float sum = blk_sum(e, red);
            float p = e / fmaxf(sum, 1e-30f);
            __syncthreads();
            sp[tid] = p;
            __syncthreads();
            float a = 0.f;
            for (int i = part; i < NCMP; i += 4) a += sp[i] * vc[(((size_t)b * NCMP + i) * 2 + g) * 64 + dd];
            spart[part][dd] = a;
            __syncthreads();
            if (tid < 64) {
                float o = spart[0][tid] + spart[1][tid] + spart[2][tid] + spart[3][tid];
                float gate = sigmoidf_(prow[C_NG + h * 3 + 0]);
                sout[h][tid] += gate * o;
                int j = tid;
                float im = sp[4 * j] + sp[4 * j + 1] + sp[4 * j + 2] + 0.5f * sp[4 * j + 3] + (j > 0 ? 0.5f * sp[4 * j - 1] : 0.f);
                simp[j] += im;
            }
            __syncthreads();
        }
        if (tid < 64) {
            int j = tid;
            bool forced = (j == 0) || (j == tblk) || (j == tblk - 1);
            sscore[j] = (j <= tblk) ? (simp[j] + (forced ? 1e4f : 0.f)) : NEGF;
        }
        __syncthreads();
        if (tid < 64) {
            int j = tid; float sj = sscore[j]; int rank = 0;
            for (int j2 = 0; j2 < 64; ++j2) { float s2 = sscore[j2]; if (s2 > sj || (s2 == sj && j2 < j)) ++rank; }
            if (rank < 16) sidx[rank] = j;
        }
        __syncthreads();
        for (int hp = 0; hp < 4; ++hp) {
            int h = g * 4 + hp;
            float slope = exp2f(-(float)(h + 1));
            float sv[4]; bool vl[4]; float mx = NEGF;
            for (int r = 0; r < 4; ++r) {
                int kk = tid + 256 * r;
                int kpos = sidx[kk >> 6] * 64 + (kk & 63);
                vl[r] = (kpos <= t);
                sv[r] = NEGF;
                if (vl[r]) {
                    const float* kr = proj + ((size_t)b * SEQ + kpos) * IN_COLS + C_KS + g * 64;
                    float a = 0.f;
                    for (int d = 0; d < 64; ++d) a += sq[h][d] * kr[d];
                    sv[r] = a - slope * (float)(t - kpos);
                }
                mx = fmaxf(mx, sv[r]);
            }
            float m = blk_max(mx, red);
            float es = 0.f; float ev[4];
            for (int r = 0; r < 4; ++r) { ev[r] = vl[r] ? __expf(sv[r] - m) : 0.f; es += ev[r]; }
            float sum = blk_sum(es, red);
            float inv = 1.f / fmaxf(sum, 1e-30f);
            __syncthreads();
            for (int r = 0; r < 4; ++r) sp[tid + 256 * r] = ev[r] * inv;
            __syncthreads();
            float a = 0.f;
            for (int kk = part; kk < 1024; kk += 4) {
                float p = sp[kk];
                if (p != 0.f) {
                    int kpos = sidx[kk >> 6] * 64 + (kk & 63);
                    a += p * proj[((size_t)b * SEQ + kpos) * IN_COLS + C_VS + g * 64 + dd];
                }
            }
            spart[part][dd] = a;
            __syncthreads();
            if (tid < 64) {
                float o = spart[0][tid] + spart[1][tid] + spart[2][tid] + spart[3][tid];
                float gate = sigmoidf_(prow[C_NG + h * 3 + 1]);
                sout[h][tid] += gate * o;
            }
            __syncthreads();
        }
        for (int hp = 0; hp < 4; ++hp) {
            int h = g * 4 + hp;
            float slope = exp2f(-(float)(h + 1));
            float sv[2]; bool vl[2]; float mx = NEGF;
            for (int r = 0; r < 2; ++r) {
                int kk = tid + 256 * r;
                int kpos = t - 511 + kk;
                vl[r] = (kpos >= 0);
                sv[r] = NEGF;
                if (vl[r]) {
                    const float* kr = proj + ((size_t)b * SEQ + kpos) * IN_COLS + C_KW + g * 64;
                    float a = 0.f;
                    for (int d = 0; d < 64; ++d) a += sq[h][d] * kr[d];
                    sv[r] = a - slope * (float)(t - kpos);
                }
                mx = fmaxf(mx, sv[r]);
            }
            float m = blk_max(mx, red);
            float es = 0.f; float ev[2];
            for (int r = 0; r < 2; ++r) { ev[r] = vl[r] ? __expf(sv[r] - m) : 0.f; es += ev[r]; }
            float sum = blk_sum(es, red);
            float inv = 1.f / fmaxf(sum, 1e-30f);
            __syncthreads();
            for (int r = 0; r < 2; ++r) sp[tid + 256 * r] = ev[r] * inv;
            __syncthreads();
            float a = 0.f;
            for (int kk = part; kk < 512; kk += 4) {
                float p = sp[kk];
                if (p != 0.f) {
                    int kpos = t - 511 + kk;
                    a += p * proj[((size_t)b * SEQ + kpos) * IN_COLS + C_VW + g * 64 + dd];
                }
            }
            spart[part][dd] = a;
            __syncthreads();
            if (tid < 64) {
                float o = spart[0][tid] + spart[1][tid] + spart[2][tid] + spart[3][tid];
                float gate = sigmoidf_(prow[C_NG + h * 3 + 2]);
                sout[h][tid] += gate * o;
            }
            __syncthreads();
        }
    }
    for (int e = tid; e < 512; e += 256) mix[(size_t)bt * D_MODEL + e] = sout[e >> 6][e & 63];
}

__global__ __launch_bounds__(256) void nk_gla(const float* proj, const float* w_a2, const float* b_a2, float* ograw) {
    __shared__ float sqv[64], skv[64], sav[64];
    __shared__ float red[8][32];
    const int tid = threadIdx.x;
    const int es = blockIdx.x & 3, bh = blockIdx.x >> 2, h = bh & 3, b = bh >> 2;
    const int e = tid & 31, dg = tid >> 5;
    float S[8];
    for (int i = 0; i < 8; ++i) S[i] = 0.f;
    for (int t = 0; t < SEQ; ++t) {
        const float* prow = proj + ((size_t)b * SEQ + t) * IN_COLS;
        if (tid < 64) {
            int d = tid;
            sqv[d] = prow[C_GQ + h * 64 + d] * 0.125f;
            skv[d] = prow[C_GK + h * 64 + d];
            float x = b_a2[h * 64 + d];
            for (int r = 0; r < 16; ++r) x += prow[C_GLR + r] * w_a2[r * 256 + h * 64 + d];
            float ls = -(fmaxf(-x, 0.f) + log1pf(__expf(-fabsf(x))));
            sav[d] = __expf(ls * (1.f / 16.f));
        }
        __syncthreads();
        float v = prow[C_GV + h * 128 + es * 32 + e];
        float part = 0.f;
        for (int i = 0; i < 8; ++i) {
            int d = dg * 8 + i;
            S[i] = sav[d] * S[i] + skv[d] * v;
            part += sqv[d] * S[i];
        }
        red[dg][e] = part;
        __syncthreads();
        if (tid < 32) {
            float o = 0.f;
            for (int i = 0; i < 8; ++i) o += red[i][tid];
            ograw[((size_t)b * SEQ + t) * 512 + h * 128 + es * 32 + tid] = o;
        }
    }
}
__global__ __launch_bounds__(256) void nk_gla_norm(const float* ograw, const float* proj, const float* norm_w, float* mix) {
    int wid = (blockIdx.x * 256 + threadIdx.x) >> 6; int lane = threadIdx.x & 63;
    int tok = wid >> 2, h = wid & 3;
    const float* o = ograw + (size_t)tok * 512 + h * 128;
    float a = o[lane], c = o[lane + 64];
    float s = a + c;
    for (int m = 32; m > 0; m >>= 1) s += __shfl_xor(s, m);
    float mu = s * (1.f / 128.f);
    float q = (a - mu) * (a - mu) + (c - mu) * (c - mu);
    for (int m = 32; m > 0; m >>= 1) q += __shfl_xor(q, m);
    float rstd = rsqrtf(q * (1.f / 128.f) + 1e-5f);
    const float* r = proj + (size_t)tok * IN_COLS + C_GR + h * 128;
    mix[(size_t)tok * D_MODEL + 512 + h * 128 + lane] = (a - mu) * rstd * norm_w[lane] * siluf(r[lane]);
    mix[(size_t)tok * D_MODEL + 512 + h * 128 + lane + 64] = (c - mu) * rstd * norm_w[lane + 64] * siluf(r[lane + 64]);
}

__global__ __launch_bounds__(256) void nk_route(const float* logits, const float* rbias, int* eidx, float* ew, int* counts, int* lists) {
    int wid = (blockIdx.x * 256 + threadIdx.x) >> 6; int lane = threadIdx.x & 63;
    int tok = wid;
    float s[4], sb[4];
    for (int i = 0; i < 4; ++i) { float l = logits[(size_t)tok * 256 + lane * 4 + i]; s[i] = 1.f / (1.f + __expf(-l)); sb[i] = s[i] + rbias[lane * 4 + i]; }
    float m1 = NEGF, m2 = NEGF;
    for (int i = 0; i < 4; ++i) { float v = sb[i]; if (v > m1) { m2 = m1; m1 = v; } else if (v > m2) m2 = v; }
    for (int m = 1; m < 8; m <<= 1) {
        float o1 = __shfl_xor(m1, m), o2 = __shfl_xor(m2, m);
        float n1 = fmaxf(m1, o1);
        float n2 = fmaxf(fminf(m1, o1), fmaxf(m2, o2));
        m1 = n1; m2 = n2;
    }
    float gs = m1 + m2;
    int grp = lane >> 3;
    int grank = 0;
    for (int g2 = 0; g2 < 8; ++g2) { float o = __shfl(gs, g2 * 8); if (o > gs || (o == gs && g2 < grp)) ++grank; }
    bool gsel = grank < 4;
    float cand[4];
    for (int i = 0; i < 4; ++i) cand[i] = gsel ? sb[i] : NEGF;
    float wsum = 0.f; float myw = 0.f; int mye = 0;
    for (int k = 0; k < TOPK; ++k) {
        float bv = cand[0]; int bi = 0;
        for (int i = 1; i < 4; ++i) if (cand[i] > bv) { bv = cand[i]; bi = i; }
        int be = lane * 4 + bi;
        float gv = bv; int ge = be;
        for (int m = 1; m < 64; m <<= 1) {
            float ov = __shfl_xor(gv, m); int oe = __shfl_xor(ge, m);
            if (ov > gv || (ov == gv && oe < ge)) { gv = ov; ge = oe; }
        }
        float sel_s = 0.f;
        if ((ge >> 2) == lane) {
            int i = ge & 3;
            sel_s = (i == 0) ? s[0] : (i == 1) ? s[1] : (i == 2) ? s[2] : s[3];
            if (i == 0) cand[0] = -3e38f; else if (i == 1) cand[1] = -3e38f; else if (i == 2) cand[2] = -3e38f; else cand[3] = -3e38f;
        }
        sel_s = __shfl(sel_s, ge >> 2);
        wsum += sel_s;
        if (lane == k) { myw = sel_s; mye = ge; }
    }
    if (lane < TOPK) {
        float w = myw / wsum * 2.5f;
        eidx[tok * 8 + lane] = mye; ew[tok * 8 + lane] = w;
        int pos = atomicAdd(&counts[mye], 1);
        lists[(size_t)mye * NTOK + pos] = tok * 8 + lane;
    }
}

__global__ __launch_bounds__(256) void nk_moe(const float* h2, const float* wg, const float* wu, const float* wd,
                                              const float* sg, const float* su, const float* sd,
                                              const int* counts, const int* lists, const float* ew, float* acc) {
    __shared__ float sh[8][D_MODEL];
    __shared__ float shid[8][256];
    __shared__ int stok[8]; __shared__ float sw[8];
    const int e = blockIdx.y, chunk = blockIdx.x, tid = threadIdx.x;
    const int cnt = (e == N_EXP) ? NTOK : counts[e];
    if (chunk * 8 >= cnt) return;
    const float* Wg = (e == N_EXP) ? sg : wg + (size_t)e * D_MODEL * 256;
    const float* Wu = (e == N_EXP) ? su : wu + (size_t)e * D_MODEL * 256;
    const float* Wd = (e == N_EXP) ? sd : wd + (size_t)e * 256 * D_MODEL;
    if (tid < 8) {
        int p = chunk * 8 + tid;
        if (p < cnt) {
            if (e == N_EXP) { stok[tid] = p; sw[tid] = 1.f; }
            else { int id = lists[(size_t)e * NTOK + p]; stok[tid] = id >> 3; sw[tid] = ew[id]; }
        } else { stok[tid] = -1; sw[tid] = 0.f; }
    }
    __syncthreads();
    for (int m = 0; m < 8; ++m) {
        int tk = stok[m];
        for (int k = tid; k < D_MODEL; k += 256) sh[m][k] = (tk >= 0) ? h2[(size_t)tk * D_MODEL + k] : 0.f;
    }
    __syncthreads();
    float ag[8], au[8];
#pragma unroll
    for (int m = 0; m < 8; ++m) { ag[m] = 0.f; au[m] = 0.f; }
    for (int k = 0; k < D_MODEL; ++k) {
        float g = Wg[(size_t)k * 256 + tid], u = Wu[(size_t)k * 256 + tid];
#pragma unroll
        for (int m = 0; m < 8; ++m) { float hv = sh[m][k]; ag[m] += hv * g; au[m] += hv * u; }
    }
#pragma unroll
    for (int m = 0; m < 8; ++m) shid[m][tid] = siluf(ag[m]) * au[m];
    __syncthreads();
    for (int jj = 0; jj < 4; ++jj) {
        int j = tid + 256 * jj;
        float ao[8];
#pragma unroll
        for (int m = 0; m < 8; ++m) ao[m] = 0.f;
        for (int n = 0; n < 256; ++n) {
            float w = Wd[(size_t)n * D_MODEL + j];
#pragma unroll
            for (int m = 0; m < 8; ++m) ao[m] += shid[m][n] * w;
        }
#pragma unroll
        for (int m = 0; m < 8; ++m) { int tk = stok[m]; if (tk >= 0) atomicAdd(&acc[(size_t)tk * D_MODEL + j], ao[m] * sw[m]); }
    }
}

#endif
typedef unsigned short bf16_t;
typedef short bf16x8 __attribute__((ext_vector_type(8)));
typedef float f32x4 __attribute__((ext_vector_type(4)));
typedef unsigned u32x4 __attribute__((ext_vector_type(4)));
typedef unsigned u32x2 __attribute__((ext_vector_type(2)));

#define PCOLS 2944
#define P_NQ 0
#define P_KC 512
#define P_VC 640
#define P_KS 768
#define P_VS 896
#define P_KW 1024
#define P_VW 1152
#define P_GQ 1280
#define P_GK 1536
#define P_GV 1792
#define P_GR 2304
#define P_MISC 2816
#define NASSIGN 9
#define LOG2E 1.4426950408889634f

typedef float f32x2_t __attribute__((ext_vector_type(2)));
typedef __bf16 bf16x2_t __attribute__((ext_vector_type(2)));
__device__ __forceinline__ unsigned pk_bf16(float lo, float hi) { const f32x2_t v = {lo, hi}; return __builtin_bit_cast(unsigned, __builtin_convertvector(v, bf16x2_t)); }
__device__ __forceinline__ float bflo(unsigned u) { return __uint_as_float(u << 16); }
__device__ __forceinline__ float bfhi(unsigned u) { return __uint_as_float(u & 0xffff0000u); }
__device__ __forceinline__ float bf2f(bf16_t v) { return __uint_as_float(((unsigned)v) << 16); }
__device__ __forceinline__ int opaque_tid() { int t = threadIdx.x; asm volatile("" : "+v"(t)); return t; }
__device__ __forceinline__ bf16_t f2bf(float f) { return (bf16_t)(pk_bf16(f, 0.f) & 0xffffu); }

#if DBG
#define WS_BASE ((size_t)560 << 20)
#else
#define WS_BASE ((size_t)0)
#endif
#define WS_ALIGN(x) (((size_t)(x) + 255) & ~(size_t)255)
constexpr size_t OFF_mod = WS_BASE;
constexpr size_t OFF_bias1 = OFF_mod + WS_ALIGN(4*6144*4);
constexpr size_t OFF_wint = OFF_bias1 + WS_ALIGN(2*256*4);
constexpr size_t OFF_wot = OFF_wint + WS_ALIGN((size_t)PCOLS*1024*2);
constexpr size_t OFF_wrt = OFF_wot + WS_ALIGN((size_t)1024*1024*2);
constexpr size_t OFF_w1t = OFF_wrt + WS_ALIGN((size_t)256*1024*2);
constexpr size_t OFF_w2t = OFF_w1t + WS_ALIGN((size_t)2*256*2048*2);
constexpr size_t OFF_hb = OFF_w2t + WS_ALIGN((size_t)2*64*256*2);
constexpr size_t OFF_Pb = OFF_hb + WS_ALIGN((size_t)NTOK*1024*2);
constexpr size_t OFF_VsT = OFF_Pb + WS_ALIGN((size_t)NTOK*PCOLS*2);
constexpr size_t OFF_VwT = OFF_VsT + WS_ALIGN((size_t)BATCH*128*SEQ*2);
constexpr size_t OFF_VgT = OFF_VwT + WS_ALIGN((size_t)BATCH*128*SEQ*2);
constexpr size_t OFF_misc = OFF_VgT + WS_ALIGN((size_t)BATCH*512*SEQ*2);
constexpr size_t OFF_cpart = OFF_misc + WS_ALIGN((size_t)NTOK*64*4);
constexpr size_t OFF_kc = OFF_cpart + WS_ALIGN((size_t)2*4*2048*256*4);
constexpr size_t OFF_vcT = OFF_kc + WS_ALIGN((size_t)8*256*64*2);
constexpr size_t OFF_dST = OFF_vcT + WS_ALIGN((size_t)8*64*256*2);
constexpr size_t OFF_dec = OFF_dST + WS_ALIGN((size_t)16*64*8192*4);
constexpr size_t OFF_ST = OFF_dec + WS_ALIGN((size_t)16*64*64*4);
constexpr size_t OFF_mixf = OFF_ST + WS_ALIGN((size_t)16*64*8192*2);
constexpr size_t OFF_mixb = OFF_mixf + WS_ALIGN((size_t)NTOK*512*4);
constexpr size_t OFF_y1 = OFF_mixb + WS_ALIGN((size_t)NTOK*1024*2);
constexpr size_t OFF_x1 = OFF_y1 + WS_ALIGN((size_t)NTOK*1024*4);
constexpr size_t OFF_logits = OFF_x1 + WS_ALIGN((size_t)NTOK*1024*4);
constexpr size_t OFF_ew = OFF_logits + WS_ALIGN((size_t)NTOK*256*4);
constexpr size_t OFF_counts = OFF_ew + WS_ALIGN((size_t)NTOK*NASSIGN*4);
constexpr size_t OFF_lists = OFF_counts + WS_ALIGN(512*4);
constexpr size_t OFF_bar = OFF_lists + WS_ALIGN((size_t)N_EXP*NTOK*4);
constexpr size_t OFF_hid = OFF_bar + WS_ALIGN(4096*4);
constexpr size_t OFF_outk = OFF_hid + WS_ALIGN((size_t)NTOK*NASSIGN*256*2);
constexpr size_t OFF_selm = OFF_outk + WS_ALIGN((size_t)NTOK*NASSIGN*1024*2);
constexpr size_t OFF_selu = OFF_selm + WS_ALIGN((size_t)NTOK*2*8);
constexpr size_t OFF_mixf2 = OFF_selu + WS_ALIGN((size_t)8*64*4*8);
constexpr size_t OFF_bsave = OFF_mixf2 + WS_ALIGN((size_t)NTOK*512*4);
constexpr size_t WS_TOTAL = OFF_bsave + WS_ALIGN((size_t)1024*4096*4);
struct Params {
    const float *x, *c, *w_mod, *b_mod, *w_in, *pos_k, *w1_k, *w2_k, *pos_v, *w1_v, *w2_v, *w_a2, *b_a2, *norm_w, *w_o, *ln1_g, *ln1_b,
        *w_router, *rbias, *w_e_gate, *w_e_up, *w_e_down, *w_s_gate, *w_s_up, *w_s_down, *ln2_g, *ln2_b;
    float* out;
    char* ws;
    int ph_lo, ph_hi;
    __device__ __forceinline__ float* mod() const { return (float*)(ws + OFF_mod); }
    __device__ __forceinline__ float* bias1() const { return (float*)(ws + OFF_bias1); }
    __device__ __forceinline__ bf16_t* wint() const { return (bf16_t*)(ws + OFF_wint); }
    __device__ __forceinline__ bf16_t* wot() const { return (bf16_t*)(ws + OFF_wot); }
    __device__ __forceinline__ bf16_t* wrt() const { return (bf16_t*)(ws + OFF_wrt); }
    __device__ __forceinline__ bf16_t* w1t() const { return (bf16_t*)(ws + OFF_w1t); }
    __device__ __forceinline__ bf16_t* w2t() const { return (bf16_t*)(ws + OFF_w2t); }
    __device__ __forceinline__ bf16_t* hb() const { return (bf16_t*)(ws + OFF_hb); }
    __device__ __forceinline__ bf16_t* Pb() const { return (bf16_t*)(ws + OFF_Pb); }
    __device__ __forceinline__ bf16_t* VsT() const { return (bf16_t*)(ws + OFF_VsT); }
    __device__ __forceinline__ bf16_t* VwT() const { return (bf16_t*)(ws + OFF_VwT); }
    __device__ __forceinline__ bf16_t* VgT() const { return (bf16_t*)(ws + OFF_VgT); }
    __device__ __forceinline__ float* misc() const { return (float*)(ws + OFF_misc); }
    __device__ __forceinline__ float* cpart() const { return (float*)(ws + OFF_cpart); }
    __device__ __forceinline__ bf16_t* kc() const { return (bf16_t*)(ws + OFF_kc); }
    __device__ __forceinline__ bf16_t* vcT() const { return (bf16_t*)(ws + OFF_vcT); }
    __device__ __forceinline__ float* dST() const { return (float*)(ws + OFF_dST); }
    __device__ __forceinline__ float* dec() const { return (float*)(ws + OFF_dec); }
    __device__ __forceinline__ bf16_t* ST() const { return (bf16_t*)(ws + OFF_ST); }
    __device__ __forceinline__ float* mixf() const { return (float*)(ws + OFF_mixf); }
    __device__ __forceinline__ bf16_t* mixb() const { return (bf16_t*)(ws + OFF_mixb); }
    __device__ __forceinline__ float* y1() const { return (float*)(ws + OFF_y1); }
    __device__ __forceinline__ float* x1() const { return (float*)(ws + OFF_x1); }
    __device__ __forceinline__ float* logits() const { return (float*)(ws + OFF_logits); }
    __device__ __forceinline__ float* ew() const { return (float*)(ws + OFF_ew); }
    __device__ __forceinline__ int* counts() const { return (int*)(ws + OFF_counts); }
    __device__ __forceinline__ int* lists() const { return (int*)(ws + OFF_lists); }
    __device__ __forceinline__ unsigned* bar() const { return (unsigned*)(ws + OFF_bar); }
    __device__ __forceinline__ bf16_t* hid() const { return (bf16_t*)(ws + OFF_hid); }
    __device__ __forceinline__ bf16_t* outk() const { return (bf16_t*)(ws + OFF_outk); }
};

#define LDS_ROW 72
#define TILE_BYTES 16384
#define GEMM_SMEM 69632
__device__ __forceinline__ int swz_key(int row) { return ((row >> 2) & 1) | ((((row >> 1) ^ (row >> 3)) & 1) << 1) | ((((row >> 2) ^ (row >> 4)) & 1) << 2); }
__device__ __forceinline__ int swz_off(int row, int chunk) { return row * 128 + ((chunk ^ swz_key(row)) << 4); }
typedef __attribute__((address_space(3))) unsigned lds_u32;

struct RowsBf16 {
    static constexpr bool NT = false;
    const bf16_t* base; size_t stride;
    __device__ __forceinline__ const bf16_t* ptr(int r, int k) const { return base + (size_t)r * stride + k; }
    __device__ __forceinline__ const bf16_t* pp(int i, int tid, int k) const { return ptr(i * 32 + (tid >> 3), k); }
};
struct GatherBf16 {
    static constexpr bool NT = true;
    const bf16_t* base; size_t stride; const int* rowidx;
    __device__ __forceinline__ const bf16_t* ptr(int r, int k) const { return base + (size_t)rowidx[r] * stride + k; }
    __device__ __forceinline__ const bf16_t* pp(int i, int tid, int k) const { return ptr(i * 32 + (tid >> 3), k); }
};
struct BF32Plain {
    const float* base; size_t ld;
    __device__ __forceinline__ f32x4 load4(int k, int r4) const { return *(const f32x4*)(base + (size_t)k * ld + r4); }
};
struct BF32GateUp {
    const float* g; long du; size_t ld;
    __device__ __forceinline__ f32x4 load4(int k, int r4) const {
        const long sel = ((r4 >> 5) & 1) ? du : 0l;
#ifdef NT_B
        return __builtin_nontemporal_load((const f32x4*)(g + sel + (size_t)k * ld + (r4 >> 6) * 32 + (r4 & 31)));
#else
        return *(const f32x4*)(g + sel + (size_t)k * ld + (r4 >> 6) * 32 + (r4 & 31));
#endif
    }
};

template <class L>
__device__ __forceinline__ void bf16_piece_load(u32x4& r, const L& ld, int k0, int i, int tid) { r = *(const u32x4*)ld.pp(i, tid, k0 + ((tid & 7) << 3)); }
__device__ __forceinline__ void bf16_piece_write(const u32x4& r, char* tile, int i, int tid) { *(u32x4*)(tile + swz_off(i * 32 + (tid >> 3), tid & 7)) = r; }
template <int J0, class BL>
__device__ __forceinline__ void f32_rows_load(f32x4 (&r)[8], const BL& bl, int k0, int tid) {
    const int kg = (tid >> 5) * 8, n4 = (tid & 31) * 4;
#pragma unroll
    for (int j = 0; j < 4; ++j) r[J0 + j] = bl.load4(k0 + kg + J0 + j, n4);
}
template <int I>
__device__ __forceinline__ void f32_col_write(const f32x4 (&r)[8], char* tile, int tid) {
    const int kgc = tid >> 5, n4 = (tid & 31) * 4;
    u32x4 w;
    w.x = pk_bf16(r[0][I], r[1][I]); w.y = pk_bf16(r[2][I], r[3][I]);
    w.z = pk_bf16(r[4][I], r[5][I]); w.w = pk_bf16(r[6][I], r[7][I]);
    *(u32x4*)(tile + swz_off(n4 + I, kgc)) = w;
}

#ifdef USE_SETPRIO
#define SETPRIO_HI __builtin_amdgcn_s_setprio(1);
#define SETPRIO_LO __builtin_amdgcn_s_setprio(0);
#else
#define SETPRIO_HI
#define SETPRIO_LO
#endif
template <bool SWAP, bool BF32, class AL, class BL, class EPI>
__device__ __forceinline__ void gemm_core(const AL& al, const BL& bl, int k_begin, int nk, int nkt, char* smem, f32x4 (&acc)[4][4], EPI&& epi) {
    const int tid = opaque_tid(), lane = tid & 63, wid = tid >> 6, wr = wid >> 1, wc = wid & 1, fr = lane & 15, fq = lane >> 4;
#pragma unroll
    for (int m = 0; m < 4; ++m)
#pragma unroll
        for (int n = 0; n < 4; ++n) acc[m][n] = (f32x4){0.f, 0.f, 0.f, 0.f};
    u32x4 ra[4]; u32x4 rb[4]; f32x4 rbf[8];
#pragma unroll
    for (int i = 0; i < 4; ++i) { bf16_piece_load(ra[i], al, k_begin, i, tid); if constexpr (!BF32) bf16_piece_load(rb[i], bl, k_begin, i, tid); }
    if constexpr (BF32) { f32_rows_load<0>(rbf, bl, k_begin, tid); f32_rows_load<4>(rbf, bl, k_begin, tid); }
#pragma unroll
    for (int i = 0; i < 4; ++i) { bf16_piece_write(ra[i], smem, i, tid); if constexpr (!BF32) bf16_piece_write(rb[i], smem + TILE_BYTES, i, tid); }
    if constexpr (BF32) { f32_col_write<0>(rbf, smem + TILE_BYTES, tid); f32_col_write<1>(rbf, smem + TILE_BYTES, tid); f32_col_write<2>(rbf, smem + TILE_BYTES, tid); f32_col_write<3>(rbf, smem + TILE_BYTES, tid); }
    if (nk > 1) {
#pragma unroll
        for (int i = 0; i < 4; ++i) { bf16_piece_load(ra[i], al, k_begin + 64, i, tid); if constexpr (!BF32) bf16_piece_load(rb[i], bl, k_begin + 64, i, tid); }
        if constexpr (BF32) { f32_rows_load<0>(rbf, bl, k_begin + 64, tid); f32_rows_load<4>(rbf, bl, k_begin + 64, tid); }
    }
    __syncthreads();
    int tile = 0, kin = 0;
    for (int kt = 0; kt < nk; ++kt) {
        const char* sA = smem + (kt & 1) * 2 * TILE_BYTES; const char* sB = sA + TILE_BYTES;
        char* nA = smem + ((kt & 1) ^ 1) * 2 * TILE_BYTES; char* nB = nA + TILE_BYTES;
        const bool w1 = kt + 1 < nk, l2 = kt + 2 < nk;
        const int k2 = k_begin + (kt + 2) * 64;
        bf16x8 a[2][4], b[2][4];
#pragma unroll
        for (int ks = 0; ks < 2; ++ks) {
#pragma unroll
            for (int m = 0; m < 4; ++m) a[ks][m] = *(const bf16x8*)(sA + swz_off(wr * 64 + m * 16 + fr, ks * 4 + fq));
#pragma unroll
            for (int n = 0; n < 4; ++n) b[ks][n] = *(const bf16x8*)(sB + swz_off(wc * 64 + n * 16 + fr, ks * 4 + fq));
        }
#define GEMM_GROUP(G) { \
            constexpr int ks = (G) >> 1, m0 = ((G) & 1) * 2; \
            __builtin_amdgcn_sched_barrier(0); \
            SETPRIO_HI \
            _Pragma("unroll") for (int m = m0; m < m0 + 2; ++m) \
            _Pragma("unroll") for (int n = 0; n < 4; ++n) \
                acc[m][n] = SWAP ? __builtin_amdgcn_mfma_f32_16x16x32_bf16(b[ks][n], a[ks][m], acc[m][n], 0, 0, 0) \
                                 : __builtin_amdgcn_mfma_f32_16x16x32_bf16(a[ks][m], b[ks][n], acc[m][n], 0, 0, 0); \
            SETPRIO_LO \
            __builtin_amdgcn_sched_barrier(0); \
            if (w1) bf16_piece_write(ra[G], nA, G, tid); \
            if (l2) bf16_piece_load(ra[G], al, k2, G, tid); \
            if constexpr (BF32) { \
                if constexpr ((G) == 0) { if (w1) { f32_col_write<0>(rbf, nB, tid); f32_col_write<1>(rbf, nB, tid); } } \
                if constexpr ((G) == 1) { if (w1) { f32_col_write<2>(rbf, nB, tid); f32_col_write<3>(rbf, nB, tid); } } \
                if constexpr ((G) == 2) { if (l2) f32_rows_load<0>(rbf, bl, k2, tid); } \
                if constexpr ((G) == 3) { if (l2) f32_rows_load<4>(rbf, bl, k2, tid); } \
            } else { \
                if (w1) bf16_piece_write(rb[G], nB, G, tid); \
                if (l2) bf16_piece_load(rb[G], bl, k2, G, tid); \
            } }
        GEMM_GROUP(0) GEMM_GROUP(1) GEMM_GROUP(2) GEMM_GROUP(3)
#undef GEMM_GROUP
        kin += 1;
        if (kin == nkt && kt + 1 < nk) {
            epi(tile, acc);
            tile += 1; kin = 0;
#pragma unroll
            for (int m = 0; m < 4; ++m)
#pragma unroll
                for (int n = 0; n < 4; ++n) acc[m][n] = (f32x4){0.f, 0.f, 0.f, 0.f};
        }
        __syncthreads();
    }
    epi(tile, acc);
}
struct NoEpi { __device__ __forceinline__ void operator()(int, const f32x4 (&)[4][4]) const {} };
template <bool SWAP, bool BF32, class AL, class BL>
__device__ __forceinline__ void gemm_128(const AL& al, const BL& bl, int k_begin, int nk, char* smem, f32x4 (&acc)[4][4]) {
    gemm_core<SWAP, BF32>(al, bl, k_begin, nk, nk, smem, acc, NoEpi());
}

__device__ __forceinline__ int xcd_of(const char* smem) { return (int)(((const unsigned*)(smem + GEMM_SMEM + 2048))[4] & 7u); }
__device__ __forceinline__ int rank_of(const char* smem) { return (int)((const unsigned*)(smem + GEMM_SMEM + 2048))[5]; }
__device__ __forceinline__ int nranks_of(const char* smem) { int n = (int)((const unsigned*)(smem + GEMM_SMEM + 2048))[6]; return n > 0 ? n : 1; }
template <int NB, bool SILU>
__device__ __forceinline__ void gemv_item(const float* in, const float* W, int ldw, const float* bias, float* out, int ldo, int K, int col0, float* sm) {
    const int tid = opaque_tid();
    for (int i = tid; i < NB * K; i += 256) { float v = in[i]; sm[i] = SILU ? v / (1.f + __expf(-v)) : v; }
    __syncthreads();
    float acc[NB];
#pragma unroll
    for (int b = 0; b < NB; ++b) acc[b] = 0.f;
    const int kq = tid >> 6, cl = tid & 63; const int kb = kq * (K / 4);
    for (int k = kb; k < kb + K / 4; k += 16) {
        float w[16];
#pragma unroll
        for (int u = 0; u < 16; ++u) w[u] = W[(size_t)(k + u) * ldw + col0 + cl];
#pragma unroll
        for (int u = 0; u < 16; ++u)
#pragma unroll
            for (int b = 0; b < NB; ++b) acc[b] += sm[b * K + k + u] * w[u];
    }
    float* red = sm + NB * K;
#pragma unroll
    for (int b = 0; b < NB; ++b) red[(kq * NB + b) * 64 + cl] = acc[b];
    __syncthreads();
    if (tid < 64 * NB) {
        int b = tid >> 6, cc = tid & 63;
        float s = red[(0 * NB + b) * 64 + cc] + red[(1 * NB + b) * 64 + cc] + red[(2 * NB + b) * 64 + cc] + red[(3 * NB + b) * 64 + cc];
        out[b * ldo + col0 + cc] = s + (bias ? bias[col0 + cc] : 0.f);
    }
    __syncthreads();
}

__device__ __forceinline__ int win_srccol(int n) {
    if (n < 1280) return n;
    if (n < 2304) return n + 24;
    if (n < 2816) return n + 40;
    if (n < 2840) return n - 2816 + 1280;
    if (n < 2856) return n - 2840 + 2328;
    return -1;
}
template <bool PERM>
__device__ __forceinline__ void transpose_item(const float* W, int ldw, int K, bf16_t* out, int k0, int n0, float* sm) {
    const int tid = opaque_tid();
    f32x4 v[4];
#pragma unroll
    for (int i = 0; i < 4; ++i) {
        const int c = tid + 256 * i, kk = c >> 4, nn = (c & 15) * 4;
        const int src = PERM ? win_srccol(n0 + nn) : (n0 + nn);
        v[i] = (src >= 0) ? *(const f32x4*)(W + (size_t)(k0 + kk) * ldw + src) : (f32x4){0.f, 0.f, 0.f, 0.f};
    }
#pragma unroll
    for (int i = 0; i < 4; ++i) {
        const int c = tid + 256 * i, kk = c >> 4, nn = (c & 15) * 4;
#pragma unroll
        for (int j = 0; j < 4; ++j) sm[(nn + j) * 65 + kk] = v[i][j];
    }
    __syncthreads();
#pragma unroll
    for (int i = 0; i < 2; ++i) {
        const int c = tid + 256 * i, nn = c >> 3, kc = (c & 7) * 8;
        const float* r = sm + nn * 65 + kc;
        u32x4 w;
        w.x = pk_bf16(r[0], r[1]); w.y = pk_bf16(r[2], r[3]); w.z = pk_bf16(r[4], r[5]); w.w = pk_bf16(r[6], r[7]);
        *(u32x4*)(out + (size_t)(n0 + nn) * K + k0 + kc) = w;
    }
    __syncthreads();
}

__device__ void phase0(const Params& p, char* smem) {
    float* sm = (float*)smem;
    const int nb = gridDim.x, bid = blockIdx.x;
    const int I_MOD = 96, I_B1 = 8, I_WIN = 16 * 46, I_WO = 256, I_WR = 64, I_W1 = 2 * 32 * 4, I_W2 = 2 * 4;
    const int total = I_MOD + I_B1 + I_WIN + I_WO + I_WR + I_W1 + I_W2;
    if (bid == 0 && opaque_tid() < 64) p.counts()[264 + opaque_tid()] = 0;
    if (bid == 1) for (int i = opaque_tid(); i < 264; i += 256) p.counts()[i] = 0;
    for (int it = bid; it < total; it += nb) {
        int i = it;
        if (i < I_MOD) { gemv_item<4, true>(p.c, p.w_mod, 6144, p.b_mod, p.mod(), 6144, 1024, i * 64, sm); continue; }
        i -= I_MOD;
        if (i < I_B1) { int kv = i >> 2; gemv_item<1, false>(kv ? p.pos_v : p.pos_k, kv ? p.w1_v : p.w1_k, 256, nullptr, p.bias1() + kv * 256, 256, 2048, (i & 3) * 64, sm); continue; }
        i -= I_B1;
        if (i < I_WIN) { transpose_item<true>(p.w_in, IN_COLS, 1024, p.wint(), (i % 16) * 64, (i / 16) * 64, sm); continue; }
        i -= I_WIN;
        if (i < I_WO) { transpose_item<false>(p.w_o, 1024, 1024, p.wot(), (i % 16) * 64, (i / 16) * 64, sm); continue; }
        i -= I_WO;
        if (i < I_WR) { transpose_item<false>(p.w_router, 256, 1024, p.wrt(), (i % 16) * 64, (i / 16) * 64, sm); continue; }
        i -= I_WR;
        if (i < I_W1) { int kv = i >> 7; int j = i & 127; transpose_item<false>(kv ? p.w1_v : p.w1_k, 256, 2048, p.w1t() + (size_t)kv * 256 * 2048, (j % 32) * 64, (j / 32) * 64, sm); continue; }
        i -= I_W1;
        { int kv = i >> 2; int j = i & 3; transpose_item<false>(kv ? p.w2_v : p.w2_k, 64, 256, p.w2t() + (size_t)kv * 64 * 256, j * 64, 0, sm); }
    }
}

__device__ __forceinline__ float wave_sum(float v) {
#pragma unroll
    for (int m = 32; m > 0; m >>= 1) v += __shfl_xor(v, m);
    return v;
}
__device__ void phase1(const Params& p) {
    const int lane = opaque_tid() & 63, gw = blockIdx.x * 4 + (opaque_tid() >> 6), nw = gridDim.x * 4;
    for (int row0 = gw * 2; row0 < NTOK; row0 += nw * 2) {
        f32x4 v[2][4]; float s[2];
#pragma unroll
        for (int r = 0; r < 2; ++r) {
            const float* xr = p.x + (size_t)(row0 + r) * D_MODEL;
            s[r] = 0.f;
#pragma unroll
            for (int i = 0; i < 4; ++i) v[r][i] = *(const f32x4*)(xr + i * 256 + lane * 4);
        }
        const int b = row0 / SEQ;
        const float* md = p.mod() + b * 6144;
#pragma unroll
        for (int r = 0; r < 2; ++r) {
#pragma unroll
            for (int i = 0; i < 4; ++i) s[r] += (v[r][i][0] + v[r][i][1]) + (v[r][i][2] + v[r][i][3]);
            const float mu = wave_sum(s[r]) * (1.f / D_MODEL);
            float q = 0.f;
#pragma unroll
            for (int i = 0; i < 4; ++i)
#pragma unroll
                for (int j = 0; j < 4; ++j) { float d = v[r][i][j] - mu; q += d * d; }
            const float rstd = rsqrtf(wave_sum(q) * (1.f / D_MODEL) + 1e-5f);
#pragma unroll
            for (int i = 0; i < 4; ++i) {
                const int col = i * 256 + lane * 4;
                f32x4 sh = *(const f32x4*)(md + 0 + col), sc = *(const f32x4*)(md + 1024 + col);
                float o[4];
#pragma unroll
                for (int j = 0; j < 4; ++j) o[j] = (v[r][i][j] - mu) * rstd * (1.f + sc[j]) + sh[j];
                u32x2 w; w.x = pk_bf16(o[0], o[1]); w.y = pk_bf16(o[2], o[3]);
                *(u32x2*)(p.hb() + (size_t)(row0 + r) * D_MODEL + col) = w;
            }
        }
    }
}

__device__ void phase2(const Params& p, char* smem) {
    const int xcd = xcd_of(smem), rank = rank_of(smem), nranks = nranks_of(smem);
    const int lane = opaque_tid() & 63, wid = opaque_tid() >> 6, wr = wid >> 1, wc = wid & 1, fr = lane & 15, fq = lane >> 4;
#ifndef P2_REP
#define P2_REP 1
#endif
    for (int it0 = rank; it0 < 16 * 23 * P2_REP; it0 += nranks) {
        const int it = it0 % (16 * 23);
        const int mt = (it / 23) * 8 + xcd, nt = it % 23;
        const int row0 = mt * 128, col0 = nt * 128;
        RowsBf16 al{p.hb() + (size_t)row0 * D_MODEL, D_MODEL};
        RowsBf16 bl{p.wint() + (size_t)col0 * D_MODEL, D_MODEL};
        f32x4 acc[4][4];
        const bool transposed = (nt == 7) || (nt == 9) || (nt >= 14 && nt < 18);
        if (transposed) {
            gemm_128<false, false>(al, bl, 0, 16, smem, acc);
            const int b = row0 / SEQ, t0 = row0 % SEQ;
            bf16_t* base; int rows_per;
            if (nt == 7) base = p.VsT() + (size_t)b * 128 * SEQ;
            else if (nt == 9) base = p.VwT() + (size_t)b * 128 * SEQ;
            else base = p.VgT() + ((size_t)b * 4 + (nt - 14)) * 128 * SEQ;
            (void)rows_per;
#pragma unroll
            for (int m = 0; m < 4; ++m)
#pragma unroll
                for (int n = 0; n < 4; ++n) {
                    const int feat = wc * 64 + n * 16 + fr, tok = t0 + wr * 64 + m * 16 + fq * 4;
                    u32x2 w; w.x = pk_bf16(acc[m][n][0], acc[m][n][1]); w.y = pk_bf16(acc[m][n][2], acc[m][n][3]);
                    *(u32x2*)(base + (size_t)feat * SEQ + tok) = w;
                }
        } else {
            gemm_128<true, false>(al, bl, 0, 16, smem, acc);
            if (nt == 22) {
                if (wc == 0) {
#pragma unroll
                    for (int m = 0; m < 4; ++m)
#pragma unroll
                        for (int n = 0; n < 4; ++n) {
                            const int tok = row0 + wr * 64 + m * 16 + fr, feat = n * 16 + fq * 4;
                            *(f32x4*)(p.misc() + (size_t)tok * 64 + feat) = acc[m][n];
                        }
                }
            } else {
#pragma unroll
                for (int m = 0; m < 4; ++m)
#pragma unroll
                    for (int n = 0; n < 4; ++n) {
                        const int tok = row0 + wr * 64 + m * 16 + fr, feat = col0 + wc * 64 + n * 16 + fq * 4;
                        u32x2 w; w.x = pk_bf16(acc[m][n][0], acc[m][n][1]); w.y = pk_bf16(acc[m][n][2], acc[m][n][3]);
                        *(u32x2*)(p.Pb() + (size_t)tok * PCOLS + feat) = w;
                    }
            }
        }
    }
}
struct CmpALoad {
    static constexpr bool NT = false;
    const bf16_t* Pb; int colbase; int row0;
    __device__ __forceinline__ const bf16_t* ptr(int r, int k) const {
        const int rr = row0 + r, bg = rr >> 8, i = rr & 255, b = bg >> 1, g = bg & 1;
        const int l = k >> 6, d = k & 63;
        int tok = 16 * i + l; tok = tok < SEQ ? tok : SEQ - 1;
        return Pb + ((size_t)b * SEQ + tok) * PCOLS + colbase + g * 64 + d;
    }
    __device__ __forceinline__ const bf16_t* pp(int i, int tid, int k) const { return ptr(i * 32 + (tid >> 3), k); }
};

__device__ __forceinline__ float log_sigmoid_f(float x) { return -(fmaxf(-x, 0.f) + __logf(1.f + __expf(-fabsf(x)))); }

__device__ __forceinline__ void gla_cumsum(const Params& p, int tokg0, int h, float* sb, float* sglr, float* swa, float* sqt) {
    const int tid = opaque_tid();
    for (int i = tid; i < 1024; i += 256) { int t = i >> 4, r = i & 15; sglr[i] = p.misc()[(size_t)(tokg0 + t) * 64 + 24 + r]; }
    for (int i = tid; i < 1024; i += 256) { int r = i >> 6, d = i & 63; swa[i] = p.w_a2[r * 256 + h * 64 + d]; }
    __syncthreads();
    const int d = tid & 63, tq = tid >> 6;
    const float ba = p.b_a2[h * 64 + d];
    float w[16];
#pragma unroll
    for (int r = 0; r < 16; ++r) w[r] = swa[r * 64 + d];
    float run = 0.f;
#pragma unroll
    for (int tt = 0; tt < 16; ++tt) {
        const int t = tq * 16 + tt;
        float x = ba;
#pragma unroll
        for (int r = 0; r < 16; ++r) x += sglr[t * 16 + r] * w[r];
        run += log_sigmoid_f(x) * (1.f / 16.f);
        sb[t * 64 + d] = run;
    }
    sqt[tq * 64 + d] = run;
    __syncthreads();
    float off = 0.f;
#pragma unroll
    for (int q = 0; q < 3; ++q) if (q < tq) off += sqt[q * 64 + d];
#pragma unroll
    for (int tt = 0; tt < 16; ++tt) sb[(tq * 16 + tt) * 64 + d] += off;
    __syncthreads();
}

__device__ void gla_a_item(const Params& p, int item, char* smem) {
    const int tid = opaque_tid(), lane = tid & 63, wid = tid >> 6, fr = lane & 15, fq = lane >> 4;
    const int bh = item >> 6, c = item & 63, b = bh >> 2, h = bh & 3;
    const int tok0 = c * 64, tokg0 = b * SEQ + tok0;
    float* sb = (float*)smem; float* sglr = (float*)(smem + 16384); float* swa = (float*)(smem + 20480); float* sqt = (float*)(smem + 24576);
    char* skbT = smem + 25600; char* sVT = smem + 34816;
    gla_cumsum(p, tokg0, h, sb, sglr, swa, sqt);
    {
        float* bs = (float*)(p.ws + OFF_bsave) + (size_t)item * 4096;
#pragma unroll
        for (int i = 0; i < 4; ++i) *(f32x4*)(bs + (tid + 256 * i) * 4) = *(const f32x4*)(sb + (tid + 256 * i) * 4);
    }
    {
        const int d = tid & 63, tq = tid >> 6;
        const float bl = sb[63 * 64 + d];
        float v[16];
#pragma unroll
        for (int tt = 0; tt < 16; ++tt) {
            const int s = tq * 16 + tt;
            float k = bf2f(p.Pb()[(size_t)(tokg0 + s) * PCOLS + P_GK + h * 64 + d]);
            v[tt] = k * __expf(bl - sb[s * 64 + d]);
        }
        u32x4 w0, w1;
        w0.x = pk_bf16(v[0], v[1]); w0.y = pk_bf16(v[2], v[3]); w0.z = pk_bf16(v[4], v[5]); w0.w = pk_bf16(v[6], v[7]);
        w1.x = pk_bf16(v[8], v[9]); w1.y = pk_bf16(v[10], v[11]); w1.z = pk_bf16(v[12], v[13]); w1.w = pk_bf16(v[14], v[15]);
        *(u32x4*)(skbT + (d * LDS_ROW + tq * 16) * 2) = w0;
        *(u32x4*)(skbT + (d * LDS_ROW + tq * 16 + 8) * 2) = w1;
        if (tid < 64) p.dec()[(size_t)item * 64 + d] = __expf(bl);
    }
#pragma unroll
    for (int i = 0; i < 4; ++i) {
        const int cidx = tid + 256 * i, e = cidx >> 3, ch = (cidx & 7) * 8;
        *(u32x4*)(sVT + (e * LDS_ROW + ch) * 2) = *(const u32x4*)(p.VgT() + ((size_t)bh * 128 + e) * SEQ + tok0 + ch);
    }
    __syncthreads();
    f32x4 acc[2][4];
#pragma unroll
    for (int m = 0; m < 2; ++m)
#pragma unroll
        for (int n = 0; n < 4; ++n) acc[m][n] = (f32x4){0.f, 0.f, 0.f, 0.f};
#pragma unroll
    for (int ks = 0; ks < 2; ++ks) {
        bf16x8 a[2], bb[4];
#pragma unroll
        for (int m = 0; m < 2; ++m) a[m] = *(const bf16x8*)(sVT + (((wid * 2 + m) * 16 + fr) * LDS_ROW + ks * 32 + fq * 8) * 2);
#pragma unroll
        for (int n = 0; n < 4; ++n) bb[n] = *(const bf16x8*)(skbT + ((n * 16 + fr) * LDS_ROW + ks * 32 + fq * 8) * 2);
#pragma unroll
        for (int m = 0; m < 2; ++m)
#pragma unroll
            for (int n = 0; n < 4; ++n) acc[m][n] = __builtin_amdgcn_mfma_f32_16x16x32_bf16(a[m], bb[n], acc[m][n], 0, 0, 0);
    }
    float* dst = p.dST() + (size_t)item * 8192;
#pragma unroll
    for (int m = 0; m < 2; ++m)
#pragma unroll
        for (int n = 0; n < 4; ++n)
#pragma unroll
            for (int j = 0; j < 4; ++j) dst[((wid * 2 + m) * 16 + fq * 4 + j) * 64 + n * 16 + fr] = acc[m][n][j];
    __syncthreads();
}

__device__ void phase3(const Params& p, char* smem) {
    const int lane = opaque_tid() & 63, wid = opaque_tid() >> 6, wr = wid >> 1, wc = wid & 1, fr = lane & 15, fq = lane >> 4;
    for (int it = blockIdx.x; it < 256; it += gridDim.x) {
        const int kv = it >> 7, mt = (it >> 3) & 15, nt = (it >> 2) & 1, ks = it & 3;
        CmpALoad al{p.Pb(), kv ? P_VC : P_KC, mt * 128};
        RowsBf16 bl{p.w1t() + ((size_t)kv * 256 + nt * 128) * 2048, 2048};
        f32x4 acc[4][4];
        gemm_128<true, 0>(al, bl, ks * 512, 8, smem, acc);
        float* dst = p.cpart() + ((size_t)(kv * 4 + ks) * 2048 + mt * 128) * 256 + nt * 128;
#pragma unroll
        for (int m = 0; m < 4; ++m)
#pragma unroll
            for (int n = 0; n < 4; ++n)
                *(f32x4*)(dst + (size_t)(wr * 64 + m * 16 + fr) * 256 + wc * 64 + n * 16 + fq * 4) = acc[m][n];
    }
    const int first = (blockIdx.x + gridDim.x - (256 % gridDim.x)) % gridDim.x;
    for (int it = first; it < 1024; it += gridDim.x) gla_a_item(p, it, smem);
}

#define C2_ROW 264
__device__ void cmp2_item(const Params& p, int item, char* smem) {
    const int tid = opaque_tid(), lane = tid & 63, wid = tid >> 6, fr = lane & 15, fq = lane >> 4;
    const int kv = item >> 5, r0 = (item & 31) * 64;
    char* sA = smem; char* sB = smem + 64 * C2_ROW * 2;
    const float* b1 = p.bias1() + kv * 256;
#pragma unroll 2
    for (int i = 0; i < 8; ++i) {
        const int cidx = tid + 256 * i, row = cidx >> 5, col = (cidx & 31) * 8;
        f32x4 s0 = *(const f32x4*)(b1 + col), s1 = *(const f32x4*)(b1 + col + 4);
#pragma unroll
        for (int ks = 0; ks < 4; ++ks) {
            const float* src = p.cpart() + ((size_t)(kv * 4 + ks) * 2048 + r0 + row) * 256 + col;
            s0 += *(const f32x4*)src; s1 += *(const f32x4*)(src + 4);
        }
        float o[8];
#pragma unroll
        for (int j = 0; j < 4; ++j) { o[j] = s0[j] / (1.f + __expf(-s0[j])); o[4 + j] = s1[j] / (1.f + __expf(-s1[j])); }
        u32x4 w; w.x = pk_bf16(o[0], o[1]); w.y = pk_bf16(o[2], o[3]); w.z = pk_bf16(o[4], o[5]); w.w = pk_bf16(o[6], o[7]);
        *(u32x4*)(sA + (row * C2_ROW + col) * 2) = w;
        *(u32x4*)(sB + (row * C2_ROW + col) * 2) = *(const u32x4*)(p.w2t() + ((size_t)kv * 64 + row) * 256 + col);
    }
    __syncthreads();
    f32x4 acc[4];
#pragma unroll
    for (int n = 0; n < 4; ++n) acc[n] = (f32x4){0.f, 0.f, 0.f, 0.f};
#pragma unroll
    for (int ks = 0; ks < 8; ++ks) {
        bf16x8 a = *(const bf16x8*)(sA + ((wid * 16 + fr) * C2_ROW + ks * 32 + fq * 8) * 2);
#pragma unroll
        for (int n = 0; n < 4; ++n) {
            bf16x8 bb = *(const bf16x8*)(sB + ((n * 16 + fr) * C2_ROW + ks * 32 + fq * 8) * 2);
            acc[n] = kv ? __builtin_amdgcn_mfma_f32_16x16x32_bf16(a, bb, acc[n], 0, 0, 0)
                        : __builtin_amdgcn_mfma_f32_16x16x32_bf16(bb, a, acc[n], 0, 0, 0);
        }
    }
    if (kv == 0) {
#pragma unroll
        for (int n = 0; n < 4; ++n) {
            u32x2 w; w.x = pk_bf16(acc[n][0], acc[n][1]); w.y = pk_bf16(acc[n][2], acc[n][3]);
            *(u32x2*)(p.kc() + (size_t)(r0 + wid * 16 + fr) * 64 + n * 16 + fq * 4) = w;
        }
    } else {
        const int r = r0 + wid * 16 + fq * 4, bg = r >> 8, i = r & 255;
#pragma unroll
        for (int n = 0; n < 4; ++n) {
            u32x2 w; w.x = pk_bf16(acc[n][0], acc[n][1]); w.y = pk_bf16(acc[n][2], acc[n][3]);
            *(u32x2*)(p.vcT() + ((size_t)bg * 64 + n * 16 + fr) * 256 + i) = w;
        }
    }
    __syncthreads();
}

__device__ void phase4(const Params& p, char* smem) {
    for (int it = blockIdx.x; it < 64; it += gridDim.x) cmp2_item(p, it, smem);
    const int nthreads = gridDim.x * 256;
    for (int idx = blockIdx.x * 256 + opaque_tid(); idx < 16 * 8192; idx += nthreads) {
        const int bh = idx >> 13, ed = idx & 8191, d = idx & 63;
        float S = 0.f;
        for (int c0 = 0; c0 < 64; c0 += 8) {
            float dv[8], dc[8];
#pragma unroll
            for (int u = 0; u < 8; ++u) {
                dv[u] = p.dST()[((size_t)(bh * 64 + c0 + u) << 13) + ed];
                dc[u] = p.dec()[(size_t)(bh * 64 + c0 + u) * 64 + d];
            }
#pragma unroll
            for (int u = 0; u < 8; ++u) {
                p.ST()[((size_t)(bh * 64 + c0 + u) << 13) + ed] = f2bf(S);
                S = dc[u] * S + dv[u];
            }
        }
    }
}
#define KT_BYTES (64 * LDS_ROW * 2)
#define C1_SCALE (0.125f * LOG2E)

#define MASK_BIAS (-2e30f)
__device__ __forceinline__ bf16x8 scale_frag(bf16x8 v, float c) {
    u32x4 u = __builtin_bit_cast(u32x4, v); u32x4 r;
    r.x = pk_bf16(bflo(u.x) * c, bfhi(u.x) * c); r.y = pk_bf16(bflo(u.y) * c, bfhi(u.y) * c);
    r.z = pk_bf16(bflo(u.z) * c, bfhi(u.z) * c); r.w = pk_bf16(bflo(u.w) * c, bfhi(u.w) * c);
    return __builtin_bit_cast(bf16x8, r);
}
__device__ __forceinline__ float max3f(float a, float b, float c) { return fmaxf(fmaxf(a, b), c); }
__device__ __forceinline__ float rowmax4(float x) {
    auto r = __builtin_amdgcn_permlane32_swap(__float_as_uint(x), __float_as_uint(x), false, false);
    float y = fmaxf(__uint_as_float(r[0]), __uint_as_float(r[1]));
    auto q = __builtin_amdgcn_permlane16_swap(__float_as_uint(y), __float_as_uint(y), false, false);
    return fmaxf(__uint_as_float(q[0]), __uint_as_float(q[1]));
}
template <bool PV>
__device__ __forceinline__ void flash_tile(const char* sK0, const char* sVT0, const bf16x8 (&qf)[2][2], float (&m)[2], f32x4 (&l)[2], f32x4 (&o)[2][4],
                                           float dl0, float dstride, float wlim, bool lanevalid, bool needmask, const float (&slope2)[2], int fr, int fq, bool lazy, bf16x8 ones) {
#pragma unroll 1
    for (int half = 0; half < 2; ++half) {
        const char* sK = sK0 + half * 32 * LDS_ROW * 2;
        const char* sVT = sVT0 + half * 32 * 2;
        const float dl = dl0 + dstride * (float)(half * 32);
        bf16x8 kf[2][2], vf[4];
#pragma unroll
        for (int mk = 0; mk < 2; ++mk)
#pragma unroll
            for (int ks = 0; ks < 2; ++ks) kf[mk][ks] = *(const bf16x8*)(sK + ((mk * 16 + fr) * LDS_ROW + ks * 32 + fq * 8) * 2);
        if (PV) {
#pragma unroll
            for (int md = 0; md < 4; ++md) {
                u32x2 lo = *(const u32x2*)(sVT + ((md * 16 + fr) * LDS_ROW + fq * 4) * 2);
                u32x2 hi = *(const u32x2*)(sVT + ((md * 16 + fr) * LDS_ROW + 16 + fq * 4) * 2);
                u32x4 w; w.x = lo.x; w.y = lo.y; w.z = hi.x; w.w = hi.y;
                vf[md] = __builtin_bit_cast(bf16x8, w);
            }
        }
        f32x4 s[2][2];
#pragma unroll
        for (int p = 0; p < 2; ++p) {
            const float mref = lazy ? m[p] : 0.f;
            if (needmask) {
#pragma unroll
                for (int mk = 0; mk < 2; ++mk)
#pragma unroll
                    for (int j = 0; j < 4; ++j) {
                        const float dk = dl + dstride * (float)(mk * 16 + j);
                        const bool ok = lanevalid && (dk <= 0.f) && (dk > wlim);
                        s[p][mk][j] = ok ? (slope2[p] * dk - mref) : MASK_BIAS;
                    }
            } else {
                const float sb = lanevalid ? (slope2[p] * dl - mref) : MASK_BIAS, sd = lanevalid ? slope2[p] * dstride : 0.f;
#pragma unroll
                for (int mk = 0; mk < 2; ++mk)
#pragma unroll
                    for (int j = 0; j < 4; ++j) s[p][mk][j] = sb + sd * (float)(mk * 16 + j);
            }
        }
#pragma unroll
        for (int ks = 0; ks < 2; ++ks)
#pragma unroll
            for (int p = 0; p < 2; ++p)
#pragma unroll
                for (int mk = 0; mk < 2; ++mk) s[p][mk] = __builtin_amdgcn_mfma_f32_16x16x32_bf16(kf[mk][ks], qf[p][ks], s[p][mk], 0, 0, 0);
        float mx[2];
#pragma unroll
        for (int p = 0; p < 2; ++p)
            mx[p] = max3f(max3f(max3f(s[p][0][0], s[p][0][1], s[p][0][2]), s[p][0][3], s[p][1][0]), max3f(s[p][1][1], s[p][1][2], s[p][1][3]), MASK_BIAS);
        if (!lazy) {
            float mn[2];
#pragma unroll
            for (int p = 0; p < 2; ++p) mn[p] = fmaxf(m[p], rowmax4(mx[p]));
            if (__any((mn[0] > m[0]) || (mn[1] > m[1]))) {
#pragma unroll
                for (int p = 0; p < 2; ++p) {
                    const float alpha = __builtin_amdgcn_exp2f(m[p] - mn[p]);
                    l[p] *= alpha;
                    if (PV) {
#pragma unroll
                        for (int md = 0; md < 4; ++md) o[p][md] *= alpha;
                    }
                    m[p] = mn[p];
                }
            }
#pragma unroll
            for (int p = 0; p < 2; ++p)
#pragma unroll
                for (int mk = 0; mk < 2; ++mk)
#pragma unroll
                    for (int j = 0; j < 4; ++j) s[p][mk][j] -= m[p];
        }
        bf16x8 pf[2];
#pragma unroll
        for (int p = 0; p < 2; ++p) {
#pragma unroll
            for (int mk = 0; mk < 2; ++mk)
#pragma unroll
                for (int j = 0; j < 4; ++j) s[p][mk][j] = __builtin_amdgcn_exp2f(s[p][mk][j]);
            u32x4 w;
            w.x = pk_bf16(s[p][0][0], s[p][0][1]); w.y = pk_bf16(s[p][0][2], s[p][0][3]);
            w.z = pk_bf16(s[p][1][0], s[p][1][1]); w.w = pk_bf16(s[p][1][2], s[p][1][3]);
            pf[p] = __builtin_bit_cast(bf16x8, w);
        }
#pragma unroll
        for (int p = 0; p < 2; ++p) l[p] = __builtin_amdgcn_mfma_f32_16x16x32_bf16(ones, pf[p], l[p], 0, 0, 0);
        if (PV) {
#pragma unroll
            for (int md = 0; md < 4; ++md)
#pragma unroll
                for (int p = 0; p < 2; ++p) o[p][md] = __builtin_amdgcn_mfma_f32_16x16x32_bf16(vf[md], pf[p], o[p][md], 0, 0, 0);
        }
        if (lazy) {
            float up[2];
#pragma unroll
            for (int p = 0; p < 2; ++p) up[p] = fmaxf(rowmax4(mx[p]), 0.f);
            if (__any((up[0] > 0.f) || (up[1] > 0.f))) {
#pragma unroll
                for (int p = 0; p < 2; ++p) {
                    const float alpha = __builtin_amdgcn_exp2f(-up[p]);
                    l[p] *= alpha;
                    if (PV) {
#pragma unroll
                        for (int md = 0; md < 4; ++md) o[p][md] *= alpha;
                    }
                    m[p] += up[p];
                }
            }
        }
    }
}
__device__ __forceinline__ float l_total(const f32x4& l, int fr) { return __shfl(l[0], fr); }

__device__ __forceinline__ void imp_tile(const char* sK, const bf16x8 (&qf)[2][2], const float (&m)[2], const float (&linv)[2],
                                         float dl, const float (&slope2)[2], int ct, float* simp, int fr, int fq) {
    bf16x8 kf[4][2];
#pragma unroll
    for (int mk = 0; mk < 4; ++mk)
#pragma unroll
        for (int ks = 0; ks < 2; ++ks) kf[mk][ks] = *(const bf16x8*)(sK + ((mk * 16 + fr) * LDS_ROW + ks * 32 + fq * 8) * 2);
    f32x4 hs[4];
#pragma unroll
    for (int mk = 0; mk < 4; ++mk) hs[mk] = (f32x4){0.f, 0.f, 0.f, 0.f};
#pragma unroll
    for (int p = 0; p < 2; ++p) {
#pragma unroll
        for (int mk = 0; mk < 4; ++mk) {
            f32x4 s;
#pragma unroll
            for (int j = 0; j < 4; ++j) { const float dk = dl + 16.f * (float)(mk * 16 + j); s[j] = (dk <= 0.f) ? slope2[p] * dk : MASK_BIAS; }
#pragma unroll
            for (int ks = 0; ks < 2; ++ks) s = __builtin_amdgcn_mfma_f32_16x16x32_bf16(kf[mk][ks], qf[p][ks], s, 0, 0, 0);
#pragma unroll
            for (int j = 0; j < 4; ++j) hs[mk][j] += __builtin_amdgcn_exp2f(s[j] - m[p]) * linv[p];
        }
    }
#pragma unroll
    for (int mk = 0; mk < 4; ++mk) {
        const int jb = ct * 16 + mk * 4 + fq;
        const float a = hs[mk][0] + hs[mk][1] + hs[mk][2] + 0.5f * hs[mk][3];
        const float bnext = 0.5f * hs[mk][3];
        simp[fr * 64 + jb] += a;
        __builtin_amdgcn_wave_barrier();
        if (jb + 1 < 64) simp[fr * 64 + jb + 1] += bnext;
        __builtin_amdgcn_wave_barrier();
    }
}

struct TileSrc { const bf16_t* k; const bf16_t* v; };
struct TileOff { int k[2], v[2]; };
__device__ __forceinline__ TileOff tile_offsets(int kst, int vst, int tid) {
    TileOff to;
#pragma unroll
    for (int i = 0; i < 2; ++i) { const int c = tid + 256 * i, row = c >> 3, ch = (c & 7) * 8; to.k[i] = row * kst + ch; to.v[i] = row * vst + ch; }
    return to;
}
__device__ __forceinline__ void tile_gload(const TileSrc& ts, const TileOff& to, u32x4 (&rk)[2], u32x4 (&rv)[2]) {
#pragma unroll
    for (int i = 0; i < 2; ++i) {
        rk[i] = *(const u32x4*)(ts.k + to.k[i]);
        rv[i] = *(const u32x4*)(ts.v + to.v[i]);
    }
}
__device__ __forceinline__ void tile_swrite(char* smem, int buf, const u32x4 (&rk)[2], const u32x4 (&rv)[2], int tid) {
    char* sK = smem + buf * 2 * KT_BYTES; char* sV = sK + KT_BYTES;
#pragma unroll
    for (int i = 0; i < 2; ++i) {
        const int c = tid + 256 * i, row = c >> 3, ch = (c & 7) * 8;
        *(u32x4*)(sK + (row * LDS_ROW + ch) * 2) = rk[i];
        *(u32x4*)(sV + (row * LDS_ROW + ch) * 2) = rv[i];
    }
}

__device__ void nsa_cmp_item(const Params& p, int qrev, int bg, char* smem) {
    const int tid = opaque_tid(), lane = tid & 63, wid = tid >> 6, fr = lane & 15, fq = lane >> 4;
    const int qb = 63 - qrev, b = bg >> 1, g = bg & 1;
    const int q0 = qb * 64, t = q0 + wid * 16 + fr;
    const size_t tokg = (size_t)b * SEQ + t;
    float* simp = (float*)(smem + 4 * KT_BYTES) + wid * 1024;
    auto wsb = [&]() __attribute__((always_inline)) { char* w = p.ws; asm volatile("" : "+s"(w)); return w; };
    const unsigned onew = (fr == 0) ? 0x3f803f80u : 0u;
    const bf16x8 ones = __builtin_bit_cast(bf16x8, (u32x4){onew, onew, onew, onew});
    const int ncb = (4 * qb + 3) < NCMP ? (4 * qb + 3) : NCMP;
    const int nct = (ncb + 63) >> 6;
    for (int i = tid; i < 4096; i += 256) ((float*)(smem + 4 * KT_BYTES))[i] = 0.f;
    __syncthreads();
#pragma unroll 1
    for (int hp = 0; hp < 2; ++hp) {
        const int h0 = g * 4 + hp * 2;
        bf16x8 qf[2][2]; float slope2[2];
#pragma unroll
        for (int pp = 0; pp < 2; ++pp) {
            slope2[pp] = exp2f(-(float)(h0 + pp + 1)) * LOG2E;
#pragma unroll
            for (int ks = 0; ks < 2; ++ks)
                qf[pp][ks] = scale_frag(*(const bf16x8*)((const bf16_t*)(wsb() + OFF_Pb) + tokg * PCOLS + P_NQ + (h0 + pp) * 64 + ks * 32 + fq * 8), C1_SCALE);
        }
        float m[2], linv[2]; f32x4 l[2]; f32x4 o[2][4];
#pragma unroll
        for (int pp = 0; pp < 2; ++pp) {
            m[pp] = NEGF; l[pp] = (f32x4){0.f, 0.f, 0.f, 0.f}; linv[pp] = 0.f;
#pragma unroll
            for (int md = 0; md < 4; ++md) o[pp][md] = (f32x4){0.f, 0.f, 0.f, 0.f};
        }
        u32x4 rk[2], rv[2];
        const int n = 2 * nct;
        auto src = [&](int step) __attribute__((always_inline)) {
            const int idx = step < nct ? (nct - 1 - step) : step - nct;
            char* wb = wsb();
            TileSrc ts; ts.k = (const bf16_t*)(wb + OFF_kc) + ((size_t)bg * 256 + idx * 64) * 64;
            ts.v = (const bf16_t*)(wb + OFF_vcT) + (size_t)bg * 64 * 256 + idx * 64;
            return ts;
        };
        const TileOff toff = tile_offsets(64, 256, tid);
        tile_gload(src(0), toff, rk, rv); tile_swrite(smem, 0, rk, rv, tid); __syncthreads();
#pragma unroll 1
        for (int i = 0; i < n; ++i) {
            if (i + 1 < n) tile_gload(src(i + 1), toff, rk, rv);
            __builtin_amdgcn_sched_barrier(0);
            const int idx = i < nct ? (nct - 1 - i) : i - nct;
            const char* sK = smem + (i & 1) * 2 * KT_BYTES; const char* sV = sK + KT_BYTES;
            const float dlc = (float)(16 * (idx * 64 + fq * 4) + 31 - t);
            if (i < nct) {
                const bool cmask = (16 * (idx * 64 + 63) + 31) > q0;
                flash_tile<true>(sK, sV, qf, m, l, o, dlc, 16.f, -1e9f, true, cmask, slope2, fr, fq, i >= 2, ones);
            } else {
                if (i == nct) {
                    size_t tokg_o = tokg; asm volatile("" : "+v"(tokg_o));
                    char* wb = wsb();
#pragma unroll
                    for (int pp = 0; pp < 2; ++pp) {
                        const float inv = 1.f / fmaxf(l_total(l[pp], fr), 1e-30f);
                        linv[pp] = inv;
                        const int h = h0 + pp;
                        const float gl = ((const float*)(wb + OFF_misc))[tokg_o * 64 + h * 3 + 0];
                        const float sc = inv / (1.f + __expf(-gl));
#pragma unroll
                        for (int md = 0; md < 4; ++md) *(f32x4*)((float*)(wb + OFF_mixf) + tokg_o * 512 + h * 64 + md * 16 + fq * 4) = o[pp][md] * sc;
                    }
                }
                imp_tile(sK, qf, m, linv, dlc, slope2, idx, simp, fr, fq);
            }
            __builtin_amdgcn_sched_barrier(0);
            if (i + 1 < n) tile_swrite(smem, (i + 1) & 1, rk, rv, tid);
            __syncthreads();
        }
    }
    {
        const int j = lane;
        const bool forced = (j == 0) || (j == qb) || (j == qb - 1);
        unsigned long long mine = 0ull, wave_union = 0ull;
#pragma unroll 1
        for (int qi = 0; qi < 16; ++qi) {
            const float sc = (j <= qb) ? (simp[qi * 64 + j] + (forced ? 1e4f : 0.f)) : NEGF;
            int rank = 0;
#pragma unroll 4
            for (int j2 = 0; j2 < 64; ++j2) {
                const float s2 = __builtin_bit_cast(float, __builtin_amdgcn_readlane(__builtin_bit_cast(int, sc), j2));
                rank += ((s2 > sc) || (s2 == sc && j2 < j)) ? 1 : 0;
            }
            const unsigned long long msk = __ballot(rank < 16);
            wave_union |= msk;
            if (fr == qi) mine = msk;
        }
        const unsigned long long causal = (qb >= 63) ? ~0ull : ((1ull << (qb + 1)) - 1ull);
        unsigned long long* selm = (unsigned long long*)(wsb() + OFF_selm);
        if (fq == 0) selm[(size_t)g * NTOK + tokg] = mine & causal;
        if (lane == 0) ((unsigned long long*)(wsb() + OFF_selu))[((size_t)bg * 64 + qb) * 4 + wid] = wave_union & causal;
    }
    __syncthreads();
}

__device__ void nsa_sw_item(const Params& p, int qrev, int bg, int hp, char* smem, int mode) {
    const int tid = opaque_tid(), lane = tid & 63, wid = tid >> 6, fr = lane & 15, fq = lane >> 4;
    const int qb = 63 - qrev, b = bg >> 1, g = bg & 1;
    const int q0 = qb * 64, t = q0 + wid * 16 + fr;
    const size_t tokg = (size_t)b * SEQ + t;
    int* slist = (int*)(smem + 4 * KT_BYTES);
    const int h0 = g * 4 + hp * 2;
    auto wsb = [&]() __attribute__((always_inline)) { char* w = p.ws; asm volatile("" : "+s"(w)); return w; };
    bf16x8 qf[2][2]; float slope2[2];
#pragma unroll
    for (int pp = 0; pp < 2; ++pp) {
        slope2[pp] = exp2f(-(float)(h0 + pp + 1)) * LOG2E;
#pragma unroll
        for (int ks = 0; ks < 2; ++ks)
            qf[pp][ks] = scale_frag(*(const bf16x8*)((const bf16_t*)(wsb() + OFF_Pb) + tokg * PCOLS + P_NQ + (h0 + pp) * 64 + ks * 32 + fq * 8), C1_SCALE);
    }
    const unsigned long long mymask = ((const unsigned long long*)(wsb() + OFF_selm))[(size_t)g * NTOK + tokg];
    const unsigned long long* su = (const unsigned long long*)(wsb() + OFF_selu) + ((size_t)bg * 64 + qb) * 4;
    const unsigned long long wave_union = su[wid];
    const unsigned long long un = su[0] | su[1] | su[2] | su[3];
    const int wlo = (qb - 8) > 0 ? (qb - 8) : 0;
    const int nsl = __popcll(un);
    const int n = nsl + (qb - wlo + 1);
    if (tid < 64 && ((un >> tid) & 1ull)) slist[nsl - 1 - __popcll(un & ((1ull << tid) - 1ull))] = tid;
    if (tid >= 64 && tid < 64 + (qb - wlo + 1)) slist[nsl + (tid - 64)] = 256 + (qb - (tid - 64));
    __syncthreads();
    const unsigned onew = (fr == 0) ? 0x3f803f80u : 0u;
    const bf16x8 ones = __builtin_bit_cast(bf16x8, (u32x4){onew, onew, onew, onew});
    float m[2]; f32x4 l[2]; f32x4 o[2][4];
#pragma unroll
    for (int pp = 0; pp < 2; ++pp) {
        m[pp] = NEGF; l[pp] = (f32x4){0.f, 0.f, 0.f, 0.f};
#pragma unroll
        for (int md = 0; md < 4; ++md) o[pp][md] = (f32x4){0.f, 0.f, 0.f, 0.f};
    }
    auto finish_branch = [&](int br) __attribute__((always_inline)) {
        size_t tokg_o = tokg; asm volatile("" : "+v"(tokg_o));
        char* wb = wsb();
#pragma unroll
        for (int pp = 0; pp < 2; ++pp) {
            const float inv = 1.f / fmaxf(l_total(l[pp], fr), 1e-30f);
            const int h = h0 + pp;
            const float gl = ((const float*)(wb + OFF_misc))[tokg_o * 64 + h * 3 + br];
            const float sc = inv / (1.f + __expf(-gl));
#pragma unroll
            for (int md = 0; md < 4; ++md) {
                const size_t eo = tokg_o * 512 + h * 64 + md * 16 + fq * 4;
                f32x4 v = o[pp][md] * sc;
                if (mode != 0) { asm volatile("" :: "v"(v[0]), "v"(v[1]), "v"(v[2]), "v"(v[3])); }
                else if (br == 1) *(f32x4*)((float*)(wb + OFF_mixf2) + eo) = v;
                else { v += *(const f32x4*)((const float*)(wb + OFF_mixf) + eo) + *(const f32x4*)((const float*)(wb + OFF_mixf2) + eo);
                       u32x2 w; w.x = pk_bf16(v[0], v[1]); w.y = pk_bf16(v[2], v[3]); *(u32x2*)((bf16_t*)(wb + OFF_mixb) + tokg_o * 1024 + h * 64 + md * 16 + fq * 4) = w; }
            }
            m[pp] = NEGF; l[pp] = (f32x4){0.f, 0.f, 0.f, 0.f};
#pragma unroll
            for (int md = 0; md < 4; ++md) o[pp][md] = (f32x4){0.f, 0.f, 0.f, 0.f};
        }
    };
    u32x4 rkA[2], rvA[2], rkB[2], rvB[2];
    auto src = [&](int e) __attribute__((always_inline)) {
        const int win = e >> 8, idx = e & 255;
        char* wb = wsb();
        TileSrc ts;
        ts.k = (const bf16_t*)(wb + OFF_Pb) + ((size_t)b * SEQ + idx * 64) * PCOLS + (win ? P_KW : P_KS) + g * 64;
        ts.v = (const bf16_t*)(wb + (win ? OFF_VwT : OFF_VsT)) + (size_t)bg * 64 * SEQ + idx * 64;
        return ts;
    };
    auto step = [&](int i, int buf) __attribute__((always_inline)) {
        const int e = slist[i];
        const int win = e >> 8, idx = e & 255;
        if (i == nsl) finish_branch(1);
        const char* sK = smem + buf * 2 * KT_BYTES; const char* sV = sK + KT_BYTES;
        if (mode != 1 && (win || ((wave_union >> idx) & 1ull))) {
            const bool lv = win ? true : (((mymask >> idx) & 1ull) != 0ull);
            const bool nm = (idx == qb) || (win && idx == qb - 8);
            flash_tile<true>(sK, sV, qf, m, l, o, (float)(idx * 64 + fq * 4 - t), 1.f, win ? -512.f : -1e9f, lv, nm, slope2, fr, fq, (i != 0) && (i != nsl), ones);
        }
    };
#ifdef PROF
    volatile unsigned* sprof = (volatile unsigned*)(smem + 4 * KT_BYTES + 2048);
    if (tid == 0) { sprof[1] = 0u; sprof[2] = 0u; sprof[3] = (unsigned)__builtin_amdgcn_s_memtime(); }
#define PROF_T0 if (tid == 0) sprof[0] = (unsigned)__builtin_amdgcn_s_memtime();
#define PROF_T1 if (tid == 0) { sprof[1] += (unsigned)__builtin_amdgcn_s_memtime() - sprof[0]; sprof[2] += 1u; }
#else
#define PROF_T0
#define PROF_T1
#endif
    const TileOff toff = tile_offsets(PCOLS, SEQ, tid);
    tile_gload(src(slist[0]), toff, rkA, rvA); tile_swrite(smem, 0, rkA, rvA, tid);
    if (n > 1) tile_gload(src(slist[1]), toff, rkA, rvA);
    __syncthreads();
#pragma unroll 1
    for (int i = 0; i < n; i += 2) {
        if (i + 2 < n) tile_gload(src(slist[i + 2]), toff, rkB, rvB);
        __builtin_amdgcn_sched_barrier(0);
        PROF_T0 step(i, 0); PROF_T1
        __builtin_amdgcn_sched_barrier(0);
        if (i + 1 < n) tile_swrite(smem, 1, rkA, rvA, tid);
        __syncthreads();
        if (i + 1 >= n) break;
        if (i + 3 < n) tile_gload(src(slist[i + 3]), toff, rkA, rvA);
        __builtin_amdgcn_sched_barrier(0);
        PROF_T0 step(i + 1, 1); PROF_T1
        __builtin_amdgcn_sched_barrier(0);
        if (i + 2 < n) tile_swrite(smem, 0, rkB, rvB, tid);
        __syncthreads();
    }
    finish_branch(2);
#ifdef PROF
    if (tid == 0) {
        unsigned long long* pw = (unsigned long long*)(p.ws + OFF_counts + 1024);
        atomicAdd(&pw[0], (unsigned long long)sprof[1]); atomicAdd(&pw[1], (unsigned long long)((unsigned)__builtin_amdgcn_s_memtime() - sprof[3])); atomicAdd(&pw[2], (unsigned long long)sprof[2]);
    }
#endif
}

__device__ void gla_c_item(const Params& p, int item, char* smem) {
    const int tid = opaque_tid(), lane = tid & 63, wid = tid >> 6, fr = lane & 15, fq = lane >> 4;
    const int bh = item >> 6, c = item & 63, b = bh >> 2, h = bh & 3;
    const int tok0 = c * 64, tokg0 = b * SEQ + tok0;
    float* sb = (float*)smem; float* sglr = (float*)(smem + 16384); float* swa = (float*)(smem + 20480); float* sqt = (float*)(smem + 24576);
    char* sST = smem;
    char* sQB = smem + 25600; char* sKB = smem + 34816; char* sVT = smem + 44032;
    {
        const float* bs = (const float*)(p.ws + OFF_bsave) + (size_t)item * 4096;
#pragma unroll
        for (int i = 0; i < 4; ++i) *(f32x4*)(sb + (tid + 256 * i) * 4) = *(const f32x4*)(bs + (tid + 256 * i) * 4);
        __syncthreads();
    }
    {
        const int d = tid & 63, tq = tid >> 6;
#pragma unroll 4
        for (int tt = 0; tt < 16; ++tt) {
            const int tk = tq * 16 + tt;
            const float bt = sb[tk * 64 + d];
            const float q = bf2f(p.Pb()[(size_t)(tokg0 + tk) * PCOLS + P_GQ + h * 64 + d]);
            const float k = bf2f(p.Pb()[(size_t)(tokg0 + tk) * PCOLS + P_GK + h * 64 + d]);
            *(bf16_t*)(sQB + (tk * LDS_ROW + d) * 2) = f2bf(q * 0.125f * __expf(bt));
            *(bf16_t*)(sKB + (tk * LDS_ROW + d) * 2) = f2bf(k * __expf(-bt));
        }
    }
#pragma unroll
    for (int i = 0; i < 4; ++i) {
        const int cidx = tid + 256 * i, e = cidx >> 3, ch = (cidx & 7) * 8;
        *(u32x4*)(sVT + (e * LDS_ROW + ch) * 2) = *(const u32x4*)(p.VgT() + ((size_t)bh * 128 + e) * SEQ + tok0 + ch);
    }
    __syncthreads();
#pragma unroll
    for (int i = 0; i < 4; ++i) {
        const int cidx = tid + 256 * i, e = cidx >> 3, ch = (cidx & 7) * 8;
        *(u32x4*)(sST + (e * LDS_ROW + ch) * 2) = *(const u32x4*)(p.ST() + ((size_t)item << 13) + e * 64 + ch);
    }
    __syncthreads();
    bf16x8 qbf[2];
#pragma unroll
    for (int ks = 0; ks < 2; ++ks) qbf[ks] = *(const bf16x8*)(sQB + ((wid * 16 + fr) * LDS_ROW + ks * 32 + fq * 8) * 2);
    f32x4 sa[4];
#pragma unroll
    for (int ms = 0; ms < 4; ++ms) {
        sa[ms] = (f32x4){0.f, 0.f, 0.f, 0.f};
#pragma unroll
        for (int ks = 0; ks < 2; ++ks) {
            bf16x8 a = *(const bf16x8*)(sKB + ((ms * 16 + fr) * LDS_ROW + ks * 32 + fq * 8) * 2);
            sa[ms] = __builtin_amdgcn_mfma_f32_16x16x32_bf16(a, qbf[ks], sa[ms], 0, 0, 0);
        }
#pragma unroll
        for (int j = 0; j < 4; ++j) sa[ms][j] = (ms * 16 + fq * 4 + j <= wid * 16 + fr) ? sa[ms][j] : 0.f;
    }
    bf16x8 pf[2];
#pragma unroll
    for (int kk = 0; kk < 2; ++kk) {
        u32x4 w;
        w.x = pk_bf16(sa[2 * kk][0], sa[2 * kk][1]); w.y = pk_bf16(sa[2 * kk][2], sa[2 * kk][3]);
        w.z = pk_bf16(sa[2 * kk + 1][0], sa[2 * kk + 1][1]); w.w = pk_bf16(sa[2 * kk + 1][2], sa[2 * kk + 1][3]);
        pf[kk] = __builtin_bit_cast(bf16x8, w);
    }
    f32x4 oa[8];
    float sum = 0.f;
#pragma unroll
    for (int me = 0; me < 8; ++me) {
        f32x4 acc = (f32x4){0.f, 0.f, 0.f, 0.f};
#pragma unroll
        for (int ks = 0; ks < 2; ++ks) {
            bf16x8 a = *(const bf16x8*)(sST + ((me * 16 + fr) * LDS_ROW + ks * 32 + fq * 8) * 2);
            acc = __builtin_amdgcn_mfma_f32_16x16x32_bf16(a, qbf[ks], acc, 0, 0, 0);
        }
#pragma unroll
        for (int kk = 0; kk < 2; ++kk) {
            u32x2 lo = *(const u32x2*)(sVT + ((me * 16 + fr) * LDS_ROW + kk * 32 + fq * 4) * 2);
            u32x2 hi = *(const u32x2*)(sVT + ((me * 16 + fr) * LDS_ROW + kk * 32 + 16 + fq * 4) * 2);
            u32x4 w; w.x = lo.x; w.y = lo.y; w.z = hi.x; w.w = hi.y;
            acc = __builtin_amdgcn_mfma_f32_16x16x32_bf16(__builtin_bit_cast(bf16x8, w), pf[kk], acc, 0, 0, 0);
        }
        oa[me] = acc;
        sum += (acc[0] + acc[1]) + (acc[2] + acc[3]);
    }
    sum += __shfl_xor(sum, 16); sum += __shfl_xor(sum, 32);
    const float mu = sum * (1.f / 128.f);
    float var = 0.f;
#pragma unroll
    for (int me = 0; me < 8; ++me)
#pragma unroll
        for (int j = 0; j < 4; ++j) { const float dd = oa[me][j] - mu; var += dd * dd; }
    var += __shfl_xor(var, 16); var += __shfl_xor(var, 32);
    const float rstd = rsqrtf(var * (1.f / 128.f) + 1e-5f);
    const size_t tok = (size_t)tokg0 + wid * 16 + fr;
#pragma unroll
    for (int me = 0; me < 8; ++me) {
        const int e = me * 16 + fq * 4;
        const u32x2 rr = *(const u32x2*)(p.Pb() + tok * PCOLS + P_GR + h * 128 + e);
        const f32x4 nw = *(const f32x4*)(p.norm_w + e);
        float r[4] = {bflo(rr.x), bfhi(rr.x), bflo(rr.y), bfhi(rr.y)};
        float ov[4];
#pragma unroll
        for (int j = 0; j < 4; ++j) ov[j] = (oa[me][j] - mu) * rstd * nw[j] * (r[j] / (1.f + __expf(-r[j])));
        u32x2 w; w.x = pk_bf16(ov[0], ov[1]); w.y = pk_bf16(ov[2], ov[3]);
        *(u32x2*)(p.mixb() + tok * 1024 + 512 + h * 128 + e) = w;
    }
    __syncthreads();
}

#ifndef NSA_REP
#define NSA_REP 1
#endif
#ifndef NSA_MODE2
#define NSA_MODE2 0
#endif
#ifndef GLAC_REP
#define GLAC_REP 1
#endif
__device__ void phase5a(const Params& p, char* smem, int rep) {
    int* sidx = (int*)(smem + GEMM_SMEM - 16);
    for (;;) {
        __syncthreads();
        if (opaque_tid() == 0) *sidx = atomicAdd(&p.counts()[264 + 4 * rep], 1);
        __syncthreads();
        const int it = *sidx;
        if (it >= 512) break;
        nsa_cmp_item(p, it >> 3, it & 7, smem);
    }
    for (;;) {
        __syncthreads();
        if (opaque_tid() == 0) *sidx = atomicAdd(&p.counts()[265 + 4 * rep], 1);
        __syncthreads();
        const int it = *sidx;
        if (it >= 1024 * GLAC_REP) break;
        gla_c_item(p, it & 1023, smem);
    }
}
__device__ void phase5b(const Params& p, char* smem, int rep) {
    int* sidx = (int*)(smem + GEMM_SMEM - 16);
    for (;;) {
        __syncthreads();
        if (opaque_tid() == 0) *sidx = atomicAdd(&p.counts()[266 + 4 * rep], 1);
        __syncthreads();
        const int it = *sidx;
        if (it >= 1024 * NSA_REP) break;
        const int item = it & 1023;
        nsa_sw_item(p, item >> 4, (item >> 1) & 7, item & 1, smem, it >= 1024 ? NSA_MODE2 : 0);
    }
}
__device__ void phase6(const Params& p, char* smem) {
    const int xcd = xcd_of(smem), rank = rank_of(smem), nranks = nranks_of(smem);
    const int lane = opaque_tid() & 63, wid = opaque_tid() >> 6, wr = wid >> 1, wc = wid & 1, fr = lane & 15, fq = lane >> 4;
    for (int it = rank; it < 16 * 8; it += nranks) {
        const int mt = (it / 8) * 8 + xcd, nt = it % 8;
        RowsBf16 al{p.mixb() + (size_t)mt * 128 * 1024, 1024};
        RowsBf16 bl{p.wot() + (size_t)nt * 128 * 1024, 1024};
        f32x4 acc[4][4];
        gemm_128<true, false>(al, bl, 0, 16, smem, acc);
#pragma unroll
        for (int m = 0; m < 4; ++m)
#pragma unroll
            for (int n = 0; n < 4; ++n)
                *(f32x4*)(p.y1() + (size_t)(mt * 128 + wr * 64 + m * 16 + fr) * 1024 + nt * 128 + wc * 64 + n * 16 + fq * 4) = acc[m][n];
    }
}

__device__ void phase7(const Params& p) {
    const int lane = opaque_tid() & 63, gw = blockIdx.x * 4 + (opaque_tid() >> 6), nw = gridDim.x * 4;
    const float alpha = 1.189207115f;
    for (int row0 = gw * 2; row0 < NTOK; row0 += nw * 2) {
        const int b = row0 / SEQ;
        const float* md = p.mod() + b * 6144;
        f32x4 xv[2][4], yv[2][4];
#pragma unroll
        for (int r = 0; r < 2; ++r)
#pragma unroll
            for (int i = 0; i < 4; ++i) {
                const int col = i * 256 + lane * 4;
                xv[r][i] = *(const f32x4*)(p.x + (size_t)(row0 + r) * 1024 + col);
                yv[r][i] = *(const f32x4*)(p.y1() + (size_t)(row0 + r) * 1024 + col);
            }
#pragma unroll
        for (int r = 0; r < 2; ++r) {
            const int row = row0 + r;
            f32x4 v[4]; float s = 0.f;
#pragma unroll
            for (int i = 0; i < 4; ++i) {
                const int col = i * 256 + lane * 4;
                const f32x4 ga = *(const f32x4*)(md + 2048 + col);
#pragma unroll
                for (int j = 0; j < 4; ++j) v[i][j] = alpha * xv[r][i][j] + (1.f + ga[j]) * yv[r][i][j];
                s += (v[i][0] + v[i][1]) + (v[i][2] + v[i][3]);
            }
            float mu = wave_sum(s) * (1.f / 1024.f);
            float q = 0.f;
#pragma unroll
            for (int i = 0; i < 4; ++i)
#pragma unroll
                for (int j = 0; j < 4; ++j) { float d = v[i][j] - mu; q += d * d; }
            float rstd = rsqrtf(wave_sum(q) * (1.f / 1024.f) + 1e-5f);
            s = 0.f;
#pragma unroll
            for (int i = 0; i < 4; ++i) {
                const int col = i * 256 + lane * 4;
                f32x4 g = *(const f32x4*)(p.ln1_g + col), bb = *(const f32x4*)(p.ln1_b + col);
#pragma unroll
                for (int j = 0; j < 4; ++j) v[i][j] = (v[i][j] - mu) * rstd * g[j] + bb[j];
                *(f32x4*)(p.x1() + (size_t)row * 1024 + col) = v[i];
                s += (v[i][0] + v[i][1]) + (v[i][2] + v[i][3]);
            }
            mu = wave_sum(s) * (1.f / 1024.f);
            q = 0.f;
#pragma unroll
            for (int i = 0; i < 4; ++i)
#pragma unroll
                for (int j = 0; j < 4; ++j) { float d = v[i][j] - mu; q += d * d; }
            rstd = rsqrtf(wave_sum(q) * (1.f / 1024.f) + 1e-5f);
#pragma unroll
            for (int i = 0; i < 4; ++i) {
                const int col = i * 256 + lane * 4;
                f32x4 sh = *(const f32x4*)(md + 3072 + col), sc = *(const f32x4*)(md + 4096 + col);
                float o[4];
#pragma unroll
                for (int j = 0; j < 4; ++j) o[j] = (v[i][j] - mu) * rstd * (1.f + sc[j]) + sh[j];
                u32x2 w; w.x = pk_bf16(o[0], o[1]); w.y = pk_bf16(o[2], o[3]);
                *(u32x2*)(p.hb() + (size_t)row * 1024 + col) = w;
            }
        }
    }
}

__device__ void phase8(const Params& p, char* smem) {
    const int lane = opaque_tid() & 63, wid = opaque_tid() >> 6, wr = wid >> 1, wc = wid & 1, fr = lane & 15, fq = lane >> 4;
    for (int it = blockIdx.x; it < 256; it += gridDim.x) {
        const int mt = it >> 1, nt = it & 1;
        RowsBf16 al{p.hb() + (size_t)mt * 128 * 1024, 1024};
        RowsBf16 bl{p.wrt() + (size_t)nt * 128 * 1024, 1024};
        f32x4 acc[4][4];
        gemm_128<true, false>(al, bl, 0, 16, smem, acc);
#pragma unroll
        for (int m = 0; m < 4; ++m)
#pragma unroll
            for (int n = 0; n < 4; ++n)
                *(f32x4*)(p.logits() + (size_t)(mt * 128 + wr * 64 + m * 16 + fr) * 256 + nt * 128 + wc * 64 + n * 16 + fq * 4) = acc[m][n];
    }
}

__device__ void phase9(const Params& p) {
    const int lane = opaque_tid() & 63, gw = blockIdx.x * 4 + (opaque_tid() >> 6), nw = gridDim.x * 4;
    for (int tok = gw; tok < NTOK; tok += nw) {
        float s[4], sb[4];
        const f32x4 lg = *(const f32x4*)(p.logits() + (size_t)tok * 256 + lane * 4);
        const f32x4 rb = *(const f32x4*)(p.rbias + lane * 4);
#pragma unroll
        for (int i = 0; i < 4; ++i) { s[i] = 1.f / (1.f + __expf(-lg[i])); sb[i] = s[i] + rb[i]; }
        float m1 = NEGF, m2 = NEGF;
#pragma unroll
        for (int i = 0; i < 4; ++i) { float v = sb[i]; if (v > m1) { m2 = m1; m1 = v; } else if (v > m2) m2 = v; }
#pragma unroll
        for (int mm = 1; mm < 8; mm <<= 1) {
            float o1 = __shfl_xor(m1, mm), o2 = __shfl_xor(m2, mm);
            float n1 = fmaxf(m1, o1);
            float n2 = fmaxf(fminf(m1, o1), fmaxf(m2, o2));
            m1 = n1; m2 = n2;
        }
        const float gs = m1 + m2;
        const int grp = lane >> 3;
        int grank = 0;
#pragma unroll
        for (int g2 = 0; g2 < 8; ++g2) { float o = __shfl(gs, g2 * 8); if (o > gs || (o == gs && g2 < grp)) ++grank; }
        const bool gsel = grank < 4;
        float cand[4];
#pragma unroll
        for (int i = 0; i < 4; ++i) cand[i] = gsel ? sb[i] : NEGF;
        float wsum = 0.f, myw = 0.f; int mye = 0;
#pragma unroll 1
        for (int k = 0; k < TOPK; ++k) {
            float bv = cand[0]; int bi = 0;
#pragma unroll
            for (int i = 1; i < 4; ++i) if (cand[i] > bv) { bv = cand[i]; bi = i; }
            float gv = bv; int ge = lane * 4 + bi;
#pragma unroll
            for (int mm = 1; mm < 64; mm <<= 1) {
                float ov = __shfl_xor(gv, mm); int oe = __shfl_xor(ge, mm);
                if (ov > gv || (ov == gv && oe < ge)) { gv = ov; ge = oe; }
            }
            float sel_s = 0.f;
            if ((ge >> 2) == lane) {
                const int i = ge & 3;
                sel_s = (i == 0) ? s[0] : (i == 1) ? s[1] : (i == 2) ? s[2] : s[3];
                if (i == 0) cand[0] = -3e38f; else if (i == 1) cand[1] = -3e38f; else if (i == 2) cand[2] = -3e38f; else cand[3] = -3e38f;
            }
            sel_s = __shfl(sel_s, ge >> 2);
            wsum += sel_s;
            if (lane == k) { myw = sel_s; mye = ge; }
        }
        if (lane < TOPK) {
            const int id = tok * NASSIGN + lane;
            p.ew()[id] = myw / wsum * 2.5f;
            const int pos = atomicAdd(&p.counts()[mye], 1);
            p.lists()[(size_t)mye * NTOK + pos] = id;
        } else if (lane == TOPK) {
            p.ew()[tok * NASSIGN + TOPK] = 1.f;
        }
    }
}

struct Rows4 {
    static constexpr bool NT = false;
    const bf16_t *p0, *p1, *p2, *p3; int kmask;
    __device__ __forceinline__ const bf16_t* pp(int i, int tid, int k) const { return (i == 0 ? p0 : i == 1 ? p1 : i == 2 ? p2 : p3) + (k & kmask); }
};
template <int NT_PER>
__device__ __forceinline__ int build_entries(const Params& p, int xcd, int* spre) {
    const int tid = opaque_tid();
    __syncthreads();
    if (tid < 33) {
        int items;
        if (tid < 32) { const int cnt = p.counts()[xcd + 8 * tid]; items = ((cnt + 127) >> 7) * NT_PER; }
        else items = 16 * NT_PER;
        spre[64 + tid] = items;
    }
    __syncthreads();
    if (tid == 0) { int a = 0; for (int i = 0; i < 33; ++i) { spre[i] = a; a += spre[64 + i]; } spre[33] = a; }
    __syncthreads();
    return spre[33];
}

template <int NT_PER>
__device__ __forceinline__ void decode_item(const Params& p, int xcd, const int* spre, int it, int& e, int& nt, int& mtile, int& cnt) {
    int ent = 0;
    for (int i = 1; i < 33; ++i) ent = (it >= spre[i]) ? i : ent;
    const int local = it - spre[ent];
    if (ent < 32) {
        e = xcd + 8 * ent; cnt = p.counts()[e];
        const int mtc = (cnt + 127) >> 7;
        nt = local / mtc; mtile = local % mtc;
    } else {
        e = N_EXP; cnt = NTOK; nt = local >> 4; mtile = (local & 15) * 8 + xcd;
    }
}

#ifndef P10_NT
#define P10_NT 4
#endif
struct BF32GateUpS {
    const float* g; long du;
    __device__ __forceinline__ f32x4 load4(int kk, int r4) const {
        const long sel = ((r4 >> 5) & 1) ? du : 0l;
        return *(const f32x4*)(g + sel + (size_t)(kk & 1023) * 256 + (kk >> 10) * 64 + (r4 >> 6) * 32 + (r4 & 31));
    }
};
__device__ void phase10(const Params& p, char* smem) {
    const int tid = opaque_tid(), xcd = xcd_of(smem), rank = rank_of(smem), nranks = nranks_of(smem);
    const int lane = tid & 63, wid = tid >> 6, wr = wid >> 1, wc = wid & 1, fr = lane & 15, fq = lane >> 4;
    int* srow = (int*)(smem + GEMM_SMEM);
    int* spre = srow + 256;
#ifndef P10_REP
#define P10_REP 1
#endif
    const int total = build_entries<P10_NT>(p, xcd, spre);
#ifdef STAGGER
    for (int i = 0; i < (rank & 3) * STAGGER; ++i) __builtin_amdgcn_s_sleep(32);
#endif
    for (int it0 = rank; it0 < total * P10_REP; it0 += nranks) {
        const int it = it0 % total;
        int e, nt, mtile, cnt;
        decode_item<P10_NT>(p, xcd, spre, it, e, nt, mtile, cnt);
        if (tid < 128) {
            const int pos = mtile * 128 + tid;
            int id = -1;
            if (pos < cnt) id = (e == N_EXP) ? (pos * NASSIGN + TOPK) : p.lists()[(size_t)e * NTOK + pos];
            srow[tid] = id >= 0 ? id / NASSIGN : 0;
            srow[128 + tid] = id;
        }
        __syncthreads();
        Rows4 al; al.kmask = 1023;
        al.p0 = p.hb() + (size_t)srow[(tid >> 3)] * 1024; al.p1 = p.hb() + (size_t)srow[32 + (tid >> 3)] * 1024;
        al.p2 = p.hb() + (size_t)srow[64 + (tid >> 3)] * 1024; al.p3 = p.hb() + (size_t)srow[96 + (tid >> 3)] * 1024;
        const float* Wg = (e == N_EXP) ? p.w_s_gate : p.w_e_gate + (size_t)e * 1024 * 256;
        const float* Wu = (e == N_EXP) ? p.w_s_up : p.w_e_up + (size_t)e * 1024 * 256;
        BF32GateUpS bl{Wg + nt * (256 / P10_NT), (long)(Wu - Wg)};
        f32x4 acc[4][4];
        bf16_t* hidp = p.hid();
        gemm_core<true, true>(al, bl, 0, 16 * (4 / P10_NT), 16, smem, acc, [&](int tl, const f32x4 (&a)[4][4]) __attribute__((always_inline)) {
            const int nt4 = nt * (4 / P10_NT) + tl;
#pragma unroll
            for (int m = 0; m < 4; ++m) {
                const int id = srow[128 + wr * 64 + m * 16 + fr];
                if (id >= 0) {
#pragma unroll
                    for (int n = 0; n < 2; ++n) {
                        float hv[4];
#pragma unroll
                        for (int j = 0; j < 4; ++j) { const float gte = a[m][n][j]; hv[j] = gte / (1.f + __expf(-gte)) * a[m][n + 2][j]; }
                        u32x2 w; w.x = pk_bf16(hv[0], hv[1]); w.y = pk_bf16(hv[2], hv[3]);
                        *(u32x2*)(hidp + (size_t)id * 256 + nt4 * 64 + wc * 32 + n * 16 + fq * 4) = w;
                    }
                }
            }
        });
        __syncthreads();
    }
}

struct DownB {
    const float* base;
    __device__ __forceinline__ f32x4 load4(int kk, int r4) const {
#ifdef NT_B
        return __builtin_nontemporal_load((const f32x4*)(base + (size_t)(kk & 255) * 1024 + (kk >> 8) * 128 + r4));
#else
        return *(const f32x4*)(base + (size_t)(kk & 255) * 1024 + (kk >> 8) * 128 + r4);
#endif
    }
};
struct HidA {
    static constexpr bool NT = true;
    const bf16_t* base; const int* rowidx;
    __device__ __forceinline__ const bf16_t* ptr(int r, int kk) const { return base + (size_t)rowidx[r] * 256 + (kk & 255); }
    __device__ __forceinline__ const bf16_t* pp(int i, int tid, int k) const { return ptr(i * 32 + (tid >> 3), k); }
};
#ifndef P11_NT
#define P11_NT 4
#endif
__device__ void phase11(const Params& p, char* smem) {
    const int tid = opaque_tid(), xcd = xcd_of(smem), rank = rank_of(smem), nranks = nranks_of(smem);
    const int lane = tid & 63, wid = tid >> 6, wr = wid >> 1, wc = wid & 1, fr = lane & 15, fq = lane >> 4;
    int* srow = (int*)(smem + GEMM_SMEM);
    int* spre = srow + 256;
    float* sew = (float*)(srow + 384);
#ifndef P11_REP
#define P11_REP 1
#endif
    const int total = build_entries<P11_NT>(p, xcd, spre);
    for (int it0 = rank; it0 < total * P11_REP; it0 += nranks) {
        const int it = it0 % total;
        int e, nt, mtile, cnt;
        decode_item<P11_NT>(p, xcd, spre, it, e, nt, mtile, cnt);
        if (tid < 128) {
            const int pos = mtile * 128 + tid;
            int id = -1;
            if (pos < cnt) id = (e == N_EXP) ? (pos * NASSIGN + TOPK) : p.lists()[(size_t)e * NTOK + pos];
            srow[tid] = id >= 0 ? id : 0;
            srow[128 + tid] = id;
            sew[tid] = id >= 0 ? p.ew()[id] : 0.f;
        }
        __syncthreads();
        Rows4 al; al.kmask = 255;
        al.p0 = p.hid() + (size_t)srow[(tid >> 3)] * 256; al.p1 = p.hid() + (size_t)srow[32 + (tid >> 3)] * 256;
        al.p2 = p.hid() + (size_t)srow[64 + (tid >> 3)] * 256; al.p3 = p.hid() + (size_t)srow[96 + (tid >> 3)] * 256;
        DownB bl{(e == N_EXP) ? p.w_s_down : p.w_e_down + (size_t)e * 256 * 1024};
        f32x4 acc[4][4];
        bf16_t* outk = p.outk();
        auto epi = [&](int tile, const f32x4 (&a)[4][4]) __attribute__((always_inline)) {
#pragma unroll
            for (int m = 0; m < 4; ++m) {
                const int rr = wr * 64 + m * 16 + fr;
                const int id = srow[128 + rr];
                if (id >= 0) {
                    const float w8 = sew[rr];
#pragma unroll
                    for (int n = 0; n < 4; ++n) {
                        u32x2 w; w.x = pk_bf16(a[m][n][0] * w8, a[m][n][1] * w8); w.y = pk_bf16(a[m][n][2] * w8, a[m][n][3] * w8);
                        *(u32x2*)(outk + (size_t)id * 1024 + tile * 128 + wc * 64 + n * 16 + fq * 4) = w;
                    }
                }
            }
        };
        gemm_core<true, true>(al, bl, nt * (2048 / P11_NT), 32 / P11_NT, 4, smem, acc, [&](int tl, const f32x4 (&a)[4][4]) __attribute__((always_inline)) { epi(nt * (8 / P11_NT) + tl, a); });
        __syncthreads();
    }
}

__device__ void phase12(const Params& p) {
    const int lane = opaque_tid() & 63, gw = blockIdx.x * 4 + (opaque_tid() >> 6), nw = gridDim.x * 4;
    const float alpha = 1.189207115f;
    for (int row = gw; row < NTOK; row += nw) {
        const int b = row / SEQ;
        const float* md = p.mod() + b * 6144;
        float v[16];
#pragma unroll
        for (int i = 0; i < 16; ++i) v[i] = 0.f;
#pragma unroll
        for (int k = 0; k < NASSIGN; ++k) {
#pragma unroll
            for (int cidx = 0; cidx < 2; ++cidx) {
                const u32x4 w = *(const u32x4*)(p.outk() + ((size_t)row * NASSIGN + k) * 1024 + cidx * 512 + lane * 8);
                v[cidx * 8 + 0] += bflo(w.x); v[cidx * 8 + 1] += bfhi(w.x); v[cidx * 8 + 2] += bflo(w.y); v[cidx * 8 + 3] += bfhi(w.y);
                v[cidx * 8 + 4] += bflo(w.z); v[cidx * 8 + 5] += bfhi(w.z); v[cidx * 8 + 6] += bflo(w.w); v[cidx * 8 + 7] += bfhi(w.w);
            }
        }
        float s = 0.f;
#pragma unroll
        for (int cidx = 0; cidx < 2; ++cidx)
#pragma unroll
            for (int hh = 0; hh < 2; ++hh) {
                const int col = cidx * 512 + lane * 8 + hh * 4;
                const f32x4 xv = *(const f32x4*)(p.x1() + (size_t)row * 1024 + col), ga = *(const f32x4*)(md + 5120 + col);
#pragma unroll
                for (int j = 0; j < 4; ++j) { float t = alpha * xv[j] + (1.f + ga[j]) * v[cidx * 8 + hh * 4 + j]; v[cidx * 8 + hh * 4 + j] = t; s += t; }
            }
        const float mu = wave_sum(s) * (1.f / 1024.f);
        float q = 0.f;
#pragma unroll
        for (int i = 0; i < 16; ++i) { float d = v[i] - mu; q += d * d; }
        const float rstd = rsqrtf(wave_sum(q) * (1.f / 1024.f) + 1e-5f);
#pragma unroll
        for (int cidx = 0; cidx < 2; ++cidx)
#pragma unroll
            for (int hh = 0; hh < 2; ++hh) {
                const int col = cidx * 512 + lane * 8 + hh * 4;
                const f32x4 g = *(const f32x4*)(p.ln2_g + col), bb = *(const f32x4*)(p.ln2_b + col);
                f32x4 o;
#pragma unroll
                for (int j = 0; j < 4; ++j) o[j] = (v[cidx * 8 + hh * 4 + j] - mu) * rstd * g[j] + bb[j];
                *(f32x4*)(p.out + (size_t)row * 1024 + col) = o;
            }
    }
}

#define XB_TMO      128
#define XB_XCNT(j)  (256  + 64 * (j))
#define XB_XSUB(j)  (1280 + 64 * (j))
#define XB_XGEN(j)  (2304 + 64 * (j))
#define XB_TOP      3328
#define XB_TOPGEN   3392
#define XCD_BAR_WORDS 3456
#define XB_SPIN_CAP (1u << 22)
#define LAS __attribute__((address_space(3)))
__device__ __forceinline__ unsigned xb_ld(unsigned* p) { return __hip_atomic_load(p, __ATOMIC_RELAXED, __HIP_MEMORY_SCOPE_AGENT); }
__device__ __forceinline__ unsigned xb_add(unsigned* p, unsigned v) { return __hip_atomic_fetch_add(p, v, __ATOMIC_RELAXED, __HIP_MEMORY_SCOPE_AGENT); }
__device__ __forceinline__ unsigned xb_xcc_id() { return (unsigned)__builtin_amdgcn_s_getreg((3 << 11) | 20) & 0xFu; }
#define XB_SPIN(cond, bar) do { unsigned _sp = 0; while (cond) { __builtin_amdgcn_s_sleep(1); \
    if ((++_sp & 255u) == 0u) { if (xb_ld(&(bar)[XB_TMO])) break; if (_sp > XB_SPIN_CAP) { atomicAdd(&(bar)[XB_TMO], 1u); break; } } } } while (0)
struct XcdBarrier { unsigned* bar; unsigned x; volatile LAS unsigned* st; };
__device__ __forceinline__ XcdBarrier xcd_barrier_post(unsigned* bar, volatile LAS unsigned* st) {
    XcdBarrier b; b.bar = bar; b.x = xb_xcc_id(); b.st = st;
    if (opaque_tid() == 0) st[2] = xb_add(&bar[XB_XCNT(b.x)], 1u);
    return b;
}
__device__ __forceinline__ void xcd_barrier_complete(unsigned* bar, unsigned x, unsigned& nloc, unsigned& nx, unsigned& dense) {
    const unsigned G = gridDim.x * gridDim.y * gridDim.z;
    unsigned sum, cnt, mine, below, sp = 0u;
    for (;;) {
        sum = 0u; cnt = 0u; mine = 0u; below = 0u;
#pragma unroll
        for (unsigned j = 0; j < 16; ++j) { const unsigned c = xb_ld(&bar[XB_XCNT(j)]); sum += c; cnt += (c > 0u) ? 1u : 0u; mine = (j == x) ? c : mine; below += (j < x && c > 0u) ? 1u : 0u; }
        if (sum == G) break;
        __builtin_amdgcn_s_sleep(1);
        if ((++sp & 255u) == 0u) { if (xb_ld(&bar[XB_TMO])) break; if (sp > XB_SPIN_CAP) { atomicAdd(&bar[XB_TMO], 1u); break; } }
    }
    nloc = mine > 0u ? mine : 1u; nx = cnt > 0u ? cnt : 1u; dense = below;
}
__device__ __forceinline__ void xcd_barrier(unsigned* bar, volatile LAS unsigned* st) {
    asm volatile("s_waitcnt vmcnt(0)" ::: "memory");
    __syncthreads();
    if (opaque_tid() == 0) {
        __builtin_amdgcn_s_waitcnt(0);
        const unsigned x = st[3];
        unsigned nloc = st[0], nx = st[1];
        if (nloc == 0u) {
            unsigned dense;
            xcd_barrier_complete(bar, x, nloc, nx, dense); st[0] = nloc; st[1] = nx;
            const unsigned use_xcc = (nx == 8u) ? 1u : 0u;
            st[4] = use_xcc ? dense : (blockIdx.x & 7u);
            st[5] = use_xcc ? st[2] : (blockIdx.x >> 3);
            st[6] = use_xcc ? nloc : (gridDim.x >> 3);
        }
        const unsigned old = xb_add(&bar[XB_XSUB(x)], 1u);
        const unsigned gen = old / nloc;
        if (old + 1u == (gen + 1u) * nloc) {
            __builtin_amdgcn_fence(__ATOMIC_RELEASE, "agent");
            asm volatile("s_waitcnt vmcnt(0)" ::: "memory");
            const unsigned og = xb_add(&bar[XB_TOP], 1u);
            const unsigned tg = og / nx;
            if (og + 1u == (tg + 1u) * nx) xb_add(&bar[XB_TOPGEN], 1u);
            else XB_SPIN(xb_ld(&bar[XB_TOPGEN]) == tg, bar);
            __builtin_amdgcn_fence(__ATOMIC_ACQUIRE, "agent");
            xb_add(&bar[XB_XGEN(x)], 1u);
            asm volatile("s_waitcnt vmcnt(0)" ::: "memory");
        } else {
            XB_SPIN(xb_ld(&bar[XB_XGEN(x)]) == gen, bar);
            __builtin_amdgcn_fence(__ATOMIC_ACQUIRE, "agent");
            asm volatile("s_waitcnt vmcnt(0)" ::: "memory");
        }
    }
    __syncthreads();
}

#define MEGA_SMEM (GEMM_SMEM + 2048 + 64)
#define N_PHASES 14
__global__ void __launch_bounds__(256, 2) mega(Params p) {
    extern __shared__ __attribute__((aligned(16))) char smem[];
    volatile LAS unsigned* st = (volatile LAS unsigned*)(smem + GEMM_SMEM + 2048);
    if (p.ph_hi - p.ph_lo > 1) {
        if (opaque_tid() == 0) {
            const unsigned x = xb_xcc_id();
            st[0] = 0u; st[1] = 0u; st[3] = x;
            st[2] = xb_add(&p.bar()[XB_XCNT(x)], 1u);
        }
    } else {
        if (opaque_tid() == 0) { st[0] = gridDim.x >> 3; st[1] = 8u; st[2] = blockIdx.x >> 3; st[3] = blockIdx.x & 7; st[4] = blockIdx.x & 7; st[5] = blockIdx.x >> 3; st[6] = gridDim.x >> 3; }
    }
    __syncthreads();
#ifndef REP_PHASE
#define REP_PHASE -1
#endif
#ifdef PHPROF
#define PH_STAMP(N) if (blockIdx.x == 0 && opaque_tid() == 0) ((unsigned long long*)(p.ws + OFF_counts + 1536))[N] = __builtin_amdgcn_s_memrealtime();
#else
#define PH_STAMP(N)
#endif
#define RUN_PHASE(N, CALL) if (p.ph_lo <= N && N < p.ph_hi) { if (N > p.ph_lo) xcd_barrier(p.bar(), st); PH_STAMP(N) { const int rep = 0; (void)rep; CALL; } \
        if (REP_PHASE == N) { xcd_barrier(p.bar(), st); { const int rep = 1; (void)rep; CALL; } } }
    RUN_PHASE(0, phase0(p, smem))
    RUN_PHASE(1, phase1(p))
    RUN_PHASE(2, phase2(p, smem))
    RUN_PHASE(3, phase3(p, smem))
    RUN_PHASE(4, phase4(p, smem))
    RUN_PHASE(5, phase5a(p, smem, rep))
    RUN_PHASE(6, phase5b(p, smem, rep))
    RUN_PHASE(7, phase6(p, smem))
    RUN_PHASE(8, phase7(p))
    RUN_PHASE(9, phase8(p, smem))
    RUN_PHASE(10, phase9(p))
    RUN_PHASE(11, phase10(p, smem))
    RUN_PHASE(12, phase11(p, smem))
    RUN_PHASE(13, phase12(p))
#ifdef EXTRA_BARRIERS
    for (int i = 0; i < EXTRA_BARRIERS; ++i) xcd_barrier(p.bar(), st);
#endif
    PH_STAMP(14)
    PH_STAMP(15)
}
#if DBG
struct NaiveBufs { float *mod, *h, *proj, *flat, *hidk, *hidv, *kc, *vc, *mix, *ograw, *y, *x1, *logits; };
__device__ __forceinline__ void dbg_pair(int seam, size_t i, const Params& p, const NaiveBufs& nb, float& a, float& b, bool& use) {
    use = true; a = 0.f; b = 0.f;
    switch (seam) {
        case 0: {
            a = nb.mod[i]; b = p.mod()[i]; break; }
        case 1: {
            size_t tok = i / PCOLS; int n = (int)(i % PCOLS);
            int src = win_srccol(n);
            bool transposed = (n >= 896 && n < 1024) || (n >= 1152 && n < 1280) || (n >= 1792 && n < 2304) || n >= 2816;
            if (transposed || src < 0) { use = false; break; }
            a = nb.proj[tok * IN_COLS + src]; b = bf2f(p.Pb()[i]); break; }
        case 2: {
            size_t half = (size_t)BATCH * 128 * SEQ; int which = i >= half; size_t j = which ? i - half : i;
            int t = (int)(j % SEQ); int f = (int)((j / SEQ) % 128); int bb = (int)(j / ((size_t)SEQ * 128));
            a = nb.proj[((size_t)bb * SEQ + t) * IN_COLS + (which ? C_VW : C_VS) + f];
            b = bf2f(which ? p.VwT()[j] : p.VsT()[j]); break; }
        case 3: {
            size_t nv = (size_t)BATCH * 512 * SEQ;
            if (i < nv) { int t = (int)(i % SEQ); int f = (int)((i / SEQ) % 512); int bb = (int)(i / ((size_t)SEQ * 512));
                a = nb.proj[((size_t)bb * SEQ + t) * IN_COLS + C_GV + f]; b = bf2f(p.VgT()[i]); }
            else { size_t j = i - nv; size_t tok = j / 40; int f = (int)(j % 40);
                a = nb.proj[tok * IN_COLS + (f < 24 ? C_NG + f : C_GLR + f - 24)]; b = p.misc()[tok * 64 + f]; }
            break; }
        case 4: {
            size_t nk = (size_t)BATCH * NCMP * 2 * 64;
            size_t j = i < nk ? i : i - nk;
            int d = (int)(j % 64); int g = (int)((j / 64) % 2); int ii = (int)((j / 128) % NCMP); int bb = (int)(j / (128 * NCMP));
            if (i < nk) { a = nb.kc[j]; b = bf2f(p.kc()[((size_t)(bb * 2 + g) * 256 + ii) * 64 + d]); }
            else { a = nb.vc[j]; b = bf2f(p.vcT()[((size_t)(bb * 2 + g) * 64 + d) * 256 + ii]); }
            break; }
        case 5: {
            size_t tok = i / 512; int cidx = (int)(i % 512);
            a = nb.mix[tok * 1024 + cidx]; b = bf2f(p.mixb()[tok * 1024 + cidx]); break; }
        case 6: {
            size_t tok = i / 512; int cidx = (int)(i % 512);
            a = nb.mix[tok * 1024 + 512 + cidx]; b = bf2f(p.mixb()[tok * 1024 + 512 + cidx]); break; }
        case 7: { a = nb.x1[i]; b = p.x1()[i]; break; }
        case 8: { a = nb.logits[i]; b = p.logits()[i]; break; }
    }
}
__global__ __launch_bounds__(256) void dbg_compare(int seam, size_t n, Params p, NaiveBufs nb, float* dbg) {
    __shared__ float red[256];
    float sd = 0.f, sa = 0.f;
    for (size_t i = (size_t)blockIdx.x * 256 + threadIdx.x; i < n; i += (size_t)gridDim.x * 256) {
        float a, b; bool use;
        dbg_pair(seam, i, p, nb, a, b, use);
        if (use) { float d = a - b; if (!(d == d)) d = 1e10f; sd += d * d; sa += a * a; }
    }
    sd = blk_sum(sd, red); sa = blk_sum(sa, red);
    if (threadIdx.x == 0) { atomicAdd(&dbg[2 * seam], sd); atomicAdd(&dbg[2 * seam + 1], sa); }
}
__global__ void dbg_decide(float* dbg, int nseams, int report_seam) {
    float code = 0.f;
    for (int k = 0; k < nseams; ++k) {
        float err = dbg[2 * k] / fmaxf(dbg[2 * k + 1], 1e-30f);
        const float thr = (k == 5) ? 3e-2f : 1e-3f;
        bool bad = !(err < thr);
        if (bad || k == report_seam) {
            float lg = log10f(fmaxf(err, 1e-12f));
            int dgt = (int)floorf(lg) + 6; dgt = dgt < 0 ? 0 : (dgt > 9 ? 9 : dgt);
            code = 100.f * (k + 1) + 10.f * dgt; break;
        }
    }
    dbg[64] = code;
}
__global__ void dbg_apply(const float* dbg, float* out, size_t n) {
    float code = dbg[64];
    if (code <= 0.f) return;
    float cst = sqrtf(code);
    for (size_t i = (size_t)blockIdx.x * 256 + threadIdx.x; i < n; i += (size_t)gridDim.x * 256) out[i] = cst;
}
#endif

#ifdef PROF
__global__ void prof_apply(const unsigned long long* pw, float* out, size_t n, int sel) {
    const double proc = (double)pw[0], tot = (double)pw[1], steps = (double)pw[2];
    float code = 0.f;
    if (sel == 0) code = (float)(100.0 * proc / tot);
    if (sel == 1) code = (float)(tot / steps / 10.0);
    if (sel == 2) code = (float)(proc / steps / 10.0);
    if (sel == 3) code = (float)(steps / 1024.0);
    const float cst = sqrtf(code);
    for (size_t i = (size_t)blockIdx.x * 256 + threadIdx.x; i < n; i += (size_t)gridDim.x * 256) out[i] = cst;
}
#endif
#ifdef PHPROF
__global__ void phase_prof_apply(const unsigned long long* ts, float* out, size_t n, int sel) {
    double us;
    if (sel >= 100) us = (double)(ts[15] - ts[0]) / 100.0;
    else us = (double)(ts[sel + 1] - ts[sel]) / 100.0;
    const float cst = (float)log2(us > 1.0 ? us : 1.0);
    for (size_t i = (size_t)blockIdx.x * 256 + threadIdx.x; i < n; i += (size_t)gridDim.x * 256) out[i] = cst;
}
#endif
extern "C" void kernel_launch(void* const* d_in, const int* in_sizes, int n_in, void* d_out, int out_size,
                              void* d_ws, size_t ws_size, hipStream_t stream) {
    Params p{};
    const float** ins = (const float**)&p;
    for (int i = 0; i < 27; ++i) ins[i] = (const float*)d_in[i];
    p.out = (float*)d_out;

    char* ws = (char*)d_ws;
    p.ws = ws;
    if (WS_TOTAL > ws_size) return;
#if DBG
    size_t off = 0;
    auto alloc = [&](size_t bytes) { char* q = ws + off; off += (bytes + 255) & ~(size_t)255; return q; };
    NaiveBufs nb{};
    nb.mod = (float*)alloc(4 * 6144 * 4);
    nb.h = (float*)alloc((size_t)NTOK * 1024 * 4);
    nb.proj = (float*)alloc((size_t)NTOK * IN_COLS * 4);
    nb.flat = (float*)alloc((size_t)2040 * 2048 * 4);
    nb.hidk = (float*)alloc((size_t)2040 * 256 * 4);
    nb.hidv = (float*)alloc((size_t)2040 * 256 * 4);
    nb.kc = (float*)alloc((size_t)2040 * 64 * 4);
    nb.vc = (float*)alloc((size_t)2040 * 64 * 4);
    nb.mix = (float*)alloc((size_t)NTOK * 1024 * 4);
    nb.ograw = (float*)alloc((size_t)NTOK * 512 * 4);
    nb.y = (float*)alloc((size_t)NTOK * 1024 * 4);
    nb.x1 = (float*)alloc((size_t)NTOK * 1024 * 4);
    nb.logits = (float*)alloc((size_t)NTOK * 256 * 4);
    float* dbg = (float*)alloc(1024);
    if (off > WS_BASE) return;
#endif

    static int grid = 0;
    if (grid == 0) {
        int dev = 0, cus = 0, per_cu = 0;
        (void)hipGetDevice(&dev);
        (void)hipDeviceGetAttribute(&cus, hipDeviceAttributeMultiprocessorCount, dev);
        (void)hipFuncSetAttribute((const void*)mega, hipFuncAttributeMaxDynamicSharedMemorySize, MEGA_SMEM);
        (void)hipOccupancyMaxActiveBlocksPerMultiprocessor(&per_cu, (const void*)mega, 256, MEGA_SMEM);
        if (per_cu > 2) per_cu = 2;
        if (per_cu < 1) per_cu = 1;
        grid = cus * per_cu;
        grid &= ~7;
    }
    (void)hipMemsetAsync(ws + OFF_bar, 0, XCD_BAR_WORDS * 4, stream);

#if DBG
    (void)hipMemsetAsync(dbg, 0, 1024, stream);
    nk_mod<<<dim3(24, 4), 256, 0, stream>>>(p.c, p.w_mod, p.b_mod, nb.mod);
    nk_lnmod<<<NTOK, 256, 0, stream>>>(p.x, nb.mod, 0, 1024, nb.h);
    nk_gemm<<<dim3((IN_COLS + 63) / 64, NTOK / 64), 256, 0, stream>>>(nb.h, 1024, p.w_in, IN_COLS, nb.proj, IN_COLS, NTOK, IN_COLS, 1024);
    nk_flat<<<2040, 256, 0, stream>>>(nb.proj, C_KC, p.pos_k, nb.flat);
    nk_gemm<<<dim3(4, 32), 256, 0, stream>>>(nb.flat, 2048, p.w1_k, 256, nb.hidk, 256, 2040, 256, 2048);
    nk_silu<<<(2040 * 256 + 255) / 256, 256, 0, stream>>>(nb.hidk, 2040 * 256);
    nk_gemm<<<dim3(1, 32), 256, 0, stream>>>(nb.hidk, 256, p.w2_k, 64, nb.kc, 64, 2040, 64, 256);
    nk_flat<<<2040, 256, 0, stream>>>(nb.proj, C_VC, p.pos_v, nb.flat);
    nk_gemm<<<dim3(4, 32), 256, 0, stream>>>(nb.flat, 2048, p.w1_v, 256, nb.hidv, 256, 2040, 256, 2048);
    nk_silu<<<(2040 * 256 + 255) / 256, 256, 0, stream>>>(nb.hidv, 2040 * 256);
    nk_gemm<<<dim3(1, 32), 256, 0, stream>>>(nb.hidv, 256, p.w2_v, 64, nb.vc, 64, 2040, 64, 256);
    nk_nsa<<<NTOK, 256, 0, stream>>>(nb.proj, nb.kc, nb.vc, nb.mix);
    nk_gla<<<64, 256, 0, stream>>>(nb.proj, p.w_a2, p.b_a2, nb.ograw);
    nk_gla_norm<<<NTOK, 256, 0, stream>>>(nb.ograw, nb.proj, p.norm_w, nb.mix);
    nk_gemm<<<dim3(16, NTOK / 64), 256, 0, stream>>>(nb.mix, 1024, p.w_o, 1024, nb.y, 1024, NTOK, 1024, 1024);
    nk_resln<<<NTOK, 256, 0, stream>>>(p.x, nb.y, nb.mod, 2048, p.ln1_g, p.ln1_b, nb.x1);
    nk_lnmod<<<NTOK, 256, 0, stream>>>(nb.x1, nb.mod, 3072, 4096, nb.h);
    nk_gemm<<<dim3(4, NTOK / 64), 256, 0, stream>>>(nb.h, 1024, p.w_router, 256, nb.logits, 256, NTOK, 256, 1024);
    auto cmp = [&](int seam, size_t n) { dbg_compare<<<1024, 256, 0, stream>>>(seam, n, p, nb, dbg); };
#endif

#if SINGLE_LAUNCH
    p.ph_lo = 0; p.ph_hi = N_PHASES;
    mega<<<grid, 256, MEGA_SMEM, stream>>>(p);
#else
    for (int ph = 0; ph < N_PHASES; ++ph) {
        p.ph_lo = ph; p.ph_hi = ph + 1;
        mega<<<grid, 256, MEGA_SMEM, stream>>>(p);
#if DBG
        if (ph == 0) cmp(0, 4 * 6144);
        if (ph == 2) { cmp(1, (size_t)NTOK * PCOLS); cmp(2, (size_t)2 * BATCH * 128 * SEQ); cmp(3, (size_t)BATCH * 512 * SEQ + (size_t)NTOK * 40); }
        if (ph == 4) cmp(4, (size_t)2 * BATCH * NCMP * 128);
        if (ph == 5) { cmp(5, (size_t)NTOK * 512); cmp(6, (size_t)NTOK * 512); }
        if (ph == 7) cmp(7, (size_t)NTOK * 1024);
        if (ph == 8) cmp(8, (size_t)NTOK * 256);
#endif
    }
#endif
#ifdef PHPROF
    phase_prof_apply<<<1024, 256, 0, stream>>>((const unsigned long long*)(ws + OFF_counts + 1536), p.out, (size_t)NTOK * 1024, PHPROF);
#endif
#ifdef PROF
    prof_apply<<<1024, 256, 0, stream>>>((const unsigned long long*)(ws + OFF_counts + 1024), p.out, (size_t)NTOK * 1024, PROF);
#endif
#if DBG
    dbg_decide<<<1, 1, 0, stream>>>(dbg, 9, DBG_REPORT);
    dbg_apply<<<1024, 256, 0, stream>>>(dbg, p.out, (size_t)NTOK * 1024);
#endif
}
```

```cpp
#include <hip/hip_runtime.h>
#include <hip/hip_bf16.h>
#include <stdint.h>

#define D_MODEL 1024
#define BATCH 4
#define SEQ 4096
#define NTOK (BATCH * SEQ)
#define IN_COLS 2856
#define NCMP 255
#define NEGF (-1e30f)
#define C_NQ 0
#define C_KC 512
#define C_VC 640
#define C_KS 768
#define C_VS 896
#define C_KW 1024
#define C_VW 1152
#define C_NG 1280
#define C_GQ 1304
#define C_GK 1560
#define C_GV 1816
#define C_GLR 2328
#define C_GR 2344
#define N_EXP 256
#define TOPK 8

__device__ __forceinline__ float siluf(float x) { return x / (1.f + __expf(-x)); }
__device__ __forceinline__ float sigmoidf_(float x) { return 1.f / (1.f + __expf(-x)); }

__device__ __forceinline__ float blk_sum(float v, float* red) {
    int t = threadIdx.x;
    __syncthreads();
    red[t] = v; __syncthreads();
    for (int s = 128; s > 0; s >>= 1) { if (t < s) red[t] += red[t + s]; __syncthreads(); }
    float r = red[0];
    return r;
}
__device__ __forceinline__ float blk_max(float v, float* red) {
    int t = threadIdx.x;
    __syncthreads();
    red[t] = v; __syncthreads();
    for (int s = 128; s > 0; s >>= 1) { if (t < s) red[t] = fmaxf(red[t], red[t + s]); __syncthreads(); }
    float r = red[0];
    return r;
}

#define DBG 0
#define SINGLE_LAUNCH 1
#define DBG_REPORT -1
#define REP_PHASE -1
#if DBG
__global__ __launch_bounds__(256) void nk_mod(const float* c, const float* w_mod, const float* b_mod, float* mod) {
    int j = blockIdx.x * 256 + threadIdx.x; int b = blockIdx.y;
    float acc = b_mod[j];
    for (int k = 0; k < D_MODEL; ++k) acc += siluf(c[b * D_MODEL + k]) * w_mod[(size_t)k * 6144 + j];
    mod[b * 6144 + j] = acc;
}

__global__ __launch_bounds__(256) void nk_lnmod(const float* x, const float* mod, int sh_off, int sc_off, float* out) {
    __shared__ float red[256];
    int row = blockIdx.x; int b = row / SEQ; int t = threadIdx.x;
    const float* xr = x + (size_t)row * D_MODEL;
    float v[4]; float s = 0.f;
    for (int i = 0; i < 4; ++i) { v[i] = xr[t + 256 * i]; s += v[i]; }
    float mu = blk_sum(s, red) * (1.f / D_MODEL);
    float q = 0.f;
    for (int i = 0; i < 4; ++i) { float d = v[i] - mu; q += d * d; }
    float var = blk_sum(q, red) * (1.f / D_MODEL);
    float rstd = rsqrtf(var + 1e-5f);
    for (int i = 0; i < 4; ++i) {
        int col = t + 256 * i;
        out[(size_t)row * D_MODEL + col] = (v[i] - mu) * rstd * (1.f + mod[b * 6144 + sc_off + col]) + mod[b * 6144 + sh_off + col];
    }
}

__global__ __launch_bounds__(256) void nk_resln(const float* x, const float* y, const float* mod, int ga_off, const float* g, const float* bb, float* out) {
    __shared__ float red[256];
    int row = blockIdx.x; int b = row / SEQ; int t = threadIdx.x;
    const float alpha = 1.189207115f;
    float v[4]; float s = 0.f;
    for (int i = 0; i < 4; ++i) {
        int col = t + 256 * i;
        v[i] = alpha * x[(size_t)row * D_MODEL + col] + (1.f + mod[b * 6144 + ga_off + col]) * y[(size_t)row * D_MODEL + col];
        s += v[i];
    }
    float mu = blk_sum(s, red) * (1.f / D_MODEL);
    float q = 0.f;
    for (int i = 0; i < 4; ++i) { float d = v[i] - mu; q += d * d; }
    float var = blk_sum(q, red) * (1.f / D_MODEL);
    float rstd = rsqrtf(var + 1e-5f);
    for (int i = 0; i < 4; ++i) {
        int col = t + 256 * i;
        out[(size_t)row * D_MODEL + col] = (v[i] - mu) * rstd * g[col] + bb[col];
    }
}

__global__ __launch_bounds__(256) void nk_gemm(const float* A, int lda, const float* B, int ldb, float* C, int ldc, int M, int N, int K) {
    __shared__ float sA[16][64 + 1];
    __shared__ float sB[16][64 + 1];
    int tx = threadIdx.x & 15, ty = threadIdx.x >> 4;
    int m0 = blockIdx.y * 64, n0 = blockIdx.x * 64;
    float acc[4][4];
    for (int i = 0; i < 4; ++i) for (int j = 0; j < 4; ++j) acc[i][j] = 0.f;
    for (int k0 = 0; k0 < K; k0 += 16) {
        for (int e = threadIdx.x; e < 1024; e += 256) {
            int r = e >> 4, kk = e & 15;
            int gm = m0 + r;
            sA[kk][r] = (gm < M) ? A[(size_t)gm * lda + k0 + kk] : 0.f;
            int kb = e >> 6, nn = e & 63;
            int gn = n0 + nn;
            sB[kb][nn] = (gn < N) ? B[(size_t)(k0 + kb) * ldb + gn] : 0.f;
        }
        __syncthreads();
#pragma unroll
        for (int kk = 0; kk < 16; ++kk) {
            float a[4], bv[4];
#pragma unroll
            for (int i = 0; i < 4; ++i) a[i] = sA[kk][ty * 4 + i];
#pragma unroll
            for (int j = 0; j < 4; ++j) bv[j] = sB[kk][tx * 4 + j];
#pragma unroll
            for (int i = 0; i < 4; ++i)
#pragma unroll
                for (int j = 0; j < 4; ++j) acc[i][j] += a[i] * bv[j];
        }
        __syncthreads();
    }
#pragma unroll
    for (int i = 0; i < 4; ++i)
#pragma unroll
        for (int j = 0; j < 4; ++j) {
            int gm = m0 + ty * 4 + i, gn = n0 + tx * 4 + j;
            if (gm < M && gn < N) C[(size_t)gm * ldc + gn] = acc[i][j];
        }
}

__global__ __launch_bounds__(256) void nk_flat(const float* proj, int col0, const float* pos, float* flat) {
    int r = blockIdx.x;
    int g = r & 1; int bi = r >> 1; int i = bi % NCMP; int b = bi / NCMP;
    for (int e = threadIdx.x; e < 2048; e += 256) {
        int l = e >> 6, d = e & 63;
        flat[(size_t)r * 2048 + e] = proj[((size_t)b * SEQ + 16 * i + l) * IN_COLS + col0 + g * 64 + d] + pos[l * 64 + d];
    }
}
__global__ void nk_silu(float* x, int n) { int i = blockIdx.x * 256 + threadIdx.x; if (i < n) x[i] = siluf(x[i]); }

__global__ __launch_bounds__(256) void nk_nsa(const float* proj, const float* kc, const float* vc, float* mix) {
    __shared__ float sq[8][64];
    __shared__ float sp[1024];
    __shared__ float red[256];
    __shared__ float simp[64];
    __shared__ float sscore[64];
    __shared__ int sidx[16];
    __shared__ float sout[8][64];
    __shared__ float spart[4][64];
    const int tid = threadIdx.x;
    const int bt = blockIdx.x; const int b = bt / SEQ, t = bt % SEQ;
    const float* prow = proj + (size_t)bt * IN_COLS;
    for (int e = tid; e < 512; e += 256) { sq[e >> 6][e & 63] = prow[C_NQ + e] * 0.125f; sout[e >> 6][e & 63] = 0.f; }
    __syncthreads();
    const int tblk = t >> 6;
    const int dd = tid & 63, part = tid >> 6;
    for (int g = 0; g < 2; ++g) {
        if (tid < 64) simp[tid] = 0.f;
        __syncthreads();
        for (int hp = 0; hp < 4; ++hp) {
            int h = g * 4 + hp;
            float slope = exp2f(-(float)(h + 1));
            float s = NEGF; bool valid = false;
            if (tid < NCMP) {
                int ce = 16 * tid + 31;
                valid = (t >= ce);
                if (valid) {
                    const float* kr = kc + (((size_t)b * NCMP + tid) * 2 + g) * 64;
                    float a = 0.f;
                    for (int d = 0; d < 64; ++d) a += sq[h][d] * kr[d];
                    s = a - slope * (float)(t - ce);
                }
            }
            float m = blk_max(s, red);
            float e = valid ? __expf(s - m) : 0.f;
            float sum = blk_sum(e, red);
            float p = e / fmaxf(sum, 1e-30f);
            __syncthreads();
            sp[tid] = p;
            __syncthreads();
            float a = 0.f;
            for (int i = part; i < NCMP; i += 4) a += sp[i] * vc[(((size_t)b * NCMP + i) * 2 + g) * 64 + dd];
            spart[part][dd] = a;
            __syncthreads();
            if (tid < 64) {
                float o = spart[0][tid] + spart[1][tid] + spart[2][tid] + spart[3][tid];
                float gate = sigmoidf_(prow[C_NG + h * 3 + 0]);
                sout[h][tid] += gate * o;
                int j = tid;
                float im = sp[4 * j] + sp[4 * j + 1] + sp[4 * j + 2] + 0.5f * sp[4 * j + 3] + (j > 0 ? 0.5f * sp[4 * j - 1] : 0.f);
                simp[j] += im;
            }
            __syncthreads();
        }
        if (tid < 64) {
            int j = tid;
            bool forced = (j == 0) || (j == tblk) || (j == tblk - 1);
            sscore[j] = (j <= tblk) ? (simp[j] + (forced ? 1e4f : 0.f)) : NEGF;
        }
        __syncthreads();
        if (tid < 64) {
            int j = tid; float sj = sscore[j]; int rank = 0;
            for (int j2 = 0; j2 < 64; ++j2) { float s2 = sscore[j2]; if (s2 > sj || (s2 == sj && j2 < j)) ++rank; }
            if (rank < 16) sidx[rank] = j;
        }
        __syncthreads();
        for (int hp = 0; hp < 4; ++hp) {
            int h = g * 4 + hp;
            float slope = exp2f(-(float)(h + 1));
            float sv[4]; bool vl[4]; float mx = NEGF;
            for (int r = 0; r < 4; ++r) {
                int kk = tid + 256 * r;
                int kpos = sidx[kk >> 6] * 64 + (kk & 63);
                vl[r] = (kpos <= t);
                sv[r] = NEGF;
                if (vl[r]) {
                    const float* kr = proj + ((size_t)b * SEQ + kpos) * IN_COLS + C_KS + g * 64;
                    float a = 0.f;
                    for (int d = 0; d < 64; ++d) a += sq[h][d] * kr[d];
                    sv[r] = a - slope * (float)(t - kpos);
                }
                mx = fmaxf(mx, sv[r]);
            }
            float m = blk_max(mx, red);
            float es = 0.f; float ev[4];
            for (int r = 0; r < 4; ++r) { ev[r] = vl[r] ? __expf(sv[r] - m) : 0.f; es += ev[r]; }
            float sum = blk_sum(es, red);
            float inv = 1.f / fmaxf(sum, 1e-30f);
            __syncthreads();
            for (int r = 0; r < 4; ++r) sp[tid + 256 * r] = ev[r] * inv;
            __syncthreads();
            float a = 0.f;
            for (int kk = part; kk < 1024; kk += 4) {
                float p = sp[kk];
                if (p != 0.f) {
                    int kpos = sidx[kk >> 6] * 64 + (kk & 63);
                    a += p * proj[((size_t)b * SEQ + kpos) * IN_COLS + C_VS + g * 64 + dd];
                }
            }
            spart[part][dd] = a;
            __syncthreads();
            if (tid < 64) {
                float o = spart[0][tid] + spart[1][tid] + spart[2][tid] + spart[3][tid];
                float gate = sigmoidf_(prow[C_NG + h * 3 + 1]);
                sout[h][tid] += gate * o;
            }
            __syncthreads();
        }
        for (int hp = 0; hp < 4; ++hp) {
            int h = g * 4 + hp;
            float slope = exp2f(-(float)(h + 1));
            float sv[2]; bool vl[2]; float mx = NEGF;
            for (int r = 0; r < 2; ++r) {
                int kk = tid + 256 * r;
                int kpos = t - 511 + kk;
                vl[r] = (kpos >= 0);
                sv[r] = NEGF;
                if (vl[r]) {
                    const float* kr = proj + ((size_t)b * SEQ + kpos) * IN_COLS + C_KW + g * 64;
                    float a = 0.f;
                    for (int d = 0; d < 64; ++d) a += sq[h][d] * kr[d];
                    sv[r] = a - slope * (float)(t - kpos);
                }
                mx = fmaxf(mx, sv[r]);
            }
            float m = blk_max(mx, red);
            float es = 0.f; float ev[2];
            for (int r = 0; r < 2; ++r) { ev[r] = vl[r] ? __expf(sv[r] - m) : 0.f; es += ev[r]; }
            float sum = blk_sum(es, red);
            float inv = 1.f / fmaxf(sum, 1e-30f);
            __syncthreads();
            for (int r = 0; r < 2; ++r) sp[tid + 256 * r] = ev[r] * inv;
            __syncthreads();
            float a = 0.f;
            for (int kk = part; kk < 512; kk += 4) {
                float p = sp[kk];
                if (p != 0.f) {
                    int kpos = t - 511 + kk;
                    a += p * proj[((size_t)b * SEQ + kpos) * IN_COLS + C_VW + g * 64 + dd];
                }
            }
            spart[part][dd] = a;
            __syncthreads();
            if (tid < 64) {
                float o = spart[0][tid] + spart[1][tid] + spart[2][tid] + spart[3][tid];
                float gate = sigmoidf_(prow[C_NG + h * 3 + 2]);
                sout[h][tid] += gate * o;
            }
            __syncthreads();
        }
    }
    for (int e = tid; e < 512; e += 256) mix[(size_t)bt * D_MODEL + e] = sout[e >> 6][e & 63];
}

__global__ __launch_bounds__(256) void nk_gla(const float* proj, const float* w_a2, const float* b_a2, float* ograw) {
    __shared__ float sqv[64], skv[64], sav[64];
    __shared__ float red[8][32];
    const int tid = threadIdx.x;
    const int es = blockIdx.x & 3, bh = blockIdx.x >> 2, h = bh & 3, b = bh >> 2;
    const int e = tid & 31, dg = tid >> 5;
    float S[8];
    for (int i = 0; i < 8; ++i) S[i] = 0.f;
    for (int t = 0; t < SEQ; ++t) {
        const float* prow = proj + ((size_t)b * SEQ + t) * IN_COLS;
        if (tid < 64) {
            int d = tid;
            sqv[d] = prow[C_GQ + h * 64 + d] * 0.125f;
            skv[d] = prow[C_GK + h * 64 + d];
            float x = b_a2[h * 64 + d];
            for (int r = 0; r < 16; ++r) x += prow[C_GLR + r] * w_a2[r * 256 + h * 64 + d];
            float ls = -(fmaxf(-x, 0.f) + log1pf(__expf(-fabsf(x))));
            sav[d] = __expf(ls * (1.f / 16.f));
        }
        __syncthreads();
        float v = prow[C_GV + h * 128 + es * 32 + e];
        float part = 0.f;
        for (int i = 0; i < 8; ++i) {
            int d = dg * 8 + i;
            S[i] = sav[d] * S[i] + skv[d] * v;
            part += sqv[d] * S[i];
        }
        red[dg][e] = part;
        __syncthreads();
        if (tid < 32) {
            float o = 0.f;
            for (int i = 0; i < 8; ++i) o += red[i][tid];
            ograw[((size_t)b * SEQ + t) * 512 + h * 128 + es * 32 + tid] = o;
        }
    }
}
__global__ __launch_bounds__(256) void nk_gla_norm(const float* ograw, const float* proj, const float* norm_w, float* mix) {
    int wid = (blockIdx.x * 256 + threadIdx.x) >> 6; int lane = threadIdx.x & 63;
    int tok = wid >> 2, h = wid & 3;
    const float* o = ograw + (size_t)tok * 512 + h * 128;
    float a = o[lane], c = o[lane + 64];
    float s = a + c;
    for (int m = 32; m > 0; m >>= 1) s += __shfl_xor(s, m);
    float mu = s * (1.f / 128.f);
    float q = (a - mu) * (a - mu) + (c - mu) * (c - mu);
    for (int m = 32; m > 0; m >>= 1) q += __shfl_xor(q, m);
    float rstd = rsqrtf(q * (1.f / 128.f) + 1e-5f);
    const float* r = proj + (size_t)tok * IN_COLS + C_GR + h * 128;
    mix[(size_t)tok * D_MODEL + 512 + h * 128 + lane] = (a - mu) * rstd * norm_w[lane] * siluf(r[lane]);
    mix[(size_t)tok * D_MODEL + 512 + h * 128 + lane + 64] = (c - mu) * rstd * norm_w[lane + 64] * siluf(r[lane + 64]);
}

__global__ __launch_bounds__(256) void nk_route(const float* logits, const float* rbias, int* eidx, float* ew, int* counts, int* lists) {
    int wid = (blockIdx.x * 256 + threadIdx.x) >> 6; int lane = threadIdx.x & 63;
    int tok = wid;
    float s[4], sb[4];
    for (int i = 0; i < 4; ++i) { float l = logits[(size_t)tok * 256 + lane * 4 + i]; s[i] = 1.f / (1.f + __expf(-l)); sb[i] = s[i] + rbias[lane * 4 + i]; }
    float m1 = NEGF, m2 = NEGF;
    for (int i = 0; i < 4; ++i) { float v = sb[i]; if (v > m1) { m2 = m1; m1 = v; } else if (v > m2) m2 = v; }
    for (int m = 1; m < 8; m <<= 1) {
        float o1 = __shfl_xor(m1, m), o2 = __shfl_xor(m2, m);
        float n1 = fmaxf(m1, o1);
        float n2 = fmaxf(fminf(m1, o1), fmaxf(m2, o2));
        m1 = n1; m2 = n2;
    }
    float gs = m1 + m2;
    int grp = lane >> 3;
    int grank = 0;
    for (int g2 = 0; g2 < 8; ++g2) { float o = __shfl(gs, g2 * 8); if (o > gs || (o == gs && g2 < grp)) ++grank; }
    bool gsel = grank < 4;
    float cand[4];
    for (int i = 0; i < 4; ++i) cand[i] = gsel ? sb[i] : NEGF;
    float wsum = 0.f; float myw = 0.f; int mye = 0;
    for (int k = 0; k < TOPK; ++k) {
        float bv = cand[0]; int bi = 0;
        for (int i = 1; i < 4; ++i) if (cand[i] > bv) { bv = cand[i]; bi = i; }
        int be = lane * 4 + bi;
        float gv = bv; int ge = be;
        for (int m = 1; m < 64; m <<= 1) {
            float ov = __shfl_xor(gv, m); int oe = __shfl_xor(ge, m);
            if (ov > gv || (ov == gv && oe < ge)) { gv = ov; ge = oe; }
        }
        float sel_s = 0.f;
        if ((ge >> 2) == lane) {
            int i = ge & 3;
            sel_s = (i == 0) ? s[0] : (i == 1) ? s[1] : (i == 2) ? s[2] : s[3];
            if (i == 0) cand[0] = -3e38f; else if (i == 1) cand[1] = -3e38f; else if (i == 2) cand[2] = -3e38f; else cand[3] = -3e38f;
        }
        sel_s = __shfl(sel_s, ge >> 2);
        wsum += sel_s;
        if (lane == k) { myw = sel_s; mye = ge; }
    }
    if (lane < TOPK) {
        float w = myw / wsum * 2.5f;
        eidx[tok * 8 + lane] = mye; ew[tok * 8 + lane] = w;
        int pos = atomicAdd(&counts[mye], 1);
        lists[(size_t)mye * NTOK + pos] = tok * 8 + lane;
    }
}

__global__ __launch_bounds__(256) void nk_moe(const float* h2, const float* wg, const float* wu, const float* wd,
                                              const float* sg, const float* su, const float* sd,
                                              const int* counts, const int* lists, const float* ew, float* acc) {
    __shared__ float sh[8][D_MODEL];
    __shared__ float shid[8][256];
    __shared__ int stok[8]; __shared__ float sw[8];
    const int e = blockIdx.y, chunk = blockIdx.x, tid = threadIdx.x;
    const int cnt = (e == N_EXP) ? NTOK : counts[e];
    if (chunk * 8 >= cnt) return;
    const float* Wg = (e == N_EXP) ? sg : wg + (size_t)e * D_MODEL * 256;
    const float* Wu = (e == N_EXP) ? su : wu + (size_t)e * D_MODEL * 256;
    const float* Wd = (e == N_EXP) ? sd : wd + (size_t)e * 256 * D_MODEL;
    if (tid < 8) {
        int p = chunk * 8 + tid;
        if (p < cnt) {
            if (e == N_EXP) { stok[tid] = p; sw[tid] = 1.f; }
            else { int id = lists[(size_t)e * NTOK + p]; stok[tid] = id >> 3; sw[tid] = ew[id]; }
        } else { stok[tid] = -1; sw[tid] = 0.f; }
    }
    __syncthreads();
    for (int m = 0; m < 8; ++m) {
        int tk = stok[m];
        for (int k = tid; k < D_MODEL; k += 256) sh[m][k] = (tk >= 0) ? h2[(size_t)tk * D_MODEL + k] : 0.f;
    }
    __syncthreads();
    float ag[8], au[8];
#pragma unroll
    for (int m = 0; m < 8; ++m) { ag[m] = 0.f; au[m] = 0.f; }
    for (int k = 0; k < D_MODEL; ++k) {
        float g = Wg[(size_t)k * 256 + tid], u = Wu[(size_t)k * 256 + tid];
#pragma unroll
        for (int m = 0; m < 8; ++m) { float hv = sh[m][k]; ag[m] += hv * g; au[m] += hv * u; }
    }
#pragma unroll
    for (int m = 0; m < 8; ++m) shid[m][tid] = siluf(ag[m]) * au[m];
    __syncthreads();
    for (int jj = 0; jj < 4; ++jj) {
        int j = tid + 256 * jj;
        float ao[8];
#pragma unroll
        for (int m = 0; m < 8; ++m) ao[m] = 0.f;
        for (int n = 0; n < 256; ++n) {
            float w = Wd[(size_t)n * D_MODEL + j];
#pragma unroll
            for (int m = 0; m < 8; ++m) ao[m] += shid[m][n] * w;
        }
#pragma unroll
        for (int m = 0; m < 8; ++m) { int tk = stok[m]; if (tk >= 0) atomicAdd(&acc[(size_t)tk * D_MODEL + j], ao[m] * sw[m]); }
    }
}

#endif
typedef unsigned short bf16_t;
typedef short bf16x8 __attribute__((ext_vector_type(8)));
typedef float f32x4 __attribute__((ext_vector_type(4)));
typedef unsigned u32x4 __attribute__((ext_vector_type(4)));
typedef unsigned u32x2 __attribute__((ext_vector_type(2)));

#define PCOLS 2944
#define P_NQ 0
#define P_KC 512
#define P_VC 640
#define P_KS 768
#define P_VS 896
#define P_KW 1024
#define P_VW 1152
#define P_GQ 1280
#define P_GK 1536
#define P_GV 1792
#define P_GR 2304
#define P_MISC 2816
#define NASSIGN 9
#define LOG2E 1.4426950408889634f

typedef float f32x2_t __attribute__((ext_vector_type(2)));
typedef __bf16 bf16x2_t __attribute__((ext_vector_type(2)));
__device__ __forceinline__ unsigned pk_bf16(float lo, float hi) { const f32x2_t v = {lo, hi}; return __builtin_bit_cast(unsigned, __builtin_convertvector(v, bf16x2_t)); }
__device__ __forceinline__ float bflo(unsigned u) { return __uint_as_float(u << 16); }
__device__ __forceinline__ float bfhi(unsigned u) { return __uint_as_float(u & 0xffff0000u); }
__device__ __forceinline__ float bf2f(bf16_t v) { return __uint_as_float(((unsigned)v) << 16); }
__device__ __forceinline__ int opaque_tid() { int t = threadIdx.x; asm volatile("" : "+v"(t)); return t; }
__device__ __forceinline__ bf16_t f2bf(float f) { return (bf16_t)(pk_bf16(f, 0.f) & 0xffffu); }

#if DBG
#define WS_BASE ((size_t)560 << 20)
#else
#define WS_BASE ((size_t)0)
#endif
#define WS_ALIGN(x) (((size_t)(x) + 255) & ~(size_t)255)
constexpr size_t OFF_mod = WS_BASE;
constexpr size_t OFF_bias1 = OFF_mod + WS_ALIGN(4*6144*4);
constexpr size_t OFF_wint = OFF_bias1 + WS_ALIGN(2*256*4);
constexpr size_t OFF_wot = OFF_wint + WS_ALIGN((size_t)PCOLS*1024*2);
constexpr size_t OFF_wrt = OFF_wot + WS_ALIGN((size_t)1024*1024*2);
constexpr size_t OFF_w1t = OFF_wrt + WS_ALIGN((size_t)256*1024*2);
constexpr size_t OFF_w2t = OFF_w1t + WS_ALIGN((size_t)2*256*2048*2);
constexpr size_t OFF_hb = OFF_w2t + WS_ALIGN((size_t)2*64*256*2);
constexpr size_t OFF_Pb = OFF_hb + WS_ALIGN((size_t)NTOK*1024*2);
constexpr size_t OFF_VsT = OFF_Pb + WS_ALIGN((size_t)NTOK*PCOLS*2);
constexpr size_t OFF_VwT = OFF_VsT + WS_ALIGN((size_t)BATCH*128*SEQ*2);
constexpr size_t OFF_VgT = OFF_VwT + WS_ALIGN((size_t)BATCH*128*SEQ*2);
constexpr size_t OFF_misc = OFF_VgT + WS_ALIGN((size_t)BATCH*512*SEQ*2);
constexpr size_t OFF_cpart = OFF_misc + WS_ALIGN((size_t)NTOK*64*4);
constexpr size_t OFF_kc = OFF_cpart + WS_ALIGN((size_t)2*4*2048*256*4);
constexpr size_t OFF_vcT = OFF_kc + WS_ALIGN((size_t)8*256*64*2);
constexpr size_t OFF_dST = OFF_vcT + WS_ALIGN((size_t)8*64*256*2);
constexpr size_t OFF_dec = OFF_dST + WS_ALIGN((size_t)16*64*8192*4);
constexpr size_t OFF_ST = OFF_dec + WS_ALIGN((size_t)16*64*64*4);
constexpr size_t OFF_mixf = OFF_ST + WS_ALIGN((size_t)16*64*8192*2);
constexpr size_t OFF_mixb = OFF_mixf + WS_ALIGN((size_t)NTOK*512*4);
constexpr size_t OFF_y1 = OFF_mixb + WS_ALIGN((size_t)NTOK*1024*2);
constexpr size_t OFF_x1 = OFF_y1 + WS_ALIGN((size_t)NTOK*1024*4);
constexpr size_t OFF_logits = OFF_x1 + WS_ALIGN((size_t)NTOK*1024*4);
constexpr size_t OFF_ew = OFF_logits + WS_ALIGN((size_t)NTOK*256*4);
constexpr size_t OFF_counts = OFF_ew + WS_ALIGN((size_t)NTOK*NASSIGN*4);
constexpr size_t OFF_lists = OFF_counts + WS_ALIGN(512*4);
constexpr size_t OFF_bar = OFF_lists + WS_ALIGN((size_t)N_EXP*NTOK*4);
constexpr size_t OFF_hid = OFF_bar + WS_ALIGN(4096*4);
constexpr size_t OFF_outk = OFF_hid + WS_ALIGN((size_t)NTOK*NASSIGN*256*2);
constexpr size_t OFF_selm = OFF_outk + WS_ALIGN((size_t)NTOK*NASSIGN*1024*2);
constexpr size_t OFF_selu = OFF_selm + WS_ALIGN((size_t)NTOK*2*8);
constexpr size_t OFF_mixf2 = OFF_selu + WS_ALIGN((size_t)8*64*4*8);
constexpr size_t OFF_bsave = OFF_mixf2 + WS_ALIGN((size_t)NTOK*512*4);
constexpr size_t WS_TOTAL = OFF_bsave + WS_ALIGN((size_t)1024*4096*4);
struct Params {
    const float *x, *c, *w_mod, *b_mod, *w_in, *pos_k, *w1_k, *w2_k, *pos_v, *w1_v, *w2_v, *w_a2, *b_a2, *norm_w, *w_o, *ln1_g, *ln1_b,
        *w_router, *rbias, *w_e_gate, *w_e_up, *w_e_down, *w_s_gate, *w_s_up, *w_s_down, *ln2_g, *ln2_b;
    float* out;
    char* ws;
    int ph_lo, ph_hi;
    __device__ __forceinline__ float* mod() const { return (float*)(ws + OFF_mod); }
    __device__ __forceinline__ float* bias1() const { return (float*)(ws + OFF_bias1); }
    __device__ __forceinline__ bf16_t* wint() const { return (bf16_t*)(ws + OFF_wint); }
    __device__ __forceinline__ bf16_t* wot() const { return (bf16_t*)(ws + OFF_wot); }
    __device__ __forceinline__ bf16_t* wrt() const { return (bf16_t*)(ws + OFF_wrt); }
    __device__ __forceinline__ bf16_t* w1t() const { return (bf16_t*)(ws + OFF_w1t); }
    __device__ __forceinline__ bf16_t* w2t() const { return (bf16_t*)(ws + OFF_w2t); }
    __device__ __forceinline__ bf16_t* hb() const { return (bf16_t*)(ws + OFF_hb); }
    __device__ __forceinline__ bf16_t* Pb() const { return (bf16_t*)(ws + OFF_Pb); }
    __device__ __forceinline__ bf16_t* VsT() const { return (bf16_t*)(ws + OFF_VsT); }
    __device__ __forceinline__ bf16_t* VwT() const { return (bf16_t*)(ws + OFF_VwT); }
    __device__ __forceinline__ bf16_t* VgT() const { return (bf16_t*)(ws + OFF_VgT); }
    __device__ __forceinline__ float* misc() const { return (float*)(ws + OFF_misc); }
    __device__ __forceinline__ float* cpart() const { return (float*)(ws + OFF_cpart); }
    __device__ __forceinline__ bf16_t* kc() const { return (bf16_t*)(ws + OFF_kc); }
    __device__ __forceinline__ bf16_t* vcT() const { return (bf16_t*)(ws + OFF_vcT); }
    __device__ __forceinline__ float* dST() const { return (float*)(ws + OFF_dST); }
    __device__ __forceinline__ float* dec() const { return (float*)(ws + OFF_dec); }
    __device__ __forceinline__ bf16_t* ST() const { return (bf16_t*)(ws + OFF_ST); }
    __device__ __forceinline__ float* mixf() const { return (float*)(ws + OFF_mixf); }
    __device__ __forceinline__ bf16_t* mixb() const { return (bf16_t*)(ws + OFF_mixb); }
    __device__ __forceinline__ float* y1() const { return (float*)(ws + OFF_y1); }
    __device__ __forceinline__ float* x1() const { return (float*)(ws + OFF_x1); }
    __device__ __forceinline__ float* logits() const { return (float*)(ws + OFF_logits); }
    __device__ __forceinline__ float* ew() const { return (float*)(ws + OFF_ew); }
    __device__ __forceinline__ int* counts() const { return (int*)(ws + OFF_counts); }
    __device__ __forceinline__ int* lists() const { return (int*)(ws + OFF_lists); }
    __device__ __forceinline__ unsigned* bar() const { return (unsigned*)(ws + OFF_bar); }
    __device__ __forceinline__ bf16_t* hid() const { return (bf16_t*)(ws + OFF_hid); }
    __device__ __forceinline__ bf16_t* outk() const { return (bf16_t*)(ws + OFF_outk); }
};

#define LDS_ROW 72
#define TILE_BYTES 16384
#define GEMM_SMEM 69632
__device__ __forceinline__ int swz_key(int row) { return ((row >> 2) & 1) | ((((row >> 1) ^ (row >> 3)) & 1) << 1) | ((((row >> 2) ^ (row >> 4)) & 1) << 2); }
__device__ __forceinline__ int swz_off(int row, int chunk) { return row * 128 + ((chunk ^ swz_key(row)) << 4); }
typedef __attribute__((address_space(3))) unsigned lds_u32;

struct RowsBf16 {
    static constexpr bool NT = false;
    const bf16_t* base; size_t stride;
    __device__ __forceinline__ const bf16_t* ptr(int r, int k) const { return base + (size_t)r * stride + k; }
    __device__ __forceinline__ const bf16_t* pp(int i, int tid, int k) const { return ptr(i * 32 + (tid >> 3), k); }
};
struct GatherBf16 {
    static constexpr bool NT = true;
    const bf16_t* base; size_t stride; const int* rowidx;
    __device__ __forceinline__ const bf16_t* ptr(int r, int k) const { return base + (size_t)rowidx[r] * stride + k; }
    __device__ __forceinline__ const bf16_t* pp(int i, int tid, int k) const { return ptr(i * 32 + (tid >> 3), k); }
};
struct BF32Plain {
    const float* base; size_t ld;
    __device__ __forceinline__ f32x4 load4(int k, int r4) const { return *(const f32x4*)(base + (size_t)k * ld + r4); }
};
struct BF32GateUp {
    const float* g; long du; size_t ld;
    __device__ __forceinline__ f32x4 load4(int k, int r4) const {
        const long sel = ((r4 >> 5) & 1) ? du : 0l;
#ifdef NT_B
        return __builtin_nontemporal_load((const f32x4*)(g + sel + (size_t)k * ld + (r4 >> 6) * 32 + (r4 & 31)));
#else
        return *(const f32x4*)(g + sel + (size_t)k * ld + (r4 >> 6) * 32 + (r4 & 31));
#endif
    }
    __device__ __forceinline__ const float* addr(int k, int r4) const { const long sel = ((r4 >> 5) & 1) ? du : 0l; return g + sel + (size_t)k * ld + (r4 >> 6) * 32 + (r4 & 31); }
};

template <class L>
__device__ __forceinline__ void bf16_piece_load(u32x4& r, const L& ld, int k0, int i, int tid) { r = *(const u32x4*)ld.pp(i, tid, k0 + ((tid & 7) << 3)); }
__device__ __forceinline__ void bf16_piece_write(const u32x4& r, char* tile, int i, int tid) { *(u32x4*)(tile + swz_off(i * 32 + (tid >> 3), tid & 7)) = r; }
template <int J0, class BL>
__device__ __forceinline__ void f32_rows_load(f32x4 (&r)[8], const BL& bl, int k0, int tid) {
    const int kg = (tid >> 5) * 8, n4 = (tid & 31) * 4;
#pragma unroll
    for (int j = 0; j < 4; ++j) r[J0 + j] = bl.load4(k0 + kg + J0 + j, n4);
}
template <int I>
__device__ __forceinline__ void f32_col_write(const f32x4 (&r)[8], char* tile, int tid) {
    const int kgc = tid >> 5, n4 = (tid & 31) * 4;
    u32x4 w;
    w.x = pk_bf16(r[0][I], r[1][I]); w.y = pk_bf16(r[2][I], r[3][I]);
    w.z = pk_bf16(r[4][I], r[5][I]); w.w = pk_bf16(r[6][I], r[7][I]);
    *(u32x4*)(tile + swz_off(n4 + I, kgc)) = w;
}

#ifdef USE_SETPRIO
#define SETPRIO_HI __builtin_amdgcn_s_setprio(1);
#define SETPRIO_LO __builtin_amdgcn_s_setprio(0);
#else
#define SETPRIO_HI
#define SETPRIO_LO
#endif
template <bool SWAP, bool BF32, class AL, class BL, class EPI>
__device__ __forceinline__ void gemm_core(const AL& al, const BL& bl, int k_begin, int nk, int nkt, char* smem, f32x4 (&acc)[4][4], EPI&& epi) {
    const int tid = opaque_tid(), lane = tid & 63, wid = tid >> 6, wr = wid >> 1, wc = wid & 1, fr = lane & 15, fq = lane >> 4;
#pragma unroll
    for (int m = 0; m < 4; ++m)
#pragma unroll
        for (int n = 0; n < 4; ++n) acc[m][n] = (f32x4){0.f, 0.f, 0.f, 0.f};
    u32x4 ra[4]; u32x4 rb[4]; f32x4 rbf[8];
#ifdef L2PF
    float pf0 = 0.f;
#endif
#pragma unroll
    for (int i = 0; i < 4; ++i) { bf16_piece_load(ra[i], al, k_begin, i, tid); if constexpr (!BF32) bf16_piece_load(rb[i], bl, k_begin, i, tid); }
    if constexpr (BF32) { f32_rows_load<0>(rbf, bl, k_begin, tid); f32_rows_load<4>(rbf, bl, k_begin, tid); }
#pragma unroll
    for (int i = 0; i < 4; ++i) { bf16_piece_write(ra[i], smem, i, tid); if constexpr (!BF32) bf16_piece_write(rb[i], smem + TILE_BYTES, i, tid); }
    if constexpr (BF32) { f32_col_write<0>(rbf, smem + TILE_BYTES, tid); f32_col_write<1>(rbf, smem + TILE_BYTES, tid); f32_col_write<2>(rbf, smem + TILE_BYTES, tid); f32_col_write<3>(rbf, smem + TILE_BYTES, tid); }
    if (nk > 1) {
#pragma unroll
        for (int i = 0; i < 4; ++i) { bf16_piece_load(ra[i], al, k_begin + 64, i, tid); if constexpr (!BF32) bf16_piece_load(rb[i], bl, k_begin + 64, i, tid); }
        if constexpr (BF32) { f32_rows_load<0>(rbf, bl, k_begin + 64, tid); f32_rows_load<4>(rbf, bl, k_begin + 64, tid); }
    }
    __syncthreads();
    int tile = 0, kin = 0;
    for (int kt = 0; kt < nk; ++kt) {
        const char* sA = smem + (kt & 1) * 2 * TILE_BYTES; const char* sB = sA + TILE_BYTES;
        char* nA = smem + ((kt & 1) ^ 1) * 2 * TILE_BYTES; char* nB = nA + TILE_BYTES;
        const bool w1 = kt + 1 < nk, l2 = kt + 2 < nk;
        const int k2 = k_begin + (kt + 2) * 64;
#ifdef L2PF
        if constexpr (BF32) {
            asm volatile("" :: "v"(pf0));
            if (kt + L2PF < nk) pf0 = *bl.addr(k_begin + (kt + L2PF) * 64 + wid * 16 + (lane >> 2), (lane & 3) * 32);
        }
#endif
        bf16x8 a[2][4], b[2][4];
#pragma unroll
        for (int m = 0; m < 4; ++m) a[0][m] = *(const bf16x8*)(sA + swz_off(wr * 64 + m * 16 + fr, fq));
#pragma unroll
        for (int n = 0; n < 4; ++n) b[0][n] = *(const bf16x8*)(sB + swz_off(wc * 64 + n * 16 + fr, fq));
#define GEMM_GROUP(G) { \
            constexpr int ks = (G) >> 1, m0 = ((G) & 1) * 2; \
            __builtin_amdgcn_sched_barrier(0); \
            SETPRIO_HI \
            _Pragma("unroll") for (int m = m0; m < m0 + 2; ++m) \
            _Pragma("unroll") for (int n = 0; n < 4; ++n) \
                acc[m][n] = SWAP ? __builtin_amdgcn_mfma_f32_16x16x32_bf16(b[ks][n], a[ks][m], acc[m][n], 0, 0, 0) \
                                 : __builtin_amdgcn_mfma_f32_16x16x32_bf16(a[ks][m], b[ks][n], acc[m][n], 0, 0, 0); \
            SETPRIO_LO \
            __builtin_amdgcn_sched_barrier(0); \
            if (w1) bf16_piece_write(ra[G], nA, G, tid); \
            if (l2) bf16_piece_load(ra[G], al, k2, G, tid); \
            if constexpr (BF32) { \
                if constexpr ((G) == 0) { if (w1) { f32_col_write<0>(rbf, nB, tid); f32_col_write<1>(rbf, nB, tid); } } \
                if constexpr ((G) == 1) { if (w1) { f32_col_write<2>(rbf, nB, tid); f32_col_write<3>(rbf, nB, tid); } } \
                if constexpr ((G) == 2) { if (l2) f32_rows_load<0>(rbf, bl, k2, tid); } \
                if constexpr ((G) == 3) { if (l2) f32_rows_load<4>(rbf, bl, k2, tid); } \
            } else { \
                if (w1) bf16_piece_write(rb[G], nB, G, tid); \
                if (l2) bf16_piece_load(rb[G], bl, k2, G, tid); \
            } }
        GEMM_GROUP(0) GEMM_GROUP(1)
#pragma unroll
        for (int m = 0; m < 4; ++m) a[1][m] = *(const bf16x8*)(sA + swz_off(wr * 64 + m * 16 + fr, 4 + fq));
#pragma unroll
        for (int n = 0; n < 4; ++n) b[1][n] = *(const bf16x8*)(sB + swz_off(wc * 64 + n * 16 + fr, 4 + fq));
        GEMM_GROUP(2) GEMM_GROUP(3)
#undef GEMM_GROUP
        kin += 1;
        if (kin == nkt && kt + 1 < nk) {
            epi(tile, acc);
            tile += 1; kin = 0;
#pragma unroll
            for (int m = 0; m < 4; ++m)
#pragma unroll
                for (int n = 0; n < 4; ++n) acc[m][n] = (f32x4){0.f, 0.f, 0.f, 0.f};
        }
        __syncthreads();
    }
    epi(tile, acc);
}
struct NoEpi { __device__ __forceinline__ void operator()(int, const f32x4 (&)[4][4]) const {} };
template <bool SWAP, bool BF32, class AL, class BL>
__device__ __forceinline__ void gemm_128(const AL& al, const BL& bl, int k_begin, int nk, char* smem, f32x4 (&acc)[4][4]) {
    gemm_core<SWAP, BF32>(al, bl, k_begin, nk, nk, smem, acc, NoEpi());
}

__device__ __forceinline__ int xcd_of(const char* smem) { return (int)(((const unsigned*)(smem + GEMM_SMEM + 2048))[4] & 7u); }
__device__ __forceinline__ int rank_of(const char* smem) { return (int)((const unsigned*)(smem + GEMM_SMEM + 2048))[5]; }
__device__ __forceinline__ int nranks_of(const char* smem) { int n = (int)((const unsigned*)(smem + GEMM_SMEM + 2048))[6]; return n > 0 ? n : 1; }
template <int NB, bool SILU>
__device__ __forceinline__ void gemv_item(const float* in, const float* W, int ldw, const float* bias, float* out, int ldo, int K, int col0, float* sm) {
    const int tid = opaque_tid();
    for (int i = tid; i < NB * K; i += 256) { float v = in[i]; sm[i] = SILU ? v / (1.f + __expf(-v)) : v; }
    __syncthreads();
    float acc[NB];
#pragma unroll
    for (int b = 0; b < NB; ++b) acc[b] = 0.f;
    const int kq = tid >> 6, cl = tid & 63; const int kb = kq * (K / 4);
    for (int k = kb; k < kb + K / 4; k += 16) {
        float w[16];
#pragma unroll
        for (int u = 0; u < 16; ++u) w[u] = W[(size_t)(k + u) * ldw + col0 + cl];
#pragma unroll
        for (int u = 0; u < 16; ++u)
#pragma unroll
            for (int b = 0; b < NB; ++b) acc[b] += sm[b * K + k + u] * w[u];
    }
    float* red = sm + NB * K;
#pragma unroll
    for (int b = 0; b < NB; ++b) red[(kq * NB + b) * 64 + cl] = acc[b];
    __syncthreads();
    if (tid < 64 * NB) {
        int b = tid >> 6, cc = tid & 63;
        float s = red[(0 * NB + b) * 64 + cc] + red[(1 * NB + b) * 64 + cc] + red[(2 * NB + b) * 64 + cc] + red[(3 * NB + b) * 64 + cc];
        out[b * ldo + col0 + cc] = s + (bias ? bias[col0 + cc] : 0.f);
    }
    __syncthreads();
}

__device__ __forceinline__ int win_srccol(int n) {
    if (n < 1280) return n;
    if (n < 2304) return n + 24;
    if (n < 2816) return n + 40;
    if (n < 2840) return n - 2816 + 1280;
    if (n < 2856) return n - 2840 + 2328;
    return -1;
}
template <bool PERM>
__device__ __forceinline__ void transpose_item(const float* W, int ldw, int K, bf16_t* out, int k0, int n0, float* sm) {
    const int tid = opaque_tid();
    f32x4 v[4];
#pragma unroll
    for (int i = 0; i < 4; ++i) {
        const int c = tid + 256 * i, kk = c >> 4, nn = (c & 15) * 4;
        const int src = PERM ? win_srccol(n0 + nn) : (n0 + nn);
        v[i] = (src >= 0) ? *(const f32x4*)(W + (size_t)(k0 + kk) * ldw + src) : (f32x4){0.f, 0.f, 0.f, 0.f};
    }
#pragma unroll
    for (int i = 0; i < 4; ++i) {
        const int c = tid + 256 * i, kk = c >> 4, nn = (c & 15) * 4;
#pragma unroll
        for (int j = 0; j < 4; ++j) sm[(nn + j) * 65 + kk] = v[i][j];
    }
    __syncthreads();
#pragma unroll
    for (int i = 0; i < 2; ++i) {
        const int c = tid + 256 * i, nn = c >> 3, kc = (c & 7) * 8;
        const float* r = sm + nn * 65 + kc;
        u32x4 w;
        w.x = pk_bf16(r[0], r[1]); w.y = pk_bf16(r[2], r[3]); w.z = pk_bf16(r[4], r[5]); w.w = pk_bf16(r[6], r[7]);
        *(u32x4*)(out + (size_t)(n0 + nn) * K + k0 + kc) = w;
    }
    __syncthreads();
}

__device__ void phase0(const Params& p, char* smem) {
    float* sm = (float*)smem;
    const int nb = gridDim.x, bid = blockIdx.x;
    const int I_MOD = 96, I_B1 = 8, I_WIN = 16 * 46, I_WO = 256, I_WR = 64, I_W1 = 2 * 32 * 4, I_W2 = 2 * 4;
    const int total = I_MOD + I_B1 + I_WIN + I_WO + I_WR + I_W1 + I_W2;
    if (bid == 0 && opaque_tid() < 64) p.counts()[264 + opaque_tid()] = 0;
    if (bid == 1) for (int i = opaque_tid(); i < 264; i += 256) p.counts()[i] = 0;
    for (int it = bid; it < total; it += nb) {
        int i = it;
        if (i < I_MOD) { gemv_item<4, true>(p.c, p.w_mod, 6144, p.b_mod, p.mod(), 6144, 1024, i * 64, sm); continue; }
        i -= I_MOD;
        if (i < I_B1) { int kv = i >> 2; gemv_item<1, false>(kv ? p.pos_v : p.pos_k, kv ? p.w1_v : p.w1_k, 256, nullptr, p.bias1() + kv * 256, 256, 2048, (i & 3) * 64, sm); continue; }
        i -= I_B1;
        if (i < I_WIN) { transpose_item<true>(p.w_in, IN_COLS, 1024, p.wint(), (i % 16) * 64, (i / 16) * 64, sm); continue; }
        i -= I_WIN;
        if (i < I_WO) { transpose_item<false>(p.w_o, 1024, 1024, p.wot(), (i % 16) * 64, (i / 16) * 64, sm); continue; }
        i -= I_WO;
        if (i < I_WR) { transpose_item<false>(p.w_router, 256, 1024, p.wrt(), (i % 16) * 64, (i / 16) * 64, sm); continue; }
        i -= I_WR;
        if (i < I_W1) { int kv = i >> 7; int j = i & 127; transpose_item<false>(kv ? p.w1_v : p.w1_k, 256, 2048, p.w1t() + (size_t)kv * 256 * 2048, (j % 32) * 64, (j / 32) * 64, sm); continue; }
        i -= I_W1;
        { int kv = i >> 2; int j = i & 3; transpose_item<false>(kv ? p.w2_v : p.w2_k, 64, 256, p.w2t() + (size_t)kv * 64 * 256, j * 64, 0, sm); }
    }
}

__device__ __forceinline__ float wave_sum(float v) {
#pragma unroll
    for (int m = 32; m > 0; m >>= 1) v += __shfl_xor(v, m);
    return v;
}
__device__ void phase1(const Params& p) {
    const int lane = opaque_tid() & 63, gw = blockIdx.x * 4 + (opaque_tid() >> 6), nw = gridDim.x * 4;
    for (int row0 = gw * 2; row0 < NTOK; row0 += nw * 2) {
        f32x4 v[2][4]; float s[2];
#pragma unroll
        for (int r = 0; r < 2; ++r) {
            const float* xr = p.x + (size_t)(row0 + r) * D_MODEL;
            s[r] = 0.f;
#pragma unroll
            for (int i = 0; i < 4; ++i) v[r][i] = *(const f32x4*)(xr + i * 256 + lane * 4);
        }
        const int b = row0 / SEQ;
        const float* md = p.mod() + b * 6144;
#pragma unroll
        for (int r = 0; r < 2; ++r) {
#pragma unroll
            for (int i = 0; i < 4; ++i) s[r] += (v[r][i][0] + v[r][i][1]) + (v[r][i][2] + v[r][i][3]);
            const float mu = wave_sum(s[r]) * (1.f / D_MODEL);
            float q = 0.f;
#pragma unroll
            for (int i = 0; i < 4; ++i)
#pragma unroll
                for (int j = 0; j < 4; ++j) { float d = v[r][i][j] - mu; q += d * d; }
            const float rstd = rsqrtf(wave_sum(q) * (1.f / D_MODEL) + 1e-5f);
#pragma unroll
            for (int i = 0; i < 4; ++i) {
                const int col = i * 256 + lane * 4;
                f32x4 sh = *(const f32x4*)(md + 0 + col), sc = *(const f32x4*)(md + 1024 + col);
                float o[4];
#pragma unroll
                for (int j = 0; j < 4; ++j) o[j] = (v[r][i][j] - mu) * rstd * (1.f + sc[j]) + sh[j];
                u32x2 w; w.x = pk_bf16(o[0], o[1]); w.y = pk_bf16(o[2], o[3]);
                *(u32x2*)(p.hb() + (size_t)(row0 + r) * D_MODEL + col) = w;
            }
        }
    }
}

__device__ void phase2(const Params& p, char* smem) {
    const int xcd = xcd_of(smem), rank = rank_of(smem), nranks = nranks_of(smem);
    const int lane = opaque_tid() & 63, wid = opaque_tid() >> 6, wr = wid >> 1, wc = wid & 1, fr = lane & 15, fq = lane >> 4;
#ifndef P2_REP
#define P2_REP 1
#endif
    for (int it0 = rank; it0 < 16 * 23 * P2_REP; it0 += nranks) {
        const int it = it0 % (16 * 23);
        const int mt = (it / 23) * 8 + xcd, nt = it % 23;
        const int row0 = mt * 128, col0 = nt * 128;
        RowsBf16 al{p.hb() + (size_t)row0 * D_MODEL, D_MODEL};
        RowsBf16 bl{p.wint() + (size_t)col0 * D_MODEL, D_MODEL};
        f32x4 acc[4][4];
        const bool transposed = (nt == 7) || (nt == 9) || (nt >= 14 && nt < 18);
        if (transposed) {
            gemm_128<false, false>(al, bl, 0, 16, smem, acc);
            const int b = row0 / SEQ, t0 = row0 % SEQ;
            bf16_t* base; int rows_per;
            if (nt == 7) base = p.VsT() + (size_t)b * 128 * SEQ;
            else if (nt == 9) base = p.VwT() + (size_t)b * 128 * SEQ;
            else base = p.VgT() + ((size_t)b * 4 + (nt - 14)) * 128 * SEQ;
            (void)rows_per;
#pragma unroll
            for (int m = 0; m < 4; ++m)
#pragma unroll
                for (int n = 0; n < 4; ++n) {
                    const int feat = wc * 64 + n * 16 + fr, tok = t0 + wr * 64 + m * 16 + fq * 4;
                    u32x2 w; w.x = pk_bf16(acc[m][n][0], acc[m][n][1]); w.y = pk_bf16(acc[m][n][2], acc[m][n][3]);
                    *(u32x2*)(base + (size_t)feat * SEQ + tok) = w;
                }
        } else {
            gemm_128<true, false>(al, bl, 0, 16, smem, acc);
            if (nt == 22) {
                if (wc == 0) {
#pragma unroll
                    for (int m = 0; m < 4; ++m)
#pragma unroll
                        for (int n = 0; n < 4; ++n) {
                            const int tok = row0 + wr * 64 + m * 16 + fr, feat = n * 16 + fq * 4;
                            *(f32x4*)(p.misc() + (size_t)tok * 64 + feat) = acc[m][n];
                        }
                }
            } else {
#pragma unroll
                for (int m = 0; m < 4; ++m)
#pragma unroll
                    for (int n = 0; n < 4; ++n) {
                        const int tok = row0 + wr * 64 + m * 16 + fr, feat = col0 + wc * 64 + n * 16 + fq * 4;
                        u32x2 w; w.x = pk_bf16(acc[m][n][0], acc[m][n][1]); w.y = pk_bf16(acc[m][n][2], acc[m][n][3]);
                        *(u32x2*)(p.Pb() + (size_t)tok * PCOLS + feat) = w;
                    }
            }
        }
    }
}
struct CmpALoad {
    static constexpr bool NT = false;
    const bf16_t* Pb; int colbase; int row0;
    __device__ __forceinline__ const bf16_t* ptr(int r, int k) const {
        const int rr = row0 + r, bg = rr >> 8, i = rr & 255, b = bg >> 1, g = bg & 1;
        const int l = k >> 6, d = k & 63;
        int tok = 16 * i + l; tok = tok < SEQ ? tok : SEQ - 1;
        return Pb + ((size_t)b * SEQ + tok) * PCOLS + colbase + g * 64 + d;
    }
    __device__ __forceinline__ const bf16_t* pp(int i, int tid, int k) const { return ptr(i * 32 + (tid >> 3), k); }
};

__device__ __forceinline__ float log_sigmoid_f(float x) { return -(fmaxf(-x, 0.f) + __logf(1.f + __expf(-fabsf(x)))); }

__device__ __forceinline__ void gla_cumsum(const Params& p, int tokg0, int h, float* sb, float* sglr, float* swa, float* sqt) {
    const int tid = opaque_tid();
    for (int i = tid; i < 1024; i += 256) { int t = i >> 4, r = i & 15; sglr[i] = p.misc()[(size_t)(tokg0 + t) * 64 + 24 + r]; }
    for (int i = tid; i < 1024; i += 256) { int r = i >> 6, d = i & 63; swa[i] = p.w_a2[r * 256 + h * 64 + d]; }
    __syncthreads();
    const int d = tid & 63, tq = tid >> 6;
    const float ba = p.b_a2[h * 64 + d];
    float w[16];
#pragma unroll
    for (int r = 0; r < 16; ++r) w[r] = swa[r * 64 + d];
    float run = 0.f;
#pragma unroll
    for (int tt = 0; tt < 16; ++tt) {
        const int t = tq * 16 + tt;
        float x = ba;
#pragma unroll
        for (int r = 0; r < 16; ++r) x += sglr[t * 16 + r] * w[r];
        run += log_sigmoid_f(x) * (1.f / 16.f);
        sb[t * 64 + d] = run;
    }
    sqt[tq * 64 + d] = run;
    __syncthreads();
    float off = 0.f;
#pragma unroll
    for (int q = 0; q < 3; ++q) if (q < tq) off += sqt[q * 64 + d];
#pragma unroll
    for (int tt = 0; tt < 16; ++tt) sb[(tq * 16 + tt) * 64 + d] += off;
    __syncthreads();
}

__device__ void gla_a_item(const Params& p, int item, char* smem) {
    const int tid = opaque_tid(), lane = tid & 63, wid = tid >> 6, fr = lane & 15, fq = lane >> 4;
    const int bh = item >> 6, c = item & 63, b = bh >> 2, h = bh & 3;
    const int tok0 = c * 64, tokg0 = b * SEQ + tok0;
    float* sb = (float*)smem; float* sglr = (float*)(smem + 16384); float* swa = (float*)(smem + 20480); float* sqt = (float*)(smem + 24576);
    char* skbT = smem + 25600; char* sVT = smem + 34816;
    gla_cumsum(p, tokg0, h, sb, sglr, swa, sqt);
    {
        float* bs = (float*)(p.ws + OFF_bsave) + (size_t)item * 4096;
#pragma unroll
        for (int i = 0; i < 4; ++i) *(f32x4*)(bs + (tid + 256 * i) * 4) = *(const f32x4*)(sb + (tid + 256 * i) * 4);
    }
    {
        const int d = tid & 63, tq = tid >> 6;
        const float bl = sb[63 * 64 + d];
        float v[16];
#pragma unroll
        for (int tt = 0; tt < 16; ++tt) {
            const int s = tq * 16 + tt;
            float k = bf2f(p.Pb()[(size_t)(tokg0 + s) * PCOLS + P_GK + h * 64 + d]);
            v[tt] = k * __expf(bl - sb[s * 64 + d]);
        }
        u32x4 w0, w1;
        w0.x = pk_bf16(v[0], v[1]); w0.y = pk_bf16(v[2], v[3]); w0.z = pk_bf16(v[4], v[5]); w0.w = pk_bf16(v[6], v[7]);
        w1.x = pk_bf16(v[8], v[9]); w1.y = pk_bf16(v[10], v[11]); w1.z = pk_bf16(v[12], v[13]); w1.w = pk_bf16(v[14], v[15]);
        *(u32x4*)(skbT + (d * LDS_ROW + tq * 16) * 2) = w0;
        *(u32x4*)(skbT + (d * LDS_ROW + tq * 16 + 8) * 2) = w1;
        if (tid < 64) p.dec()[(size_t)item * 64 + d] = __expf(bl);
    }
#pragma unroll
    for (int i = 0; i < 4; ++i) {
        const int cidx = tid + 256 * i, e = cidx >> 3, ch = (cidx & 7) * 8;
        *(u32x4*)(sVT + (e * LDS_ROW + ch) * 2) = *(const u32x4*)(p.VgT() + ((size_t)bh * 128 + e) * SEQ + tok0 + ch);
    }
    __syncthreads();
    f32x4 acc[2][4];
#pragma unroll
    for (int m = 0; m < 2; ++m)
#pragma unroll
        for (int n = 0; n < 4; ++n) acc[m][n] = (f32x4){0.f, 0.f, 0.f, 0.f};
#pragma unroll
    for (int ks = 0; ks < 2; ++ks) {
        bf16x8 a[2], bb[4];
#pragma unroll
        for (int m = 0; m < 2; ++m) a[m] = *(const bf16x8*)(sVT + (((wid * 2 + m) * 16 + fr) * LDS_ROW + ks * 32 + fq * 8) * 2);
#pragma unroll
        for (int n = 0; n < 4; ++n) bb[n] = *(const bf16x8*)(skbT + ((n * 16 + fr) * LDS_ROW + ks * 32 + fq * 8) * 2);
#pragma unroll
        for (int m = 0; m < 2; ++m)
#pragma unroll
            for (int n = 0; n < 4; ++n) acc[m][n] = __builtin_amdgcn_mfma_f32_16x16x32_bf16(a[m], bb[n], acc[m][n], 0, 0, 0);
    }
    float* dst = p.dST() + (size_t)item * 8192;
#pragma unroll
    for (int m = 0; m < 2; ++m)
#pragma unroll
        for (int n = 0; n < 4; ++n)
#pragma unroll
            for (int j = 0; j < 4; ++j) dst[((wid * 2 + m) * 16 + fq * 4 + j) * 64 + n * 16 + fr] = acc[m][n][j];
    __syncthreads();
}

__device__ void phase3(const Params& p, char* smem) {
    const int lane = opaque_tid() & 63, wid = opaque_tid() >> 6, wr = wid >> 1, wc = wid & 1, fr = lane & 15, fq = lane >> 4;
    for (int it = blockIdx.x; it < 256; it += gridDim.x) {
        const int kv = it >> 7, mt = (it >> 3) & 15, nt = (it >> 2) & 1, ks = it & 3;
        CmpALoad al{p.Pb(), kv ? P_VC : P_KC, mt * 128};
        RowsBf16 bl{p.w1t() + ((size_t)kv * 256 + nt * 128) * 2048, 2048};
        f32x4 acc[4][4];
        gemm_128<true, 0>(al, bl, ks * 512, 8, smem, acc);
        float* dst = p.cpart() + ((size_t)(kv * 4 + ks) * 2048 + mt * 128) * 256 + nt * 128;
#pragma unroll
        for (int m = 0; m < 4; ++m)
#pragma unroll
            for (int n = 0; n < 4; ++n)
                *(f32x4*)(dst + (size_t)(wr * 64 + m * 16 + fr) * 256 + wc * 64 + n * 16 + fq * 4) = acc[m][n];
    }
    const int first = (blockIdx.x + gridDim.x - (256 % gridDim.x)) % gridDim.x;
    for (int it = first; it < 1024; it += gridDim.x) gla_a_item(p, it, smem);
}

#define C2_ROW 264
__device__ void cmp2_item(const Params& p, int item, char* smem) {
    const int tid = opaque_tid(), lane = tid & 63, wid = tid >> 6, fr = lane & 15, fq = lane >> 4;
    const int kv = item >> 5, r0 = (item & 31) * 64;
    char* sA = smem; char* sB = smem + 64 * C2_ROW * 2;
    const float* b1 = p.bias1() + kv * 256;
#pragma unroll 2
    for (int i = 0; i < 8; ++i) {
        const int cidx = tid + 256 * i, row = cidx >> 5, col = (cidx & 31) * 8;
        f32x4 s0 = *(const f32x4*)(b1 + col), s1 = *(const f32x4*)(b1 + col + 4);
#pragma unroll
        for (int ks = 0; ks < 4; ++ks) {
            const float* src = p.cpart() + ((size_t)(kv * 4 + ks) * 2048 + r0 + row) * 256 + col;
            s0 += *(const f32x4*)src; s1 += *(const f32x4*)(src + 4);
        }
        float o[8];
#pragma unroll
        for (int j = 0; j < 4; ++j) { o[j] = s0[j] / (1.f + __expf(-s0[j])); o[4 + j] = s1[j] / (1.f + __expf(-s1[j])); }
        u32x4 w; w.x = pk_bf16(o[0], o[1]); w.y = pk_bf16(o[2], o[3]); w.z = pk_bf16(o[4], o[5]); w.w = pk_bf16(o[6], o[7]);
        *(u32x4*)(sA + (row * C2_ROW + col) * 2) = w;
        *(u32x4*)(sB + (row * C2_ROW + col) * 2) = *(const u32x4*)(p.w2t() + ((size_t)kv * 64 + row) * 256 + col);
    }
    __syncthreads();
    f32x4 acc[4];
#pragma unroll
    for (int n = 0; n < 4; ++n) acc[n] = (f32x4){0.f, 0.f, 0.f, 0.f};
#pragma unroll
    for (int ks = 0; ks < 8; ++ks) {
        bf16x8 a = *(const bf16x8*)(sA + ((wid * 16 + fr) * C2_ROW + ks * 32 + fq * 8) * 2);
#pragma unroll
        for (int n = 0; n < 4; ++n) {
            bf16x8 bb = *(const bf16x8*)(sB + ((n * 16 + fr) * C2_ROW + ks * 32 + fq * 8) * 2);
            acc[n] = kv ? __builtin_amdgcn_mfma_f32_16x16x32_bf16(a, bb, acc[n], 0, 0, 0)
                        : __builtin_amdgcn_mfma_f32_16x16x32_bf16(bb, a, acc[n], 0, 0, 0);
        }
    }
    if (kv == 0) {
#pragma unroll
        for (int n = 0; n < 4; ++n) {
            u32x2 w; w.x = pk_bf16(acc[n][0], acc[n][1]); w.y = pk_bf16(acc[n][2], acc[n][3]);
            *(u32x2*)(p.kc() + (size_t)(r0 + wid * 16 + fr) * 64 + n * 16 + fq * 4) = w;
        }
    } else {
        const int r = r0 + wid * 16 + fq * 4, bg = r >> 8, i = r & 255;
#pragma unroll
        for (int n = 0; n < 4; ++n) {
            u32x2 w; w.x = pk_bf16(acc[n][0], acc[n][1]); w.y = pk_bf16(acc[n][2], acc[n][3]);
            *(u32x2*)(p.vcT() + ((size_t)bg * 64 + n * 16 + fr) * 256 + i) = w;
        }
    }
    __syncthreads();
}

__device__ void phase4(const Params& p, char* smem) {
    for (int it = blockIdx.x; it < 64; it += gridDim.x) cmp2_item(p, it, smem);
    const int nthreads = gridDim.x * 256;
    for (int idx = blockIdx.x * 256 + opaque_tid(); idx < 16 * 8192; idx += nthreads) {
        const int bh = idx >> 13, ed = idx & 8191, d = idx & 63;
        float S = 0.f;
        for (int c0 = 0; c0 < 64; c0 += 8) {
            float dv[8], dc[8];
#pragma unroll
            for (int u = 0; u < 8; ++u) {
                dv[u] = p.dST()[((size_t)(bh * 64 + c0 + u) << 13) + ed];
                dc[u] = p.dec()[(size_t)(bh * 64 + c0 + u) * 64 + d];
            }
#pragma unroll
            for (int u = 0; u < 8; ++u) {
                p.ST()[((size_t)(bh * 64 + c0 + u) << 13) + ed] = f2bf(S);
                S = dc[u] * S + dv[u];
            }
        }
    }
}
#define KT_BYTES (64 * LDS_ROW * 2)
#define C1_SCALE (0.125f * LOG2E)

#define MASK_BIAS (-2e30f)
__device__ __forceinline__ bf16x8 scale_frag(bf16x8 v, float c) {
    u32x4 u = __builtin_bit_cast(u32x4, v); u32x4 r;
    r.x = pk_bf16(bflo(u.x) * c, bfhi(u.x) * c); r.y = pk_bf16(bflo(u.y) * c, bfhi(u.y) * c);
    r.z = pk_bf16(bflo(u.z) * c, bfhi(u.z) * c); r.w = pk_bf16(bflo(u.w) * c, bfhi(u.w) * c);
    return __builtin_bit_cast(bf16x8, r);
}
__device__ __forceinline__ float max3f(float a, float b, float c) { return fmaxf(fmaxf(a, b), c); }
__device__ __forceinline__ float rowmax4(float x) {
    auto r = __builtin_amdgcn_permlane32_swap(__float_as_uint(x), __float_as_uint(x), false, false);
    float y = fmaxf(__uint_as_float(r[0]), __uint_as_float(r[1]));
    auto q = __builtin_amdgcn_permlane16_swap(__float_as_uint(y), __float_as_uint(y), false, false);
    return fmaxf(__uint_as_float(q[0]), __uint_as_float(q[1]));
}
template <bool PV>
__device__ __forceinline__ void flash_tile(const char* sK0, const char* sVT0, const bf16x8 (&qf)[2][2], float (&m)[2], f32x4 (&l)[2], f32x4 (&o)[2][4],
                                           float dl0, float dstride, float wlim, bool lanevalid, bool needmask, const float (&slope2)[2], int fr, int fq, bool lazy, bf16x8 ones) {
#pragma unroll 1
    for (int half = 0; half < 2; ++half) {
        const char* sK = sK0 + half * 32 * LDS_ROW * 2;
        const char* sVT = sVT0 + half * 32 * 2;
        const float dl = dl0 + dstride * (float)(half * 32);
        bf16x8 kf[2][2], vf[4];
#pragma unroll
        for (int mk = 0; mk < 2; ++mk)
#pragma unroll
            for (int ks = 0; ks < 2; ++ks) kf[mk][ks] = *(const bf16x8*)(sK + ((mk * 16 + fr) * LDS_ROW + ks * 32 + fq * 8) * 2);
        if (PV) {
#pragma unroll
            for (int md = 0; md < 4; ++md) {
                u32x2 lo = *(const u32x2*)(sVT + ((md * 16 + fr) * LDS_ROW + fq * 4) * 2);
                u32x2 hi = *(const u32x2*)(sVT + ((md * 16 + fr) * LDS_ROW + 16 + fq * 4) * 2);
                u32x4 w; w.x = lo.x; w.y = lo.y; w.z = hi.x; w.w = hi.y;
                vf[md] = __builtin_bit_cast(bf16x8, w);
            }
        }
        f32x4 s[2][2];
#pragma unroll
        for (int p = 0; p < 2; ++p) {
            const float mref = lazy ? m[p] : 0.f;
            if (needmask) {
#pragma unroll
                for (int mk = 0; mk < 2; ++mk)
#pragma unroll
                    for (int j = 0; j < 4; ++j) {
                        const float dk = dl + dstride * (float)(mk * 16 + j);
                        const bool ok = lanevalid && (dk <= 0.f) && (dk > wlim);
                        s[p][mk][j] = ok ? (slope2[p] * dk - mref) : MASK_BIAS;
                    }
            } else {
                const float sb = lanevalid ? (slope2[p] * dl - mref) : MASK_BIAS, sd = lanevalid ? slope2[p] * dstride : 0.f;
#pragma unroll
                for (int mk = 0; mk < 2; ++mk)
#pragma unroll
                    for (int j = 0; j < 4; ++j) s[p][mk][j] = sb + sd * (float)(mk * 16 + j);
            }
        }
#pragma unroll
        for (int ks = 0; ks < 2; ++ks)
#pragma unroll
            for (int p = 0; p < 2; ++p)
#pragma unroll
                for (int mk = 0; mk < 2; ++mk) s[p][mk] = __builtin_amdgcn_mfma_f32_16x16x32_bf16(kf[mk][ks], qf[p][ks], s[p][mk], 0, 0, 0);
        float mx[2];
#pragma unroll
        for (int p = 0; p < 2; ++p)
            mx[p] = max3f(max3f(max3f(s[p][0][0], s[p][0][1], s[p][0][2]), s[p][0][3], s[p][1][0]), max3f(s[p][1][1], s[p][1][2], s[p][1][3]), MASK_BIAS);
        if (!lazy) {
            float mn[2];
#pragma unroll
            for (int p = 0; p < 2; ++p) mn[p] = fmaxf(m[p], rowmax4(mx[p]));
            if (__any((mn[0] > m[0]) || (mn[1] > m[1]))) {
#pragma unroll
                for (int p = 0; p < 2; ++p) {
                    const float alpha = __builtin_amdgcn_exp2f(m[p] - mn[p]);
                    l[p] *= alpha;
                    if (PV) {
#pragma unroll
                        for (int md = 0; md < 4; ++md) o[p][md] *= alpha;
                    }
                    m[p] = mn[p];
                }
            }
#pragma unroll
            for (int p = 0; p < 2; ++p)
#pragma unroll
                for (int mk = 0; mk < 2; ++mk)
#pragma unroll
                    for (int j = 0; j < 4; ++j) s[p][mk][j] -= m[p];
        }
        bf16x8 pf[2];
#pragma unroll
        for (int p = 0; p < 2; ++p) {
#pragma unroll
            for (int mk = 0; mk < 2; ++mk)
#pragma unroll
                for (int j = 0; j < 4; ++j) s[p][mk][j] = __builtin_amdgcn_exp2f(s[p][mk][j]);
            u32x4 w;
            w.x = pk_bf16(s[p][0][0], s[p][0][1]); w.y = pk_bf16(s[p][0][2], s[p][0][3]);
            w.z = pk_bf16(s[p][1][0], s[p][1][1]); w.w = pk_bf16(s[p][1][2], s[p][1][3]);
            pf[p] = __builtin_bit_cast(bf16x8, w);
        }
#pragma unroll
        for (int p = 0; p < 2; ++p) l[p] = __builtin_amdgcn_mfma_f32_16x16x32_bf16(ones, pf[p], l[p], 0, 0, 0);
        if (PV) {
#pragma unroll
            for (int md = 0; md < 4; ++md)
#pragma unroll
                for (int p = 0; p < 2; ++p) o[p][md] = __builtin_amdgcn_mfma_f32_16x16x32_bf16(vf[md], pf[p], o[p][md], 0, 0, 0);
        }
        if (lazy) {
            float up[2];
#pragma unroll
            for (int p = 0; p < 2; ++p) up[p] = fmaxf(rowmax4(mx[p]), 0.f);
            if (__any((up[0] > 0.f) || (up[1] > 0.f))) {
#pragma unroll
                for (int p = 0; p < 2; ++p) {
                    const float alpha = __builtin_amdgcn_exp2f(-up[p]);
                    l[p] *= alpha;
                    if (PV) {
#pragma unroll
                        for (int md = 0; md < 4; ++md) o[p][md] *= alpha;
                    }
                    m[p] += up[p];
                }
            }
        }
    }
}
__device__ __forceinline__ float l_total(const f32x4& l, int fr) { return __shfl(l[0], fr); }

__device__ __forceinline__ void imp_tile(const char* sK, const bf16x8 (&qf)[2][2], const float (&m)[2], const float (&linv)[2],
                                         float dl, const float (&slope2)[2], int ct, float* simp, int fr, int fq) {
    bf16x8 kf[4][2];
#pragma unroll
    for (int mk = 0; mk < 4; ++mk)
#pragma unroll
        for (int ks = 0; ks < 2; ++ks) kf[mk][ks] = *(const bf16x8*)(sK + ((mk * 16 + fr) * LDS_ROW + ks * 32 + fq * 8) * 2);
    f32x4 hs[4];
#pragma unroll
    for (int mk = 0; mk < 4; ++mk) hs[mk] = (f32x4){0.f, 0.f, 0.f, 0.f};
#pragma unroll
    for (int p = 0; p < 2; ++p) {
#pragma unroll
        for (int mk = 0; mk < 4; ++mk) {
            f32x4 s;
#pragma unroll
            for (int j = 0; j < 4; ++j) { const float dk = dl + 16.f * (float)(mk * 16 + j); s[j] = (dk <= 0.f) ? slope2[p] * dk : MASK_BIAS; }
#pragma unroll
            for (int ks = 0; ks < 2; ++ks) s = __builtin_amdgcn_mfma_f32_16x16x32_bf16(kf[mk][ks], qf[p][ks], s, 0, 0, 0);
#pragma unroll
            for (int j = 0; j < 4; ++j) hs[mk][j] += __builtin_amdgcn_exp2f(s[j] - m[p]) * linv[p];
        }
    }
#pragma unroll
    for (int mk = 0; mk < 4; ++mk) {
        const int jb = ct * 16 + mk * 4 + fq;
        const float a = hs[mk][0] + hs[mk][1] + hs[mk][2] + 0.5f * hs[mk][3];
        const float bnext = 0.5f * hs[mk][3];
        simp[fr * 64 + jb] += a;
        __builtin_amdgcn_wave_barrier();
        if (jb + 1 < 64) simp[fr * 64 + jb + 1] += bnext;
        __builtin_amdgcn_wave_barrier();
    }
}

struct TileSrc { const bf16_t* k; const bf16_t* v; };
struct TileOff { int k[2], v[2]; };
__device__ __forceinline__ TileOff tile_offsets(int kst, int vst, int tid) {
    TileOff to;
#pragma unroll
    for (int i = 0; i < 2; ++i) { const int c = tid + 256 * i, row = c >> 3, ch = (c & 7) * 8; to.k[i] = row * kst + ch; to.v[i] = row * vst + ch; }
    return to;
}
__device__ __forceinline__ void tile_gload(const TileSrc& ts, const TileOff& to, u32x4 (&rk)[2], u32x4 (&rv)[2]) {
#pragma unroll
    for (int i = 0; i < 2; ++i) {
        rk[i] = *(const u32x4*)(ts.k + to.k[i]);
        rv[i] = *(const u32x4*)(ts.v + to.v[i]);
    }
}
__device__ __forceinline__ void tile_swrite(char* smem, int buf, const u32x4 (&rk)[2], const u32x4 (&rv)[2], int tid) {
    char* sK = smem + buf * 2 * KT_BYTES; char* sV = sK + KT_BYTES;
#pragma unroll
    for (int i = 0; i < 2; ++i) {
        const int c = tid + 256 * i, row = c >> 3, ch = (c & 7) * 8;
        *(u32x4*)(sK + (row * LDS_ROW + ch) * 2) = rk[i];
        *(u32x4*)(sV + (row * LDS_ROW + ch) * 2) = rv[i];
    }
}

__device__ void nsa_cmp_item(const Params& p, int qrev, int bg, char* smem) {
    const int tid = opaque_tid(), lane = tid & 63, wid = tid >> 6, fr = lane & 15, fq = lane >> 4;
    const int qb = 63 - qrev, b = bg >> 1, g = bg & 1;
    const int q0 = qb * 64, t = q0 + wid * 16 + fr;
    const size_t tokg = (size_t)b * SEQ + t;
    float* simp = (float*)(smem + 4 * KT_BYTES) + wid * 1024;
    auto wsb = [&]() __attribute__((always_inline)) { char* w = p.ws; asm volatile("" : "+s"(w)); return w; };
    const unsigned onew = (fr == 0) ? 0x3f803f80u : 0u;
    const bf16x8 ones = __builtin_bit_cast(bf16x8, (u32x4){onew, onew, onew, onew});
    const int ncb = (4 * qb + 3) < NCMP ? (4 * qb + 3) : NCMP;
    const int nct = (ncb + 63) >> 6;
    for (int i = tid; i < 4096; i += 256) ((float*)(smem + 4 * KT_BYTES))[i] = 0.f;
    __syncthreads();
#pragma unroll 1
    for (int hp = 0; hp < 2; ++hp) {
        const int h0 = g * 4 + hp * 2;
        bf16x8 qf[2][2]; float slope2[2];
#pragma unroll
        for (int pp = 0; pp < 2; ++pp) {
            slope2[pp] = exp2f(-(float)(h0 + pp + 1)) * LOG2E;
#pragma unroll
            for (int ks = 0; ks < 2; ++ks)
                qf[pp][ks] = scale_frag(*(const bf16x8*)((const bf16_t*)(wsb() + OFF_Pb) + tokg * PCOLS + P_NQ + (h0 + pp) * 64 + ks * 32 + fq * 8), C1_SCALE);
        }
        float m[2], linv[2]; f32x4 l[2]; f32x4 o[2][4];
#pragma unroll
        for (int pp = 0; pp < 2; ++pp) {
            m[pp] = NEGF; l[pp] = (f32x4){0.f, 0.f, 0.f, 0.f}; linv[pp] = 0.f;
#pragma unroll
            for (int md = 0; md < 4; ++md) o[pp][md] = (f32x4){0.f, 0.f, 0.f, 0.f};
        }
        u32x4 rk[2], rv[2];
        const int n = 2 * nct;
        auto src = [&](int step) __attribute__((always_inline)) {
            const int idx = step < nct ? (nct - 1 - step) : step - nct;
            char* wb = wsb();
            TileSrc ts; ts.k = (const bf16_t*)(wb + OFF_kc) + ((size_t)bg * 256 + idx * 64) * 64;
            ts.v = (const bf16_t*)(wb + OFF_vcT) + (size_t)bg * 64 * 256 + idx * 64;
            return ts;
        };
        const TileOff toff = tile_offsets(64, 256, tid);
        tile_gload(src(0), toff, rk, rv); tile_swrite(smem, 0, rk, rv, tid); __syncthreads();
#pragma unroll 1
        for (int i = 0; i < n; ++i) {
            if (i + 1 < n) tile_gload(src(i + 1), toff, rk, rv);
            __builtin_amdgcn_sched_barrier(0);
            const int idx = i < nct ? (nct - 1 - i) : i - nct;
            const char* sK = smem + (i & 1) * 2 * KT_BYTES; const char* sV = sK + KT_BYTES;
            const float dlc = (float)(16 * (idx * 64 + fq * 4) + 31 - t);
            if (i < nct) {
                const bool cmask = (16 * (idx * 64 + 63) + 31) > q0;
                flash_tile<true>(sK, sV, qf, m, l, o, dlc, 16.f, -1e9f, true, cmask, slope2, fr, fq, i >= 2, ones);
            } else {
                if (i == nct) {
                    size_t tokg_o = tokg; asm volatile("" : "+v"(tokg_o));
                    char* wb = wsb();
#pragma unroll
                    for (int pp = 0; pp < 2; ++pp) {
                        const float inv = 1.f / fmaxf(l_total(l[pp], fr), 1e-30f);
                        linv[pp] = inv;
                        const int h = h0 + pp;
                        const float gl = ((const float*)(wb + OFF_misc))[tokg_o * 64 + h * 3 + 0];
                        const float sc = inv / (1.f + __expf(-gl));
#pragma unroll
                        for (int md = 0; md < 4; ++md) *(f32x4*)((float*)(wb + OFF_mixf) + tokg_o * 512 + h * 64 + md * 16 + fq * 4) = o[pp][md] * sc;
                    }
                }
                imp_tile(sK, qf, m, linv, dlc, slope2, idx, simp, fr, fq);
            }
            __builtin_amdgcn_sched_barrier(0);
            if (i + 1 < n) tile_swrite(smem, (i + 1) & 1, rk, rv, tid);
            __syncthreads();
        }
    }
    {
        const int j = lane;
        const bool forced = (j == 0) || (j == qb) || (j == qb - 1);
        unsigned long long mine = 0ull, wave_union = 0ull;
#pragma unroll 1
        for (int qi = 0; qi < 16; ++qi) {
            const float sc = (j <= qb) ? (simp[qi * 64 + j] + (forced ? 1e4f : 0.f)) : NEGF;
            int rank = 0;
#pragma unroll 4
            for (int j2 = 0; j2 < 64; ++j2) {
                const float s2 = __builtin_bit_cast(float, __builtin_amdgcn_readlane(__builtin_bit_cast(int, sc), j2));
                rank += ((s2 > sc) || (s2 == sc && j2 < j)) ? 1 : 0;
            }
            const unsigned long long msk = __ballot(rank < 16);
            wave_union |= msk;
            if (fr == qi) mine = msk;
        }
        const unsigned long long causal = (qb >= 63) ? ~0ull : ((1ull << (qb + 1)) - 1ull);
        unsigned long long* selm = (unsigned long long*)(wsb() + OFF_selm);
        if (fq == 0) selm[(size_t)g * NTOK + tokg] = mine & causal;
        if (lane == 0) ((unsigned long long*)(wsb() + OFF_selu))[((size_t)bg * 64 + qb) * 4 + wid] = wave_union & causal;
    }
    __syncthreads();
}

__device__ void nsa_sw_item(const Params& p, int qrev, int bg, int hp, char* smem, int mode) {
    const int tid = opaque_tid(), lane = tid & 63, wid = tid >> 6, fr = lane & 15, fq = lane >> 4;
    const int qb = 63 - qrev, b = bg >> 1, g = bg & 1;
    const int q0 = qb * 64, t = q0 + wid * 16 + fr;
    const size_t tokg = (size_t)b * SEQ + t;
    int* slist = (int*)(smem + 4 * KT_BYTES);
    const int h0 = g * 4 + hp * 2;
    auto wsb = [&]() __attribute__((always_inline)) { char* w = p.ws; asm volatile("" : "+s"(w)); return w; };
    bf16x8 qf[2][2]; float slope2[2];
#pragma unroll
    for (int pp = 0; pp < 2; ++pp) {
        slope2[pp] = exp2f(-(float)(h0 + pp + 1)) * LOG2E;
#pragma unroll
        for (int ks = 0; ks < 2; ++ks)
            qf[pp][ks] = scale_frag(*(const bf16x8*)((const bf16_t*)(wsb() + OFF_Pb) + tokg * PCOLS + P_NQ + (h0 + pp) * 64 + ks * 32 + fq * 8), C1_SCALE);
    }
    const unsigned long long mymask = ((const unsigned long long*)(wsb() + OFF_selm))[(size_t)g * NTOK + tokg];
    const unsigned long long* su = (const unsigned long long*)(wsb() + OFF_selu) + ((size_t)bg * 64 + qb) * 4;
    const unsigned long long wave_union = su[wid];
    const unsigned long long un = su[0] | su[1] | su[2] | su[3];
    const int wlo = (qb - 8) > 0 ? (qb - 8) : 0;
    const int nsl = __popcll(un);
    const int n = nsl + (qb - wlo + 1);
    if (tid < 64 && ((un >> tid) & 1ull)) slist[nsl - 1 - __popcll(un & ((1ull << tid) - 1ull))] = tid;
    if (tid >= 64 && tid < 64 + (qb - wlo + 1)) slist[nsl + (tid - 64)] = 256 + (qb - (tid - 64));
    __syncthreads();
    const unsigned onew = (fr == 0) ? 0x3f803f80u : 0u;
    const bf16x8 ones = __builtin_bit_cast(bf16x8, (u32x4){onew, onew, onew, onew});
    float m[2]; f32x4 l[2]; f32x4 o[2][4];
#pragma unroll
    for (int pp = 0; pp < 2; ++pp) {
        m[pp] = NEGF; l[pp] = (f32x4){0.f, 0.f, 0.f, 0.f};
#pragma unroll
        for (int md = 0; md < 4; ++md) o[pp][md] = (f32x4){0.f, 0.f, 0.f, 0.f};
    }
    auto finish_branch = [&](int br) __attribute__((always_inline)) {
        size_t tokg_o = tokg; asm volatile("" : "+v"(tokg_o));
        char* wb = wsb();
#pragma unroll
        for (int pp = 0; pp < 2; ++pp) {
            const float inv = 1.f / fmaxf(l_total(l[pp], fr), 1e-30f);
            const int h = h0 + pp;
            const float gl = ((const float*)(wb + OFF_misc))[tokg_o * 64 + h * 3 + br];
            const float sc = inv / (1.f + __expf(-gl));
#pragma unroll
            for (int md = 0; md < 4; ++md) {
                const size_t eo = tokg_o * 512 + h * 64 + md * 16 + fq * 4;
                f32x4 v = o[pp][md] * sc;
                if (mode != 0) { asm volatile("" :: "v"(v[0]), "v"(v[1]), "v"(v[2]), "v"(v[3])); }
                else if (br == 1) *(f32x4*)((float*)(wb + OFF_mixf2) + eo) = v;
                else { v += *(const f32x4*)((const float*)(wb + OFF_mixf) + eo) + *(const f32x4*)((const float*)(wb + OFF_mixf2) + eo);
                       u32x2 w; w.x = pk_bf16(v[0], v[1]); w.y = pk_bf16(v[2], v[3]); *(u32x2*)((bf16_t*)(wb + OFF_mixb) + tokg_o * 1024 + h * 64 + md * 16 + fq * 4) = w; }
            }
            m[pp] = NEGF; l[pp] = (f32x4){0.f, 0.f, 0.f, 0.f};
#pragma unroll
            for (int md = 0; md < 4; ++md) o[pp][md] = (f32x4){0.f, 0.f, 0.f, 0.f};
        }
    };
    u32x4 rkA[2], rvA[2], rkB[2], rvB[2];
    auto src = [&](int e) __attribute__((always_inline)) {
        const int win = e >> 8, idx = e & 255;
        char* wb = wsb();
        TileSrc ts;
        ts.k = (const bf16_t*)(wb + OFF_Pb) + ((size_t)b * SEQ + idx * 64) * PCOLS + (win ? P_KW : P_KS) + g * 64;
        ts.v = (const bf16_t*)(wb + (win ? OFF_VwT : OFF_VsT)) + (size_t)bg * 64 * SEQ + idx * 64;
        return ts;
    };
    auto step = [&](int i, int buf) __attribute__((always_inline)) {
        const int e = slist[i];
        const int win = e >> 8, idx = e & 255;
        if (i == nsl) finish_branch(1);
        const char* sK = smem + buf * 2 * KT_BYTES; const char* sV = sK + KT_BYTES;
        if (mode != 1 && (win || ((wave_union >> idx) & 1ull))) {
            const bool lv = win ? true : (((mymask >> idx) & 1ull) != 0ull);
            const bool nm = (idx == qb) || (win && idx == qb - 8);
            flash_tile<true>(sK, sV, qf, m, l, o, (float)(idx * 64 + fq * 4 - t), 1.f, win ? -512.f : -1e9f, lv, nm, slope2, fr, fq, (i != 0) && (i != nsl), ones);
        }
    };
#ifdef PROF
    volatile unsigned* sprof = (volatile unsigned*)(smem + 4 * KT_BYTES + 2048);
    if (tid == 0) { sprof[1] = 0u; sprof[2] = 0u; sprof[3] = (unsigned)__builtin_amdgcn_s_memtime(); }
#define PROF_T0 if (tid == 0) sprof[0] = (unsigned)__builtin_amdgcn_s_memtime();
#define PROF_T1 if (tid == 0) { sprof[1] += (unsigned)__builtin_amdgcn_s_memtime() - sprof[0]; sprof[2] += 1u; }
#else
#define PROF_T0
#define PROF_T1
#endif
    const TileOff toff = tile_offsets(PCOLS, SEQ, tid);
    tile_gload(src(slist[0]), toff, rkA, rvA); tile_swrite(smem, 0, rkA, rvA, tid);
    if (n > 1) tile_gload(src(slist[1]), toff, rkA, rvA);
    __syncthreads();
#pragma unroll 1
    for (int i = 0; i < n; i += 2) {
        if (i + 2 < n) tile_gload(src(slist[i + 2]), toff, rkB, rvB);
        __builtin_amdgcn_sched_barrier(0);
        PROF_T0 step(i, 0); PROF_T1
        __builtin_amdgcn_sched_barrier(0);
        if (i + 1 < n) tile_swrite(smem, 1, rkA, rvA, tid);
        __syncthreads();
        if (i + 1 >= n) break;
        if (i + 3 < n) tile_gload(src(slist[i + 3]), toff, rkA, rvA);
        __builtin_amdgcn_sched_barrier(0);
        PROF_T0 step(i + 1, 1); PROF_T1
        __builtin_amdgcn_sched_barrier(0);
        if (i + 2 < n) tile_swrite(smem, 0, rkB, rvB, tid);
        __syncthreads();
    }
    finish_branch(2);
#ifdef PROF
    if (tid == 0) {
        unsigned long long* pw = (unsigned long long*)(p.ws + OFF_counts + 1024);
        atomicAdd(&pw[0], (unsigned long long)sprof[1]); atomicAdd(&pw[1], (unsigned long long)((unsigned)__builtin_amdgcn_s_memtime() - sprof[3])); atomicAdd(&pw[2], (unsigned long long)sprof[2]);
    }
#endif
}

__device__ void gla_c_item(const Params& p, int item, char* smem) {
    const int tid = opaque_tid(), lane = tid & 63, wid = tid >> 6, fr = lane & 15, fq = lane >> 4;
    const int bh = item >> 6, c = item & 63, b = bh >> 2, h = bh & 3;
    const int tok0 = c * 64, tokg0 = b * SEQ + tok0;
    float* sb = (float*)smem; float* sglr = (float*)(smem + 16384); float* swa = (float*)(smem + 20480); float* sqt = (float*)(smem + 24576);
    char* sST = smem;
    char* sQB = smem + 25600; char* sKB = smem + 34816; char* sVT = smem + 44032;
    {
        const float* bs = (const float*)(p.ws + OFF_bsave) + (size_t)item * 4096;
#pragma unroll
        for (int i = 0; i < 4; ++i) *(f32x4*)(sb + (tid + 256 * i) * 4) = *(const f32x4*)(bs + (tid + 256 * i) * 4);
        __syncthreads();
    }
    {
        const int d = tid & 63, tq = tid >> 6;
#pragma unroll 4
        for (int tt = 0; tt < 16; ++tt) {
            const int tk = tq * 16 + tt;
            const float bt = sb[tk * 64 + d];
            const float q = bf2f(p.Pb()[(size_t)(tokg0 + tk) * PCOLS + P_GQ + h * 64 + d]);
            const float k = bf2f(p.Pb()[(size_t)(tokg0 + tk) * PCOLS + P_GK + h * 64 + d]);
            *(bf16_t*)(sQB + (tk * LDS_ROW + d) * 2) = f2bf(q * 0.125f * __expf(bt));
            *(bf16_t*)(sKB + (tk * LDS_ROW + d) * 2) = f2bf(k * __expf(-bt));
        }
    }
#pragma unroll
    for (int i = 0; i < 4; ++i) {
        const int cidx = tid + 256 * i, e = cidx >> 3, ch = (cidx & 7) * 8;
        *(u32x4*)(sVT + (e * LDS_ROW + ch) * 2) = *(const u32x4*)(p.VgT() + ((size_t)bh * 128 + e) * SEQ + tok0 + ch);
    }
    __syncthreads();
#pragma unroll
    for (int i = 0; i < 4; ++i) {
        const int cidx = tid + 256 * i, e = cidx >> 3, ch = (cidx & 7) * 8;
        *(u32x4*)(sST + (e * LDS_ROW + ch) * 2) = *(const u32x4*)(p.ST() + ((size_t)item << 13) + e * 64 + ch);
    }
    __syncthreads();
    bf16x8 qbf[2];
#pragma unroll
    for (int ks = 0; ks < 2; ++ks) qbf[ks] = *(const bf16x8*)(sQB + ((wid * 16 + fr) * LDS_ROW + ks * 32 + fq * 8) * 2);
    f32x4 sa[4];
#pragma unroll
    for (int ms = 0; ms < 4; ++ms) {
        sa[ms] = (f32x4){0.f, 0.f, 0.f, 0.f};
#pragma unroll
        for (int ks = 0; ks < 2; ++ks) {
            bf16x8 a = *(const bf16x8*)(sKB + ((ms * 16 + fr) * LDS_ROW + ks * 32 + fq * 8) * 2);
            sa[ms] = __builtin_amdgcn_mfma_f32_16x16x32_bf16(a, qbf[ks], sa[ms], 0, 0, 0);
        }
#pragma unroll
        for (int j = 0; j < 4; ++j) sa[ms][j] = (ms * 16 + fq * 4 + j <= wid * 16 + fr) ? sa[ms][j] : 0.f;
    }
    bf16x8 pf[2];
#pragma unroll
    for (int kk = 0; kk < 2; ++kk) {
        u32x4 w;
        w.x = pk_bf16(sa[2 * kk][0], sa[2 * kk][1]); w.y = pk_bf16(sa[2 * kk][2], sa[2 * kk][3]);
        w.z = pk_bf16(sa[2 * kk + 1][0], sa[2 * kk + 1][1]); w.w = pk_bf16(sa[2 * kk + 1][2], sa[2 * kk + 1][3]);
        pf[kk] = __builtin_bit_cast(bf16x8, w);
    }
    f32x4 oa[8];
    float sum = 0.f;
#pragma unroll
    for (int me = 0; me < 8; ++me) {
        f32x4 acc = (f32x4){0.f, 0.f, 0.f, 0.f};
#pragma unroll
        for (int ks = 0; ks < 2; ++ks) {
            bf16x8 a = *(const bf16x8*)(sST + ((me * 16 + fr) * LDS_ROW + ks * 32 + fq * 8) * 2);
            acc = __builtin_amdgcn_mfma_f32_16x16x32_bf16(a, qbf[ks], acc, 0, 0, 0);
        }
#pragma unroll
        for (int kk = 0; kk < 2; ++kk) {
            u32x2 lo = *(const u32x2*)(sVT + ((me * 16 + fr) * LDS_ROW + kk * 32 + fq * 4) * 2);
            u32x2 hi = *(const u32x2*)(sVT + ((me * 16 + fr) * LDS_ROW + kk * 32 + 16 + fq * 4) * 2);
            u32x4 w; w.x = lo.x; w.y = lo.y; w.z = hi.x; w.w = hi.y;
            acc = __builtin_amdgcn_mfma_f32_16x16x32_bf16(__builtin_bit_cast(bf16x8, w), pf[kk], acc, 0, 0, 0);
        }
        oa[me] = acc;
        sum += (acc[0] + acc[1]) + (acc[2] + acc[3]);
    }
    sum += __shfl_xor(sum, 16); sum += __shfl_xor(sum, 32);
    const float mu = sum * (1.f / 128.f);
    float var = 0.f;
#pragma unroll
    for (int me = 0; me < 8; ++me)
#pragma unroll
        for (int j = 0; j < 4; ++j) { const float dd = oa[me][j] - mu; var += dd * dd; }
    var += __shfl_xor(var, 16); var += __shfl_xor(var, 32);
    const float rstd = rsqrtf(var * (1.f / 128.f) + 1e-5f);
    const size_t tok = (size_t)tokg0 + wid * 16 + fr;
#pragma unroll
    for (int me = 0; me < 8; ++me) {
        const int e = me * 16 + fq * 4;
        const u32x2 rr = *(const u32x2*)(p.Pb() + tok * PCOLS + P_GR + h * 128 + e);
        const f32x4 nw = *(const f32x4*)(p.norm_w + e);
        float r[4] = {bflo(rr.x), bfhi(rr.x), bflo(rr.y), bfhi(rr.y)};
        float ov[4];
#pragma unroll
        for (int j = 0; j < 4; ++j) ov[j] = (oa[me][j] - mu) * rstd * nw[j] * (r[j] / (1.f + __expf(-r[j])));
        u32x2 w; w.x = pk_bf16(ov[0], ov[1]); w.y = pk_bf16(ov[2], ov[3]);
        *(u32x2*)(p.mixb() + tok * 1024 + 512 + h * 128 + e) = w;
    }
    __syncthreads();
}

#ifndef NSA_REP
#define NSA_REP 1
#endif
#ifndef NSA_MODE2
#define NSA_MODE2 0
#endif
#ifndef GLAC_REP
#define GLAC_REP 1
#endif
__device__ void phase5a(const Params& p, char* smem, int rep) {
    int* sidx = (int*)(smem + GEMM_SMEM - 16);
    for (;;) {
        __syncthreads();
        if (opaque_tid() == 0) *sidx = atomicAdd(&p.counts()[264 + 4 * rep], 1);
        __syncthreads();
        const int it = *sidx;
        if (it >= 512) break;
        nsa_cmp_item(p, it >> 3, it & 7, smem);
    }
    for (;;) {
        __syncthreads();
        if (opaque_tid() == 0) *sidx = atomicAdd(&p.counts()[265 + 4 * rep], 1);
        __syncthreads();
        const int it = *sidx;
        if (it >= 1024 * GLAC_REP) break;
        gla_c_item(p, it & 1023, smem);
    }
}
__device__ void phase5b(const Params& p, char* smem, int rep) {
    int* sidx = (int*)(smem + GEMM_SMEM - 16);
    for (;;) {
        __syncthreads();
        if (opaque_tid() == 0) *sidx = atomicAdd(&p.counts()[266 + 4 * rep], 1);
        __syncthreads();
        const int it = *sidx;
        if (it >= 1024 * NSA_REP) break;
        const int item = it & 1023;
        nsa_sw_item(p, item >> 4, (item >> 1) & 7, item & 1, smem, it >= 1024 ? NSA_MODE2 : 0);
    }
}
__device__ void phase6(const Params& p, char* smem) {
    const int xcd = xcd_of(smem), rank = rank_of(smem), nranks = nranks_of(smem);
    const int lane = opaque_tid() & 63, wid = opaque_tid() >> 6, wr = wid >> 1, wc = wid & 1, fr = lane & 15, fq = lane >> 4;
    for (int it = rank; it < 16 * 8; it += nranks) {
        const int mt = (it / 8) * 8 + xcd, nt = it % 8;
        RowsBf16 al{p.mixb() + (size_t)mt * 128 * 1024, 1024};
        RowsBf16 bl{p.wot() + (size_t)nt * 128 * 1024, 1024};
        f32x4 acc[4][4];
        gemm_128<true, false>(al, bl, 0, 16, smem, acc);
#pragma unroll
        for (int m = 0; m < 4; ++m)
#pragma unroll
            for (int n = 0; n < 4; ++n)
                *(f32x4*)(p.y1() + (size_t)(mt * 128 + wr * 64 + m * 16 + fr) * 1024 + nt * 128 + wc * 64 + n * 16 + fq * 4) = acc[m][n];
    }
}

__device__ void phase7(const Params& p) {
    const int lane = opaque_tid() & 63, gw = blockIdx.x * 4 + (opaque_tid() >> 6), nw = gridDim.x * 4;
    const float alpha = 1.189207115f;
    for (int row0 = gw * 2; row0 < NTOK; row0 += nw * 2) {
        const int b = row0 / SEQ;
        const float* md = p.mod() + b * 6144;
        f32x4 xv[2][4], yv[2][4];
#pragma unroll
        for (int r = 0; r < 2; ++r)
#pragma unroll
            for (int i = 0; i < 4; ++i) {
                const int col = i * 256 + lane * 4;
                xv[r][i] = *(const f32x4*)(p.x + (size_t)(row0 + r) * 1024 + col);
                yv[r][i] = *(const f32x4*)(p.y1() + (size_t)(row0 + r) * 1024 + col);
            }
#pragma unroll
        for (int r = 0; r < 2; ++r) {
            const int row = row0 + r;
            f32x4 v[4]; float s = 0.f;
#pragma unroll
            for (int i = 0; i < 4; ++i) {
                const int col = i * 256 + lane * 4;
                const f32x4 ga = *(const f32x4*)(md + 2048 + col);
#pragma unroll
                for (int j = 0; j < 4; ++j) v[i][j] = alpha * xv[r][i][j] + (1.f + ga[j]) * yv[r][i][j];
                s += (v[i][0] + v[i][1]) + (v[i][2] + v[i][3]);
            }
            float mu = wave_sum(s) * (1.f / 1024.f);
            float q = 0.f;
#pragma unroll
            for (int i = 0; i < 4; ++i)
#pragma unroll
                for (int j = 0; j < 4; ++j) { float d = v[i][j] - mu; q += d * d; }
            float rstd = rsqrtf(wave_sum(q) * (1.f / 1024.f) + 1e-5f);
            s = 0.f;
#pragma unroll
            for (int i = 0; i < 4; ++i) {
                const int col = i * 256 + lane * 4;
                f32x4 g = *(const f32x4*)(p.ln1_g + col), bb = *(const f32x4*)(p.ln1_b + col);
#pragma unroll
                for (int j = 0; j < 4; ++j) v[i][j] = (v[i][j] - mu) * rstd * g[j] + bb[j];
                *(f32x4*)(p.x1() + (size_t)row * 1024 + col) = v[i];
                s += (v[i][0] + v[i][1]) + (v[i][2] + v[i][3]);
            }
            mu = wave_sum(s) * (1.f / 1024.f);
            q = 0.f;
#pragma unroll
            for (int i = 0; i < 4; ++i)
#pragma unroll
                for (int j = 0; j < 4; ++j) { float d = v[i][j] - mu; q += d * d; }
            rstd = rsqrtf(wave_sum(q) * (1.f / 1024.f) + 1e-5f);
#pragma unroll
            for (int i = 0; i < 4; ++i) {
                const int col = i * 256 + lane * 4;
                f32x4 sh = *(const f32x4*)(md + 3072 + col), sc = *(const f32x4*)(md + 4096 + col);
                float o[4];
#pragma unroll
                for (int j = 0; j < 4; ++j) o[j] = (v[i][j] - mu) * rstd * (1.f + sc[j]) + sh[j];
                u32x2 w; w.x = pk_bf16(o[0], o[1]); w.y = pk_bf16(o[2], o[3]);
                *(u32x2*)(p.hb() + (size_t)row * 1024 + col) = w;
            }
        }
    }
}

__device__ void phase8(const Params& p, char* smem) {
    const int lane = opaque_tid() & 63, wid = opaque_tid() >> 6, wr = wid >> 1, wc = wid & 1, fr = lane & 15, fq = lane >> 4;
    for (int it = blockIdx.x; it < 256; it += gridDim.x) {
        const int mt = it >> 1, nt = it & 1;
        RowsBf16 al{p.hb() + (size_t)mt * 128 * 1024, 1024};
        RowsBf16 bl{p.wrt() + (size_t)nt * 128 * 1024, 1024};
        f32x4 acc[4][4];
        gemm_128<true, false>(al, bl, 0, 16, smem, acc);
#pragma unroll
        for (int m = 0; m < 4; ++m)
#pragma unroll
            for (int n = 0; n < 4; ++n)
                *(f32x4*)(p.logits() + (size_t)(mt * 128 + wr * 64 + m * 16 + fr) * 256 + nt * 128 + wc * 64 + n * 16 + fq * 4) = acc[m][n];
    }
}

__device__ void phase9(const Params& p) {
    const int lane = opaque_tid() & 63, gw = blockIdx.x * 4 + (opaque_tid() >> 6), nw = gridDim.x * 4;
    for (int tok = gw; tok < NTOK; tok += nw) {
        float s[4], sb[4];
        const f32x4 lg = *(const f32x4*)(p.logits() + (size_t)tok * 256 + lane * 4);
        const f32x4 rb = *(const f32x4*)(p.rbias + lane * 4);
#pragma unroll
        for (int i = 0; i < 4; ++i) { s[i] = 1.f / (1.f + __expf(-lg[i])); sb[i] = s[i] + rb[i]; }
        float m1 = NEGF, m2 = NEGF;
#pragma unroll
        for (int i = 0; i < 4; ++i) { float v = sb[i]; if (v > m1) { m2 = m1; m1 = v; } else if (v > m2) m2 = v; }
#pragma unroll
        for (int mm = 1; mm < 8; mm <<= 1) {
            float o1 = __shfl_xor(m1, mm), o2 = __shfl_xor(m2, mm);
            float n1 = fmaxf(m1, o1);
            float n2 = fmaxf(fminf(m1, o1), fmaxf(m2, o2));
            m1 = n1; m2 = n2;
        }
        const float gs = m1 + m2;
        const int grp = lane >> 3;
        int grank = 0;
#pragma unroll
        for (int g2 = 0; g2 < 8; ++g2) { float o = __shfl(gs, g2 * 8); if (o > gs || (o == gs && g2 < grp)) ++grank; }
        const bool gsel = grank < 4;
        float cand[4];
#pragma unroll
        for (int i = 0; i < 4; ++i) cand[i] = gsel ? sb[i] : NEGF;
        float wsum = 0.f, myw = 0.f; int mye = 0;
#pragma unroll 1
        for (int k = 0; k < TOPK; ++k) {
            float bv = cand[0]; int bi = 0;
#pragma unroll
            for (int i = 1; i < 4; ++i) if (cand[i] > bv) { bv = cand[i]; bi = i; }
            float gv = bv; int ge = lane * 4 + bi;
#pragma unroll
            for (int mm = 1; mm < 64; mm <<= 1) {
                float ov = __shfl_xor(gv, mm); int oe = __shfl_xor(ge, mm);
                if (ov > gv || (ov == gv && oe < ge)) { gv = ov; ge = oe; }
            }
            float sel_s = 0.f;
            if ((ge >> 2) == lane) {
                const int i = ge & 3;
                sel_s = (i == 0) ? s[0] : (i == 1) ? s[1] : (i == 2) ? s[2] : s[3];
                if (i == 0) cand[0] = -3e38f; else if (i == 1) cand[1] = -3e38f; else if (i == 2) cand[2] = -3e38f; else cand[3] = -3e38f;
            }
            sel_s = __shfl(sel_s, ge >> 2);
            wsum += sel_s;
            if (lane == k) { myw = sel_s; mye = ge; }
        }
        if (lane < TOPK) {
            const int id = tok * NASSIGN + lane;
            p.ew()[id] = myw / wsum * 2.5f;
            const int pos = atomicAdd(&p.counts()[mye], 1);
            p.lists()[(size_t)mye * NTOK + pos] = id;
        } else if (lane == TOPK) {
            p.ew()[tok * NASSIGN + TOPK] = 1.f;
        }
    }
}

struct Rows4 {
    static constexpr bool NT = false;
    const bf16_t *p0, *p1, *p2, *p3; int kmask;
    __device__ __forceinline__ const bf16_t* pp(int i, int tid, int k) const { return (i == 0 ? p0 : i == 1 ? p1 : i == 2 ? p2 : p3) + (k & kmask); }
};
template <int NT_PER>
__device__ __forceinline__ int build_entries(const Params& p, int xcd, int* spre) {
    const int tid = opaque_tid();
    __syncthreads();
    if (tid < 33) {
        int items;
        if (tid < 32) { const int cnt = p.counts()[xcd + 8 * tid]; items = ((cnt + 127) >> 7) * NT_PER; }
        else items = 16 * NT_PER;
        spre[64 + tid] = items;
    }
    __syncthreads();
    if (tid == 0) { int a = 0; for (int i = 0; i < 33; ++i) { spre[i] = a; a += spre[64 + i]; } spre[33] = a; }
    __syncthreads();
    return spre[33];
}

template <int NT_PER>
__device__ __forceinline__ void decode_item(const Params& p, int xcd, const int* spre, int it, int& e, int& nt, int& mtile, int& cnt) {
    int ent = 0;
    for (int i = 1; i < 33; ++i) ent = (it >= spre[i]) ? i : ent;
    const int local = it - spre[ent];
    if (ent < 32) {
        e = xcd + 8 * ent; cnt = p.counts()[e];
        const int mtc = (cnt + 127) >> 7;
        nt = local / mtc; mtile = local % mtc;
    } else {
        e = N_EXP; cnt = NTOK; nt = local >> 4; mtile = (local & 15) * 8 + xcd;
    }
}

#ifndef P10_NT
#define P10_NT 4
#endif
struct BF32GateUpS {
    const float* g; long du;
    __device__ __forceinline__ const float* addr(int kk, int r4) const { const long sel = ((r4 >> 5) & 1) ? du : 0l; return g + sel + (size_t)(kk & 1023) * 256 + (kk >> 10) * 64 + (r4 >> 6) * 32 + (r4 & 31); }
    __device__ __forceinline__ f32x4 load4(int kk, int r4) const {
        const long sel = ((r4 >> 5) & 1) ? du : 0l;
        return *(const f32x4*)(g + sel + (size_t)(kk & 1023) * 256 + (kk >> 10) * 64 + (r4 >> 6) * 32 + (r4 & 31));
    }
};
__device__ void phase10(const Params& p, char* smem) {
    const int tid = opaque_tid(), xcd = xcd_of(smem), rank = rank_of(smem), nranks = nranks_of(smem);
    const int lane = tid & 63, wid = tid >> 6, wr = wid >> 1, wc = wid & 1, fr = lane & 15, fq = lane >> 4;
    int* srow = (int*)(smem + GEMM_SMEM);
    int* spre = srow + 256;
#ifndef P10_REP
#define P10_REP 1
#endif
    const int total = build_entries<P10_NT>(p, xcd, spre);
#ifdef STAGGER
    for (int i = 0; i < (rank & 3) * STAGGER; ++i) __builtin_amdgcn_s_sleep(32);
#endif
    for (int it0 = rank; it0 < total * P10_REP; it0 += nranks) {
        const int it = it0 % total;
        int e, nt, mtile, cnt;
        decode_item<P10_NT>(p, xcd, spre, it, e, nt, mtile, cnt);
        if (tid < 128) {
            const int pos = mtile * 128 + tid;
            int id = -1;
            if (pos < cnt) id = (e == N_EXP) ? (pos * NASSIGN + TOPK) : p.lists()[(size_t)e * NTOK + pos];
            srow[tid] = id >= 0 ? id / NASSIGN : 0;
            srow[128 + tid] = id;
        }
        __syncthreads();
        Rows4 al; al.kmask = 1023;
        al.p0 = p.hb() + (size_t)srow[(tid >> 3)] * 1024; al.p1 = p.hb() + (size_t)srow[32 + (tid >> 3)] * 1024;
        al.p2 = p.hb() + (size_t)srow[64 + (tid >> 3)] * 1024; al.p3 = p.hb() + (size_t)srow[96 + (tid >> 3)] * 1024;
        const float* Wg = (e == N_EXP) ? p.w_s_gate : p.w_e_gate + (size_t)e * 1024 * 256;
        const float* Wu = (e == N_EXP) ? p.w_s_up : p.w_e_up + (size_t)e * 1024 * 256;
        BF32GateUpS bl{Wg + nt * (256 / P10_NT), (long)(Wu - Wg)};
        f32x4 acc[4][4];
        bf16_t* hidp = p.hid();
        gemm_core<true, true>(al, bl, 0, 16 * (4 / P10_NT), 16, smem, acc, [&](int tl, const f32x4 (&a)[4][4]) __attribute__((always_inline)) {
            const int nt4 = nt * (4 / P10_NT) + tl;
#pragma unroll
            for (int m = 0; m < 4; ++m) {
                const int id = srow[128 + wr * 64 + m * 16 + fr];
                if (id >= 0) {
#pragma unroll
                    for (int n = 0; n < 2; ++n) {
                        float hv[4];
#pragma unroll
                        for (int j = 0; j < 4; ++j) { const float gte = a[m][n][j]; hv[j] = gte / (1.f + __expf(-gte)) * a[m][n + 2][j]; }
                        u32x2 w; w.x = pk_bf16(hv[0], hv[1]); w.y = pk_bf16(hv[2], hv[3]);
                        *(u32x2*)(hidp + (size_t)id * 256 + nt4 * 64 + wc * 32 + n * 16 + fq * 4) = w;
                    }
                }
            }
        });
        __syncthreads();
    }
}

struct DownB {
    const float* base;
    __device__ __forceinline__ const float* addr(int kk, int r4) const { return base + (size_t)(kk & 255) * 1024 + (kk >> 8) * 128 + r4; }
    __device__ __forceinline__ f32x4 load4(int kk, int r4) const {
#ifdef NT_B
        return __builtin_nontemporal_load((const f32x4*)(base + (size_t)(kk & 255) * 1024 + (kk >> 8) * 128 + r4));
#else
        return *(const f32x4*)(base + (size_t)(kk & 255) * 1024 + (kk >> 8) * 128 + r4);
#endif
    }
};
struct HidA {
    static constexpr bool NT = true;
    const bf16_t* base; const int* rowidx;
    __device__ __forceinline__ const bf16_t* ptr(int r, int kk) const { return base + (size_t)rowidx[r] * 256 + (kk & 255); }
    __device__ __forceinline__ const bf16_t* pp(int i, int tid, int k) const { return ptr(i * 32 + (tid >> 3), k); }
};
#ifndef P11_NT
#define P11_NT 4
#endif
__device__ void phase11(const Params& p, char* smem) {
    const int tid = opaque_tid(), xcd = xcd_of(smem), rank = rank_of(smem), nranks = nranks_of(smem);
    const int lane = tid & 63, wid = tid >> 6, wr = wid >> 1, wc = wid & 1, fr = lane & 15, fq = lane >> 4;
    int* srow = (int*)(smem + GEMM_SMEM);
    int* spre = srow + 256;
    float* sew = (float*)(srow + 384);
#ifndef P11_REP
#define P11_REP 1
#endif
    const int total = build_entries<P11_NT>(p, xcd, spre);
    for (int it0 = rank; it0 < total * P11_REP; it0 += nranks) {
        const int it = it0 % total;
        int e, nt, mtile, cnt;
        decode_item<P11_NT>(p, xcd, spre, it, e, nt, mtile, cnt);
        if (tid < 128) {
            const int pos = mtile * 128 + tid;
            int id = -1;
            if (pos < cnt) id = (e == N_EXP) ? (pos * NASSIGN + TOPK) : p.lists()[(size_t)e * NTOK + pos];
            srow[tid] = id >= 0 ? id : 0;
            srow[128 + tid] = id;
            sew[tid] = id >= 0 ? p.ew()[id] : 0.f;
        }
        __syncthreads();
        Rows4 al; al.kmask = 255;
        al.p0 = p.hid() + (size_t)srow[(tid >> 3)] * 256; al.p1 = p.hid() + (size_t)srow[32 + (tid >> 3)] * 256;
        al.p2 = p.hid() + (size_t)srow[64 + (tid >> 3)] * 256; al.p3 = p.hid() + (size_t)srow[96 + (tid >> 3)] * 256;
        DownB bl{(e == N_EXP) ? p.w_s_down : p.w_e_down + (size_t)e * 256 * 1024};
        f32x4 acc[4][4];
        bf16_t* outk = p.outk();
        auto epi = [&](int tile, const f32x4 (&a)[4][4]) __attribute__((always_inline)) {
#pragma unroll
            for (int m = 0; m < 4; ++m) {
                const int rr = wr * 64 + m * 16 + fr;
                const int id = srow[128 + rr];
                if (id >= 0) {
                    const float w8 = sew[rr];
#pragma unroll
                    for (int n = 0; n < 4; ++n) {
                        u32x2 w; w.x = pk_bf16(a[m][n][0] * w8, a[m][n][1] * w8); w.y = pk_bf16(a[m][n][2] * w8, a[m][n][3] * w8);
                        *(u32x2*)(outk + (size_t)id * 1024 + tile * 128 + wc * 64 + n * 16 + fq * 4) = w;
                    }
                }
            }
        };
        gemm_core<true, true>(al, bl, nt * (2048 / P11_NT), 32 / P11_NT, 4, smem, acc, [&](int tl, const f32x4 (&a)[4][4]) __attribute__((always_inline)) { epi(nt * (8 / P11_NT) + tl, a); });
        __syncthreads();
    }
}

__device__ void phase12(const Params& p) {
    const int lane = opaque_tid() & 63, gw = blockIdx.x * 4 + (opaque_tid() >> 6), nw = gridDim.x * 4;
    const float alpha = 1.189207115f;
    for (int row = gw; row < NTOK; row += nw) {
        const int b = row / SEQ;
        const float* md = p.mod() + b * 6144;
        float v[16];
#pragma unroll
        for (int i = 0; i < 16; ++i) v[i] = 0.f;
#pragma unroll
        for (int k = 0; k < NASSIGN; ++k) {
#pragma unroll
            for (int cidx = 0; cidx < 2; ++cidx) {
                const u32x4 w = *(const u32x4*)(p.outk() + ((size_t)row * NASSIGN + k) * 1024 + cidx * 512 + lane * 8);
                v[cidx * 8 + 0] += bflo(w.x); v[cidx * 8 + 1] += bfhi(w.x); v[cidx * 8 + 2] += bflo(w.y); v[cidx * 8 + 3] += bfhi(w.y);
                v[cidx * 8 + 4] += bflo(w.z); v[cidx * 8 + 5] += bfhi(w.z); v[cidx * 8 + 6] += bflo(w.w); v[cidx * 8 + 7] += bfhi(w.w);
            }
        }
        float s = 0.f;
#pragma unroll
        for (int cidx = 0; cidx < 2; ++cidx)
#pragma unroll
            for (int hh = 0; hh < 2; ++hh) {
                const int col = cidx * 512 + lane * 8 + hh * 4;
                const f32x4 xv = *(const f32x4*)(p.x1() + (size_t)row * 1024 + col), ga = *(const f32x4*)(md + 5120 + col);
#pragma unroll
                for (int j = 0; j < 4; ++j) { float t = alpha * xv[j] + (1.f + ga[j]) * v[cidx * 8 + hh * 4 + j]; v[cidx * 8 + hh * 4 + j] = t; s += t; }
            }
        const float mu = wave_sum(s) * (1.f / 1024.f);
        float q = 0.f;
#pragma unroll
        for (int i = 0; i < 16; ++i) { float d = v[i] - mu; q += d * d; }
        const float rstd = rsqrtf(wave_sum(q) * (1.f / 1024.f) + 1e-5f);
#pragma unroll
        for (int cidx = 0; cidx < 2; ++cidx)
#pragma unroll
            for (int hh = 0; hh < 2; ++hh) {
                const int col = cidx * 512 + lane * 8 + hh * 4;
                const f32x4 g = *(const f32x4*)(p.ln2_g + col), bb = *(const f32x4*)(p.ln2_b + col);
                f32x4 o;
#pragma unroll
                for (int j = 0; j < 4; ++j) o[j] = (v[cidx * 8 + hh * 4 + j] - mu) * rstd * g[j] + bb[j];
                *(f32x4*)(p.out + (size_t)row * 1024 + col) = o;
            }
    }
}

#define XB_TMO      128
#define XB_XCNT(j)  (256  + 64 * (j))
#define XB_XSUB(j)  (1280 + 64 * (j))
#define XB_XGEN(j)  (2304 + 64 * (j))
#define XB_TOP      3328
#define XB_TOPGEN   3392
#define XCD_BAR_WORDS 3456
#define XB_SPIN_CAP (1u << 22)
#define LAS __attribute__((address_space(3)))
__device__ __forceinline__ unsigned xb_ld(unsigned* p) { return __hip_atomic_load(p, __ATOMIC_RELAXED, __HIP_MEMORY_SCOPE_AGENT); }
__device__ __forceinline__ unsigned xb_add(unsigned* p, unsigned v) { return __hip_atomic_fetch_add(p, v, __ATOMIC_RELAXED, __HIP_MEMORY_SCOPE_AGENT); }
__device__ __forceinline__ unsigned xb_xcc_id() { return (unsigned)__builtin_amdgcn_s_getreg((3 << 11) | 20) & 0xFu; }
#define XB_SPIN(cond, bar) do { unsigned _sp = 0; while (cond) { __builtin_amdgcn_s_sleep(1); \
    if ((++_sp & 255u) == 0u) { if (xb_ld(&(bar)[XB_TMO])) break; if (_sp > XB_SPIN_CAP) { atomicAdd(&(bar)[XB_TMO], 1u); break; } } } } while (0)
struct XcdBarrier { unsigned* bar; unsigned x; volatile LAS unsigned* st; };
__device__ __forceinline__ XcdBarrier xcd_barrier_post(unsigned* bar, volatile LAS unsigned* st) {
    XcdBarrier b; b.bar = bar; b.x = xb_xcc_id(); b.st = st;
    if (opaque_tid() == 0) st[2] = xb_add(&bar[XB_XCNT(b.x)], 1u);
    return b;
}
__device__ __forceinline__ void xcd_barrier_complete(unsigned* bar, unsigned x, unsigned& nloc, unsigned& nx, unsigned& dense) {
    const unsigned G = gridDim.x * gridDim.y * gridDim.z;
    unsigned sum, cnt, mine, below, sp = 0u;
    for (;;) {
        sum = 0u; cnt = 0u; mine = 0u; below = 0u;
#pragma unroll
        for (unsigned j = 0; j < 16; ++j) { const unsigned c = xb_ld(&bar[XB_XCNT(j)]); sum += c; cnt += (c > 0u) ? 1u : 0u; mine = (j == x) ? c : mine; below += (j < x && c > 0u) ? 1u : 0u; }
        if (sum == G) break;
        __builtin_amdgcn_s_sleep(1);
        if ((++sp & 255u) == 0u) { if (xb_ld(&bar[XB_TMO])) break; if (sp > XB_SPIN_CAP) { atomicAdd(&bar[XB_TMO], 1u); break; } }
    }
    nloc = mine > 0u ? mine : 1u; nx = cnt > 0u ? cnt : 1u; dense = below;
}
__device__ __forceinline__ void xcd_barrier(unsigned* bar, volatile LAS unsigned* st) {
    asm volatile("s_waitcnt vmcnt(0)" ::: "memory");
    __syncthreads();
    if (opaque_tid() == 0) {
        __builtin_amdgcn_s_waitcnt(0);
        const unsigned x = st[3];
        unsigned nloc = st[0], nx = st[1];
        if (nloc == 0u) {
            unsigned dense;
            xcd_barrier_complete(bar, x, nloc, nx, dense); st[0] = nloc; st[1] = nx;
            const unsigned use_xcc = (nx == 8u) ? 1u : 0u;
            st[4] = use_xcc ? dense : (blockIdx.x & 7u);
            st[5] = use_xcc ? st[2] : (blockIdx.x >> 3);
            st[6] = use_xcc ? nloc : (gridDim.x >> 3);
        }
        const unsigned old = xb_add(&bar[XB_XSUB(x)], 1u);
        const unsigned gen = old / nloc;
        if (old + 1u == (gen + 1u) * nloc) {
            __builtin_amdgcn_fence(__ATOMIC_RELEASE, "agent");
            asm volatile("s_waitcnt vmcnt(0)" ::: "memory");
            const unsigned og = xb_add(&bar[XB_TOP], 1u);
            const unsigned tg = og / nx;
            if (og + 1u == (tg + 1u) * nx) xb_add(&bar[XB_TOPGEN], 1u);
            else XB_SPIN(xb_ld(&bar[XB_TOPGEN]) == tg, bar);
            __builtin_amdgcn_fence(__ATOMIC_ACQUIRE, "agent");
            xb_add(&bar[XB_XGEN(x)], 1u);
            asm volatile("s_waitcnt vmcnt(0)" ::: "memory");
        } else {
            XB_SPIN(xb_ld(&bar[XB_XGEN(x)]) == gen, bar);
            __builtin_amdgcn_fence(__ATOMIC_ACQUIRE, "agent");
            asm volatile("s_waitcnt vmcnt(0)" ::: "memory");
        }
    }
    __syncthreads();
}

#define MEGA_SMEM (GEMM_SMEM + 2048 + 64)
#define N_PHASES 14
__global__ void __launch_bounds__(256, 2) mega(Params p) {
    extern __shared__ __attribute__((aligned(16))) char smem[];
    volatile LAS unsigned* st = (volatile LAS unsigned*)(smem + GEMM_SMEM + 2048);
    if (p.ph_hi - p.ph_lo > 1) {
        if (opaque_tid() == 0) {
            const unsigned x = xb_xcc_id();
            st[0] = 0u; st[1] = 0u; st[3] = x;
            st[2] = xb_add(&p.bar()[XB_XCNT(x)], 1u);
        }
    } else {
        if (opaque_tid() == 0) { st[0] = gridDim.x >> 3; st[1] = 8u; st[2] = blockIdx.x >> 3; st[3] = blockIdx.x & 7; st[4] = blockIdx.x & 7; st[5] = blockIdx.x >> 3; st[6] = gridDim.x >> 3; }
    }
    __syncthreads();
#ifndef REP_PHASE
#define REP_PHASE -1
#endif
#ifdef PHPROF
#define PH_STAMP(N) if (blockIdx.x == 0 && opaque_tid() == 0) ((unsigned long long*)(p.ws + OFF_counts + 1536))[N] = __builtin_amdgcn_s_memrealtime();
#else
#define PH_STAMP(N)
#endif
#define RUN_PHASE(N, CALL) if (p.ph_lo <= N && N < p.ph_hi) { if (N > p.ph_lo) xcd_barrier(p.bar(), st); PH_STAMP(N) { const int rep = 0; (void)rep; CALL; } \
        if (REP_PHASE == N) { xcd_barrier(p.bar(), st); { const int rep = 1; (void)rep; CALL; } } }
    RUN_PHASE(0, phase0(p, smem))
    RUN_PHASE(1, phase1(p))
    RUN_PHASE(2, phase2(p, smem))
    RUN_PHASE(3, phase3(p, smem))
    RUN_PHASE(4, phase4(p, smem))
    RUN_PHASE(5, phase5a(p, smem, rep))
    RUN_PHASE(6, phase5b(p, smem, rep))
    RUN_PHASE(7, phase6(p, smem))
    RUN_PHASE(8, phase7(p))
    RUN_PHASE(9, phase8(p, smem))
    RUN_PHASE(10, phase9(p))
    RUN_PHASE(11, phase10(p, smem))
    RUN_PHASE(12, phase11(p, smem))
    RUN_PHASE(13, phase12(p))
#ifdef EXTRA_BARRIERS
    for (int i = 0; i < EXTRA_BARRIERS; ++i) xcd_barrier(p.bar(), st);
#endif
    PH_STAMP(14)
    PH_STAMP(15)
}
#if DBG
struct NaiveBufs { float *mod, *h, *proj, *flat, *hidk, *hidv, *kc, *vc, *mix, *ograw, *y, *x1, *logits; };
__device__ __forceinline__ void dbg_pair(int seam, size_t i, const Params& p, const NaiveBufs& nb, float& a, float& b, bool& use) {
    use = true; a = 0.f; b = 0.f;
    switch (seam) {
        case 0: {
            a = nb.mod[i]; b = p.mod()[i]; break; }
        case 1: {
            size_t tok = i / PCOLS; int n = (int)(i % PCOLS);
            int src = win_srccol(n);
            bool transposed = (n >= 896 && n < 1024) || (n >= 1152 && n < 1280) || (n >= 1792 && n < 2304) || n >= 2816;
            if (transposed || src < 0) { use = false; break; }
            a = nb.proj[tok * IN_COLS + src]; b = bf2f(p.Pb()[i]); break; }
        case 2: {
            size_t half = (size_t)BATCH * 128 * SEQ; int which = i >= half; size_t j = which ? i - half : i;
            int t = (int)(j % SEQ); int f = (int)((j / SEQ) % 128); int bb = (int)(j / ((size_t)SEQ * 128));
            a = nb.proj[((size_t)bb * SEQ + t) * IN_COLS + (which ? C_VW : C_VS) + f];
            b = bf2f(which ? p.VwT()[j] : p.VsT()[j]); break; }
        case 3: {
            size_t nv = (size_t)BATCH * 512 * SEQ;
            if (i < nv) { int t = (int)(i % SEQ); int f = (int)((i / SEQ) % 512); int bb = (int)(i / ((size_t)SEQ * 512));
                a = nb.proj[((size_t)bb * SEQ + t) * IN_COLS + C_GV + f]; b = bf2f(p.VgT()[i]); }
            else { size_t j = i - nv; size_t tok = j / 40; int f = (int)(j % 40);
                a = nb.proj[tok * IN_COLS + (f < 24 ? C_NG + f : C_GLR + f - 24)]; b = p.misc()[tok * 64 + f]; }
            break; }
        case 4: {
            size_t nk = (size_t)BATCH * NCMP * 2 * 64;
            size_t j = i < nk ? i : i - nk;
            int d = (int)(j % 64); int g = (int)((j / 64) % 2); int ii = (int)((j / 128) % NCMP); int bb = (int)(j / (128 * NCMP));
            if (i < nk) { a = nb.kc[j]; b = bf2f(p.kc()[((size_t)(bb * 2 + g) * 256 + ii) * 64 + d]); }
            else { a = nb.vc[j]; b = bf2f(p.vcT()[((size_t)(bb * 2 + g) * 64 + d) * 256 + ii]); }
            break; }
        case 5: {
            size_t tok = i / 512; int cidx = (int)(i % 512);
            a = nb.mix[tok * 1024 + cidx]; b = bf2f(p.mixb()[tok * 1024 + cidx]); break; }
        case 6: {
            size_t tok = i / 512; int cidx = (int)(i % 512);
            a = nb.mix[tok * 1024 + 512 + cidx]; b = bf2f(p.mixb()[tok * 1024 + 512 + cidx]); break; }
        case 7: { a = nb.x1[i]; b = p.x1()[i]; break; }
        case 8: { a = nb.logits[i]; b = p.logits()[i]; break; }
    }
}
__global__ __launch_bounds__(256) void dbg_compare(int seam, size_t n, Params p, NaiveBufs nb, float* dbg) {
    __shared__ float red[256];
    float sd = 0.f, sa = 0.f;
    for (size_t i = (size_t)blockIdx.x * 256 + threadIdx.x; i < n; i += (size_t)gridDim.x * 256) {
        float a, b; bool use;
        dbg_pair(seam, i, p, nb, a, b, use);
        if (use) { float d = a - b; if (!(d == d)) d = 1e10f; sd += d * d; sa += a * a; }
    }
    sd = blk_sum(sd, red); sa = blk_sum(sa, red);
    if (threadIdx.x == 0) { atomicAdd(&dbg[2 * seam], sd); atomicAdd(&dbg[2 * seam + 1], sa); }
}
__global__ void dbg_decide(float* dbg, int nseams, int report_seam) {
    float code = 0.f;
    for (int k = 0; k < nseams; ++k) {
        float err = dbg[2 * k] / fmaxf(dbg[2 * k + 1], 1e-30f);
        const float thr = (k == 5) ? 3e-2f : 1e-3f;
        bool bad = !(err < thr);
        if (bad || k == report_seam) {
            float lg = log10f(fmaxf(err, 1e-12f));
            int dgt = (int)floorf(lg) + 6; dgt = dgt < 0 ? 0 : (dgt > 9 ? 9 : dgt);
            code = 100.f * (k + 1) + 10.f * dgt; break;
        }
    }
    dbg[64] = code;
}
__global__ void dbg_apply(const float* dbg, float* out, size_t n) {
    float code = dbg[64];
    if (code <= 0.f) return;
    float cst = sqrtf(code);
    for (size_t i = (size_t)blockIdx.x * 256 + threadIdx.x; i < n; i += (size_t)gridDim.x * 256) out[i] = cst;
}
#endif

#ifdef PROF
__global__ void prof_apply(const unsigned long long* pw, float* out, size_t n, int sel) {
    const double proc = (double)pw[0], tot = (double)pw[1], steps = (double)pw[2];
    float code = 0.f;
    if (sel == 0) code = (float)(100.0 * proc / tot);
    if (sel == 1) code = (float)(tot / steps / 10.0);
    if (sel == 2) code = (float)(proc / steps / 10.0);
    if (sel == 3) code = (float)(steps / 1024.0);
    const float cst = sqrtf(code);
    for (size_t i = (size_t)blockIdx.x * 256 + threadIdx.x; i < n; i += (size_t)gridDim.x * 256) out[i] = cst;
}
#endif
#ifdef PHPROF
__global__ void phase_prof_apply(const unsigned long long* ts, float* out, size_t n, int sel) {
    double us;
    if (sel >= 100) us = (double)(ts[15] - ts[0]) / 100.0;
    else us = (double)(ts[sel + 1] - ts[sel]) / 100.0;
    const float cst = (float)log2(us > 1.0 ? us : 1.0);
    for (size_t i = (size_t)blockIdx.x * 256 + threadIdx.x; i < n; i += (size_t)gridDim.x * 256) out[i] = cst;
}
#endif
extern "C" void kernel_launch(void* const* d_in, const int* in_sizes, int n_in, void* d_out, int out_size,
                              void* d_ws, size_t ws_size, hipStream_t stream) {
    Params p{};
    const float** ins = (const float**)&p;
    for (int i = 0; i < 27; ++i) ins[i] = (const float*)d_in[i];
    p.out = (float*)d_out;

    char* ws = (char*)d_ws;
    p.ws = ws;
    if (WS_TOTAL > ws_size) return;
#if DBG
    size_t off = 0;
    auto alloc = [&](size_t bytes) { char* q = ws + off; off += (bytes + 255) & ~(size_t)255; return q; };
    NaiveBufs nb{};
    nb.mod = (float*)alloc(4 * 6144 * 4);
    nb.h = (float*)alloc((size_t)NTOK * 1024 * 4);
    nb.proj = (float*)alloc((size_t)NTOK * IN_COLS * 4);
    nb.flat = (float*)alloc((size_t)2040 * 2048 * 4);
    nb.hidk = (float*)alloc((size_t)2040 * 256 * 4);
    nb.hidv = (float*)alloc((size_t)2040 * 256 * 4);
    nb.kc = (float*)alloc((size_t)2040 * 64 * 4);
    nb.vc = (float*)alloc((size_t)2040 * 64 * 4);
    nb.mix = (float*)alloc((size_t)NTOK * 1024 * 4);
    nb.ograw = (float*)alloc((size_t)NTOK * 512 * 4);
    nb.y = (float*)alloc((size_t)NTOK * 1024 * 4);
    nb.x1 = (float*)alloc((size_t)NTOK * 1024 * 4);
    nb.logits = (float*)alloc((size_t)NTOK * 256 * 4);
    float* dbg = (float*)alloc(1024);
    if (off > WS_BASE) return;
#endif

    static int grid = 0;
    if (grid == 0) {
        int dev = 0, cus = 0, per_cu = 0;
        (void)hipGetDevice(&dev);
        (void)hipDeviceGetAttribute(&cus, hipDeviceAttributeMultiprocessorCount, dev);
        (void)hipFuncSetAttribute((const void*)mega, hipFuncAttributeMaxDynamicSharedMemorySize, MEGA_SMEM);
        (void)hipOccupancyMaxActiveBlocksPerMultiprocessor(&per_cu, (const void*)mega, 256, MEGA_SMEM);
        if (per_cu > 2) per_cu = 2;
        if (per_cu < 1) per_cu = 1;
        grid = cus * per_cu;
        grid &= ~7;
    }
    (void)hipMemsetAsync(ws + OFF_bar, 0, XCD_BAR_WORDS * 4, stream);

#if DBG
    (void)hipMemsetAsync(dbg, 0, 1024, stream);
    nk_mod<<<dim3(24, 4), 256, 0, stream>>>(p.c, p.w_mod, p.b_mod, nb.mod);
    nk_lnmod<<<NTOK, 256, 0, stream>>>(p.x, nb.mod, 0, 1024, nb.h);
    nk_gemm<<<dim3((IN_COLS + 63) / 64, NTOK / 64), 256, 0, stream>>>(nb.h, 1024, p.w_in, IN_COLS, nb.proj, IN_COLS, NTOK, IN_COLS, 1024);
    nk_flat<<<2040, 256, 0, stream>>>(nb.proj, C_KC, p.pos_k, nb.flat);
    nk_gemm<<<dim3(4, 32), 256, 0, stream>>>(nb.flat, 2048, p.w1_k, 256, nb.hidk, 256, 2040, 256, 2048);
    nk_silu<<<(2040 * 256 + 255) / 256, 256, 0, stream>>>(nb.hidk, 2040 * 256);
    nk_gemm<<<dim3(1, 32), 256, 0, stream>>>(nb.hidk, 256, p.w2_k, 64, nb.kc, 64, 2040, 64, 256);
    nk_flat<<<2040, 256, 0, stream>>>(nb.proj, C_VC, p.pos_v, nb.flat);
    nk_gemm<<<dim3(4, 32), 256, 0, stream>>>(nb.flat, 2048, p.w1_v, 256, nb.hidv, 256, 2040, 256, 2048);
    nk_silu<<<(2040 * 256 + 255) / 256, 256, 0, stream>>>(nb.hidv, 2040 * 256);
    nk_gemm<<<dim3(1, 32), 256, 0, stream>>>(nb.hidv, 256, p.w2_v, 64, nb.vc, 64, 2040, 64, 256);
    nk_nsa<<<NTOK, 256, 0, stream>>>(nb.proj, nb.kc, nb.vc, nb.mix);
    nk_gla<<<64, 256, 0, stream>>>(nb.proj, p.w_a2, p.b_a2, nb.ograw);
    nk_gla_norm<<<NTOK, 256, 0, stream>>>(nb.ograw, nb.proj, p.norm_w, nb.mix);
    nk_gemm<<<dim3(16, NTOK / 64), 256, 0, stream>>>(nb.mix, 1024, p.w_o, 1024, nb.y, 1024, NTOK, 1024, 1024);
    nk_resln<<<NTOK, 256, 0, stream>>>(p.x, nb.y, nb.mod, 2048, p.ln1_g, p.ln1_b, nb.x1);
    nk_lnmod<<<NTOK, 256, 0, stream>>>(nb.x1, nb.mod, 3072, 4096, nb.h);
    nk_gemm<<<dim3(4, NTOK / 64), 256, 0, stream>>>(nb.h, 1024, p.w_router, 256, nb.logits, 256, NTOK, 256, 1024);
    auto cmp = [&](int seam, size_t n) { dbg_compare<<<1024, 256, 0, stream>>>(seam, n, p, nb, dbg); };
#endif

#if SINGLE_LAUNCH
    p.ph_lo = 0; p.ph_hi = N_PHASES;
    mega<<<grid, 256, MEGA_SMEM, stream>>>(p);
#else
    for (int ph = 0; ph < N_PHASES; ++ph) {
        p.ph_lo = ph; p.ph_hi = ph + 1;
        mega<<<grid, 256, MEGA_SMEM, stream>>>(p);
#if DBG
        if (ph == 0) cmp(0, 4 * 6144);
        if (ph == 2) { cmp(1, (size_t)NTOK * PCOLS); cmp(2, (size_t)2 * BATCH * 128 * SEQ); cmp(3, (size_t)BATCH * 512 * SEQ + (size_t)NTOK * 40); }
        if (ph == 4) cmp(4, (size_t)2 * BATCH * NCMP * 128);
        if (ph == 5) { cmp(5, (size_t)NTOK * 512); cmp(6, (size_t)NTOK * 512); }
        if (ph == 7) cmp(7, (size_t)NTOK * 1024);
        if (ph == 8) cmp(8, (size_t)NTOK * 256);
#endif
    }
#endif
#ifdef PHPROF
    phase_prof_apply<<<1024, 256, 0, stream>>>((const unsigned long long*)(ws + OFF_counts + 1536), p.out, (size_t)NTOK * 1024, PHPROF);
#endif
#ifdef PROF
    prof_apply<<<1024, 256, 0, stream>>>((const unsigned long long*)(ws + OFF_counts + 1024), p.out, (size_t)NTOK * 1024, PROF);
#endif
#if DBG
    dbg_decide<<<1, 1, 0, stream>>>(dbg, 9, DBG_REPORT);
    dbg_apply<<<1024, 256, 0, stream>>>(dbg, p.out, (size_t)NTOK * 1024);
#endif
}
```

```cpp
#include <hip/hip_runtime.h>
#include <hip/hip_bf16.h>
#include <stdint.h>

#define D_MODEL 1024
#define BATCH 4
#define SEQ 4096
#define NTOK (BATCH * SEQ)
#define IN_COLS 2856
#define NCMP 255
#define NEGF (-1e30f)
#define C_NQ 0
#define C_KC 512
#define C_VC 640
#define C_KS 768
#define C_VS 896
#define C_KW 1024
#define C_VW 1152
#define C_NG 1280
#define C_GQ 1304
#define C_GK 1560
#define C_GV 1816
#define C_GLR 2328
#define C_GR 2344
#define N_EXP 256
#define TOPK 8

__device__ __forceinline__ float siluf(float x) { return x / (1.f + __expf(-x)); }
__device__ __forceinline__ float sigmoidf_(float x) { return 1.f / (1.f + __expf(-x)); }

__device__ __forceinline__ float blk_sum(float v, float* red) {
    int t = threadIdx.x;
    __syncthreads();
    red[t] = v; __syncthreads();
    for (int s = 128; s > 0; s >>= 1) { if (t < s) red[t] += red[t + s]; __syncthreads(); }
    float r = red[0];
    return r;
}
__device__ __forceinline__ float blk_max(float v, float* red) {
    int t = threadIdx.x;
    __syncthreads();
    red[t] = v; __syncthreads();
    for (int s = 128; s > 0; s >>= 1) { if (t < s) red[t] = fmaxf(red[t], red[t + s]); __syncthreads(); }
    float r = red[0];
    return r;
}

#define DBG 0
#define SINGLE_LAUNCH 1
#define DBG_REPORT -1
#define REP_PHASE -1
#if DBG
__global__ __launch_bounds__(256) void nk_mod(const float* c, const float* w_mod, const float* b_mod, float* mod) {
    int j = blockIdx.x * 256 + threadIdx.x; int b = blockIdx.y;
    float acc = b_mod[j];
    for (int k = 0; k < D_MODEL; ++k) acc += siluf(c[b * D_MODEL + k]) * w_mod[(size_t)k * 6144 + j];
    mod[b * 6144 + j] = acc;
}

__global__ __launch_bounds__(256) void nk_lnmod(const float* x, const float* mod, int sh_off, int sc_off, float* out) {
    __shared__ float red[256];
    int row = blockIdx.x; int b = row / SEQ; int t = threadIdx.x;
    const float* xr = x + (size_t)row * D_MODEL;
    float v[4]; float s = 0.f;
    for (int i = 0; i < 4; ++i) { v[i] = xr[t + 256 * i]; s += v[i]; }
    float mu = blk_sum(s, red) * (1.f / D_MODEL);
    float q = 0.f;
    for (int i = 0; i < 4; ++i) { float d = v[i] - mu; q += d * d; }
    float var = blk_sum(q, red) * (1.f / D_MODEL);
    float rstd = rsqrtf(var + 1e-5f);
    for (int i = 0; i < 4; ++i) {
        int col = t + 256 * i;
        out[(size_t)row * D_MODEL + col] = (v[i] - mu) * rstd * (1.f + mod[b * 6144 + sc_off + col]) + mod[b * 6144 + sh_off + col];
    }
}

__global__ __launch_bounds__(256) void nk_resln(const float* x, const float* y, const float* mod, int ga_off, const float* g, const float* bb, float* out) {
    __shared__ float red[256];
    int row = blockIdx.x; int b = row / SEQ; int t = threadIdx.x;
    const float alpha = 1.189207115f;
    float v[4]; float s = 0.f;
    for (int i = 0; i < 4; ++i) {
        int col = t + 256 * i;
        v[i] = alpha * x[(size_t)row * D_MODEL + col] + (1.f + mod[b * 6144 + ga_off + col]) * y[(size_t)row * D_MODEL + col];
        s += v[i];
    }
    float mu = blk_sum(s, red) * (1.f / D_MODEL);
    float q = 0.f;
    for (int i = 0; i < 4; ++i) { float d = v[i] - mu; q += d * d; }
    float var = blk_sum(q, red) * (1.f / D_MODEL);
    float rstd = rsqrtf(var + 1e-5f);
    for (int i = 0; i < 4; ++i) {
        int col = t + 256 * i;
        out[(size_t)row * D_MODEL + col] = (v[i] - mu) * rstd * g[col] + bb[col];
    }
}

__global__ __launch_bounds__(256) void nk_gemm(const float* A, int lda, const float* B, int ldb, float* C, int ldc, int M, int N, int K) {
    __shared__ float sA[16][64 + 1];
    __shared__ float sB[16][64 + 1];
    int tx = threadIdx.x & 15, ty = threadIdx.x >> 4;
    int m0 = blockIdx.y * 64, n0 = blockIdx.x * 64;
    float acc[4][4];
    for (int i = 0; i < 4; ++i) for (int j = 0; j < 4; ++j) acc[i][j] = 0.f;
    for (int k0 = 0; k0 < K; k0 += 16) {
        for (int e = threadIdx.x; e < 1024; e += 256) {
            int r = e >> 4, kk = e & 15;
            int gm = m0 + r;
            sA[kk][r] = (gm < M) ? A[(size_t)gm * lda + k0 + kk] : 0.f;
            int kb = e >> 6, nn = e & 63;
            int gn = n0 + nn;
            sB[kb][nn] = (gn < N) ? B[(size_t)(k0 + kb) * ldb + gn] : 0.f;
        }
        __syncthreads();
#pragma unroll
        for (int kk = 0; kk < 16; ++kk) {
            float a[4], bv[4];
#pragma unroll
            for (int i = 0; i < 4; ++i) a[i] = sA[kk][ty * 4 + i];
#pragma unroll
            for (int j = 0; j < 4; ++j) bv[j] = sB[kk][tx * 4 + j];
#pragma unroll
            for (int i = 0; i < 4; ++i)
#pragma unroll
                for (int j = 0; j < 4; ++j) acc[i][j] += a[i] * bv[j];
        }
        __syncthreads();
    }
#pragma unroll
    for (int i = 0; i < 4; ++i)
#pragma unroll
        for (int j = 0; j < 4; ++j) {
            int gm = m0 + ty * 4 + i, gn = n0 + tx * 4 + j;
            if (gm < M && gn < N) C[(size_t)gm * ldc + gn] = acc[i][j];
        }
}

__global__ __launch_bounds__(256) void nk_flat(const float* proj, int col0, const float* pos, float* flat) {
    int r = blockIdx.x;
    int g = r & 1; int bi = r >> 1; int i = bi % NCMP; int b = bi / NCMP;
    for (int e = threadIdx.x; e < 2048; e += 256) {
        int l = e >> 6, d = e & 63;
        flat[(size_t)r * 2048 + e] = proj[((size_t)b * SEQ + 16 * i + l) * IN_COLS + col0 + g * 64 + d] + pos[l * 64 + d];
    }
}
__global__ void nk_silu(float* x, int n) { int i = blockIdx.x * 256 + threadIdx.x; if (i < n) x[i] = siluf(x[i]); }

__global__ __launch_bounds__(256) void nk_nsa(const float* proj, const float* kc, const float* vc, float* mix) {
    __shared__ float sq[8][64];
    __shared__ float sp[1024];
    __shared__ float red[256];
    __shared__ float simp[64];
    __shared__ float sscore[64];
    __shared__ int sidx[16];
    __shared__ float sout[8][64];
    __shared__ float spart[4][64];
    const int tid = threadIdx.x;
    const int bt = blockIdx.x; const int b = bt / SEQ, t = bt % SEQ;
    const float* prow = proj + (size_t)bt * IN_COLS;
    for (int e = tid; e < 512; e += 256) { sq[e >> 6][e & 63] = prow[C_NQ + e] * 0.125f; sout[e >> 6][e & 63] = 0.f; }
    __syncthreads();
    const int tblk = t >> 6;
    const int dd = tid & 63, part = tid >> 6;
    for (int g = 0; g < 2; ++g) {
        if (tid < 64) simp[tid] = 0.f;
        __syncthreads();
        for (int hp = 0; hp < 4; ++hp) {
            int h = g * 4 + hp;
            float slope = exp2f(-(float)(h + 1));
            float s = NEGF; bool valid = false;
            if (tid < NCMP) {
                int ce = 16 * tid + 31;
                valid = (t >= ce);
                if (valid) {
                    const float* kr = kc + (((size_t)b * NCMP + tid) * 2 + g) * 64;
                    float a = 0.f;
                    for (int d = 0; d < 64; ++d) a += sq[h][d] * kr[d];
                    s = a - slope * (float)(t - ce);
                }
            }
            float m = blk_max(s, red);
            float e = valid ? __expf(s - m) : 0.f;
            float sum = blk_sum(e, red);
            float p = e / fmaxf(sum, 1e-30f);
            __syncthreads();
            sp[tid] = p;
            __syncthreads();
            float a = 0.f;
            for (int i = part; i < NCMP; i += 4) a += sp[i] * vc[(((size_t)b * NCMP + i) * 2 + g) * 64 + dd];
            spart[part][dd] = a;
            __syncthreads();
            if (tid < 64) {
                float o = spart[0][tid] + spart[1][tid] + spart[2][tid] + spart[3][tid];
                float gate = sigmoidf_(prow[C_NG + h * 3 + 0]);
                sout[h][tid] += gate * o;
                int j = tid;
                float im = sp[4 * j] + sp[4 * j + 1] + sp[4 * j + 2] + 0.5f * sp[4 * j + 3] + (j > 0 ? 0.5f * sp[4 * j - 1] : 0.f);
                simp[j] += im;
            }
            __syncthreads();
        }
        if (tid < 64) {
            int j = tid;
            bool forced = (j == 0) || (j == tblk) || (j == tblk - 1);
            sscore[j] = (j <= tblk) ? (simp[j] + (forced ? 1e4f : 0.f)) : NEGF;
        }
        __syncthreads();
        if (tid < 64) {
            int j = tid; float sj = sscore[j]; int rank = 0;
            for (int j2 = 0; j2 < 64; ++j2) { float s2 = sscore[j2]; if (s2 > sj || (s2 == sj && j2 < j)) ++rank; }
            if (rank < 16) sidx[rank] = j;
        }
        __syncthreads();
        for (int hp = 0; hp < 4; ++hp) {
            int h = g * 4 + hp;
            float slope = exp2f(-(float)(h + 1));
            float sv[4]; bool vl[4]; float mx = NEGF;
            for (int r = 0; r < 4; ++r) {
                int kk = tid + 256 * r;
                int kpos = sidx[kk >> 6] * 64 + (kk & 63);
                vl[r] = (kpos <= t);
                sv[r] = NEGF;
                if (vl[r]) {
                    const float* kr = proj + ((size_t)b * SEQ + kpos) * IN_COLS + C_KS + g * 64;
                    float a = 0.f;
                    for (int d = 0; d < 64; ++d) a += sq[h][d] * kr[d];
                    sv[r] = a - slope * (float)(t - kpos);
                }
                mx = fmaxf(mx, sv[r]);
            }
            float m = blk_max(mx, red);
            float es = 0.f; float ev[4];
            for (int r = 0; r < 4; ++r) { ev[r] = vl[r] ? __expf(sv[r] - m) : 0.f; es += ev[r]; }
            float sum = blk_sum(es, red);
            float inv = 1.f / fmaxf(sum, 1e-30f);
            __syncthreads();
            for (int r = 0; r < 4; ++r) sp[tid + 256 * r] = ev[r] * inv;
            __syncthreads();
            float a = 0.f;
            for (int kk = part; kk < 1024; kk += 4) {
                float p = sp[kk];
                if (p != 0.f) {
                    int kpos = sidx[kk >> 6] * 64 + (kk & 63);
                    a += p * proj[((size_t)b * SEQ + kpos) * IN_COLS + C_VS + g * 64 + dd];
                }
            }
            spart[part][dd] = a;
            __syncthreads();
            if (tid < 64) {
                float o = spart[0][tid] + spart[1][tid] + spart[2][tid] + spart[3][tid];
                float gate = sigmoidf_(prow[C_NG + h * 3 + 1]);
                sout[h][tid] += gate * o;
            }
            __syncthreads();
        }
        for (int hp = 0; hp < 4; ++hp) {
            int h = g * 4 + hp;
            float slope = exp2f(-(float)(h + 1));
            float sv[2]; bool vl[2]; float mx = NEGF;
            for (int r = 0; r < 2; ++r) {
                int kk = tid + 256 * r;
                int kpos = t - 511 + kk;
                vl[r] = (kpos >= 0);
                sv[r] = NEGF;
                if (vl[r]) {
                    const float* kr = proj + ((size_t)b * SEQ + kpos) * IN_COLS + C_KW + g * 64;
                    float a = 0.f;
                    for (int d = 0; d < 64; ++d) a += sq[h][d] * kr[d];
                    sv[r] = a - slope * (float)(t - kpos);
                }
                mx = fmaxf(mx, sv[r]);
            }
            float m = blk_max(mx, red);
            float es = 0.f; float ev[2];
            for (int r = 0; r < 2; ++r) { ev[r] = vl[r] ? __expf(sv[r] - m) : 0.f; es += ev[r]; }
            float sum = blk_sum(es, red);
            float inv = 1.f / fmaxf(sum, 1e-30f);
            __syncthreads();
            for (int r = 0; r < 2; ++r) sp[tid + 256 * r] = ev[r] * inv;
            __syncthreads();
            float a = 0.f;
            for (int kk = part; kk < 512; kk += 4) {
                float p = sp[kk];
                if (p != 0.f) {
                    int kpos = t - 511 + kk;
                    a += p * proj[((size_t)b * SEQ + kpos) * IN_COLS + C_VW + g * 64 + dd];
                }
            }
            spart[part][dd] = a;
            __syncthreads();
            if (tid < 64) {
                float o = spart[0][tid] + spart[1][tid] + spart[2][tid] + spart[3][tid];
                float gate = sigmoidf_(prow[C_NG + h * 3 + 2]);
                sout[h][tid] += gate * o;
            }
            __syncthreads();
        }
    }
    for (int e = tid; e < 512; e += 256) mix[(size_t)bt * D_MODEL + e] = sout[e >> 6][e & 63];
}

__global__ __launch_bounds__(256) void nk_gla(const float* proj, const float* w_a2, const float* b_a2, float* ograw) {
    __shared__ float sqv[64], skv[64], sav[64];
    __shared__ float red[8][32];
    const int tid = threadIdx.x;
    const int es = blockIdx.x & 3, bh = blockIdx.x >> 2, h = bh & 3, b = bh >> 2;
    const int e = tid & 31, dg = tid >> 5;
    float S[8];
    for (int i = 0; i < 8; ++i) S[i] = 0.f;
    for (int t = 0; t < SEQ; ++t) {
        const float* prow = proj + ((size_t)b * SEQ + t) * IN_COLS;
        if (tid < 64) {
            int d = tid;
            sqv[d] = prow[C_GQ + h * 64 + d] * 0.125f;
            skv[d] = prow[C_GK + h * 64 + d];
            float x = b_a2[h * 64 + d];
            for (int r = 0; r < 16; ++r) x += prow[C_GLR + r] * w_a2[r * 256 + h * 64 + d];
            float ls = -(fmaxf(-x, 0.f) + log1pf(__expf(-fabsf(x))));
            sav[d] = __expf(ls * (1.f / 16.f));
        }
        __syncthreads();
        float v = prow[C_GV + h * 128 + es * 32 + e];
        float part = 0.f;
        for (int i = 0; i < 8; ++i) {
            int d = dg * 8 + i;
            S[i] = sav[d] * S[i] + skv[d] * v;
            part += sqv[d] * S[i];
        }
        red[dg][e] = part;
        __syncthreads();
        if (tid < 32) {
            float o = 0.f;
            for (int i = 0; i < 8; ++i) o += red[i][tid];
            ograw[((size_t)b * SEQ + t) * 512 + h * 128 + es * 32 + tid] = o;
        }
    }
}
__global__ __launch_bounds__(256) void nk_gla_norm(const float* ograw, const float* proj, const float* norm_w, float* mix) {
    int wid = (blockIdx.x * 256 + threadIdx.x) >> 6; int lane = threadIdx.x & 63;
    int tok = wid >> 2, h = wid & 3;
    const float* o = ograw + (size_t)tok * 512 + h * 128;
    float a = o[lane], c = o[lane + 64];
    float s = a + c;
    for (int m = 32; m > 0; m >>= 1) s += __shfl_xor(s, m);
    float mu = s * (1.f / 128.f);
    float q = (a - mu) * (a - mu) + (c - mu) * (c - mu);
    for (int m = 32; m > 0; m >>= 1) q += __shfl_xor(q, m);
    float rstd = rsqrtf(q * (1.f / 128.f) + 1e-5f);
    const float* r = proj + (size_t)tok * IN_COLS + C_GR + h * 128;
    mix[(size_t)tok * D_MODEL + 512 + h * 128 + lane] = (a - mu) * rstd * norm_w[lane] * siluf(r[lane]);
    mix[(size_t)tok * D_MODEL + 512 + h * 128 + lane + 64] = (c - mu) * rstd * norm_w[lane + 64] * siluf(r[lane + 64]);
}

__global__ __launch_bounds__(256) void nk_route(const float* logits, const float* rbias, int* eidx, float* ew, int* counts, int* lists) {
    int wid = (blockIdx.x * 256 + threadIdx.x) >> 6; int lane = threadIdx.x & 63;
    int tok = wid;
    float s[4], sb[4];
    for (int i = 0; i < 4; ++i) { float l = logits[(size_t)tok * 256 + lane * 4 + i]; s[i] = 1.f / (1.f + __expf(-l)); sb[i] = s[i] + rbias[lane * 4 + i]; }
    float m1 = NEGF, m2 = NEGF;
    for (int i = 0; i < 4; ++i) { float v = sb[i]; if (v > m1) { m2 = m1; m1 = v; } else if (v > m2) m2 = v; }
    for (int m = 1; m < 8; m <<= 1) {
        float o1 = __shfl_xor(m1, m), o2 = __shfl_xor(m2, m);
        float n1 = fmaxf(m1, o1);
        float n2 = fmaxf(fminf(m1, o1), fmaxf(m2, o2));
        m1 = n1; m2 = n2;
    }
    float gs = m1 + m2;
    int grp = lane >> 3;
    int grank = 0;
    for (int g2 = 0; g2 < 8; ++g2) { float o = __shfl(gs, g2 * 8); if (o > gs || (o == gs && g2 < grp)) ++grank; }
    bool gsel = grank < 4;
    float cand[4];
    for (int i = 0; i < 4; ++i) cand[i] = gsel ? sb[i] : NEGF;
    float wsum = 0.f; float myw = 0.f; int mye = 0;
    for (int k = 0; k < TOPK; ++k) {
        float bv = cand[0]; int bi = 0;
        for (int i = 1; i < 4; ++i) if (cand[i] > bv) { bv = cand[i]; bi = i; }
        int be = lane * 4 + bi;
        float gv = bv; int ge = be;
        for (int m = 1; m < 64; m <<= 1) {
            float ov = __shfl_xor(gv, m); int oe = __shfl_xor(ge, m);
            if (ov > gv || (ov == gv && oe < ge)) { gv = ov; ge = oe; }
        }
        float sel_s = 0.f;
        if ((ge >> 2) == lane) {
            int i = ge & 3;
            sel_s = (i == 0) ? s[0] : (i == 1) ? s[1] : (i == 2) ? s[2] : s[3];
            if (i == 0) cand[0] = -3e38f; else if (i == 1) cand[1] = -3e38f; else if (i == 2) cand[2] = -3e38f; else cand[3] = -3e38f;
        }
        sel_s = __shfl(sel_s, ge >> 2);
        wsum += sel_s;
        if (lane == k) { myw = sel_s; mye = ge; }
    }
    if (lane < TOPK) {
        float w = myw / wsum * 2.5f;
        eidx[tok * 8 + lane] = mye; ew[tok * 8 + lane] = w;
        int pos = atomicAdd(&counts[mye], 1);
        lists[(size_t)mye * NTOK + pos] = tok * 8 + lane;
    }
}

__global__ __launch_bounds__(256) void nk_moe(const float* h2, const float* wg, const float* wu, const float* wd,
                                              const float* sg, const float* su, const float* sd,
                                              const int* counts, const int* lists, const float* ew, float* acc) {
    __shared__ float sh[8][D_MODEL];
    __shared__ float shid[8][256];
    __shared__ int stok[8]; __shared__ float sw[8];
    const int e = blockIdx.y, chunk = blockIdx.x, tid = threadIdx.x;
    const int cnt = (e == N_EXP) ? NTOK : counts[e];
    if (chunk * 8 >= cnt) return;
    const float* Wg = (e == N_EXP) ? sg : wg + (size_t)e * D_MODEL * 256;
    const float* Wu = (e == N_EXP) ? su : wu + (size_t)e * D_MODEL * 256;
    const float* Wd = (e == N_EXP) ? sd : wd + (size_t)e * 256 * D_MODEL;
    if (tid < 8) {
        int p = chunk * 8 + tid;
        if (p < cnt) {
            if (e == N_EXP) { stok[tid] = p; sw[tid] = 1.f; }
            else { int id = lists[(size_t)e * NTOK + p]; stok[tid] = id >> 3; sw[tid] = ew[id]; }
        } else { stok[tid] = -1; sw[tid] = 0.f; }
    }
    __syncthreads();
    for (int m = 0; m < 8; ++m) {
        int tk = stok[m];
        for (int k = tid; k < D_MODEL; k += 256) sh[m][k] = (tk >= 0) ? h2[(size_t)tk * D_MODEL + k] : 0.f;
    }
    __syncthreads();
    float ag[8], au[8];
#pragma unroll
    for (int m = 0; m < 8; ++m) { ag[m] = 0.f; au[m] = 0.f; }
    for (int k = 0; k < D_MODEL; ++k) {
        float g = Wg[(size_t)k * 256 + tid], u = Wu[(size_t)k * 256 + tid];
#pragma unroll
        for (int m = 0; m < 8; ++m) { float hv = sh[m][k]; ag[m] += hv * g; au[m] += hv * u; }
    }
#pragma unroll
    for (int m = 0; m < 8; ++m) shid[m][tid] = siluf(ag[m]) * au[m];
    __syncthreads();
    for (int jj = 0; jj < 4; ++jj) {
        int j = tid + 256 * jj;
        float ao[8];
#pragma unroll
        for (int m = 0; m < 8; ++m) ao[m] = 0.f;
        for (int n = 0; n < 256; ++n) {
            float w = Wd[(size_t)n * D_MODEL + j];
#pragma unroll
            for (int m = 0; m < 8; ++m) ao[m] += shid[m][n] * w;
        }
#pragma unroll
        for (int m = 0; m < 8; ++m) { int tk = stok[m]; if (tk >= 0) atomicAdd(&acc[(size_t)tk * D_MODEL + j], ao[m] * sw[m]); }
    }
}

#endif
typedef unsigned short bf16_t;
typedef short bf16x8 __attribute__((ext_vector_type(8)));
typedef float f32x4 __attribute__((ext_vector_type(4)));
typedef unsigned u32x4 __attribute__((ext_vector_type(4)));
typedef unsigned u32x2 __attribute__((ext_vector_type(2)));

#define PCOLS 2944
#define P_NQ 0
#define P_KC 512
#define P_VC 640
#define P_KS 768
#define P_VS 896
#define P_KW 1024
#define P_VW 1152
#define P_GQ 1280
#define P_GK 1536
#define P_GV 1792
#define P_GR 2304
#define P_MISC 2816
#define NASSIGN 9
#define LOG2E 1.4426950408889634f

typedef float f32x2_t __attribute__((ext_vector_type(2)));
typedef __bf16 bf16x2_t __attribute__((ext_vector_type(2)));
__device__ __forceinline__ unsigned pk_bf16(float lo, float hi) { const f32x2_t v = {lo, hi}; return __builtin_bit_cast(unsigned, __builtin_convertvector(v, bf16x2_t)); }
__device__ __forceinline__ float bflo(unsigned u) { return __uint_as_float(u << 16); }
__device__ __forceinline__ float bfhi(unsigned u) { return __uint_as_float(u & 0xffff0000u); }
__device__ __forceinline__ float bf2f(bf16_t v) { return __uint_as_float(((unsigned)v) << 16); }
__device__ __forceinline__ int opaque_tid() { int t = threadIdx.x; asm volatile("" : "+v"(t)); return t; }
__device__ __forceinline__ bf16_t f2bf(float f) { return (bf16_t)(pk_bf16(f, 0.f) & 0xffffu); }

#if DBG
#define WS_BASE ((size_t)560 << 20)
#else
#define WS_BASE ((size_t)0)
#endif
#define WS_ALIGN(x) (((size_t)(x) + 255) & ~(size_t)255)
constexpr size_t OFF_mod = WS_BASE;
constexpr size_t OFF_bias1 = OFF_mod + WS_ALIGN(4*6144*4);
constexpr size_t OFF_wint = OFF_bias1 + WS_ALIGN(2*256*4);
constexpr size_t OFF_wot = OFF_wint + WS_ALIGN((size_t)PCOLS*1024*2);
constexpr size_t OFF_wrt = OFF_wot + WS_ALIGN((size_t)1024*1024*2);
constexpr size_t OFF_w1t = OFF_wrt + WS_ALIGN((size_t)256*1024*2);
constexpr size_t OFF_w2t = OFF_w1t + WS_ALIGN((size_t)2*256*2048*2);
constexpr size_t OFF_hb = OFF_w2t + WS_ALIGN((size_t)2*64*256*2);
constexpr size_t OFF_Pb = OFF_hb + WS_ALIGN((size_t)NTOK*1024*2);
constexpr size_t OFF_VsT = OFF_Pb + WS_ALIGN((size_t)NTOK*PCOLS*2);
constexpr size_t OFF_VwT = OFF_VsT + WS_ALIGN((size_t)BATCH*128*SEQ*2);
constexpr size_t OFF_VgT = OFF_VwT + WS_ALIGN((size_t)BATCH*128*SEQ*2);
constexpr size_t OFF_misc = OFF_VgT + WS_ALIGN((size_t)BATCH*512*SEQ*2);
constexpr size_t OFF_cpart = OFF_misc + WS_ALIGN((size_t)NTOK*64*4);
constexpr size_t OFF_kc = OFF_cpart + WS_ALIGN((size_t)2*4*2048*256*4);
constexpr size_t OFF_vcT = OFF_kc + WS_ALIGN((size_t)8*256*64*2);
constexpr size_t OFF_dST = OFF_vcT + WS_ALIGN((size_t)8*64*256*2);
constexpr size_t OFF_dec = OFF_dST + WS_ALIGN((size_t)16*64*8192*4);
constexpr size_t OFF_ST = OFF_dec + WS_ALIGN((size_t)16*64*64*4);
constexpr size_t OFF_mixf = OFF_ST + WS_ALIGN((size_t)16*64*8192*2);
constexpr size_t OFF_mixb = OFF_mixf + WS_ALIGN((size_t)NTOK*512*4);
constexpr size_t OFF_y1 = OFF_mixb + WS_ALIGN((size_t)NTOK*1024*2);
constexpr size_t OFF_x1 = OFF_y1 + WS_ALIGN((size_t)NTOK*1024*4);
constexpr size_t OFF_logits = OFF_x1 + WS_ALIGN((size_t)NTOK*1024*4);
constexpr size_t OFF_ew = OFF_logits + WS_ALIGN((size_t)NTOK*256*4);
constexpr size_t OFF_counts = OFF_ew + WS_ALIGN((size_t)NTOK*NASSIGN*4);
constexpr size_t OFF_lists = OFF_counts + WS_ALIGN(512*4);
constexpr size_t OFF_bar = OFF_lists + WS_ALIGN((size_t)N_EXP*NTOK*4);
constexpr size_t OFF_hid = OFF_bar + WS_ALIGN(4096*4);
constexpr size_t OFF_outk = OFF_hid + WS_ALIGN((size_t)NTOK*NASSIGN*256*2);
constexpr size_t OFF_selm = OFF_outk + WS_ALIGN((size_t)NTOK*NASSIGN*1024*2);
constexpr size_t OFF_selu = OFF_selm + WS_ALIGN((size_t)NTOK*2*8);
constexpr size_t OFF_mixf2 = OFF_selu + WS_ALIGN((size_t)8*64*4*8);
constexpr size_t OFF_bsave = OFF_mixf2 + WS_ALIGN((size_t)NTOK*512*4);
constexpr size_t WS_TOTAL = OFF_bsave + WS_ALIGN((size_t)1024*4096*4);
struct Params {
    const float *x, *c, *w_mod, *b_mod, *w_in, *pos_k, *w1_k, *w2_k, *pos_v, *w1_v, *w2_v, *w_a2, *b_a2, *norm_w, *w_o, *ln1_g, *ln1_b,
        *w_router, *rbias, *w_e_gate, *w_e_up, *w_e_down, *w_s_gate, *w_s_up, *w_s_down, *ln2_g, *ln2_b;
    float* out;
    char* ws;
    int ph_lo, ph_hi;
    __device__ __forceinline__ float* mod() const { return (float*)(ws + OFF_mod); }
    __device__ __forceinline__ float* bias1() const { return (float*)(ws + OFF_bias1); }
    __device__ __forceinline__ bf16_t* wint() const { return (bf16_t*)(ws + OFF_wint); }
    __device__ __forceinline__ bf16_t* wot() const { return (bf16_t*)(ws + OFF_wot); }
    __device__ __forceinline__ bf16_t* wrt() const { return (bf16_t*)(ws + OFF_wrt); }
    __device__ __forceinline__ bf16_t* w1t() const { return (bf16_t*)(ws + OFF_w1t); }
    __device__ __forceinline__ bf16_t* w2t() const { return (bf16_t*)(ws + OFF_w2t); }
    __device__ __forceinline__ bf16_t* hb() const { return (bf16_t*)(ws + OFF_hb); }
    __device__ __forceinline__ bf16_t* Pb() const { return (bf16_t*)(ws + OFF_Pb); }
    __device__ __forceinline__ bf16_t* VsT() const { return (bf16_t*)(ws + OFF_VsT); }
    __device__ __forceinline__ bf16_t* VwT() const { return (bf16_t*)(ws + OFF_VwT); }
    __device__ __forceinline__ bf16_t* VgT() const { return (bf16_t*)(ws + OFF_VgT); }
    __device__ __forceinline__ float* misc() const { return (float*)(ws + OFF_misc); }
    __device__ __forceinline__ float* cpart() const { return (float*)(ws + OFF_cpart); }
    __device__ __forceinline__ bf16_t* kc() const { return (bf16_t*)(ws + OFF_kc); }
    __device__ __forceinline__ bf16_t* vcT() const { return (bf16_t*)(ws + OFF_vcT); }
    __device__ __forceinline__ float* dST() const { return (float*)(ws + OFF_dST); }
    __device__ __forceinline__ float* dec() const { return (float*)(ws + OFF_dec); }
    __device__ __forceinline__ bf16_t* ST() const { return (bf16_t*)(ws + OFF_ST); }
    __device__ __forceinline__ float* mixf() const { return (float*)(ws + OFF_mixf); }
    __device__ __forceinline__ bf16_t* mixb() const { return (bf16_t*)(ws + OFF_mixb); }
    __device__ __forceinline__ float* y1() const { return (float*)(ws + OFF_y1); }
    __device__ __forceinline__ float* x1() const { return (float*)(ws + OFF_x1); }
    __device__ __forceinline__ float* logits() const { return (float*)(ws + OFF_logits); }
    __device__ __forceinline__ float* ew() const { return (float*)(ws + OFF_ew); }
    __device__ __forceinline__ int* counts() const { return (int*)(ws + OFF_counts); }
    __device__ __forceinline__ int* lists() const { return (int*)(ws + OFF_lists); }
    __device__ __forceinline__ unsigned* bar() const { return (unsigned*)(ws + OFF_bar); }
    __device__ __forceinline__ bf16_t* hid() const { return (bf16_t*)(ws + OFF_hid); }
    __device__ __forceinline__ bf16_t* outk() const { return (bf16_t*)(ws + OFF_outk); }
};

#define LDS_ROW 72
#define TILE_BYTES 16384
#define GEMM_SMEM 69632
__device__ __forceinline__ int swz_key(int row) { return ((row >> 2) & 1) | ((((row >> 1) ^ (row >> 3)) & 1) << 1) | ((((row >> 2) ^ (row >> 4)) & 1) << 2); }
__device__ __forceinline__ int swz_off(int row, int chunk) { return row * 128 + ((chunk ^ swz_key(row)) << 4); }
typedef __attribute__((address_space(3))) unsigned lds_u32;

struct RowsBf16 {
    static constexpr bool NT = false;
    const bf16_t* base; size_t stride;
    __device__ __forceinline__ const bf16_t* ptr(int r, int k) const { return base + (size_t)r * stride + k; }
    __device__ __forceinline__ const bf16_t* pp(int i, int tid, int k) const { return ptr(i * 32 + (tid >> 3), k); }
};
struct GatherBf16 {
    static constexpr bool NT = true;
    const bf16_t* base; size_t stride; const int* rowidx;
    __device__ __forceinline__ const bf16_t* ptr(int r, int k) const { return base + (size_t)rowidx[r] * stride + k; }
    __device__ __forceinline__ const bf16_t* pp(int i, int tid, int k) const { return ptr(i * 32 + (tid >> 3), k); }
};
struct BF32Plain {
    const float* base; size_t ld;
    __device__ __forceinline__ f32x4 load4(int k, int r4) const { return *(const f32x4*)(base + (size_t)k * ld + r4); }
};
struct BF32GateUp {
    const float* g; long du; size_t ld;
    __device__ __forceinline__ f32x4 load4(int k, int r4) const {
        const long sel = ((r4 >> 5) & 1) ? du : 0l;
#ifdef NT_B
        return __builtin_nontemporal_load((const f32x4*)(g + sel + (size_t)k * ld + (r4 >> 6) * 32 + (r4 & 31)));
#else
        return *(const f32x4*)(g + sel + (size_t)k * ld + (r4 >> 6) * 32 + (r4 & 31));
#endif
    }
    __device__ __forceinline__ const float* addr(int k, int r4) const { const long sel = ((r4 >> 5) & 1) ? du : 0l; return g + sel + (size_t)k * ld + (r4 >> 6) * 32 + (r4 & 31); }
};

template <class L>
__device__ __forceinline__ void bf16_piece_load(u32x4& r, const L& ld, int k0, int i, int tid) { r = *(const u32x4*)ld.pp(i, tid, k0 + ((tid & 7) << 3)); }
__device__ __forceinline__ void bf16_piece_write(const u32x4& r, char* tile, int i, int tid) { *(u32x4*)(tile + swz_off(i * 32 + (tid >> 3), tid & 7)) = r; }
template <int J0, class BL>
__device__ __forceinline__ void f32_rows_load(f32x4 (&r)[8], const BL& bl, int k0, int tid) {
    const int kg = (tid >> 5) * 8, n4 = (tid & 31) * 4;
#pragma unroll
    for (int j = 0; j < 4; ++j) r[J0 + j] = bl.load4(k0 + kg + J0 + j, n4);
}
template <int I>
__device__ __forceinline__ void f32_col_write(const f32x4 (&r)[8], char* tile, int tid) {
    const int kgc = tid >> 5, n4 = (tid & 31) * 4;
    u32x4 w;
    w.x = pk_bf16(r[0][I], r[1][I]); w.y = pk_bf16(r[2][I], r[3][I]);
    w.z = pk_bf16(r[4][I], r[5][I]); w.w = pk_bf16(r[6][I], r[7][I]);
    *(u32x4*)(tile + swz_off(n4 + I, kgc)) = w;
}

#ifdef USE_SETPRIO
#define SETPRIO_HI __builtin_amdgcn_s_setprio(1);
#define SETPRIO_LO __builtin_amdgcn_s_setprio(0);
#else
#define SETPRIO_HI
#define SETPRIO_LO
#endif
template <bool SWAP, bool BF32, class AL, class BL, class EPI>
__device__ __forceinline__ void gemm_core(const AL& al, const BL& bl, int k_begin, int nk, int nkt, char* smem, f32x4 (&acc)[4][4], EPI&& epi) {
    const int tid = opaque_tid(), lane = tid & 63, wid = tid >> 6, wr = wid >> 1, wc = wid & 1, fr = lane & 15, fq = lane >> 4;
#pragma unroll
    for (int m = 0; m < 4; ++m)
#pragma unroll
        for (int n = 0; n < 4; ++n) acc[m][n] = (f32x4){0.f, 0.f, 0.f, 0.f};
    u32x4 ra[4]; u32x4 rb[4]; f32x4 rbf[8];
#ifdef L2PF
    float pf0 = 0.f;
#endif
#pragma unroll
    for (int i = 0; i < 4; ++i) { bf16_piece_load(ra[i], al, k_begin, i, tid); if constexpr (!BF32) bf16_piece_load(rb[i], bl, k_begin, i, tid); }
    if constexpr (BF32) { f32_rows_load<0>(rbf, bl, k_begin, tid); f32_rows_load<4>(rbf, bl, k_begin, tid); }
#pragma unroll
    for (int i = 0; i < 4; ++i) { bf16_piece_write(ra[i], smem, i, tid); if constexpr (!BF32) bf16_piece_write(rb[i], smem + TILE_BYTES, i, tid); }
    if constexpr (BF32) { f32_col_write<0>(rbf, smem + TILE_BYTES, tid); f32_col_write<1>(rbf, smem + TILE_BYTES, tid); f32_col_write<2>(rbf, smem + TILE_BYTES, tid); f32_col_write<3>(rbf, smem + TILE_BYTES, tid); }
    if (nk > 1) {
#pragma unroll
        for (int i = 0; i < 4; ++i) { bf16_piece_load(ra[i], al, k_begin + 64, i, tid); if constexpr (!BF32) bf16_piece_load(rb[i], bl, k_begin + 64, i, tid); }
        if constexpr (BF32) { f32_rows_load<0>(rbf, bl, k_begin + 64, tid); f32_rows_load<4>(rbf, bl, k_begin + 64, tid); }
    }
    __syncthreads();
    int tile = 0, kin = 0;
    for (int kt = 0; kt < nk; ++kt) {
        const char* sA = smem + (kt & 1) * 2 * TILE_BYTES; const char* sB = sA + TILE_BYTES;
        char* nA = smem + ((kt & 1) ^ 1) * 2 * TILE_BYTES; char* nB = nA + TILE_BYTES;
        const bool w1 = kt + 1 < nk, l2 = kt + 2 < nk;
        const int k2 = k_begin + (kt + 2) * 64;
#ifdef L2PF
        if constexpr (BF32) {
            asm volatile("" :: "v"(pf0));
            if (kt + L2PF < nk) pf0 = *bl.addr(k_begin + (kt + L2PF) * 64 + wid * 16 + (lane >> 2), (lane & 3) * 32);
        }
#endif
        bf16x8 a[2][4], b[2][4];
#pragma unroll
        for (int m = 0; m < 4; ++m) a[0][m] = *(const bf16x8*)(sA + swz_off(wr * 64 + m * 16 + fr, fq));
#pragma unroll
        for (int n = 0; n < 4; ++n) b[0][n] = *(const bf16x8*)(sB + swz_off(wc * 64 + n * 16 + fr, fq));
#define GEMM_MM(KS, M) \
            __builtin_amdgcn_sched_barrier(0); \
            _Pragma("unroll") for (int n = 0; n < 4; ++n) \
                acc[M][n] = SWAP ? __builtin_amdgcn_mfma_f32_16x16x32_bf16(b[KS][n], a[KS][M], acc[M][n], 0, 0, 0) \
                                 : __builtin_amdgcn_mfma_f32_16x16x32_bf16(a[KS][M], b[KS][n], acc[M][n], 0, 0, 0); \
            __builtin_amdgcn_sched_barrier(0);
#define GEMM_PA(G) { if (w1) bf16_piece_write(ra[G], nA, G, tid); if (l2) bf16_piece_load(ra[G], al, k2, G, tid); }
#define GEMM_PB(G) { \
            if constexpr (BF32) { \
                if constexpr ((G) == 0) { if (w1) { f32_col_write<0>(rbf, nB, tid); f32_col_write<1>(rbf, nB, tid); } } \
                if constexpr ((G) == 1) { if (w1) { f32_col_write<2>(rbf, nB, tid); f32_col_write<3>(rbf, nB, tid); } } \
                if constexpr ((G) == 2) { if (l2) f32_rows_load<0>(rbf, bl, k2, tid); } \
                if constexpr ((G) == 3) { if (l2) f32_rows_load<4>(rbf, bl, k2, tid); } \
            } else { \
                if (w1) bf16_piece_write(rb[G], nB, G, tid); \
                if (l2) bf16_piece_load(rb[G], bl, k2, G, tid); \
            } }
        GEMM_MM(0, 0) GEMM_PA(0) GEMM_MM(0, 1) GEMM_PB(0) GEMM_MM(0, 2) GEMM_PA(1) GEMM_MM(0, 3) GEMM_PB(1)
#pragma unroll
        for (int m = 0; m < 4; ++m) a[1][m] = *(const bf16x8*)(sA + swz_off(wr * 64 + m * 16 + fr, 4 + fq));
#pragma unroll
        for (int n = 0; n < 4; ++n) b[1][n] = *(const bf16x8*)(sB + swz_off(wc * 64 + n * 16 + fr, 4 + fq));
        GEMM_MM(1, 0) GEMM_PA(2) GEMM_MM(1, 1) GEMM_PB(2) GEMM_MM(1, 2) GEMM_PA(3) GEMM_MM(1, 3) GEMM_PB(3)
#undef GEMM_MM
#undef GEMM_PA
#undef GEMM_PB

        kin += 1;
        if (kin == nkt && kt + 1 < nk) {
            epi(tile, acc);
            tile += 1; kin = 0;
#pragma unroll
            for (int m = 0; m < 4; ++m)
#pragma unroll
                for (int n = 0; n < 4; ++n) acc[m][n] = (f32x4){0.f, 0.f, 0.f, 0.f};
        }
        __syncthreads();
    }
    epi(tile, acc);
}
struct NoEpi { __device__ __forceinline__ void operator()(int, const f32x4 (&)[4][4]) const {} };
template <bool SWAP, bool BF32, class AL, class BL>
__device__ __forceinline__ void gemm_128(const AL& al, const BL& bl, int k_begin, int nk, char* smem, f32x4 (&acc)[4][4]) {
    gemm_core<SWAP, BF32>(al, bl, k_begin, nk, nk, smem, acc, NoEpi());
}

__device__ __forceinline__ int xcd_of(const char* smem) { return (int)(((const unsigned*)(smem + GEMM_SMEM + 2048))[4] & 7u); }
__device__ __forceinline__ int rank_of(const char* smem) { return (int)((const unsigned*)(smem + GEMM_SMEM + 2048))[5]; }
__device__ __forceinline__ int nranks_of(const char* smem) { int n = (int)((const unsigned*)(smem + GEMM_SMEM + 2048))[6]; return n > 0 ? n : 1; }
template <int NB, bool SILU>
__device__ __forceinline__ void gemv_item(const float* in, const float* W, int ldw, const float* bias, float* out, int ldo, int K, int col0, float* sm) {
    const int tid = opaque_tid();
    for (int i = tid; i < NB * K; i += 256) { float v = in[i]; sm[i] = SILU ? v / (1.f + __expf(-v)) : v; }
    __syncthreads();
    float acc[NB];
#pragma unroll
    for (int b = 0; b < NB; ++b) acc[b] = 0.f;
    const int kq = tid >> 6, cl = tid & 63; const int kb = kq * (K / 4);
    for (int k = kb; k < kb + K / 4; k += 16) {
        float w[16];
#pragma unroll
        for (int u = 0; u < 16; ++u) w[u] = W[(size_t)(k + u) * ldw + col0 + cl];
#pragma unroll
        for (int u = 0; u < 16; ++u)
#pragma unroll
            for (int b = 0; b < NB; ++b) acc[b] += sm[b * K + k + u] * w[u];
    }
    float* red = sm + NB * K;
#pragma unroll
    for (int b = 0; b < NB; ++b) red[(kq * NB + b) * 64 + cl] = acc[b];
    __syncthreads();
    if (tid < 64 * NB) {
        int b = tid >> 6, cc = tid & 63;
        float s = red[(0 * NB + b) * 64 + cc] + red[(1 * NB + b) * 64 + cc] + red[(2 * NB + b) * 64 + cc] + red[(3 * NB + b) * 64 + cc];
        out[b * ldo + col0 + cc] = s + (bias ? bias[col0 + cc] : 0.f);
    }
    __syncthreads();
}

__device__ __forceinline__ int win_srccol(int n) {
    if (n < 1280) return n;
    if (n < 2304) return n + 24;
    if (n < 2816) return n + 40;
    if (n < 2840) return n - 2816 + 1280;
    if (n < 2856) return n - 2840 + 2328;
    return -1;
}
template <bool PERM>
__device__ __forceinline__ void transpose_item(const float* W, int ldw, int K, bf16_t* out, int k0, int n0, float* sm) {
    const int tid = opaque_tid();
    f32x4 v[4];
#pragma unroll
    for (int i = 0; i < 4; ++i) {
        const int c = tid + 256 * i, kk = c >> 4, nn = (c & 15) * 4;
        const int src = PERM ? win_srccol(n0 + nn) : (n0 + nn);
        v[i] = (src >= 0) ? *(const f32x4*)(W + (size_t)(k0 + kk) * ldw + src) : (f32x4){0.f, 0.f, 0.f, 0.f};
    }
#pragma unroll
    for (int i = 0; i < 4; ++i) {
        const int c = tid + 256 * i, kk = c >> 4, nn = (c & 15) * 4;
#pragma unroll
        for (int j = 0; j < 4; ++j) sm[(nn + j) * 65 + kk] = v[i][j];
    }
    __syncthreads();
#pragma unroll
    for (int i = 0; i < 2; ++i) {
        const int c = tid + 256 * i, nn = c >> 3, kc = (c & 7) * 8;
        const float* r = sm + nn * 65 + kc;
        u32x4 w;
        w.x = pk_bf16(r[0], r[1]); w.y = pk_bf16(r[2], r[3]); w.z = pk_bf16(r[4], r[5]); w.w = pk_bf16(r[6], r[7]);
        *(u32x4*)(out + (size_t)(n0 + nn) * K + k0 + kc) = w;
    }
    __syncthreads();
}

__device__ void phase0(const Params& p, char* smem) {
    float* sm = (float*)smem;
    const int nb = gridDim.x, bid = blockIdx.x;
    const int I_MOD = 96, I_B1 = 8, I_WIN = 16 * 46, I_WO = 256, I_WR = 64, I_W1 = 2 * 32 * 4, I_W2 = 2 * 4;
    const int total = I_MOD + I_B1 + I_WIN + I_WO + I_WR + I_W1 + I_W2;
    if (bid == 0 && opaque_tid() < 64) p.counts()[264 + opaque_tid()] = 0;
    if (bid == 1) for (int i = opaque_tid(); i < 264; i += 256) p.counts()[i] = 0;
    for (int it = bid; it < total; it += nb) {
        int i = it;
        if (i < I_MOD) { gemv_item<4, true>(p.c, p.w_mod, 6144, p.b_mod, p.mod(), 6144, 1024, i * 64, sm); continue; }
        i -= I_MOD;
        if (i < I_B1) { int kv = i >> 2; gemv_item<1, false>(kv ? p.pos_v : p.pos_k, kv ? p.w1_v : p.w1_k, 256, nullptr, p.bias1() + kv * 256, 256, 2048, (i & 3) * 64, sm); continue; }
        i -= I_B1;
        if (i < I_WIN) { transpose_item<true>(p.w_in, IN_COLS, 1024, p.wint(), (i % 16) * 64, (i / 16) * 64, sm); continue; }
        i -= I_WIN;
        if (i < I_WO) { transpose_item<false>(p.w_o, 1024, 1024, p.wot(), (i % 16) * 64, (i / 16) * 64, sm); continue; }
        i -= I_WO;
        if (i < I_WR) { transpose_item<false>(p.w_router, 256, 1024, p.wrt(), (i % 16) * 64, (i / 16) * 64, sm); continue; }
        i -= I_WR;
        if (i < I_W1) { int kv = i >> 7; int j = i & 127; transpose_item<false>(kv ? p.w1_v : p.w1_k, 256, 2048, p.w1t() + (size_t)kv * 256 * 2048, (j % 32) * 64, (j / 32) * 64, sm); continue; }
        i -= I_W1;
        { int kv = i >> 2; int j = i & 3; transpose_item<false>(kv ? p.w2_v : p.w2_k, 64, 256, p.w2t() + (size_t)kv * 64 * 256, j * 64, 0, sm); }
    }
}

__device__ __forceinline__ float wave_sum(float v) {
#pragma unroll
    for (int m = 32; m > 0; m >>= 1) v += __shfl_xor(v, m);
    return v;
}
__device__ void phase1(const Params& p) {
    const int lane = opaque_tid() & 63, gw = blockIdx.x * 4 + (opaque_tid() >> 6), nw = gridDim.x * 4;
    for (int row0 = gw * 2; row0 < NTOK; row0 += nw * 2) {
        f32x4 v[2][4]; float s[2];
#pragma unroll
        for (int r = 0; r < 2; ++r) {
            const float* xr = p.x + (size_t)(row0 + r) * D_MODEL;
            s[r] = 0.f;
#pragma unroll
            for (int i = 0; i < 4; ++i) v[r][i] = *(const f32x4*)(xr + i * 256 + lane * 4);
        }
        const int b = row0 / SEQ;
        const float* md = p.mod() + b * 6144;
#pragma unroll
        for (int r = 0; r < 2; ++r) {
#pragma unroll
            for (int i = 0; i < 4; ++i) s[r] += (v[r][i][0] + v[r][i][1]) + (v[r][i][2] + v[r][i][3]);
            const float mu = wave_sum(s[r]) * (1.f / D_MODEL);
            float q = 0.f;
#pragma unroll
            for (int i = 0; i < 4; ++i)
#pragma unroll
                for (int j = 0; j < 4; ++j) { float d = v[r][i][j] - mu; q += d * d; }
            const float rstd = rsqrtf(wave_sum(q) * (1.f / D_MODEL) + 1e-5f);
#pragma unroll
            for (int i = 0; i < 4; ++i) {
                const int col = i * 256 + lane * 4;
                f32x4 sh = *(const f32x4*)(md + 0 + col), sc = *(const f32x4*)(md + 1024 + col);
                float o[4];
#pragma unroll
                for (int j = 0; j < 4; ++j) o[j] = (v[r][i][j] - mu) * rstd * (1.f + sc[j]) + sh[j];
                u32x2 w; w.x = pk_bf16(o[0], o[1]); w.y = pk_bf16(o[2], o[3]);
                *(u32x2*)(p.hb() + (size_t)(row0 + r) * D_MODEL + col) = w;
            }
        }
    }
}

__device__ void phase2(const Params& p, char* smem) {
    const int xcd = xcd_of(smem), rank = rank_of(smem), nranks = nranks_of(smem);
    const int lane = opaque_tid() & 63, wid = opaque_tid() >> 6, wr = wid >> 1, wc = wid & 1, fr = lane & 15, fq = lane >> 4;
#ifndef P2_REP
#define P2_REP 1
#endif
    for (int it0 = rank; it0 < 16 * 23 * P2_REP; it0 += nranks) {
        const int it = it0 % (16 * 23);
        const int mt = (it / 23) * 8 + xcd, nt = it % 23;
        const int row0 = mt * 128, col0 = nt * 128;
        RowsBf16 al{p.hb() + (size_t)row0 * D_MODEL, D_MODEL};
        RowsBf16 bl{p.wint() + (size_t)col0 * D_MODEL, D_MODEL};
        f32x4 acc[4][4];
        const bool transposed = (nt == 7) || (nt == 9) || (nt >= 14 && nt < 18);
        if (transposed) {
            gemm_128<false, false>(al, bl, 0, 16, smem, acc);
            const int b = row0 / SEQ, t0 = row0 % SEQ;
            bf16_t* base; int rows_per;
            if (nt == 7) base = p.VsT() + (size_t)b * 128 * SEQ;
            else if (nt == 9) base = p.VwT() + (size_t)b * 128 * SEQ;
            else base = p.VgT() + ((size_t)b * 4 + (nt - 14)) * 128 * SEQ;
            (void)rows_per;
#pragma unroll
            for (int m = 0; m < 4; ++m)
#pragma unroll
                for (int n = 0; n < 4; ++n) {
                    const int feat = wc * 64 + n * 16 + fr, tok = t0 + wr * 64 + m * 16 + fq * 4;
                    u32x2 w; w.x = pk_bf16(acc[m][n][0], acc[m][n][1]); w.y = pk_bf16(acc[m][n][2], acc[m][n][3]);
                    *(u32x2*)(base + (size_t)feat * SEQ + tok) = w;
                }
        } else {
            gemm_128<true, false>(al, bl, 0, 16, smem, acc);
            if (nt == 22) {
                if (wc == 0) {
#pragma unroll
                    for (int m = 0; m < 4; ++m)
#pragma unroll
                        for (int n = 0; n < 4; ++n) {
                            const int tok = row0 + wr * 64 + m * 16 + fr, feat = n * 16 + fq * 4;
                            *(f32x4*)(p.misc() + (size_t)tok * 64 + feat) = acc[m][n];
                        }
                }
            } else {
#pragma unroll
                for (int m = 0; m < 4; ++m)
#pragma unroll
                    for (int n = 0; n < 4; ++n) {
                        const int tok = row0 + wr * 64 + m * 16 + fr, feat = col0 + wc * 64 + n * 16 + fq * 4;
                        u32x2 w; w.x = pk_bf16(acc[m][n][0], acc[m][n][1]); w.y = pk_bf16(acc[m][n][2], acc[m][n][3]);
                        *(u32x2*)(p.Pb() + (size_t)tok * PCOLS + feat) = w;
                    }
            }
        }
    }
}
struct CmpALoad {
    static constexpr bool NT = false;
    const bf16_t* Pb; int colbase; int row0;
    __device__ __forceinline__ const bf16_t* ptr(int r, int k) const {
        const int rr = row0 + r, bg = rr >> 8, i = rr & 255, b = bg >> 1, g = bg & 1;
        const int l = k >> 6, d = k & 63;
        int tok = 16 * i + l; tok = tok < SEQ ? tok : SEQ - 1;
        return Pb + ((size_t)b * SEQ + tok) * PCOLS + colbase + g * 64 + d;
    }
    __device__ __forceinline__ const bf16_t* pp(int i, int tid, int k) const { return ptr(i * 32 + (tid >> 3), k); }
};

__device__ __forceinline__ float log_sigmoid_f(float x) { return -(fmaxf(-x, 0.f) + __logf(1.f + __expf(-fabsf(x)))); }

__device__ __forceinline__ void gla_cumsum(const Params& p, int tokg0, int h, float* sb, float* sglr, float* swa, float* sqt) {
    const int tid = opaque_tid();
    for (int i = tid; i < 1024; i += 256) { int t = i >> 4, r = i & 15; sglr[i] = p.misc()[(size_t)(tokg0 + t) * 64 + 24 + r]; }
    for (int i = tid; i < 1024; i += 256) { int r = i >> 6, d = i & 63; swa[i] = p.w_a2[r * 256 + h * 64 + d]; }
    __syncthreads();
    const int d = tid & 63, tq = tid >> 6;
    const float ba = p.b_a2[h * 64 + d];
    float w[16];
#pragma unroll
    for (int r = 0; r < 16; ++r) w[r] = swa[r * 64 + d];
    float run = 0.f;
#pragma unroll
    for (int tt = 0; tt < 16; ++tt) {
        const int t = tq * 16 + tt;
        float x = ba;
#pragma unroll
        for (int r = 0; r < 16; ++r) x += sglr[t * 16 + r] * w[r];
        run += log_sigmoid_f(x) * (1.f / 16.f);
        sb[t * 64 + d] = run;
    }
    sqt[tq * 64 + d] = run;
    __syncthreads();
    float off = 0.f;
#pragma unroll
    for (int q = 0; q < 3; ++q) if (q < tq) off += sqt[q * 64 + d];
#pragma unroll
    for (int tt = 0; tt < 16; ++tt) sb[(tq * 16 + tt) * 64 + d] += off;
    __syncthreads();
}

__device__ void gla_a_item(const Params& p, int item, char* smem) {
    const int tid = opaque_tid(), lane = tid & 63, wid = tid >> 6, fr = lane & 15, fq = lane >> 4;
    const int bh = item >> 6, c = item & 63, b = bh >> 2, h = bh & 3;
    const int tok0 = c * 64, tokg0 = b * SEQ + tok0;
    float* sb = (float*)smem; float* sglr = (float*)(smem + 16384); float* swa = (float*)(smem + 20480); float* sqt = (float*)(smem + 24576);
    char* skbT = smem + 25600; char* sVT = smem + 34816;
    gla_cumsum(p, tokg0, h, sb, sglr, swa, sqt);
    {
        float* bs = (float*)(p.ws + OFF_bsave) + (size_t)item * 4096;
#pragma unroll
        for (int i = 0; i < 4; ++i) *(f32x4*)(bs + (tid + 256 * i) * 4) = *(const f32x4*)(sb + (tid + 256 * i) * 4);
    }
    {
        const int d = tid & 63, tq = tid >> 6;
        const float bl = sb[63 * 64 + d];
        float v[16];
#pragma unroll
        for (int tt = 0; tt < 16; ++tt) {
            const int s = tq * 16 + tt;
            float k = bf2f(p.Pb()[(size_t)(tokg0 + s) * PCOLS + P_GK + h * 64 + d]);
            v[tt] = k * __expf(bl - sb[s * 64 + d]);
        }
        u32x4 w0, w1;
        w0.x = pk_bf16(v[0], v[1]); w0.y = pk_bf16(v[2], v[3]); w0.z = pk_bf16(v[4], v[5]); w0.w = pk_bf16(v[6], v[7]);
        w1.x = pk_bf16(v[8], v[9]); w1.y = pk_bf16(v[10], v[11]); w1.z = pk_bf16(v[12], v[13]); w1.w = pk_bf16(v[14], v[15]);
        *(u32x4*)(skbT + (d * LDS_ROW + tq * 16) * 2) = w0;
        *(u32x4*)(skbT + (d * LDS_ROW + tq * 16 + 8) * 2) = w1;
        if (tid < 64) p.dec()[(size_t)item * 64 + d] = __expf(bl);
    }
#pragma unroll
    for (int i = 0; i < 4; ++i) {
        const int cidx = tid + 256 * i, e = cidx >> 3, ch = (cidx & 7) * 8;
        *(u32x4*)(sVT + (e * LDS_ROW + ch) * 2) = *(const u32x4*)(p.VgT() + ((size_t)bh * 128 + e) * SEQ + tok0 + ch);
    }
    __syncthreads();
    f32x4 acc[2][4];
#pragma unroll
    for (int m = 0; m < 2; ++m)
#pragma unroll
        for (int n = 0; n < 4; ++n) acc[m][n] = (f32x4){0.f, 0.f, 0.f, 0.f};
#pragma unroll
    for (int ks = 0; ks < 2; ++ks) {
        bf16x8 a[2], bb[4];
#pragma unroll
        for (int m = 0; m < 2; ++m) a[m] = *(const bf16x8*)(sVT + (((wid * 2 + m) * 16 + fr) * LDS_ROW + ks * 32 + fq * 8) * 2);
#pragma unroll
        for (int n = 0; n < 4; ++n) bb[n] = *(const bf16x8*)(skbT + ((n * 16 + fr) * LDS_ROW + ks * 32 + fq * 8) * 2);
#pragma unroll
        for (int m = 0; m < 2; ++m)
#pragma unroll
            for (int n = 0; n < 4; ++n) acc[m][n] = __builtin_amdgcn_mfma_f32_16x16x32_bf16(a[m], bb[n], acc[m][n], 0, 0, 0);
    }
    float* dst = p.dST() + (size_t)item * 8192;
#pragma unroll
    for (int m = 0; m < 2; ++m)
#pragma unroll
        for (int n = 0; n < 4; ++n)
#pragma unroll
            for (int j = 0; j < 4; ++j) dst[((wid * 2 + m) * 16 + fq * 4 + j) * 64 + n * 16 + fr] = acc[m][n][j];
    __syncthreads();
}

__device__ void phase3(const Params& p, char* smem) {
    const int lane = opaque_tid() & 63, wid = opaque_tid() >> 6, wr = wid >> 1, wc = wid & 1, fr = lane & 15, fq = lane >> 4;
    for (int it = blockIdx.x; it < 256; it += gridDim.x) {
        const int kv = it >> 7, mt = (it >> 3) & 15, nt = (it >> 2) & 1, ks = it & 3;
        CmpALoad al{p.Pb(), kv ? P_VC : P_KC, mt * 128};
        RowsBf16 bl{p.w1t() + ((size_t)kv * 256 + nt * 128) * 2048, 2048};
        f32x4 acc[4][4];
        gemm_128<true, 0>(al, bl, ks * 512, 8, smem, acc);
        float* dst = p.cpart() + ((size_t)(kv * 4 + ks) * 2048 + mt * 128) * 256 + nt * 128;
#pragma unroll
        for (int m = 0; m < 4; ++m)
#pragma unroll
            for (int n = 0; n < 4; ++n)
                *(f32x4*)(dst + (size_t)(wr * 64 + m * 16 + fr) * 256 + wc * 64 + n * 16 + fq * 4) = acc[m][n];
    }
    const int first = (blockIdx.x + gridDim.x - (256 % gridDim.x)) % gridDim.x;
    for (int it = first; it < 1024; it += gridDim.x) gla_a_item(p, it, smem);
}

#define C2_ROW 264
__device__ void cmp2_item(const Params& p, int item, char* smem) {
    const int tid = opaque_tid(), lane = tid & 63, wid = tid >> 6, fr = lane & 15, fq = lane >> 4;
    const int kv = item >> 5, r0 = (item & 31) * 64;
    char* sA = smem; char* sB = smem + 64 * C2_ROW * 2;
    const float* b1 = p.bias1() + kv * 256;
#pragma unroll 2
    for (int i = 0; i < 8; ++i) {
        const int cidx = tid + 256 * i, row = cidx >> 5, col = (cidx & 31) * 8;
        f32x4 s0 = *(const f32x4*)(b1 + col), s1 = *(const f32x4*)(b1 + col + 4);
#pragma unroll
        for (int ks = 0; ks < 4; ++ks) {
            const float* src = p.cpart() + ((size_t)(kv * 4 + ks) * 2048 + r0 + row) * 256 + col;
            s0 += *(const f32x4*)src; s1 += *(const f32x4*)(src + 4);
        }
        float o[8];
#pragma unroll
        for (int j = 0; j < 4; ++j) { o[j] = s0[j] / (1.f + __expf(-s0[j])); o[4 + j] = s1[j] / (1.f + __expf(-s1[j])); }
        u32x4 w; w.x = pk_bf16(o[0], o[1]); w.y = pk_bf16(o[2], o[3]); w.z = pk_bf16(o[4], o[5]); w.w = pk_bf16(o[6], o[7]);
        *(u32x4*)(sA + (row * C2_ROW + col) * 2) = w;
        *(u32x4*)(sB + (row * C2_ROW + col) * 2) = *(const u32x4*)(p.w2t() + ((size_t)kv * 64 + row) * 256 + col);
    }
    __syncthreads();
    f32x4 acc[4];
#pragma unroll
    for (int n = 0; n < 4; ++n) acc[n] = (f32x4){0.f, 0.f, 0.f, 0.f};
#pragma unroll
    for (int ks = 0; ks < 8; ++ks) {
        bf16x8 a = *(const bf16x8*)(sA + ((wid * 16 + fr) * C2_ROW + ks * 32 + fq * 8) * 2);
#pragma unroll
        for (int n = 0; n < 4; ++n) {
            bf16x8 bb = *(const bf16x8*)(sB + ((n * 16 + fr) * C2_ROW + ks * 32 + fq * 8) * 2);
            acc[n] = kv ? __builtin_amdgcn_mfma_f32_16x16x32_bf16(a, bb, acc[n], 0, 0, 0)
                        : __builtin_amdgcn_mfma_f32_16x16x32_bf16(bb, a, acc[n], 0, 0, 0);
        }
    }
    if (kv == 0) {
#pragma unroll
        for (int n = 0; n < 4; ++n) {
            u32x2 w; w.x = pk_bf16(acc[n][0], acc[n][1]); w.y = pk_bf16(acc[n][2], acc[n][3]);
            *(u32x2*)(p.kc() + (size_t)(r0 + wid * 16 + fr) * 64 + n * 16 + fq * 4) = w;
        }
    } else {
        const int r = r0 + wid * 16 + fq * 4, bg = r >> 8, i = r & 255;
#pragma unroll
        for (int n = 0; n < 4; ++n) {
            u32x2 w; w.x = pk_bf16(acc[n][0], acc[n][1]); w.y = pk_bf16(acc[n][2], acc[n][3]);
            *(u32x2*)(p.vcT() + ((size_t)bg * 64 + n * 16 + fr) * 256 + i) = w;
        }
    }
    __syncthreads();
}

__device__ void phase4(const Params& p, char* smem) {
    for (int it = blockIdx.x; it < 64; it += gridDim.x) cmp2_item(p, it, smem);
    const int nthreads = gridDim.x * 256;
    for (int idx = blockIdx.x * 256 + opaque_tid(); idx < 16 * 8192; idx += nthreads) {
        const int bh = idx >> 13, ed = idx & 8191, d = idx & 63;
        float S = 0.f;
        for (int c0 = 0; c0 < 64; c0 += 8) {
            float dv[8], dc[8];
#pragma unroll
            for (int u = 0; u < 8; ++u) {
                dv[u] = p.dST()[((size_t)(bh * 64 + c0 + u) << 13) + ed];
                dc[u] = p.dec()[(size_t)(bh * 64 + c0 + u) * 64 + d];
            }
#pragma unroll
            for (int u = 0; u < 8; ++u) {
                p.ST()[((size_t)(bh * 64 + c0 + u) << 13) + ed] = f2bf(S);
                S = dc[u] * S + dv[u];
            }
        }
    }
}
#define KT_BYTES (64 * LDS_ROW * 2)
#define C1_SCALE (0.125f * LOG2E)

#define MASK_BIAS (-2e30f)
__device__ __forceinline__ bf16x8 scale_frag(bf16x8 v, float c) {
    u32x4 u = __builtin_bit_cast(u32x4, v); u32x4 r;
    r.x = pk_bf16(bflo(u.x) * c, bfhi(u.x) * c); r.y = pk_bf16(bflo(u.y) * c, bfhi(u.y) * c);
    r.z = pk_bf16(bflo(u.z) * c, bfhi(u.z) * c); r.w = pk_bf16(bflo(u.w) * c, bfhi(u.w) * c);
    return __builtin_bit_cast(bf16x8, r);
}
__device__ __forceinline__ float max3f(float a, float b, float c) { return fmaxf(fmaxf(a, b), c); }
__device__ __forceinline__ float rowmax4(float x) {
    auto r = __builtin_amdgcn_permlane32_swap(__float_as_uint(x), __float_as_uint(x), false, false);
    float y = fmaxf(__uint_as_float(r[0]), __uint_as_float(r[1]));
    auto q = __builtin_amdgcn_permlane16_swap(__float_as_uint(y), __float_as_uint(y), false, false);
    return fmaxf(__uint_as_float(q[0]), __uint_as_float(q[1]));
}
template <bool PV>
__device__ __forceinline__ void flash_tile(const char* sK0, const char* sVT0, const bf16x8 (&qf)[2][2], float (&m)[2], f32x4 (&l)[2], f32x4 (&o)[2][4],
                                           float dl0, float dstride, float wlim, bool lanevalid, bool needmask, const float (&slope2)[2], int fr, int fq, bool lazy, bf16x8 ones) {
#pragma unroll 1
    for (int half = 0; half < 2; ++half) {
        const char* sK = sK0 + half * 32 * LDS_ROW * 2;
        const char* sVT = sVT0 + half * 32 * 2;
        const float dl = dl0 + dstride * (float)(half * 32);
        bf16x8 kf[2][2], vf[4];
#pragma unroll
        for (int mk = 0; mk < 2; ++mk)
#pragma unroll
            for (int ks = 0; ks < 2; ++ks) kf[mk][ks] = *(const bf16x8*)(sK + ((mk * 16 + fr) * LDS_ROW + ks * 32 + fq * 8) * 2);
        if (PV) {
#pragma unroll
            for (int md = 0; md < 4; ++md) {
                u32x2 lo = *(const u32x2*)(sVT + ((md * 16 + fr) * LDS_ROW + fq * 4) * 2);
                u32x2 hi = *(const u32x2*)(sVT + ((md * 16 + fr) * LDS_ROW + 16 + fq * 4) * 2);
                u32x4 w; w.x = lo.x; w.y = lo.y; w.z = hi.x; w.w = hi.y;
                vf[md] = __builtin_bit_cast(bf16x8, w);
            }
        }
        f32x4 s[2][2];
#pragma unroll
        for (int p = 0; p < 2; ++p) {
            const float mref = lazy ? m[p] : 0.f;
            if (needmask) {
#pragma unroll
                for (int mk = 0; mk < 2; ++mk)
#pragma unroll
                    for (int j = 0; j < 4; ++j) {
                        const float dk = dl + dstride * (float)(mk * 16 + j);
                        const bool ok = lanevalid && (dk <= 0.f) && (dk > wlim);
                        s[p][mk][j] = ok ? (slope2[p] * dk - mref) : MASK_BIAS;
                    }
            } else {
                const float sb = lanevalid ? (slope2[p] * dl - mref) : MASK_BIAS, sd = lanevalid ? slope2[p] * dstride : 0.f;
#pragma unroll
                for (int mk = 0; mk < 2; ++mk)
#pragma unroll
                    for (int j = 0; j < 4; ++j) s[p][mk][j] = sb + sd * (float)(mk * 16 + j);
            }
        }
#pragma unroll
        for (int ks = 0; ks < 2; ++ks)
#pragma unroll
            for (int p = 0; p < 2; ++p)
#pragma unroll
                for (int mk = 0; mk < 2; ++mk) s[p][mk] = __builtin_amdgcn_mfma_f32_16x16x32_bf16(kf[mk][ks], qf[p][ks], s[p][mk], 0, 0, 0);
        float mx[2];
#pragma unroll
        for (int p = 0; p < 2; ++p)
            mx[p] = max3f(max3f(max3f(s[p][0][0], s[p][0][1], s[p][0][2]), s[p][0][3], s[p][1][0]), max3f(s[p][1][1], s[p][1][2], s[p][1][3]), MASK_BIAS);
        if (!lazy) {
            float mn[2];
#pragma unroll
            for (int p = 0; p < 2; ++p) mn[p] = fmaxf(m[p], rowmax4(mx[p]));
            if (__any((mn[0] > m[0]) || (mn[1] > m[1]))) {
#pragma unroll
                for (int p = 0; p < 2; ++p) {
                    const float alpha = __builtin_amdgcn_exp2f(m[p] - mn[p]);
                    l[p] *= alpha;
                    if (PV) {
#pragma unroll
                        for (int md = 0; md < 4; ++md) o[p][md] *= alpha;
                    }
                    m[p] = mn[p];
                }
            }
#pragma unroll
            for (int p = 0; p < 2; ++p)
#pragma unroll
                for (int mk = 0; mk < 2; ++mk)
#pragma unroll
                    for (int j = 0; j < 4; ++j) s[p][mk][j] -= m[p];
        }
        bf16x8 pf[2];
#pragma unroll
        for (int p = 0; p < 2; ++p) {
#pragma unroll
            for (int mk = 0; mk < 2; ++mk)
#pragma unroll
                for (int j = 0; j < 4; ++j) s[p][mk][j] = __builtin_amdgcn_exp2f(s[p][mk][j]);
            u32x4 w;
            w.x = pk_bf16(s[p][0][0], s[p][0][1]); w.y = pk_bf16(s[p][0][2], s[p][0][3]);
            w.z = pk_bf16(s[p][1][0], s[p][1][1]); w.w = pk_bf16(s[p][1][2], s[p][1][3]);
            pf[p] = __builtin_bit_cast(bf16x8, w);
        }
#pragma unroll
        for (int p = 0; p < 2; ++p) l[p] = __builtin_amdgcn_mfma_f32_16x16x32_bf16(ones, pf[p], l[p], 0, 0, 0);
        if (PV) {
#pragma unroll
            for (int md = 0; md < 4; ++md)
#pragma unroll
                for (int p = 0; p < 2; ++p) o[p][md] = __builtin_amdgcn_mfma_f32_16x16x32_bf16(vf[md], pf[p], o[p][md], 0, 0, 0);
        }
        if (lazy) {
            float up[2];
#pragma unroll
            for (int p = 0; p < 2; ++p) up[p] = fmaxf(rowmax4(mx[p]), 0.f);
            if (__any((up[0] > 0.f) || (up[1] > 0.f))) {
#pragma unroll
                for (int p = 0; p < 2; ++p) {
                    const float alpha = __builtin_amdgcn_exp2f(-up[p]);
                    l[p] *= alpha;
                    if (PV) {
#pragma unroll
                        for (int md = 0; md < 4; ++md) o[p][md] *= alpha;
                    }
                    m[p] += up[p];
                }
            }
        }
    }
}
__device__ __forceinline__ float l_total(const f32x4& l, int fr) { return __shfl(l[0], fr); }

__device__ __forceinline__ void imp_tile(const char* sK, const bf16x8 (&qf)[2][2], const float (&m)[2], const float (&linv)[2],
                                         float dl, const float (&slope2)[2], int ct, float* simp, int fr, int fq) {
    bf16x8 kf[4][2];
#pragma unroll
    for (int mk = 0; mk < 4; ++mk)
#pragma unroll
        for (int ks = 0; ks < 2; ++ks) kf[mk][ks] = *(const bf16x8*)(sK + ((mk * 16 + fr) * LDS_ROW + ks * 32 + fq * 8) * 2);
    f32x4 hs[4];
#pragma unroll
    for (int mk = 0; mk < 4; ++mk) hs[mk] = (f32x4){0.f, 0.f, 0.f, 0.f};
#pragma unroll
    for (int p = 0; p < 2; ++p) {
#pragma unroll
        for (int mk = 0; mk < 4; ++mk) {
            f32x4 s;
#pragma unroll
            for (int j = 0; j < 4; ++j) { const float dk = dl + 16.f * (float)(mk * 16 + j); s[j] = (dk <= 0.f) ? slope2[p] * dk : MASK_BIAS; }
#pragma unroll
            for (int ks = 0; ks < 2; ++ks) s = __builtin_amdgcn_mfma_f32_16x16x32_bf16(kf[mk][ks], qf[p][ks], s, 0, 0, 0);
#pragma unroll
            for (int j = 0; j < 4; ++j) hs[mk][j] += __builtin_amdgcn_exp2f(s[j] - m[p]) * linv[p];
        }
    }
#pragma unroll
    for (int mk = 0; mk < 4; ++mk) {
        const int jb = ct * 16 + mk * 4 + fq;
        const float a = hs[mk][0] + hs[mk][1] + hs[mk][2] + 0.5f * hs[mk][3];
        const float bnext = 0.5f * hs[mk][3];
        simp[fr * 64 + jb] += a;
        __builtin_amdgcn_wave_barrier();
        if (jb + 1 < 64) simp[fr * 64 + jb + 1] += bnext;
        __builtin_amdgcn_wave_barrier();
    }
}

struct TileSrc { const bf16_t* k; const bf16_t* v; };
struct TileOff { int k[2], v[2]; };
__device__ __forceinline__ TileOff tile_offsets(int kst, int vst, int tid) {
    TileOff to;
#pragma unroll
    for (int i = 0; i < 2; ++i) { const int c = tid + 256 * i, row = c >> 3, ch = (c & 7) * 8; to.k[i] = row * kst + ch; to.v[i] = row * vst + ch; }
    return to;
}
__device__ __forceinline__ void tile_gload(const TileSrc& ts, const TileOff& to, u32x4 (&rk)[2], u32x4 (&rv)[2]) {
#pragma unroll
    for (int i = 0; i < 2; ++i) {
        rk[i] = *(const u32x4*)(ts.k + to.k[i]);
        rv[i] = *(const u32x4*)(ts.v + to.v[i]);
    }
}
__device__ __forceinline__ void tile_swrite(char* smem, int buf, const u32x4 (&rk)[2], const u32x4 (&rv)[2], int tid) {
    char* sK = smem + buf * 2 * KT_BYTES; char* sV = sK + KT_BYTES;
#pragma unroll
    for (int i = 0; i < 2; ++i) {
        const int c = tid + 256 * i, row = c >> 3, ch = (c & 7) * 8;
        *(u32x4*)(sK + (row * LDS_ROW + ch) * 2) = rk[i];
        *(u32x4*)(sV + (row * LDS_ROW + ch) * 2) = rv[i];
    }
}

__device__ void nsa_cmp_item(const Params& p, int qrev, int bg, char* smem) {
    const int tid = opaque_tid(), lane = tid & 63, wid = tid >> 6, fr = lane & 15, fq = lane >> 4;
    const int qb = 63 - qrev, b = bg >> 1, g = bg & 1;
    const int q0 = qb * 64, t = q0 + wid * 16 + fr;
    const size_t tokg = (size_t)b * SEQ + t;
    float* simp = (float*)(smem + 4 * KT_BYTES) + wid * 1024;
    auto wsb = [&]() __attribute__((always_inline)) { char* w = p.ws; asm volatile("" : "+s"(w)); return w; };
    const unsigned onew = (fr == 0) ? 0x3f803f80u : 0u;
    const bf16x8 ones = __builtin_bit_cast(bf16x8, (u32x4){onew, onew, onew, onew});
    const int ncb = (4 * qb + 3) < NCMP ? (4 * qb + 3) : NCMP;
    const int nct = (ncb + 63) >> 6;
    for (int i = tid; i < 4096; i += 256) ((float*)(smem + 4 * KT_BYTES))[i] = 0.f;
    __syncthreads();
#pragma unroll 1
    for (int hp = 0; hp < 2; ++hp) {
        const int h0 = g * 4 + hp * 2;
        bf16x8 qf[2][2]; float slope2[2];
#pragma unroll
        for (int pp = 0; pp < 2; ++pp) {
            slope2[pp] = exp2f(-(float)(h0 + pp + 1)) * LOG2E;
#pragma unroll
            for (int ks = 0; ks < 2; ++ks)
                qf[pp][ks] = scale_frag(*(const bf16x8*)((const bf16_t*)(wsb() + OFF_Pb) + tokg * PCOLS + P_NQ + (h0 + pp) * 64 + ks * 32 + fq * 8), C1_SCALE);
        }
        float m[2], linv[2]; f32x4 l[2]; f32x4 o[2][4];
#pragma unroll
        for (int pp = 0; pp < 2; ++pp) {
            m[pp] = NEGF; l[pp] = (f32x4){0.f, 0.f, 0.f, 0.f}; linv[pp] = 0.f;
#pragma unroll
            for (int md = 0; md < 4; ++md) o[pp][md] = (f32x4){0.f, 0.f, 0.f, 0.f};
        }
        u32x4 rk[2], rv[2];
        const int n = 2 * nct;
        auto src = [&](int step) __attribute__((always_inline)) {
            const int idx = step < nct ? (nct - 1 - step) : step - nct;
            char* wb = wsb();
            TileSrc ts; ts.k = (const bf16_t*)(wb + OFF_kc) + ((size_t)bg * 256 + idx * 64) * 64;
            ts.v = (const bf16_t*)(wb + OFF_vcT) + (size_t)bg * 64 * 256 + idx * 64;
            return ts;
        };
        const TileOff toff = tile_offsets(64, 256, tid);
        tile_gload(src(0), toff, rk, rv); tile_swrite(smem, 0, rk, rv, tid); __syncthreads();
#pragma unroll 1
        for (int i = 0; i < n; ++i) {
            if (i + 1 < n) tile_gload(src(i + 1), toff, rk, rv);
            __builtin_amdgcn_sched_barrier(0);
            const int idx = i < nct ? (nct - 1 - i) : i - nct;
            const char* sK = smem + (i & 1) * 2 * KT_BYTES; const char* sV = sK + KT_BYTES;
            const float dlc = (float)(16 * (idx * 64 + fq * 4) + 31 - t);
            if (i < nct) {
                const bool cmask = (16 * (idx * 64 + 63) + 31) > q0;
                flash_tile<true>(sK, sV, qf, m, l, o, dlc, 16.f, -1e9f, true, cmask, slope2, fr, fq, i >= 2, ones);
            } else {
                if (i == nct) {
                    size_t tokg_o = tokg; asm volatile("" : "+v"(tokg_o));
                    char* wb = wsb();
#pragma unroll
                    for (int pp = 0; pp < 2; ++pp) {
                        const float inv = 1.f / fmaxf(l_total(l[pp], fr), 1e-30f);
                        linv[pp] = inv;
                        const int h = h0 + pp;
                        const float gl = ((const float*)(wb + OFF_misc))[tokg_o * 64 + h * 3 + 0];
                        const float sc = inv / (1.f + __expf(-gl));
#pragma unroll
                        for (int md = 0; md < 4; ++md) *(f32x4*)((float*)(wb + OFF_mixf) + tokg_o * 512 + h * 64 + md * 16 + fq * 4) = o[pp][md] * sc;
                    }
                }
                imp_tile(sK, qf, m, linv, dlc, slope2, idx, simp, fr, fq);
            }
            __builtin_amdgcn_sched_barrier(0);
            if (i + 1 < n) tile_swrite(smem, (i + 1) & 1, rk, rv, tid);
            __syncthreads();
        }
    }
    {
        const int j = lane;
        const bool forced = (j == 0) || (j == qb) || (j == qb - 1);
        unsigned long long mine = 0ull, wave_union = 0ull;
#pragma unroll 1
        for (int qi = 0; qi < 16; ++qi) {
            const float sc = (j <= qb) ? (simp[qi * 64 + j] + (forced ? 1e4f : 0.f)) : NEGF;
            int rank = 0;
#pragma unroll 4
            for (int j2 = 0; j2 < 64; ++j2) {
                const float s2 = __builtin_bit_cast(float, __builtin_amdgcn_readlane(__builtin_bit_cast(int, sc), j2));
                rank += ((s2 > sc) || (s2 == sc && j2 < j)) ? 1 : 0;
            }
            const unsigned long long msk = __ballot(rank < 16);
            wave_union |= msk;
            if (fr == qi) mine = msk;
        }
        const unsigned long long causal = (qb >= 63) ? ~0ull : ((1ull << (qb + 1)) - 1ull);
        unsigned long long* selm = (unsigned long long*)(wsb() + OFF_selm);
        if (fq == 0) selm[(size_t)g * NTOK + tokg] = mine & causal;
        if (lane == 0) ((unsigned long long*)(wsb() + OFF_selu))[((size_t)bg * 64 + qb) * 4 + wid] = wave_union & causal;
    }
    __syncthreads();
}

__device__ void nsa_sw_item(const Params& p, int qrev, int bg, int hp, char* smem, int mode) {
    const int tid = opaque_tid(), lane = tid & 63, wid = tid >> 6, fr = lane & 15, fq = lane >> 4;
    const int qb = 63 - qrev, b = bg >> 1, g = bg & 1;
    const int q0 = qb * 64, t = q0 + wid * 16 + fr;
    const size_t tokg = (size_t)b * SEQ + t;
    int* slist = (int*)(smem + 4 * KT_BYTES);
    const int h0 = g * 4 + hp * 2;
    auto wsb = [&]() __attribute__((always_inline)) { char* w = p.ws; asm volatile("" : "+s"(w)); return w; };
    bf16x8 qf[2][2]; float slope2[2];
#pragma unroll
    for (int pp = 0; pp < 2; ++pp) {
        slope2[pp] = exp2f(-(float)(h0 + pp + 1)) * LOG2E;
#pragma unroll
        for (int ks = 0; ks < 2; ++ks)
            qf[pp][ks] = scale_frag(*(const bf16x8*)((const bf16_t*)(wsb() + OFF_Pb) + tokg * PCOLS + P_NQ + (h0 + pp) * 64 + ks * 32 + fq * 8), C1_SCALE);
    }
    const unsigned long long mymask = ((const unsigned long long*)(wsb() + OFF_selm))[(size_t)g * NTOK + tokg];
    const unsigned long long* su = (const unsigned long long*)(wsb() + OFF_selu) + ((size_t)bg * 64 + qb) * 4;
    const unsigned long long wave_union = su[wid];
    const unsigned long long un = su[0] | su[1] | su[2] | su[3];
    const int wlo = (qb - 8) > 0 ? (qb - 8) : 0;
    const int nsl = __popcll(un);
    const int n = nsl + (qb - wlo + 1);
    if (tid < 64 && ((un >> tid) & 1ull)) slist[nsl - 1 - __popcll(un & ((1ull << tid) - 1ull))] = tid;
    if (tid >= 64 && tid < 64 + (qb - wlo + 1)) slist[nsl + (tid - 64)] = 256 + (qb - (tid - 64));
    __syncthreads();
    const unsigned onew = (fr == 0) ? 0x3f803f80u : 0u;
    const bf16x8 ones = __builtin_bit_cast(bf16x8, (u32x4){onew, onew, onew, onew});
    float m[2]; f32x4 l[2]; f32x4 o[2][4];
#pragma unroll
    for (int pp = 0; pp < 2; ++pp) {
        m[pp] = NEGF; l[pp] = (f32x4){0.f, 0.f, 0.f, 0.f};
#pragma unroll
        for (int md = 0; md < 4; ++md) o[pp][md] = (f32x4){0.f, 0.f, 0.f, 0.f};
    }
    auto finish_branch = [&](int br) __attribute__((always_inline)) {
        size_t tokg_o = tokg; asm volatile("" : "+v"(tokg_o));
        char* wb = wsb();
#pragma unroll
        for (int pp = 0; pp < 2; ++pp) {
            const float inv = 1.f / fmaxf(l_total(l[pp], fr), 1e-30f);
            const int h = h0 + pp;
            const float gl = ((const float*)(wb + OFF_misc))[tokg_o * 64 + h * 3 + br];
            const float sc = inv / (1.f + __expf(-gl));
#pragma unroll
            for (int md = 0; md < 4; ++md) {
                const size_t eo = tokg_o * 512 + h * 64 + md * 16 + fq * 4;
                f32x4 v = o[pp][md] * sc;
                if (mode != 0) { asm volatile("" :: "v"(v[0]), "v"(v[1]), "v"(v[2]), "v"(v[3])); }
                else if (br == 1) *(f32x4*)((float*)(wb + OFF_mixf2) + eo) = v;
                else { v += *(const f32x4*)((const float*)(wb + OFF_mixf) + eo) + *(const f32x4*)((const float*)(wb + OFF_mixf2) + eo);
                       u32x2 w; w.x = pk_bf16(v[0], v[1]); w.y = pk_bf16(v[2], v[3]); *(u32x2*)((bf16_t*)(wb + OFF_mixb) + tokg_o * 1024 + h * 64 + md * 16 + fq * 4) = w; }
            }
            m[pp] = NEGF; l[pp] = (f32x4){0.f, 0.f, 0.f, 0.f};
#pragma unroll
            for (int md = 0; md < 4; ++md) o[pp][md] = (f32x4){0.f, 0.f, 0.f, 0.f};
        }
    };
    u32x4 rkA[2], rvA[2], rkB[2], rvB[2];
    auto src = [&](int e) __attribute__((always_inline)) {
        const int win = e >> 8, idx = e & 255;
        char* wb = wsb();
        TileSrc ts;
        ts.k = (const bf16_t*)(wb + OFF_Pb) + ((size_t)b * SEQ + idx * 64) * PCOLS + (win ? P_KW : P_KS) + g * 64;
        ts.v = (const bf16_t*)(wb + (win ? OFF_VwT : OFF_VsT)) + (size_t)bg * 64 * SEQ + idx * 64;
        return ts;
    };
    auto step = [&](int i, int buf) __attribute__((always_inline)) {
        const int e = slist[i];
        const int win = e >> 8, idx = e & 255;
        if (i == nsl) finish_branch(1);
        const char* sK = smem + buf * 2 * KT_BYTES; const char* sV = sK + KT_BYTES;
        if (mode != 1 && (win || ((wave_union >> idx) & 1ull))) {
            const bool lv = win ? true : (((mymask >> idx) & 1ull) != 0ull);
            const bool nm = (idx == qb) || (win && idx == qb - 8);
            flash_tile<true>(sK, sV, qf, m, l, o, (float)(idx * 64 + fq * 4 - t), 1.f, win ? -512.f : -1e9f, lv, nm, slope2, fr, fq, (i != 0) && (i != nsl), ones);
        }
    };
#ifdef PROF
    volatile unsigned* sprof = (volatile unsigned*)(smem + 4 * KT_BYTES + 2048);
    if (tid == 0) { sprof[1] = 0u; sprof[2] = 0u; sprof[3] = (unsigned)__builtin_amdgcn_s_memtime(); }
#define PROF_T0 if (tid == 0) sprof[0] = (unsigned)__builtin_amdgcn_s_memtime();
#define PROF_T1 if (tid == 0) { sprof[1] += (unsigned)__builtin_amdgcn_s_memtime() - sprof[0]; sprof[2] += 1u; }
#else
#define PROF_T0
#define PROF_T1
#endif
    const TileOff toff = tile_offsets(PCOLS, SEQ, tid);
    tile_gload(src(slist[0]), toff, rkA, rvA); tile_swrite(smem, 0, rkA, rvA, tid);
    if (n > 1) tile_gload(src(slist[1]), toff, rkA, rvA);
    __syncthreads();
#pragma unroll 1
    for (int i = 0; i < n; i += 2) {
        if (i + 2 < n) tile_gload(src(slist[i + 2]), toff, rkB, rvB);
        __builtin_amdgcn_sched_barrier(0);
        PROF_T0 step(i, 0); PROF_T1
        __builtin_amdgcn_sched_barrier(0);
        if (i + 1 < n) tile_swrite(smem, 1, rkA, rvA, tid);
        __syncthreads();
        if (i + 1 >= n) break;
        if (i + 3 < n) tile_gload(src(slist[i + 3]), toff, rkA, rvA);
        __builtin_amdgcn_sched_barrier(0);
        PROF_T0 step(i + 1, 1); PROF_T1
        __builtin_amdgcn_sched_barrier(0);
        if (i + 2 < n) tile_swrite(smem, 0, rkB, rvB, tid);
        __syncthreads();
    }
    finish_branch(2);
#ifdef PROF
    if (tid == 0) {
        unsigned long long* pw = (unsigned long long*)(p.ws + OFF_counts + 1024);
        atomicAdd(&pw[0], (unsigned long long)sprof[1]); atomicAdd(&pw[1], (unsigned long long)((unsigned)__builtin_amdgcn_s_memtime() - sprof[3])); atomicAdd(&pw[2], (unsigned long long)sprof[2]);
    }
#endif
}

__device__ void gla_c_item(const Params& p, int item, char* smem) {
    const int tid = opaque_tid(), lane = tid & 63, wid = tid >> 6, fr = lane & 15, fq = lane >> 4;
    const int bh = item >> 6, c = item & 63, b = bh >> 2, h = bh & 3;
    const int tok0 = c * 64, tokg0 = b * SEQ + tok0;
    float* sb = (float*)smem; float* sglr = (float*)(smem + 16384); float* swa = (float*)(smem + 20480); float* sqt = (float*)(smem + 24576);
    char* sST = smem;
    char* sQB = smem + 25600; char* sKB = smem + 34816; char* sVT = smem + 44032;
    {
        const float* bs = (const float*)(p.ws + OFF_bsave) + (size_t)item * 4096;
#pragma unroll
        for (int i = 0; i < 4; ++i) *(f32x4*)(sb + (tid + 256 * i) * 4) = *(const f32x4*)(bs + (tid + 256 * i) * 4);
        __syncthreads();
    }
    {
        const int d = tid & 63, tq = tid >> 6;
#pragma unroll 4
        for (int tt = 0; tt < 16; ++tt) {
            const int tk = tq * 16 + tt;
            const float bt = sb[tk * 64 + d];
            const float q = bf2f(p.Pb()[(size_t)(tokg0 + tk) * PCOLS + P_GQ + h * 64 + d]);
            const float k = bf2f(p.Pb()[(size_t)(tokg0 + tk) * PCOLS + P_GK + h * 64 + d]);
            *(bf16_t*)(sQB + (tk * LDS_ROW + d) * 2) = f2bf(q * 0.125f * __expf(bt));
            *(bf16_t*)(sKB + (tk * LDS_ROW + d) * 2) = f2bf(k * __expf(-bt));
        }
    }
#pragma unroll
    for (int i = 0; i < 4; ++i) {
        const int cidx = tid + 256 * i, e = cidx >> 3, ch = (cidx & 7) * 8;
        *(u32x4*)(sVT + (e * LDS_ROW + ch) * 2) = *(const u32x4*)(p.VgT() + ((size_t)bh * 128 + e) * SEQ + tok0 + ch);
    }
    __syncthreads();
#pragma unroll
    for (int i = 0; i < 4; ++i) {
        const int cidx = tid + 256 * i, e = cidx >> 3, ch = (cidx & 7) * 8;
        *(u32x4*)(sST + (e * LDS_ROW + ch) * 2) = *(const u32x4*)(p.ST() + ((size_t)item << 13) + e * 64 + ch);
    }
    __syncthreads();
    bf16x8 qbf[2];
#pragma unroll
    for (int ks = 0; ks < 2; ++ks) qbf[ks] = *(const bf16x8*)(sQB + ((wid * 16 + fr) * LDS_ROW + ks * 32 + fq * 8) * 2);
    f32x4 sa[4];
#pragma unroll
    for (int ms = 0; ms < 4; ++ms) {
        sa[ms] = (f32x4){0.f, 0.f, 0.f, 0.f};
#pragma unroll
        for (int ks = 0; ks < 2; ++ks) {
            bf16x8 a = *(const bf16x8*)(sKB + ((ms * 16 + fr) * LDS_ROW + ks * 32 + fq * 8) * 2);
            sa[ms] = __builtin_amdgcn_mfma_f32_16x16x32_bf16(a, qbf[ks], sa[ms], 0, 0, 0);
        }
#pragma unroll
        for (int j = 0; j < 4; ++j) sa[ms][j] = (ms * 16 + fq * 4 + j <= wid * 16 + fr) ? sa[ms][j] : 0.f;
    }
    bf16x8 pf[2];
#pragma unroll
    for (int kk = 0; kk < 2; ++kk) {
        u32x4 w;
        w.x = pk_bf16(sa[2 * kk][0], sa[2 * kk][1]); w.y = pk_bf16(sa[2 * kk][2], sa[2 * kk][3]);
        w.z = pk_bf16(sa[2 * kk + 1][0], sa[2 * kk + 1][1]); w.w = pk_bf16(sa[2 * kk + 1][2], sa[2 * kk + 1][3]);
        pf[kk] = __builtin_bit_cast(bf16x8, w);
    }
    f32x4 oa[8];
    float sum = 0.f;
#pragma unroll
    for (int me = 0; me < 8; ++me) {
        f32x4 acc = (f32x4){0.f, 0.f, 0.f, 0.f};
#pragma unroll
        for (int ks = 0; ks < 2; ++ks) {
            bf16x8 a = *(const bf16x8*)(sST + ((me * 16 + fr) * LDS_ROW + ks * 32 + fq * 8) * 2);
            acc = __builtin_amdgcn_mfma_f32_16x16x32_bf16(a, qbf[ks], acc, 0, 0, 0);
        }
#pragma unroll
        for (int kk = 0; kk < 2; ++kk) {
            u32x2 lo = *(const u32x2*)(sVT + ((me * 16 + fr) * LDS_ROW + kk * 32 + fq * 4) * 2);
            u32x2 hi = *(const u32x2*)(sVT + ((me * 16 + fr) * LDS_ROW + kk * 32 + 16 + fq * 4) * 2);
            u32x4 w; w.x = lo.x; w.y = lo.y; w.z = hi.x; w.w = hi.y;
            acc = __builtin_amdgcn_mfma_f32_16x16x32_bf16(__builtin_bit_cast(bf16x8, w), pf[kk], acc, 0, 0, 0);
        }
        oa[me] = acc;
        sum += (acc[0] + acc[1]) + (acc[2] + acc[3]);
    }
    sum += __shfl_xor(sum, 16); sum += __shfl_xor(sum, 32);
    const float mu = sum * (1.f / 128.f);
    float var = 0.f;
#pragma unroll
    for (int me = 0; me < 8; ++me)
#pragma unroll
        for (int j = 0; j < 4; ++j) { const float dd = oa[me][j] - mu; var += dd * dd; }
    var += __shfl_xor(var, 16); var += __shfl_xor(var, 32);
    const float rstd = rsqrtf(var * (1.f / 128.f) + 1e-5f);
    const size_t tok = (size_t)tokg0 + wid * 16 + fr;
#pragma unroll
    for (int me = 0; me < 8; ++me) {
        const int e = me * 16 + fq * 4;
        const u32x2 rr = *(const u32x2*)(p.Pb() + tok * PCOLS + P_GR + h * 128 + e);
        const f32x4 nw = *(const f32x4*)(p.norm_w + e);
        float r[4] = {bflo(rr.x), bfhi(rr.x), bflo(rr.y), bfhi(rr.y)};
        float ov[4];
#pragma unroll
        for (int j = 0; j < 4; ++j) ov[j] = (oa[me][j] - mu) * rstd * nw[j] * (r[j] / (1.f + __expf(-r[j])));
        u32x2 w; w.x = pk_bf16(ov[0], ov[1]); w.y = pk_bf16(ov[2], ov[3]);
        *(u32x2*)(p.mixb() + tok * 1024 + 512 + h * 128 + e) = w;
    }
    __syncthreads();
}

#ifndef NSA_REP
#define NSA_REP 1
#endif
#ifndef NSA_MODE2
#define NSA_MODE2 0
#endif
#ifndef GLAC_REP
#define GLAC_REP 1
#endif
__device__ void phase5a(const Params& p, char* smem, int rep) {
    int* sidx = (int*)(smem + GEMM_SMEM - 16);
    for (;;) {
        __syncthreads();
        if (opaque_tid() == 0) *sidx = atomicAdd(&p.counts()[264 + 4 * rep], 1);
        __syncthreads();
        const int it = *sidx;
        if (it >= 512) break;
        nsa_cmp_item(p, it >> 3, it & 7, smem);
    }
    for (;;) {
        __syncthreads();
        if (opaque_tid() == 0) *sidx = atomicAdd(&p.counts()[265 + 4 * rep], 1);
        __syncthreads();
        const int it = *sidx;
        if (it >= 1024 * GLAC_REP) break;
        gla_c_item(p, it & 1023, smem);
    }
}
__device__ void phase5b(const Params& p, char* smem, int rep) {
    int* sidx = (int*)(smem + GEMM_SMEM - 16);
    for (;;) {
        __syncthreads();
        if (opaque_tid() == 0) *sidx = atomicAdd(&p.counts()[266 + 4 * rep], 1);
        __syncthreads();
        const int it = *sidx;
        if (it >= 1024 * NSA_REP) break;
        const int item = it & 1023;
        nsa_sw_item(p, item >> 4, (item >> 1) & 7, item & 1, smem, it >= 1024 ? NSA_MODE2 : 0);
    }
}
__device__ void phase6(const Params& p, char* smem) {
    const int xcd = xcd_of(smem), rank = rank_of(smem), nranks = nranks_of(smem);
    const int lane = opaque_tid() & 63, wid = opaque_tid() >> 6, wr = wid >> 1, wc = wid & 1, fr = lane & 15, fq = lane >> 4;
    for (int it = rank; it < 16 * 8; it += nranks) {
        const int mt = (it / 8) * 8 + xcd, nt = it % 8;
        RowsBf16 al{p.mixb() + (size_t)mt * 128 * 1024, 1024};
        RowsBf16 bl{p.wot() + (size_t)nt * 128 * 1024, 1024};
        f32x4 acc[4][4];
        gemm_128<true, false>(al, bl, 0, 16, smem, acc);
#pragma unroll
        for (int m = 0; m < 4; ++m)
#pragma unroll
            for (int n = 0; n < 4; ++n)
                *(f32x4*)(p.y1() + (size_t)(mt * 128 + wr * 64 + m * 16 + fr) * 1024 + nt * 128 + wc * 64 + n * 16 + fq * 4) = acc[m][n];
    }
}

__device__ void phase7(const Params& p) {
    const int lane = opaque_tid() & 63, gw = blockIdx.x * 4 + (opaque_tid() >> 6), nw = gridDim.x * 4;
    const float alpha = 1.189207115f;
    for (int row0 = gw * 2; row0 < NTOK; row0 += nw * 2) {
        const int b = row0 / SEQ;
        const float* md = p.mod() + b * 6144;
        f32x4 xv[2][4], yv[2][4];
#pragma unroll
        for (int r = 0; r < 2; ++r)
#pragma unroll
            for (int i = 0; i < 4; ++i) {
                const int col = i * 256 + lane * 4;
                xv[r][i] = *(const f32x4*)(p.x + (size_t)(row0 + r) * 1024 + col);
                yv[r][i] = *(const f32x4*)(p.y1() + (size_t)(row0 + r) * 1024 + col);
            }
#pragma unroll
        for (int r = 0; r < 2; ++r) {
            const int row = row0 + r;
            f32x4 v[4]; float s = 0.f;
#pragma unroll
            for (int i = 0; i < 4; ++i) {
                const int col = i * 256 + lane * 4;
                const f32x4 ga = *(const f32x4*)(md + 2048 + col);
#pragma unroll
                for (int j = 0; j < 4; ++j) v[i][j] = alpha * xv[r][i][j] + (1.f + ga[j]) * yv[r][i][j];
                s += (v[i][0] + v[i][1]) + (v[i][2] + v[i][3]);
            }
            float mu = wave_sum(s) * (1.f / 1024.f);
            float q = 0.f;
#pragma unroll
            for (int i = 0; i < 4; ++i)
#pragma unroll
                for (int j = 0; j < 4; ++j) { float d = v[i][j] - mu; q += d * d; }
            float rstd = rsqrtf(wave_sum(q) * (1.f / 1024.f) + 1e-5f);
            s = 0.f;
#pragma unroll
            for (int i = 0; i < 4; ++i) {
                const int col = i * 256 + lane * 4;
                f32x4 g = *(const f32x4*)(p.ln1_g + col), bb = *(const f32x4*)(p.ln1_b + col);
#pragma unroll
                for (int j = 0; j < 4; ++j) v[i][j] = (v[i][j] - mu) * rstd * g[j] + bb[j];
                *(f32x4*)(p.x1() + (size_t)row * 1024 + col) = v[i];
                s += (v[i][0] + v[i][1]) + (v[i][2] + v[i][3]);
            }
            mu = wave_sum(s) * (1.f / 1024.f);
            q = 0.f;
#pragma unroll
            for (int i = 0; i < 4; ++i)
#pragma unroll
                for (int j = 0; j < 4; ++j) { float d = v[i][j] - mu; q += d * d; }
            rstd = rsqrtf(wave_sum(q) * (1.f / 1024.f) + 1e-5f);
#pragma unroll
            for (int i = 0; i < 4; ++i) {
                const int col = i * 256 + lane * 4;
                f32x4 sh = *(const f32x4*)(md + 3072 + col), sc = *(const f32x4*)(md + 4096 + col);
                float o[4];
#pragma unroll
                for (int j = 0; j < 4; ++j) o[j] = (v[i][j] - mu) * rstd * (1.f + sc[j]) + sh[j];
                u32x2 w; w.x = pk_bf16(o[0], o[1]); w.y = pk_bf16(o[2], o[3]);
                *(u32x2*)(p.hb() + (size_t)row * 1024 + col) = w;
            }
        }
    }
}

__device__ void phase8(const Params& p, char* smem) {
    const int lane = opaque_tid() & 63, wid = opaque_tid() >> 6, wr = wid >> 1, wc = wid & 1, fr = lane & 15, fq = lane >> 4;
    for (int it = blockIdx.x; it < 256; it += gridDim.x) {
        const int mt = it >> 1, nt = it & 1;
        RowsBf16 al{p.hb() + (size_t)mt * 128 * 1024, 1024};
        RowsBf16 bl{p.wrt() + (size_t)nt * 128 * 1024, 1024};
        f32x4 acc[4][4];
        gemm_128<true, false>(al, bl, 0, 16, smem, acc);
#pragma unroll
        for (int m = 0; m < 4; ++m)
#pragma unroll
            for (int n = 0; n < 4; ++n)
                *(f32x4*)(p.logits() + (size_t)(mt * 128 + wr * 64 + m * 16 + fr) * 256 + nt * 128 + wc * 64 + n * 16 + fq * 4) = acc[m][n];
    }
}

__device__ void phase9(const Params& p) {
    const int lane = opaque_tid() & 63, gw = blockIdx.x * 4 + (opaque_tid() >> 6), nw = gridDim.x * 4;
    for (int tok = gw; tok < NTOK; tok += nw) {
        float s[4], sb[4];
        const f32x4 lg = *(const f32x4*)(p.logits() + (size_t)tok * 256 + lane * 4);
        const f32x4 rb = *(const f32x4*)(p.rbias + lane * 4);
#pragma unroll
        for (int i = 0; i < 4; ++i) { s[i] = 1.f / (1.f + __expf(-lg[i])); sb[i] = s[i] + rb[i]; }
        float m1 = NEGF, m2 = NEGF;
#pragma unroll
        for (int i = 0; i < 4; ++i) { float v = sb[i]; if (v > m1) { m2 = m1; m1 = v; } else if (v > m2) m2 = v; }
#pragma unroll
        for (int mm = 1; mm < 8; mm <<= 1) {
            float o1 = __shfl_xor(m1, mm), o2 = __shfl_xor(m2, mm);
            float n1 = fmaxf(m1, o1);
            float n2 = fmaxf(fminf(m1, o1), fmaxf(m2, o2));
            m1 = n1; m2 = n2;
        }
        const float gs = m1 + m2;
        const int grp = lane >> 3;
        int grank = 0;
#pragma unroll
        for (int g2 = 0; g2 < 8; ++g2) { float o = __shfl(gs, g2 * 8); if (o > gs || (o == gs && g2 < grp)) ++grank; }
        const bool gsel = grank < 4;
        float cand[4];
#pragma unroll
        for (int i = 0; i < 4; ++i) cand[i] = gsel ? sb[i] : NEGF;
        float wsum = 0.f, myw = 0.f; int mye = 0;
#pragma unroll 1
        for (int k = 0; k < TOPK; ++k) {
            float bv = cand[0]; int bi = 0;
#pragma unroll
            for (int i = 1; i < 4; ++i) if (cand[i] > bv) { bv = cand[i]; bi = i; }
            float gv = bv; int ge = lane * 4 + bi;
#pragma unroll
            for (int mm = 1; mm < 64; mm <<= 1) {
                float ov = __shfl_xor(gv, mm); int oe = __shfl_xor(ge, mm);
                if (ov > gv || (ov == gv && oe < ge)) { gv = ov; ge = oe; }
            }
            float sel_s = 0.f;
            if ((ge >> 2) == lane) {
                const int i = ge & 3;
                sel_s = (i == 0) ? s[0] : (i == 1) ? s[1] : (i == 2) ? s[2] : s[3];
                if (i == 0) cand[0] = -3e38f; else if (i == 1) cand[1] = -3e38f; else if (i == 2) cand[2] = -3e38f; else cand[3] = -3e38f;
            }
            sel_s = __shfl(sel_s, ge >> 2);
            wsum += sel_s;
            if (lane == k) { myw = sel_s; mye = ge; }
        }
        if (lane < TOPK) {
            const int id = tok * NASSIGN + lane;
            p.ew()[id] = myw / wsum * 2.5f;
            const int pos = atomicAdd(&p.counts()[mye], 1);
            p.lists()[(size_t)mye * NTOK + pos] = id;
        } else if (lane == TOPK) {
            p.ew()[tok * NASSIGN + TOPK] = 1.f;
        }
    }
}

struct Rows4 {
    static constexpr bool NT = false;
    const bf16_t *p0, *p1, *p2, *p3; int kmask;
    __device__ __forceinline__ const bf16_t* pp(int i, int tid, int k) const { return (i == 0 ? p0 : i == 1 ? p1 : i == 2 ? p2 : p3) + (k & kmask); }
};
template <int NT_PER>
__device__ __forceinline__ int build_entries(const Params& p, int xcd, int* spre) {
    const int tid = opaque_tid();
    __syncthreads();
    if (tid < 33) {
        int items;
        if (tid < 32) { const int cnt = p.counts()[xcd + 8 * tid]; items = ((cnt + 127) >> 7) * NT_PER; }
        else items = 16 * NT_PER;
        spre[64 + tid] = items;
    }
    __syncthreads();
    if (tid == 0) { int a = 0; for (int i = 0; i < 33; ++i) { spre[i] = a; a += spre[64 + i]; } spre[33] = a; }
    __syncthreads();
    return spre[33];
}

template <int NT_PER>
__device__ __forceinline__ void decode_item(const Params& p, int xcd, const int* spre, int it, int& e, int& nt, int& mtile, int& cnt) {
    int ent = 0;
    for (int i = 1; i < 33; ++i) ent = (it >= spre[i]) ? i : ent;
    const int local = it - spre[ent];
    if (ent < 32) {
        e = xcd + 8 * ent; cnt = p.counts()[e];
        const int mtc = (cnt + 127) >> 7;
        nt = local / mtc; mtile = local % mtc;
    } else {
        e = N_EXP; cnt = NTOK; nt = local >> 4; mtile = (local & 15) * 8 + xcd;
    }
}

#ifndef P10_NT
#define P10_NT 4
#endif
struct BF32GateUpS {
    const float* g; long du;
    __device__ __forceinline__ const float* addr(int kk, int r4) const { const long sel = ((r4 >> 5) & 1) ? du : 0l; return g + sel + (size_t)(kk & 1023) * 256 + (kk >> 10) * 64 + (r4 >> 6) * 32 + (r4 & 31); }
    __device__ __forceinline__ f32x4 load4(int kk, int r4) const {
        const long sel = ((r4 >> 5) & 1) ? du : 0l;
        return *(const f32x4*)(g + sel + (size_t)(kk & 1023) * 256 + (kk >> 10) * 64 + (r4 >> 6) * 32 + (r4 & 31));
    }
};
__device__ void phase10(const Params& p, char* smem) {
    const int tid = opaque_tid(), xcd = xcd_of(smem), rank = rank_of(smem), nranks = nranks_of(smem);
    const int lane = tid & 63, wid = tid >> 6, wr = wid >> 1, wc = wid & 1, fr = lane & 15, fq = lane >> 4;
    int* srow = (int*)(smem + GEMM_SMEM);
    int* spre = srow + 256;
#ifndef P10_REP
#define P10_REP 1
#endif
    const int total = build_entries<P10_NT>(p, xcd, spre);
#ifdef STAGGER
    for (int i = 0; i < (rank & 3) * STAGGER; ++i) __builtin_amdgcn_s_sleep(32);
#endif
    for (int it0 = rank; it0 < total * P10_REP; it0 += nranks) {
        const int it = it0 % total;
        int e, nt, mtile, cnt;
        decode_item<P10_NT>(p, xcd, spre, it, e, nt, mtile, cnt);
        if (tid < 128) {
            const int pos = mtile * 128 + tid;
            int id = -1;
            if (pos < cnt) id = (e == N_EXP) ? (pos * NASSIGN + TOPK) : p.lists()[(size_t)e * NTOK + pos];
            srow[tid] = id >= 0 ? id / NASSIGN : 0;
            srow[128 + tid] = id;
        }
        __syncthreads();
        Rows4 al; al.kmask = 1023;
        al.p0 = p.hb() + (size_t)srow[(tid >> 3)] * 1024; al.p1 = p.hb() + (size_t)srow[32 + (tid >> 3)] * 1024;
        al.p2 = p.hb() + (size_t)srow[64 + (tid >> 3)] * 1024; al.p3 = p.hb() + (size_t)srow[96 + (tid >> 3)] * 1024;
        const float* Wg = (e == N_EXP) ? p.w_s_gate : p.w_e_gate + (size_t)e * 1024 * 256;
        const float* Wu = (e == N_EXP) ? p.w_s_up : p.w_e_up + (size_t)e * 1024 * 256;
        BF32GateUpS bl{Wg + nt * (256 / P10_NT), (long)(Wu - Wg)};
        f32x4 acc[4][4];
        bf16_t* hidp = p.hid();
        gemm_core<true, true>(al, bl, 0, 16 * (4 / P10_NT), 16, smem, acc, [&](int tl, const f32x4 (&a)[4][4]) __attribute__((always_inline)) {
            const int nt4 = nt * (4 / P10_NT) + tl;
#pragma unroll
            for (int m = 0; m < 4; ++m) {
                const int id = srow[128 + wr * 64 + m * 16 + fr];
                if (id >= 0) {
#pragma unroll
                    for (int n = 0; n < 2; ++n) {
                        float hv[4];
#pragma unroll
                        for (int j = 0; j < 4; ++j) { const float gte = a[m][n][j]; hv[j] = gte / (1.f + __expf(-gte)) * a[m][n + 2][j]; }
                        u32x2 w; w.x = pk_bf16(hv[0], hv[1]); w.y = pk_bf16(hv[2], hv[3]);
                        *(u32x2*)(hidp + (size_t)id * 256 + nt4 * 64 + wc * 32 + n * 16 + fq * 4) = w;
                    }
                }
            }
        });
        __syncthreads();
    }
}

struct DownB {
    const float* base;
    __device__ __forceinline__ const float* addr(int kk, int r4) const { return base + (size_t)(kk & 255) * 1024 + (kk >> 8) * 128 + r4; }
    __device__ __forceinline__ f32x4 load4(int kk, int r4) const {
#ifdef NT_B
        return __builtin_nontemporal_load((const f32x4*)(base + (size_t)(kk & 255) * 1024 + (kk >> 8) * 128 + r4));
#else
        return *(const f32x4*)(base + (size_t)(kk & 255) * 1024 + (kk >> 8) * 128 + r4);
#endif
    }
};
struct HidA {
    static constexpr bool NT = true;
    const bf16_t* base; const int* rowidx;
    __device__ __forceinline__ const bf16_t* ptr(int r, int kk) const { return base + (size_t)rowidx[r] * 256 + (kk & 255); }
    __device__ __forceinline__ const bf16_t* pp(int i, int tid, int k) const { return ptr(i * 32 + (tid >> 3), k); }
};
#ifndef P11_NT
#define P11_NT 4
#endif
__device__ void phase11(const Params& p, char* smem) {
    const int tid = opaque_tid(), xcd = xcd_of(smem), rank = rank_of(smem), nranks = nranks_of(smem);
    const int lane = tid & 63, wid = tid >> 6, wr = wid >> 1, wc = wid & 1, fr = lane & 15, fq = lane >> 4;
    int* srow = (int*)(smem + GEMM_SMEM);
    int* spre = srow + 256;
    float* sew = (float*)(srow + 384);
#ifndef P11_REP
#define P11_REP 1
#endif
    const int total = build_entries<P11_NT>(p, xcd, spre);
    for (int it0 = rank; it0 < total * P11_REP; it0 += nranks) {
        const int it = it0 % total;
        int e, nt, mtile, cnt;
        decode_item<P11_NT>(p, xcd, spre, it, e, nt, mtile, cnt);
        if (tid < 128) {
            const int pos = mtile * 128 + tid;
            int id = -1;
            if (pos < cnt) id = (e == N_EXP) ? (pos * NASSIGN + TOPK) : p.lists()[(size_t)e * NTOK + pos];
            srow[tid] = id >= 0 ? id : 0;
            srow[128 + tid] = id;
            sew[tid] = id >= 0 ? p.ew()[id] : 0.f;
        }
        __syncthreads();
        Rows4 al; al.kmask = 255;
        al.p0 = p.hid() + (size_t)srow[(tid >> 3)] * 256; al.p1 = p.hid() + (size_t)srow[32 + (tid >> 3)] * 256;
        al.p2 = p.hid() + (size_t)srow[64 + (tid >> 3)] * 256; al.p3 = p.hid() + (size_t)srow[96 + (tid >> 3)] * 256;
        DownB bl{(e == N_EXP) ? p.w_s_down : p.w_e_down + (size_t)e * 256 * 1024};
        f32x4 acc[4][4];
        bf16_t* outk = p.outk();
        auto epi = [&](int tile, const f32x4 (&a)[4][4]) __attribute__((always_inline)) {
#pragma unroll
            for (int m = 0; m < 4; ++m) {
                const int rr = wr * 64 + m * 16 + fr;
                const int id = srow[128 + rr];
                if (id >= 0) {
                    const float w8 = sew[rr];
#pragma unroll
                    for (int n = 0; n < 4; ++n) {
                        u32x2 w; w.x = pk_bf16(a[m][n][0] * w8, a[m][n][1] * w8); w.y = pk_bf16(a[m][n][2] * w8, a[m][n][3] * w8);
                        *(u32x2*)(outk + (size_t)id * 1024 + tile * 128 + wc * 64 + n * 16 + fq * 4) = w;
                    }
                }
            }
        };
        gemm_core<true, true>(al, bl, nt * (2048 / P11_NT), 32 / P11_NT, 4, smem, acc, [&](int tl, const f32x4 (&a)[4][4]) __attribute__((always_inline)) { epi(nt * (8 / P11_NT) + tl, a); });
        __syncthreads();
    }
}

__device__ void phase12(const Params& p) {
    const int lane = opaque_tid() & 63, gw = blockIdx.x * 4 + (opaque_tid() >> 6), nw = gridDim.x * 4;
    const float alpha = 1.189207115f;
    for (int row = gw; row < NTOK; row += nw) {
        const int b = row / SEQ;
        const float* md = p.mod() + b * 6144;
        float v[16];
#pragma unroll
        for (int i = 0; i < 16; ++i) v[i] = 0.f;
#pragma unroll
        for (int k = 0; k < NASSIGN; ++k) {
#pragma unroll
            for (int cidx = 0; cidx < 2; ++cidx) {
                const u32x4 w = *(const u32x4*)(p.outk() + ((size_t)row * NASSIGN + k) * 1024 + cidx * 512 + lane * 8);
                v[cidx * 8 + 0] += bflo(w.x); v[cidx * 8 + 1] += bfhi(w.x); v[cidx * 8 + 2] += bflo(w.y); v[cidx * 8 + 3] += bfhi(w.y);
                v[cidx * 8 + 4] += bflo(w.z); v[cidx * 8 + 5] += bfhi(w.z); v[cidx * 8 + 6] += bflo(w.w); v[cidx * 8 + 7] += bfhi(w.w);
            }
        }
        float s = 0.f;
#pragma unroll
        for (int cidx = 0; cidx < 2; ++cidx)
#pragma unroll
            for (int hh = 0; hh < 2; ++hh) {
                const int col = cidx * 512 + lane * 8 + hh * 4;
                const f32x4 xv = *(const f32x4*)(p.x1() + (size_t)row * 1024 + col), ga = *(const f32x4*)(md + 5120 + col);
#pragma unroll
                for (int j = 0; j < 4; ++j) { float t = alpha * xv[j] + (1.f + ga[j]) * v[cidx * 8 + hh * 4 + j]; v[cidx * 8 + hh * 4 + j] = t; s += t; }
            }
        const float mu = wave_sum(s) * (1.f / 1024.f);
        float q = 0.f;
#pragma unroll
        for (int i = 0; i < 16; ++i) { float d = v[i] - mu; q += d * d; }
        const float rstd = rsqrtf(wave_sum(q) * (1.f / 1024.f) + 1e-5f);
#pragma unroll
        for (int cidx = 0; cidx < 2; ++cidx)
#pragma unroll
            for (int hh = 0; hh < 2; ++hh) {
                const int col = cidx * 512 + lane * 8 + hh * 4;
                const f32x4 g = *(const f32x4*)(p.ln2_g + col), bb = *(const f32x4*)(p.ln2_b + col);
                f32x4 o;
#pragma unroll
                for (int j = 0; j < 4; ++j) o[j] = (v[cidx * 8 + hh * 4 + j] - mu) * rstd * g[j] + bb[j];
                *(f32x4*)(p.out + (size_t)row * 1024 + col) = o;
            }
    }
}

#define XB_TMO      128
#define XB_XCNT(j)  (256  + 64 * (j))
#define XB_XSUB(j)  (1280 + 64 * (j))
#define XB_XGEN(j)  (2304 + 64 * (j))
#define XB_TOP      3328
#define XB_TOPGEN   3392
#define XCD_BAR_WORDS 3456
#define XB_SPIN_CAP (1u << 22)
#define LAS __attribute__((address_space(3)))
__device__ __forceinline__ unsigned xb_ld(unsigned* p) { return __hip_atomic_load(p, __ATOMIC_RELAXED, __HIP_MEMORY_SCOPE_AGENT); }
__device__ __forceinline__ unsigned xb_add(unsigned* p, unsigned v) { return __hip_atomic_fetch_add(p, v, __ATOMIC_RELAXED, __HIP_MEMORY_SCOPE_AGENT); }
__device__ __forceinline__ unsigned xb_xcc_id() { return (unsigned)__builtin_amdgcn_s_getreg((3 << 11) | 20) & 0xFu; }
#define XB_SPIN(cond, bar) do { unsigned _sp = 0; while (cond) { __builtin_amdgcn_s_sleep(1); \
    if ((++_sp & 255u) == 0u) { if (xb_ld(&(bar)[XB_TMO])) break; if (_sp > XB_SPIN_CAP) { atomicAdd(&(bar)[XB_TMO], 1u); break; } } } } while (0)
struct XcdBarrier { unsigned* bar; unsigned x; volatile LAS unsigned* st; };
__device__ __forceinline__ XcdBarrier xcd_barrier_post(unsigned* bar, volatile LAS unsigned* st) {
    XcdBarrier b; b.bar = bar; b.x = xb_xcc_id(); b.st = st;
    if (opaque_tid() == 0) st[2] = xb_add(&bar[XB_XCNT(b.x)], 1u);
    return b;
}
__device__ __forceinline__ void xcd_barrier_complete(unsigned* bar, unsigned x, unsigned& nloc, unsigned& nx, unsigned& dense) {
    const unsigned G = gridDim.x * gridDim.y * gridDim.z;
    unsigned sum, cnt, mine, below, sp = 0u;
    for (;;) {
        sum = 0u; cnt = 0u; mine = 0u; below = 0u;
#pragma unroll
        for (unsigned j = 0; j < 16; ++j) { const unsigned c = xb_ld(&bar[XB_XCNT(j)]); sum += c; cnt += (c > 0u) ? 1u : 0u; mine = (j == x) ? c : mine; below += (j < x && c > 0u) ? 1u : 0u; }
        if (sum == G) break;
        __builtin_amdgcn_s_sleep(1);
        if ((++sp & 255u) == 0u) { if (xb_ld(&bar[XB_TMO])) break; if (sp > XB_SPIN_CAP) { atomicAdd(&bar[XB_TMO], 1u); break; } }
    }
    nloc = mine > 0u ? mine : 1u; nx = cnt > 0u ? cnt : 1u; dense = below;
}
__device__ __forceinline__ void xcd_barrier(unsigned* bar, volatile LAS unsigned* st) {
    asm volatile("s_waitcnt vmcnt(0)" ::: "memory");
    __syncthreads();
    if (opaque_tid() == 0) {
        __builtin_amdgcn_s_waitcnt(0);
        const unsigned x = st[3];
        unsigned nloc = st[0], nx = st[1];
        if (nloc == 0u) {
            unsigned dense;
            xcd_barrier_complete(bar, x, nloc, nx, dense); st[0] = nloc; st[1] = nx;
            const unsigned use_xcc = (nx == 8u) ? 1u : 0u;
            st[4] = use_xcc ? dense : (blockIdx.x & 7u);
            st[5] = use_xcc ? st[2] : (blockIdx.x >> 3);
            st[6] = use_xcc ? nloc : (gridDim.x >> 3);
        }
        const unsigned old = xb_add(&bar[XB_XSUB(x)], 1u);
        const unsigned gen = old / nloc;
        if (old + 1u == (gen + 1u) * nloc) {
            __builtin_amdgcn_fence(__ATOMIC_RELEASE, "agent");
            asm volatile("s_waitcnt vmcnt(0)" ::: "memory");
            const unsigned og = xb_add(&bar[XB_TOP], 1u);
            const unsigned tg = og / nx;
            if (og + 1u == (tg + 1u) * nx) xb_add(&bar[XB_TOPGEN], 1u);
            else XB_SPIN(xb_ld(&bar[XB_TOPGEN]) == tg, bar);
            __builtin_amdgcn_fence(__ATOMIC_ACQUIRE, "agent");
            xb_add(&bar[XB_XGEN(x)], 1u);
            asm volatile("s_waitcnt vmcnt(0)" ::: "memory");
        } else {
            XB_SPIN(xb_ld(&bar[XB_XGEN(x)]) == gen, bar);
            __builtin_amdgcn_fence(__ATOMIC_ACQUIRE, "agent");
            asm volatile("s_waitcnt vmcnt(0)" ::: "memory");
        }
    }
    __syncthreads();
}

#define MEGA_SMEM (GEMM_SMEM + 2048 + 64)
#define N_PHASES 14
__global__ void __launch_bounds__(256, 2) mega(Params p) {
    extern __shared__ __attribute__((aligned(16))) char smem[];
    volatile LAS unsigned* st = (volatile LAS unsigned*)(smem + GEMM_SMEM + 2048);
    if (p.ph_hi - p.ph_lo > 1) {
        if (opaque_tid() == 0) {
            const unsigned x = xb_xcc_id();
            st[0] = 0u; st[1] = 0u; st[3] = x;
            st[2] = xb_add(&p.bar()[XB_XCNT(x)], 1u);
        }
    } else {
        if (opaque_tid() == 0) { st[0] = gridDim.x >> 3; st[1] = 8u; st[2] = blockIdx.x >> 3; st[3] = blockIdx.x & 7; st[4] = blockIdx.x & 7; st[5] = blockIdx.x >> 3; st[6] = gridDim.x >> 3; }
    }
    __syncthreads();
#ifndef REP_PHASE
#define REP_PHASE -1
#endif
#ifdef PHPROF
#define PH_STAMP(N) if (blockIdx.x == 0 && opaque_tid() == 0) ((unsigned long long*)(p.ws + OFF_counts + 1536))[N] = __builtin_amdgcn_s_memrealtime();
#else
#define PH_STAMP(N)
#endif
#define RUN_PHASE(N, CALL) if (p.ph_lo <= N && N < p.ph_hi) { if (N > p.ph_lo) xcd_barrier(p.bar(), st); PH_STAMP(N) { const int rep = 0; (void)rep; CALL; } \
        if (REP_PHASE == N) { xcd_barrier(p.bar(), st); { const int rep = 1; (void)rep; CALL; } } }
    RUN_PHASE(0, phase0(p, smem))
    RUN_PHASE(1, phase1(p))
    RUN_PHASE(2, phase2(p, smem))
    RUN_PHASE(3, phase3(p, smem))
    RUN_PHASE(4, phase4(p, smem))
    RUN_PHASE(5, phase5a(p, smem, rep))
    RUN_PHASE(6, phase5b(p, smem, rep))
    RUN_PHASE(7, phase6(p, smem))
    RUN_PHASE(8, phase7(p))
    RUN_PHASE(9, phase8(p, smem))
    RUN_PHASE(10, phase9(p))
    RUN_PHASE(11, phase10(p, smem))
    RUN_PHASE(12, phase11(p, smem))
    RUN_PHASE(13, phase12(p))
#ifdef EXTRA_BARRIERS
    for (int i = 0; i < EXTRA_BARRIERS; ++i) xcd_barrier(p.bar(), st);
#endif
    PH_STAMP(14)
    PH_STAMP(15)
}
#if DBG
struct NaiveBufs { float *mod, *h, *proj, *flat, *hidk, *hidv, *kc, *vc, *mix, *ograw, *y, *x1, *logits; };
__device__ __forceinline__ void dbg_pair(int seam, size_t i, const Params& p, const NaiveBufs& nb, float& a, float& b, bool& use) {
    use = true; a = 0.f; b = 0.f;
    switch (seam) {
        case 0: {
            a = nb.mod[i]; b = p.mod()[i]; break; }
        case 1: {
            size_t tok = i / PCOLS; int n = (int)(i % PCOLS);
            int src = win_srccol(n);
            bool transposed = (n >= 896 && n < 1024) || (n >= 1152 && n < 1280) || (n >= 1792 && n < 2304) || n >= 2816;
            if (transposed || src < 0) { use = false; break; }
            a = nb.proj[tok * IN_COLS + src]; b = bf2f(p.Pb()[i]); break; }
        case 2: {
            size_t half = (size_t)BATCH * 128 * SEQ; int which = i >= half; size_t j = which ? i - half : i;
            int t = (int)(j % SEQ); int f = (int)((j / SEQ) % 128); int bb = (int)(j / ((size_t)SEQ * 128));
            a = nb.proj[((size_t)bb * SEQ + t) * IN_COLS + (which ? C_VW : C_VS) + f];
            b = bf2f(which ? p.VwT()[j] : p.VsT()[j]); break; }
        case 3: {
            size_t nv = (size_t)BATCH * 512 * SEQ;
            if (i < nv) { int t = (int)(i % SEQ); int f = (int)((i / SEQ) % 512); int bb = (int)(i / ((size_t)SEQ * 512));
                a = nb.proj[((size_t)bb * SEQ + t) * IN_COLS + C_GV + f]; b = bf2f(p.VgT()[i]); }
            else { size_t j = i - nv; size_t tok = j / 40; int f = (int)(j % 40);
                a = nb.proj[tok * IN_COLS + (f < 24 ? C_NG + f : C_GLR + f - 24)]; b = p.misc()[tok * 64 + f]; }
            break; }
        case 4: {
            size_t nk = (size_t)BATCH * NCMP * 2 * 64;
            size_t j = i < nk ? i : i - nk;
            int d = (int)(j % 64); int g = (int)((j / 64) % 2); int ii = (int)((j / 128) % NCMP); int bb = (int)(j / (128 * NCMP));
            if (i < nk) { a = nb.kc[j]; b = bf2f(p.kc()[((size_t)(bb * 2 + g) * 256 + ii) * 64 + d]); }
            else { a = nb.vc[j]; b = bf2f(p.vcT()[((size_t)(bb * 2 + g) * 64 + d) * 256 + ii]); }
            break; }
        case 5: {
            size_t tok = i / 512; int cidx = (int)(i % 512);
            a = nb.mix[tok * 1024 + cidx]; b = bf2f(p.mixb()[tok * 1024 + cidx]); break; }
        case 6: {
            size_t tok = i / 512; int cidx = (int)(i % 512);
            a = nb.mix[tok * 1024 + 512 + cidx]; b = bf2f(p.mixb()[tok * 1024 + 512 + cidx]); break; }
        case 7: { a = nb.x1[i]; b = p.x1()[i]; break; }
        case 8: { a = nb.logits[i]; b = p.logits()[i]; break; }
    }
}
__global__ __launch_bounds__(256) void dbg_compare(int seam, size_t n, Params p, NaiveBufs nb, float* dbg) {
    __shared__ float red[256];
    float sd = 0.f, sa = 0.f;
    for (size_t i = (size_t)blockIdx.x * 256 + threadIdx.x; i < n; i += (size_t)gridDim.x * 256) {
        float a, b; bool use;
        dbg_pair(seam, i, p, nb, a, b, use);
        if (use) { float d = a - b; if (!(d == d)) d = 1e10f; sd += d * d; sa += a * a; }
    }
    sd = blk_sum(sd, red); sa = blk_sum(sa, red);
    if (threadIdx.x == 0) { atomicAdd(&dbg[2 * seam], sd); atomicAdd(&dbg[2 * seam + 1], sa); }
}
__global__ void dbg_decide(float* dbg, int nseams, int report_seam) {
    float code = 0.f;
    for (int k = 0; k < nseams; ++k) {
        float err = dbg[2 * k] / fmaxf(dbg[2 * k + 1], 1e-30f);
        const float thr = (k == 5) ? 3e-2f : 1e-3f;
        bool bad = !(err < thr);
        if (bad || k == report_seam) {
            float lg = log10f(fmaxf(err, 1e-12f));
            int dgt = (int)floorf(lg) + 6; dgt = dgt < 0 ? 0 : (dgt > 9 ? 9 : dgt);
            code = 100.f * (k + 1) + 10.f * dgt; break;
        }
    }
    dbg[64] = code;
}
__global__ void dbg_apply(const float* dbg, float* out, size_t n) {
    float code = dbg[64];
    if (code <= 0.f) return;
    float cst = sqrtf(code);
    for (size_t i = (size_t)blockIdx.x * 256 + threadIdx.x; i < n; i += (size_t)gridDim.x * 256) out[i] = cst;
}
#endif

#ifdef PROF
__global__ void prof_apply(const unsigned long long* pw, float* out, size_t n, int sel) {
    const double proc = (double)pw[0], tot = (double)pw[1], steps = (double)pw[2];
    float code = 0.f;
    if (sel == 0) code = (float)(100.0 * proc / tot);
    if (sel == 1) code = (float)(tot / steps / 10.0);
    if (sel == 2) code = (float)(proc / steps / 10.0);
    if (sel == 3) code = (float)(steps / 1024.0);
    const float cst = sqrtf(code);
    for (size_t i = (size_t)blockIdx.x * 256 + threadIdx.x; i < n; i += (size_t)gridDim.x * 256) out[i] = cst;
}
#endif
#ifdef PHPROF
__global__ void phase_prof_apply(const unsigned long long* ts, float* out, size_t n, int sel) {
    double us;
    if (sel >= 100) us = (double)(ts[15] - ts[0]) / 100.0;
    else us = (double)(ts[sel + 1] - ts[sel]) / 100.0;
    const float cst = (float)log2(us > 1.0 ? us : 1.0);
    for (size_t i = (size_t)blockIdx.x * 256 + threadIdx.x; i < n; i += (size_t)gridDim.x * 256) out[i] = cst;
}
#endif
extern "C" void kernel_launch(void* const* d_in, const int* in_sizes, int n_in, void* d_out, int out_size,
                              void* d_ws, size_t ws_size, hipStream_t stream) {
    Params p{};
    const float** ins = (const float**)&p;
    for (int i = 0; i < 27; ++i) ins[i] = (const float*)d_in[i];
    p.out = (float*)d_out;

    char* ws = (char*)d_ws;
    p.ws = ws;
    if (WS_TOTAL > ws_size) return;
#if DBG
    size_t off = 0;
    auto alloc = [&](size_t bytes) { char* q = ws + off; off += (bytes + 255) & ~(size_t)255; return q; };
    NaiveBufs nb{};
    nb.mod = (float*)alloc(4 * 6144 * 4);
    nb.h = (float*)alloc((size_t)NTOK * 1024 * 4);
    nb.proj = (float*)alloc((size_t)NTOK * IN_COLS * 4);
    nb.flat = (float*)alloc((size_t)2040 * 2048 * 4);
    nb.hidk = (float*)alloc((size_t)2040 * 256 * 4);
    nb.hidv = (float*)alloc((size_t)2040 * 256 * 4);
    nb.kc = (float*)alloc((size_t)2040 * 64 * 4);
    nb.vc = (float*)alloc((size_t)2040 * 64 * 4);
    nb.mix = (float*)alloc((size_t)NTOK * 1024 * 4);
    nb.ograw = (float*)alloc((size_t)NTOK * 512 * 4);
    nb.y = (float*)alloc((size_t)NTOK * 1024 * 4);
    nb.x1 = (float*)alloc((size_t)NTOK * 1024 * 4);
    nb.logits = (float*)alloc((size_t)NTOK * 256 * 4);
    float* dbg = (float*)alloc(1024);
    if (off > WS_BASE) return;
#endif

    static int grid = 0;
    if (grid == 0) {
        int dev = 0, cus = 0, per_cu = 0;
        (void)hipGetDevice(&dev);
        (void)hipDeviceGetAttribute(&cus, hipDeviceAttributeMultiprocessorCount, dev);
        (void)hipFuncSetAttribute((const void*)mega, hipFuncAttributeMaxDynamicSharedMemorySize, MEGA_SMEM);
        (void)hipOccupancyMaxActiveBlocksPerMultiprocessor(&per_cu, (const void*)mega, 256, MEGA_SMEM);
        if (per_cu > 2) per_cu = 2;
        if (per_cu < 1) per_cu = 1;
        grid = cus * per_cu;
        grid &= ~7;
    }
    (void)hipMemsetAsync(ws + OFF_bar, 0, XCD_BAR_WORDS * 4, stream);

#if DBG
    (void)hipMemsetAsync(dbg, 0, 1024, stream);
    nk_mod<<<dim3(24, 4), 256, 0, stream>>>(p.c, p.w_mod, p.b_mod, nb.mod);
    nk_lnmod<<<NTOK, 256, 0, stream>>>(p.x, nb.mod, 0, 1024, nb.h);
    nk_gemm<<<dim3((IN_COLS + 63) / 64, NTOK / 64), 256, 0, stream>>>(nb.h, 1024, p.w_in, IN_COLS, nb.proj, IN_COLS, NTOK, IN_COLS, 1024);
    nk_flat<<<2040, 256, 0, stream>>>(nb.proj, C_KC, p.pos_k, nb.flat);
    nk_gemm<<<dim3(4, 32), 256, 0, stream>>>(nb.flat, 2048, p.w1_k, 256, nb.hidk, 256, 2040, 256, 2048);
    nk_silu<<<(2040 * 256 + 255) / 256, 256, 0, stream>>>(nb.hidk, 2040 * 256);
    nk_gemm<<<dim3(1, 32), 256, 0, stream>>>(nb.hidk, 256, p.w2_k, 64, nb.kc, 64, 2040, 64, 256);
    nk_flat<<<2040, 256, 0, stream>>>(nb.proj, C_VC, p.pos_v, nb.flat);
    nk_gemm<<<dim3(4, 32), 256, 0, stream>>>(nb.flat, 2048, p.w1_v, 256, nb.hidv, 256, 2040, 256, 2048);
    nk_silu<<<(2040 * 256 + 255) / 256, 256, 0, stream>>>(nb.hidv, 2040 * 256);
    nk_gemm<<<dim3(1, 32), 256, 0, stream>>>(nb.hidv, 256, p.w2_v, 64, nb.vc, 64, 2040, 64, 256);
    nk_nsa<<<NTOK, 256, 0, stream>>>(nb.proj, nb.kc, nb.vc, nb.mix);
    nk_gla<<<64, 256, 0, stream>>>(nb.proj, p.w_a2, p.b_a2, nb.ograw);
    nk_gla_norm<<<NTOK, 256, 0, stream>>>(nb.ograw, nb.proj, p.norm_w, nb.mix);
    nk_gemm<<<dim3(16, NTOK / 64), 256, 0, stream>>>(nb.mix, 1024, p.w_o, 1024, nb.y, 1024, NTOK, 1024, 1024);
    nk_resln<<<NTOK, 256, 0, stream>>>(p.x, nb.y, nb.mod, 2048, p.ln1_g, p.ln1_b, nb.x1);
    nk_lnmod<<<NTOK, 256, 0, stream>>>(nb.x1, nb.mod, 3072, 4096, nb.h);
    nk_gemm<<<dim3(4, NTOK / 64), 256, 0, stream>>>(nb.h, 1024, p.w_router, 256, nb.logits, 256, NTOK, 256, 1024);
    auto cmp = [&](int seam, size_t n) { dbg_compare<<<1024, 256, 0, stream>>>(seam, n, p, nb, dbg); };
#endif

#if SINGLE_LAUNCH
    p.ph_lo = 0; p.ph_hi = N_PHASES;
    mega<<<grid, 256, MEGA_SMEM, stream>>>(p);
#else
    for (int ph = 0; ph < N_PHASES; ++ph) {
        p.ph_lo = ph; p.ph_hi = ph + 1;
        mega<<<grid, 256, MEGA_SMEM, stream>>>(p);
#if DBG
        if (ph == 0) cmp(0, 4 * 6144);
        if (ph == 2) { cmp(1, (size_t)NTOK * PCOLS); cmp(2, (size_t)2 * BATCH * 128 * SEQ); cmp(3, (size_t)BATCH * 512 * SEQ + (size_t)NTOK * 40); }
        if (ph == 4) cmp(4, (size_t)2 * BATCH * NCMP * 128);
        if (ph == 5) { cmp(5, (size_t)NTOK * 512); cmp(6, (size_t)NTOK * 512); }
        if (ph == 7) cmp(7, (size_t)NTOK * 1024);
        if (ph == 8) cmp(8, (size_t)NTOK * 256);
#endif
    }
#endif
#ifdef PHPROF
    phase_prof_apply<<<1024, 256, 0, stream>>>((const unsigned long long*)(ws + OFF_counts + 1536), p.out, (size_t)NTOK * 1024, PHPROF);
#endif
#ifdef PROF
    prof_apply<<<1024, 256, 0, stream>>>((const unsigned long long*)(ws + OFF_counts + 1024), p.out, (size_t)NTOK * 1024, PROF);
#endif
#if DBG
    dbg_decide<<<1, 1, 0, stream>>>(dbg, 9, DBG_REPORT);
    dbg_apply<<<1024, 256, 0, stream>>>(dbg, p.out, (size_t)NTOK * 1024);
#endif
}
```
